# Optimizing an MI355X kernel written in HIP

```python
import math
import jax
import jax.numpy as jnp
from jax import lax
import numpy as np

D_MODEL = 1024
BATCH = 2
SEQ = 16384
DEPTH = 1
DEC_BATCH = 8
DEC_SEQ = 64
PAST_LEN = 1024

CHUNK = 64
ATTN_HEADS = 4
ATTN_HEAD_DIM = D_MODEL // 16
D_ATTN_QK = ATTN_HEADS * 2 * ATTN_HEAD_DIM
D_ATTN = ATTN_HEADS * 2 * ATTN_HEAD_DIM
REC_HEADS = 4
REC_KEY_DIM = D_MODEL // 8
REC_VAL_DIM = D_MODEL // 8
D_REC_K = REC_HEADS * REC_KEY_DIM
D_REC = REC_HEADS * REC_VAL_DIM
D_MIX = D_ATTN + D_REC
SPLIT_SIZES = (D_ATTN_QK, D_ATTN_QK, D_ATTN, D_ATTN, D_REC_K, D_REC_K, D_REC, D_REC)
PROJ_WIDTH = 2 * D_ATTN_QK + 2 * D_ATTN + 2 * D_REC_K + 2 * D_REC
Q_BLOCK = 128
EPS = 1e-6
ATTN_SCALE = ATTN_HEAD_DIM ** -0.5

kernel_name = 'hybrid_diffattn_hgrn2_streaming'


def _rmsnorm(x, g):
    xf = x.astype(jnp.float32)
    y = xf * lax.rsqrt(jnp.mean(xf * xf, axis=-1, keepdims=True) + EPS)
    return (y * g.astype(jnp.float32)).astype(x.dtype)


def _project(xn, w):
    u = xn @ w
    parts, start = [], 0
    for size in SPLIT_SIZES:
        parts.append(u[..., start:start + size])
        start += size
    return parts


def _attn_heads(qa, ka, va):
    b, s = qa.shape[:2]
    q = qa.reshape(b, s, ATTN_HEADS, 2, ATTN_HEAD_DIM)
    k = ka.reshape(b, s, ATTN_HEADS, 2, ATTN_HEAD_DIM)
    v = va.reshape(b, s, ATTN_HEADS, 2 * ATTN_HEAD_DIM)
    return q, k, v


def _diff_attend(q, k, v, q_pos, k_pos, lam, slopes):
    scores = jnp.einsum('bqhmd,bkhmd->bhmqk', q, k).astype(jnp.float32) * ATTN_SCALE
    dist = jnp.abs(q_pos[:, None] - k_pos[None, :]).astype(jnp.float32)
    bias = -slopes[:, None, None, None] * dist
    visible = (k_pos[None, :] // CHUNK) <= (q_pos[:, None] // CHUNK)
    scores = jnp.where(visible, scores + bias, -jnp.inf)
    p = jax.nn.softmax(scores, axis=-1)
    a = p[:, :, 0] - lam * p[:, :, 1]
    return jnp.einsum('bhqk,bkhe->bqhe', a.astype(v.dtype), v)


def _diff_attn_blocked(q, k, v, lam, slopes):
    b, s = q.shape[:2]
    nblk = s // Q_BLOCK
    qb = jnp.moveaxis(q.reshape(b, nblk, Q_BLOCK, ATTN_HEADS, 2, ATTN_HEAD_DIM), 1, 0)
    k_pos = jnp.arange(s, dtype=jnp.int32)
    q_pos = k_pos.reshape(nblk, Q_BLOCK)

    def one_block(args):
        q_blk, qp = args
        return _diff_attend(q_blk, k, v, qp, k_pos, lam, slopes)

    out = lax.map(one_block, (qb, q_pos))
    return jnp.moveaxis(out, 0, 1).reshape(b, s, ATTN_HEADS, 2 * ATTN_HEAD_DIM)


def _rec_inputs(qr, fr, ir, lb):
    b, s = qr.shape[:2]
    f32 = jnp.float32

    def heads(t, d):
        return jnp.swapaxes(t.reshape(b, s, REC_HEADS, d), 1, 2)

    fpre = fr.astype(f32)
    log_f = jnp.logaddexp(jnp.log(lb), jnp.log1p(-lb) + jax.nn.log_sigmoid(fpre))
    key = (1.0 - lb) * jax.nn.sigmoid(-fpre)
    q = jax.nn.silu(qr.astype(f32))
    return heads(q, REC_KEY_DIM), heads(key, REC_KEY_DIM), heads(log_f, REC_KEY_DIM), heads(ir.astype(f32), REC_VAL_DIM)


def _rec_chunk(state, q, k, log_f, v):
    c = q.shape[2]
    cum = jnp.cumsum(log_f, axis=2)
    causal = jnp.tril(jnp.ones((c, c), dtype=bool))
    diff = cum[:, :, :, None, :] - cum[:, :, None, :, :]
    decay = jnp.exp(jnp.where(causal[None, None, :, :, None], diff, -jnp.inf))
    scores = jnp.einsum('bhtsd,bhsd->bhts', decay * q[:, :, :, None, :], k)
    o = jnp.einsum('bhts,bhsv->bhtv', scores, v) + jnp.einsum('bhtd,bhdv->bhtv', q * jnp.exp(cum), state)
    last = cum[:, :, -1:, :]
    new_state = jnp.exp(last[:, :, 0, :, None]) * state + jnp.einsum('bhsd,bhsv->bhdv', k * jnp.exp(last - cum), v)
    return new_state, o


def _rec_scan(q, k, log_f, v):
    b, h, s, _ = q.shape
    nc = s // CHUNK

    def chunks(t):
        return jnp.moveaxis(t.reshape(b, h, nc, CHUNK, t.shape[-1]), 2, 0)

    s0 = jnp.zeros((b, h, REC_KEY_DIM, REC_VAL_DIM), jnp.float32)

    def step(state, inp):
        return _rec_chunk(state, *inp)

    s_fin, o = lax.scan(step, s0, (chunks(q), chunks(k), chunks(log_f), chunks(v)))
    return s_fin, jnp.moveaxis(o, 0, 2).reshape(b, h, s, REC_VAL_DIM)


def _merge(oa, orec, za, zr, sub_g, rec_g, lam_init, w_out_l):
    b, s = za.shape[:2]
    oa = _rmsnorm(oa, sub_g) * (1.0 - lam_init)
    orec = _rmsnorm(jnp.swapaxes(orec, 1, 2), rec_g)
    mix = jnp.concatenate([
        oa.reshape(b, s, D_ATTN) * jax.nn.silu(za),
        orec.reshape(b, s, D_REC).astype(za.dtype) * jax.nn.silu(zr)], axis=-1)
    return mix @ w_out_l


def setup_inputs(seed: int = 0) -> dict:
    key = jax.random.key(seed)
    ks = jax.random.split(key, 13)
    nrm = jax.random.normal
    f32 = jnp.float32
    return {
        'x_prompt': nrm(ks[0], (BATCH, SEQ, D_MODEL), f32),
        'x_sample': nrm(ks[1], (DEC_BATCH, DEC_SEQ, D_MODEL), f32),
        'cache_k': nrm(ks[2], (DEPTH, DEC_BATCH, PAST_LEN, ATTN_HEADS, 2 * ATTN_HEAD_DIM), f32),
        'cache_v': nrm(ks[3], (DEPTH, DEC_BATCH, PAST_LEN, ATTN_HEADS, 2 * ATTN_HEAD_DIM), f32),
        'state_h': 0.5 * nrm(ks[4], (DEPTH, DEC_BATCH, REC_HEADS, REC_KEY_DIM, REC_VAL_DIM), f32),
        'norm_g': 1.0 + 0.02 * nrm(ks[5], (DEPTH, D_MODEL), f32),
        'w_in': nrm(ks[6], (DEPTH, D_MODEL, PROJ_WIDTH), f32) * D_MODEL ** -0.5,
        'lambda_qk': 0.1 * nrm(ks[7], (DEPTH, 4, ATTN_HEAD_DIM), f32),
        'subln_g': 1.0 + 0.02 * nrm(ks[8], (DEPTH, 2 * ATTN_HEAD_DIM), f32),
        'rec_lb': 0.1 * nrm(ks[9], (DEPTH + 1, D_REC_K), f32),
        'rec_norm_g': 1.0 + 0.02 * nrm(ks[10], (DEPTH, REC_VAL_DIM), f32),
        'w_out': nrm(ks[11], (DEPTH, D_MIX, D_MODEL), f32) * D_MIX ** -0.5,
        'final_g': 1.0 + 0.02 * nrm(ks[12], (D_MODEL,), f32),
    }


def reference(x_prompt, x_sample, cache_k, cache_v, state_h, norm_g, w_in, lambda_qk, subln_g, rec_lb, rec_norm_g, w_out, final_g):
    f32 = jnp.float32
    slopes = jnp.exp2(-8.0 * jnp.arange(1, ATTN_HEADS + 1, dtype=f32) / ATTN_HEADS)
    lb_all = jnp.cumsum(jax.nn.softmax(rec_lb.astype(f32), axis=0), axis=0)
    bp, sp = x_prompt.shape[:2]
    bs, ts = x_sample.shape[:2]
    past = cache_k.shape[2]
    hp, hs = x_prompt, x_sample
    kp_l, vp_l, sp_l, ks_l, vs_l, ss_l = [], [], [], [], [], []
    for l in range(DEPTH):
        lam_init = 0.8 - 0.6 * math.exp(-0.3 * l)
        lq = lambda_qk[l].astype(f32)
        lam = jnp.exp(jnp.sum(lq[0] * lq[1])) - jnp.exp(jnp.sum(lq[2] * lq[3])) + lam_init
        lb = lb_all[l]

        qa, ka, va, za, qr, fr, ir, zr = _project(_rmsnorm(hp, norm_g[l]), w_in[l])
        q, k, v = _attn_heads(qa, ka, va)
        oa = _diff_attn_blocked(q, k, v, lam, slopes)
        rq, rk, rlf, rv = _rec_inputs(qr, fr, ir, lb)
        h_p, orec = _rec_scan(rq, rk, rlf, rv)
        hp = hp + _merge(oa, orec, za, zr, subln_g[l], rec_norm_g[l], lam_init, w_out[l])
        kp_l.append(k.reshape(bp, sp, ATTN_HEADS, 2 * ATTN_HEAD_DIM))
        vp_l.append(v)
        sp_l.append(h_p)

        qa, ka, va, za, qr, fr, ir, zr = _project(_rmsnorm(hs, norm_g[l]), w_in[l])
        q, k, v = _attn_heads(qa, ka, va)
        k_all = jnp.concatenate([cache_k[l].reshape(bs, past, ATTN_HEADS, 2, ATTN_HEAD_DIM).astype(k.dtype), k], axis=1)
        v_all = jnp.concatenate([cache_v[l].astype(v.dtype), v], axis=1)
        q_pos = past + jnp.arange(ts, dtype=jnp.int32)
        k_pos = jnp.arange(past + ts, dtype=jnp.int32)
        oa = _diff_attend(q, k_all, v_all, q_pos, k_pos, lam, slopes)
        rq, rk, rlf, rv = _rec_inputs(qr, fr, ir, lb)
        h_s, orec = _rec_chunk(state_h[l].astype(f32), rq, rk, rlf, rv)
        hs = hs + _merge(oa, orec, za, zr, subln_g[l], rec_norm_g[l], lam_init, w_out[l])
        ks_l.append(k.reshape(bs, ts, ATTN_HEADS, 2 * ATTN_HEAD_DIM))
        vs_l.append(v)
        ss_l.append(h_s)

    y_prompt = _rmsnorm(hp, final_g)
    y_sample = _rmsnorm(hs, final_g)
    new_k_prompt = jnp.stack(kp_l, axis=0)
    new_v_prompt = jnp.stack(vp_l, axis=0)
    new_h_prompt = jnp.stack(sp_l, axis=0)
    new_k_sample = jnp.stack(ks_l, axis=0)
    new_v_sample = jnp.stack(vs_l, axis=0)
    new_h_sample = jnp.stack(ss_l, axis=0)
    return (y_prompt, y_sample, new_k_prompt, new_v_prompt, new_h_prompt, new_k_sample, new_v_sample, new_h_sample)
```

```cpp
#include <hip/hip_runtime.h>
#include <hip/hip_cooperative_groups.h>
#include <cstdio>
namespace cg = cooperative_groups;

#define DI __device__ __forceinline__
typedef unsigned short u16;
using bf16x8 = __attribute__((ext_vector_type(8))) short;
using s16x4  = __attribute__((ext_vector_type(4))) short;
using f32x16 = __attribute__((ext_vector_type(16))) float;
using f32x4  = __attribute__((ext_vector_type(4))) float;
using f32x2  = __attribute__((ext_vector_type(2))) float;
using u32x4  = __attribute__((ext_vector_type(4))) unsigned;
using u32x2  = __attribute__((ext_vector_type(2))) unsigned;
typedef __bf16 bf2_t __attribute__((ext_vector_type(2)));

#define MFMA(a, b, c) __builtin_amdgcn_mfma_f32_32x32x16_bf16((a), (b), (c), 0, 0, 0)

static constexpr int NTOK = 33280;
static constexpr int NPTOK = 32768;
static constexpr int KVROWS = 32768 + 8 * 1088;
static constexpr int NITEM = 2080;
static constexpr size_t OFF_Y = 0;
static constexpr size_t OFF_NKP = 34078720;
static constexpr size_t OFF_NVP = 50855936;
static constexpr size_t OFF_NHP = 67633152;
static constexpr size_t OFF_NKS = 67764224;
static constexpr size_t OFF_NVS = 68026368;
static constexpr size_t OFF_NHS = 68288512;

struct Params {
  const float *x_prompt, *x_sample, *cache_k, *cache_v, *state_h, *norm_g, *w_in, *lambda_qk, *subln_g, *rec_lb, *rec_norm_g, *w_out, *final_g;
  float* out;
  u16 *WinT, *WoutT, *Xn, *Qb, *Kall, *Vall, *Za, *Qr, *Ir, *Zr, *Mix, *SbufT;
  float *Fr, *Abuf;
  int phase_lo, phase_hi;
};

DI unsigned pack2(float a, float b) { f32x2 v = {a, b}; bf2_t r = __builtin_convertvector(v, bf2_t); return __builtin_bit_cast(unsigned, r); }
DI u16 f2bf(float a) { return (u16)(pack2(a, 0.f) & 0xffffu); }
DI float bflo(unsigned u) { return __uint_as_float(u << 16); }
DI float bfhi(unsigned u) { return __uint_as_float(u & 0xffff0000u); }
DI int crow(int e, int h) { return (e & 3) + 8 * (e >> 2) + 4 * h; }
DI float wave_sum(float v) {
#pragma unroll
  for (int o = 32; o >= 1; o >>= 1) v += __shfl_xor(v, o);
  return v;
}
DI float silu_f(float v) { return v / (1.f + __expf(-v)); }
DI s16x4 tr_read(const char* p) {
  return __builtin_amdgcn_ds_read_tr16_b64_v4i16((__attribute__((address_space(3))) s16x4*)(p));
}
DI bf16x8 tr_frag(const char* p0, int stride4) {
  s16x4 lo = tr_read(p0), hi = tr_read(p0 + stride4);
  return __builtin_shufflevector(lo, hi, 0, 1, 2, 3, 4, 5, 6, 7);
}
DI bf16x8 pack8(const f32x16& x, int s) {
  u32x4 p;
  p[0] = pack2(x[8 * s + 0], x[8 * s + 1]);
  p[1] = pack2(x[8 * s + 2], x[8 * s + 3]);
  p[2] = pack2(x[8 * s + 4], x[8 * s + 5]);
  p[3] = pack2(x[8 * s + 6], x[8 * s + 7]);
  return __builtin_bit_cast(bf16x8, p);
}
DI f32x16 zero16() { f32x16 z; for (int i = 0; i < 16; ++i) z[i] = 0.f; return z; }

DI void phase0(const Params& p, char* smem) {
  const int tid = threadIdx.x, lane = tid & 63, w = tid >> 6;
  constexpr int NT_W1 = 16 * 64, NT_W2 = 16 * 16, NT_ROW = NTOK / 4, NT_CACHE = 4096;
  constexpr int total = NT_W1 + NT_W2 + NT_ROW + NT_CACHE;
  float (*tile)[65] = (float (*)[65])smem;
  for (int it = blockIdx.x; it < total; it += gridDim.x) {
    if (it < NT_W1 + NT_W2) {
      const float* src; u16* dst; int N, kt, nt;
      if (it < NT_W1) { src = p.w_in; dst = p.WinT; N = 4096; kt = it >> 6; nt = it & 63; }
      else { int j = it - NT_W1; src = p.w_out; dst = p.WoutT; N = 1024; kt = j >> 4; nt = j & 15; }
      const int c = tid & 63, r0 = tid >> 6;
      for (int i = 0; i < 16; ++i) { int r = r0 + 4 * i; tile[r][c] = src[(size_t)(kt * 64 + r) * N + nt * 64 + c]; }
      __syncthreads();
      for (int i = 0; i < 16; ++i) { int r = r0 + 4 * i; dst[(size_t)(nt * 64 + r) * 1024 + kt * 64 + c] = f2bf(tile[c][r]); }
      __syncthreads();
    } else if (it < NT_W1 + NT_W2 + NT_ROW) {
      const int row = (it - NT_W1 - NT_W2) * 4 + w;
      const float* src = row < NPTOK ? p.x_prompt + (size_t)row * 1024 : p.x_sample + (size_t)(row - NPTOK) * 1024;
      f32x4 v[4]; float ss = 0.f;
#pragma unroll
      for (int i = 0; i < 4; ++i) { v[i] = *(const f32x4*)(src + i * 256 + lane * 4); ss += v[i][0] * v[i][0] + v[i][1] * v[i][1] + v[i][2] * v[i][2] + v[i][3] * v[i][3]; }
      ss = wave_sum(ss);
      const float sc = rsqrtf(ss * (1.f / 1024.f) + 1e-6f);
#pragma unroll
      for (int i = 0; i < 4; ++i) {
        f32x4 g = *(const f32x4*)(p.norm_g + i * 256 + lane * 4);
        u32x2 o; o[0] = pack2(v[i][0] * sc * g[0], v[i][1] * sc * g[1]); o[1] = pack2(v[i][2] * sc * g[2], v[i][3] * sc * g[3]);
        *(u32x2*)(p.Xn + (size_t)row * 1024 + i * 256 + lane * 4) = o;
      }
    } else {
      const int task = (it - NT_W1 - NT_W2 - NT_ROW) * 4 + w;
      const int which = task >> 13, rr = task & 8191;
      const float* src = (which ? p.cache_v : p.cache_k) + (size_t)rr * 512 + lane * 8;
      u16* dst = (which ? p.Vall : p.Kall) + (size_t)(NPTOK + (rr >> 10) * 1088 + (rr & 1023)) * 512 + lane * 8;
      f32x4 a = *(const f32x4*)src, b = *(const f32x4*)(src + 4);
      u32x4 o; o[0] = pack2(a[0], a[1]); o[1] = pack2(a[2], a[3]); o[2] = pack2(b[0], b[1]); o[3] = pack2(b[2], b[3]);
      *(u32x4*)dst = o;
    }
  }
}

DI void gemm128(const u16* __restrict__ A, const u16* __restrict__ BT, int K, int m0, int n0, char* smem, f32x16 (&acc)[2][2]) {
  const int tid = threadIdx.x, lane = tid & 63, w = tid >> 6, r = lane & 31, h = lane >> 5;
  const int wm = w >> 1, wn = w & 1;
#pragma unroll
  for (int i = 0; i < 2; ++i)
#pragma unroll
    for (int j = 0; j < 2; ++j) acc[i][j] = zero16();
  u32x4 ra[4], rb[4];
  const int KT = K >> 6;
  const int lrow = tid >> 3, lcc = tid & 7;
  const u16* ap = A + (size_t)(m0 + lrow) * K + lcc * 8;
  const u16* bp = BT + (size_t)(n0 + lrow) * K + lcc * 8;
  char* wbase = smem + lrow * 144 + lcc * 16;
#pragma unroll
  for (int i = 0; i < 4; ++i) { ra[i] = *(const u32x4*)(ap + (size_t)i * 32 * K); rb[i] = *(const u32x4*)(bp + (size_t)i * 32 * K); }
#pragma unroll
  for (int i = 0; i < 4; ++i) { *(u32x4*)(wbase + i * 32 * 144) = ra[i]; *(u32x4*)(wbase + 36864 + i * 32 * 144) = rb[i]; }
  __syncthreads();
  for (int kt = 0; kt < KT; ++kt) {
    if (kt + 1 < KT) {
#pragma unroll
      for (int i = 0; i < 4; ++i) { ra[i] = *(const u32x4*)(ap + (size_t)i * 32 * K + (kt + 1) * 64); rb[i] = *(const u32x4*)(bp + (size_t)i * 32 * K + (kt + 1) * 64); }
    }
    const char* as = smem + (kt & 1) * 18432 + (wm * 64 + r) * 144 + h * 16;
    const char* bs = smem + 36864 + (kt & 1) * 18432 + (wn * 64 + r) * 144 + h * 16;
#pragma unroll
    for (int s = 0; s < 4; ++s) {
      bf16x8 a0 = *(const bf16x8*)(as + s * 32), a1 = *(const bf16x8*)(as + 32 * 144 + s * 32);
      bf16x8 b0 = *(const bf16x8*)(bs + s * 32), b1 = *(const bf16x8*)(bs + 32 * 144 + s * 32);
      acc[0][0] = MFMA(a0, b0, acc[0][0]); acc[0][1] = MFMA(a0, b1, acc[0][1]);
      acc[1][0] = MFMA(a1, b0, acc[1][0]); acc[1][1] = MFMA(a1, b1, acc[1][1]);
    }
    if (kt + 1 < KT) {
      char* wb = wbase + ((kt + 1) & 1) * 18432;
#pragma unroll
      for (int i = 0; i < 4; ++i) { *(u32x4*)(wb + i * 32 * 144) = ra[i]; *(u32x4*)(wb + 36864 + i * 32 * 144) = rb[i]; }
    }
    __syncthreads();
  }
}

DI void phase1(const Params& p, char* smem) {
  const int tid = threadIdx.x, lane = tid & 63, w = tid >> 6, r = lane & 31, h = lane >> 5;
  const int wm = w >> 1, wn = w & 1;
  constexpr int MT = NTOK / 128, NT = 32;
  for (int it = blockIdx.x; it < MT * NT; it += gridDim.x) {
    const int mt = it >> 5, nt = it & 31;
    const int m0 = mt * 128, n0 = nt * 128;
    f32x16 acc[2][2];
    gemm128(p.Xn, p.WinT, 1024, m0, n0, smem, acc);
    const int sec = n0 >> 9;
    const bool samp = m0 >= NPTOK;
#pragma unroll
    for (int i = 0; i < 2; ++i)
#pragma unroll
      for (int j = 0; j < 2; ++j) {
        const int cs = (n0 & 511) + wn * 64 + j * 32 + r;
#pragma unroll
        for (int e = 0; e < 16; ++e) {
          const int t = m0 + wm * 64 + i * 32 + crow(e, h);
          const float v = acc[i][j][e];
          const size_t o512 = (size_t)t * 512 + cs;
          if (sec == 0) { p.Qb[o512] = f2bf(v * (0.125f * 1.44269504089f)); }
          else if (sec == 1 || sec == 2) {
            size_t kvr; float* od;
            if (!samp) { kvr = t; od = p.out + (sec == 1 ? OFF_NKP : OFF_NVP) + o512; }
            else { const int ts = t - NPTOK; kvr = NPTOK + (ts >> 6) * 1088 + 1024 + (ts & 63); od = p.out + (sec == 1 ? OFF_NKS : OFF_NVS) + (size_t)ts * 512 + cs; }
            *od = v;
            (sec == 1 ? p.Kall : p.Vall)[kvr * 512 + cs] = f2bf(v);
          }
          else if (sec == 3) { p.Za[o512] = f2bf(silu_f(v)); }
          else if (sec == 4) { p.Qr[o512] = f2bf(silu_f(v)); }
          else if (sec == 5) { p.Fr[o512] = v; }
          else if (sec == 6) { p.Ir[o512] = f2bf(v); }
          else { p.Zr[o512] = f2bf(silu_f(v)); }
        }
      }
  }
}

DI void rec_pre(const Params& p, int I, float* totS, float (&cum)[32], float (&key)[32], float& lastv) {
  const int tid = threadIdx.x, d = tid & 127, half = tid >> 7;
  const int hd = I & 3, t0 = (I >> 2) * 64;
  const float r0 = p.rec_lb[hd * 128 + d], r1 = p.rec_lb[512 + hd * 128 + d];
  const float lb = 1.f / (1.f + __expf(r1 - r0));
  const float* fp = p.Fr + (size_t)(t0 + half * 32) * 512 + hd * 128 + d;
  float run = 0.f;
#pragma unroll
  for (int i = 0; i < 32; ++i) {
    float x = fp[(size_t)i * 512];
    x = fminf(fmaxf(x, -30.f), 30.f);
    const float e = __expf(-x), sg = 1.f / (1.f + e);
    run += __logf(lb + (1.f - lb) * sg);
    cum[i] = run; key[i] = (1.f - lb) * e * sg;
  }
  totS[tid] = run;
  __syncthreads();
  const float tot0 = totS[d], tot1 = totS[128 + d];
  if (half) {
#pragma unroll
    for (int i = 0; i < 32; ++i) cum[i] += tot0;
  }
  lastv = tot0 + tot1;
}

DI void phase2(const Params& p, char* smem, float* BbufT) {
  const int tid = threadIdx.x, lane = tid & 63, w = tid >> 6, r = lane & 31, h = lane >> 5;
  const int q = (lane & 15) >> 2, pp = lane & 3, blk = (lane >> 4) & 1;
  const int d = tid & 127, half = tid >> 7;
  char* KdI = smem; char* VrI = smem + 17408; float* totS = (float*)(smem + 60000);
  for (int I = blockIdx.x; I < NITEM; I += gridDim.x) {
    const int hd = I & 3, t0 = (I >> 2) * 64;
    float cum[32], key[32], lastv;
    rec_pre(p, I, totS, cum, key, lastv);
#pragma unroll
    for (int i = 0; i < 32; ++i) {
      const int t = half * 32 + i;
      *(u16*)(KdI + t * 272 + d * 2) = f2bf(key[i] * __expf(lastv - cum[i]));
    }
#pragma unroll
    for (int i = 0; i < 4; ++i) {
      const int ch = tid + 256 * i, row = ch >> 4, cc = ch & 15;
      *(u32x4*)(VrI + row * 272 + cc * 16) = *(const u32x4*)(p.Ir + (size_t)(t0 + row) * 512 + hd * 128 + cc * 8);
    }
    if (half) p.Abuf[I * 128 + d] = __expf(lastv);
    __syncthreads();
    f32x16 acc[4];
#pragma unroll
    for (int ct = 0; ct < 4; ++ct) acc[ct] = zero16();
#pragma unroll
    for (int ks = 0; ks < 4; ++ks) {
      const int rowoff = (16 * ks + 8 * h + q) * 272 + 32 * blk + 8 * pp;
      bf16x8 a = tr_frag(VrI + rowoff + 64 * w, 4 * 272);
#pragma unroll
      for (int ct = 0; ct < 4; ++ct) {
        bf16x8 b = tr_frag(KdI + rowoff + 64 * ct, 4 * 272);
        acc[ct] = MFMA(a, b, acc[ct]);
      }
    }
    float* ob = BbufT + (size_t)I * 16384;
#pragma unroll
    for (int ct = 0; ct < 4; ++ct)
#pragma unroll
      for (int e = 0; e < 16; ++e) ob[(32 * w + crow(e, h)) * 128 + 32 * ct + r] = acc[ct][e];
    __syncthreads();
  }
}

DI void phase3(const Params& p, const float* BbufT) {
  const int tid = threadIdx.x;
  for (int it = blockIdx.x; it < 256 + 1024; it += gridDim.x) {
    if (it < 256) {
      const int bh = it >> 5, b = bh >> 2, hd = bh & 3;
      const int e2 = (it & 31) * 256 + tid, v = e2 >> 6, d2 = (e2 & 63) * 2;
      float sx = 0.f, sy = 0.f;
      const size_t eo = (size_t)v * 128 + d2;
#pragma unroll 8
      for (int c = 0; c < 256; ++c) {
        const int I = (b * 256 + c) * 4 + hd;
        const f32x2 a = *(const f32x2*)(p.Abuf + I * 128 + d2);
        const f32x2 bv = *(const f32x2*)(BbufT + (size_t)I * 16384 + eo);
        *(unsigned*)(p.SbufT + (size_t)I * 16384 + eo) = pack2(sx, sy);
        sx = a[0] * sx + bv[0]; sy = a[1] * sy + bv[1];
      }
      float* oh = p.out + OFF_NHP + (size_t)(b * 4 + hd) * 16384;
      oh[d2 * 128 + v] = sx; oh[(d2 + 1) * 128 + v] = sy;
    } else {
      const int j = it - 256;
      const int sh = j >> 5, bs = sh >> 2, hd = sh & 3;
      const int e2 = (j & 31) * 256 + tid, v = e2 >> 6, d2 = (e2 & 63) * 2;
      const int I = (512 + bs) * 4 + hd;
      const float* sh0 = p.state_h + (size_t)(bs * 4 + hd) * 16384;
      float sx = sh0[d2 * 128 + v], sy = sh0[(d2 + 1) * 128 + v];
      const size_t eo = (size_t)v * 128 + d2;
      const f32x2 a = *(const f32x2*)(p.Abuf + I * 128 + d2);
      const f32x2 bv = *(const f32x2*)(BbufT + (size_t)I * 16384 + eo);
      *(unsigned*)(p.SbufT + (size_t)I * 16384 + eo) = pack2(sx, sy);
      sx = a[0] * sx + bv[0]; sy = a[1] * sy + bv[1];
      float* oh = p.out + OFF_NHS + (size_t)(bs * 4 + hd) * 16384;
      oh[d2 * 128 + v] = sx; oh[(d2 + 1) * 128 + v] = sy;
    }
  }
}

DI void r3_item(const Params& p, char* smem, int I) {
  const int tid = threadIdx.x, lane = tid & 63, w = tid >> 6, r = lane & 31, h = lane >> 5;
  const int q = (lane & 15) >> 2, pp = lane & 3, blk = (lane >> 4) & 1;
  const int d = tid & 127, half = tid >> 7;
  char* QdI = smem; char* KdI = smem + 17408; char* VrI = smem + 34816;
  float* totS = (float*)(smem + 60000); float* ssS = (float*)(smem + 62048);
  const int hd = I & 3, t0 = (I >> 2) * 64;
  {
    float cum[32], key[32], lastv;
    rec_pre(p, I, totS, cum, key, lastv);
    const u16* qp = p.Qr + (size_t)(t0 + half * 32) * 512 + hd * 128 + d;
#pragma unroll
    for (int i = 0; i < 32; ++i) {
      const int t = half * 32 + i;
      const float qv = bflo(qp[(size_t)i * 512]);
      *(u16*)(QdI + t * 272 + d * 2) = f2bf(qv * __expf(cum[i]));
      *(u16*)(KdI + t * 272 + d * 2) = f2bf(key[i] * __expf(-cum[i]));
    }
  }
#pragma unroll
  for (int i = 0; i < 4; ++i) {
    const int ch = tid + 256 * i, row = ch >> 4, cc = ch & 15;
    *(u32x4*)(VrI + row * 272 + cc * 16) = *(const u32x4*)(p.Ir + (size_t)(t0 + row) * 512 + hd * 128 + cc * 8);
  }
  __syncthreads();
  const int tt = w & 1, vh = w >> 1;
  bf16x8 qf[8];
#pragma unroll
  for (int ks = 0; ks < 8; ++ks) qf[ks] = *(const bf16x8*)(QdI + (32 * tt + r) * 272 + ks * 32 + h * 16);
  f32x16 sc[2]; sc[0] = zero16(); sc[1] = zero16();
#pragma unroll
  for (int ks = 0; ks < 8; ++ks) {
    bf16x8 a0 = *(const bf16x8*)(KdI + r * 272 + ks * 32 + h * 16);
    sc[0] = MFMA(a0, qf[ks], sc[0]);
  }
  if (tt == 1) {
#pragma unroll
    for (int ks = 0; ks < 8; ++ks) {
      bf16x8 a1 = *(const bf16x8*)(KdI + (32 + r) * 272 + ks * 32 + h * 16);
      sc[1] = MFMA(a1, qf[ks], sc[1]);
    }
  }
#pragma unroll
  for (int e = 0; e < 16; ++e) {
    const bool keep = crow(e, h) <= r;
    if (tt == 0) { if (!keep) sc[0][e] = 0.f; }
    else { if (!keep) sc[1][e] = 0.f; }
  }
  bf16x8 pf[4];
  pf[0] = pack8(sc[0], 0); pf[1] = pack8(sc[0], 1); pf[2] = pack8(sc[1], 0); pf[3] = pack8(sc[1], 1);
  f32x16 o[2]; o[0] = zero16(); o[1] = zero16();
  const u16* sp = p.SbufT + (size_t)I * 16384;
#pragma unroll
  for (int vi = 0; vi < 2; ++vi) {
    const int vt = 2 * vh + vi;
#pragma unroll
    for (int k4 = 0; k4 < 4; ++k4) {
      if (k4 < 2 || tt == 1) {
        bf16x8 a = tr_frag(VrI + (16 * k4 + 4 * h + q) * 272 + (32 * vt + 16 * blk) * 2 + 8 * pp, 8 * 272);
        o[vi] = MFMA(a, pf[k4], o[vi]);
      }
    }
#pragma unroll
    for (int ks = 0; ks < 8; ++ks) {
      bf16x8 a = *(const bf16x8*)(sp + (size_t)(32 * vt + r) * 128 + ks * 16 + h * 8);
      o[vi] = MFMA(a, qf[ks], o[vi]);
    }
  }
  float ss = 0.f;
#pragma unroll
  for (int vi = 0; vi < 2; ++vi)
#pragma unroll
    for (int e = 0; e < 16; ++e) ss += o[vi][e] * o[vi][e];
  ss += __shfl_xor(ss, 32);
  if (h == 0) ssS[w * 32 + r] = ss;
  __syncthreads();
  const float tot = ssS[tt * 32 + r] + ssS[(tt + 2) * 32 + r];
  const float rs = rsqrtf(tot * (1.f / 128.f) + 1e-6f);
  const int tok = t0 + 32 * tt + r;
#pragma unroll
  for (int vi = 0; vi < 2; ++vi)
#pragma unroll
    for (int g = 0; g < 4; ++g) {
      const int v = 32 * (2 * vh + vi) + 8 * g + 4 * h;
      const f32x4 gg = *(const f32x4*)(p.rec_norm_g + v);
      const u32x2 z = *(const u32x2*)(p.Zr + (size_t)tok * 512 + hd * 128 + v);
      u32x2 ov;
      ov[0] = pack2(o[vi][4 * g + 0] * rs * gg[0] * bflo(z[0]), o[vi][4 * g + 1] * rs * gg[1] * bfhi(z[0]));
      ov[1] = pack2(o[vi][4 * g + 2] * rs * gg[2] * bflo(z[1]), o[vi][4 * g + 3] * rs * gg[3] * bfhi(z[1]));
      *(u32x2*)(p.Mix + (size_t)tok * 1024 + 512 + hd * 128 + v) = ov;
    }
  __syncthreads();
}

DI void attn_item(const Params& p, char* smem, int tq0, int qpos0, int kvbase, int ntb, int ntw, int hd, float lam, float* stash) {
  const int tid = threadIdx.x, lane = tid & 63, w = tid >> 6, r = lane & 31, h2 = lane >> 5;
  const int q = (lane & 15) >> 2, pp = lane & 3, blk = (lane >> 4) & 1;
  const float sl2 = exp2f(-2.f * (float)(hd + 1)) * 1.44269504089f;
  const int qtok = tq0 + 32 * w + r;
  const float qposf = (float)(qpos0 + 32 * w + r);
  const int krow_l = tid >> 3, kcc = tid & 7;
  const int vrow_l = tid >> 4, vcc = tid & 15;
#pragma unroll 1
  for (int m = 0; m < 2; ++m) {
    bf16x8 qf[4];
    if (ntw > 0) {
#pragma unroll
      for (int s = 0; s < 4; ++s) qf[s] = *(const bf16x8*)(p.Qb + (size_t)qtok * 512 + hd * 128 + m * 64 + 16 * s + 8 * h2);
    } else {
#pragma unroll
      for (int s = 0; s < 4; ++s) qf[s] = (bf16x8){0, 0, 0, 0, 0, 0, 0, 0};
    }
    f32x16 O[4];
#pragma unroll
    for (int vt = 0; vt < 4; ++vt) O[vt] = zero16();
    float mrun = -1e30f, lsum = 0.f;
    u32x4 rk[2], rv[4];
    const u16* kp = p.Kall + (size_t)(kvbase + krow_l) * 512 + hd * 128 + m * 64 + kcc * 8;
    const u16* vp = p.Vall + (size_t)(kvbase + vrow_l) * 512 + hd * 128 + vcc * 8;
    char* kw = smem + krow_l * 144 + kcc * 16;
    char* vw = smem + 9216 + vrow_l * 272 + vcc * 16;
#pragma unroll
    for (int i = 0; i < 2; ++i) rk[i] = *(const u32x4*)(kp + (size_t)i * 32 * 512);
#pragma unroll
    for (int i = 0; i < 4; ++i) rv[i] = *(const u32x4*)(vp + (size_t)i * 16 * 512);
#pragma unroll
    for (int i = 0; i < 2; ++i) *(u32x4*)(kw + i * 32 * 144) = rk[i];
#pragma unroll
    for (int i = 0; i < 4; ++i) *(u32x4*)(vw + i * 16 * 272) = rv[i];
    __syncthreads();
    for (int kt = 0; kt < ntb; ++kt) {
      if (kt + 1 < ntb) {
        const size_t go = (size_t)(kt + 1) * 64 * 512;
#pragma unroll
        for (int i = 0; i < 2; ++i) rk[i] = *(const u32x4*)(kp + go + (size_t)i * 32 * 512);
#pragma unroll
        for (int i = 0; i < 4; ++i) rv[i] = *(const u32x4*)(vp + go + (size_t)i * 16 * 512);
      }
      if (kt < ntw) {
        const char* ks = smem + (kt & 1) * 26624;
        const char* vs = ks + 9216;
        f32x16 S[2];
#pragma unroll
        for (int st = 0; st < 2; ++st) {
          S[st] = zero16();
#pragma unroll
          for (int s = 0; s < 4; ++s) {
            bf16x8 a = *(const bf16x8*)(ks + (32 * st + r) * 144 + s * 32 + h2 * 16);
            S[st] = MFMA(a, qf[s], S[st]);
          }
        }
        __builtin_amdgcn_sched_barrier(0);
        const float qrel = qposf - (float)(kt * 64 + 4 * h2);
        float mx = -1e30f;
#pragma unroll
        for (int st = 0; st < 2; ++st)
#pragma unroll
          for (int e = 0; e < 16; ++e) {
            const float cst = (float)(32 * st + (e & 3) + 8 * (e >> 2));
            const float sv = fmaf(-sl2, fabsf(qrel - cst), S[st][e]);
            S[st][e] = sv; mx = fmaxf(mx, sv);
          }
        mx = fmaxf(mx, __shfl_xor(mx, 32));
        const float mnew = fmaxf(mrun, mx);
        const float alpha = __builtin_amdgcn_exp2f(mrun - mnew);
        mrun = mnew;
        float rs = 0.f;
#pragma unroll
        for (int st = 0; st < 2; ++st)
#pragma unroll
          for (int e = 0; e < 16; ++e) { const float pv = __builtin_amdgcn_exp2f(S[st][e] - mnew); S[st][e] = pv; rs += pv; }
        lsum = lsum * alpha + rs;
#pragma unroll
        for (int vt = 0; vt < 4; ++vt)
#pragma unroll
          for (int e = 0; e < 16; ++e) O[vt][e] *= alpha;
        bf16x8 pf[4];
        pf[0] = pack8(S[0], 0); pf[1] = pack8(S[0], 1); pf[2] = pack8(S[1], 0); pf[3] = pack8(S[1], 1);
#pragma unroll
        for (int k4 = 0; k4 < 4; ++k4) {
          const char* vb = vs + (16 * k4 + 4 * h2 + q) * 272 + 32 * blk + 8 * pp;
#pragma unroll
          for (int vt = 0; vt < 4; ++vt) {
            bf16x8 a = tr_frag(vb + 64 * vt, 8 * 272);
            O[vt] = MFMA(a, pf[k4], O[vt]);
          }
          __builtin_amdgcn_sched_barrier(0);
        }
      }
      if (kt + 1 < ntb) {
        const int bo = ((kt + 1) & 1) * 26624;
#pragma unroll
        for (int i = 0; i < 2; ++i) *(u32x4*)(kw + bo + i * 32 * 144) = rk[i];
#pragma unroll
        for (int i = 0; i < 4; ++i) *(u32x4*)(vw + bo + i * 16 * 272) = rv[i];
      }
      __syncthreads();
    }
    const float lt = lsum + __shfl_xor(lsum, 32);
    const float inv = ntw > 0 ? 1.f / lt : 0.f;
    if (m == 0) {
#pragma unroll
      for (int vt = 0; vt < 4; ++vt)
#pragma unroll
        for (int g = 0; g < 4; ++g) {
          f32x4 t4; t4[0] = O[vt][4 * g] * inv; t4[1] = O[vt][4 * g + 1] * inv; t4[2] = O[vt][4 * g + 2] * inv; t4[3] = O[vt][4 * g + 3] * inv;
          *(f32x4*)(stash + tid * 64 + vt * 16 + g * 4) = t4;
        }
    } else {
      float ss = 0.f;
#pragma unroll
      for (int vt = 0; vt < 4; ++vt)
#pragma unroll
        for (int g = 0; g < 4; ++g) {
          const f32x4 t4 = *(const f32x4*)(stash + tid * 64 + vt * 16 + g * 4);
#pragma unroll
          for (int i = 0; i < 4; ++i) { const float ov = t4[i] - lam * O[vt][4 * g + i] * inv; O[vt][4 * g + i] = ov; ss += ov * ov; }
        }
      ss += __shfl_xor(ss, 32);
      const float rsn = rsqrtf(ss * (1.f / 128.f) + 1e-6f) * 0.8f;
      if (ntw > 0) {
#pragma unroll
        for (int vt = 0; vt < 4; ++vt)
#pragma unroll
          for (int g = 0; g < 4; ++g) {
            const int v = 32 * vt + 8 * g + 4 * h2;
            const f32x4 gg = *(const f32x4*)(p.subln_g + v);
            const u32x2 z = *(const u32x2*)(p.Za + (size_t)qtok * 512 + hd * 128 + v);
            u32x2 ov;
            ov[0] = pack2(O[vt][4 * g + 0] * rsn * gg[0] * bflo(z[0]), O[vt][4 * g + 1] * rsn * gg[1] * bfhi(z[0]));
            ov[1] = pack2(O[vt][4 * g + 2] * rsn * gg[2] * bflo(z[1]), O[vt][4 * g + 3] * rsn * gg[3] * bfhi(z[1]));
            *(u32x2*)(p.Mix + (size_t)qtok * 1024 + hd * 128 + v) = ov;
          }
      }
    }
  }
}

DI void phase4(const Params& p, char* smem, float* stash_all) {
  const int lane = threadIdx.x & 63, w = threadIdx.x >> 6;
  const int G = gridDim.x, k = blockIdx.x;
  float lam;
  {
    const float a = p.lambda_qk[lane] * p.lambda_qk[64 + lane];
    const float b = p.lambda_qk[128 + lane] * p.lambda_qk[192 + lane];
    lam = __expf(wave_sum(a)) - __expf(wave_sum(b)) + 0.2f;
  }
  float* stash = stash_all + (size_t)k * 64 * 256;
  const int nrd = (1024 + G - 1) / G;
  const int nsm = (32 - k + G - 1) / G > 0 ? (32 - k + G - 1) / G : 0;
  for (int rd = 0; rd < nrd + nsm; ++rd) {
    int tq0, qpos0, kvbase, ntb, ntw, hd;
    bool valid = true;
    if (rd < nrd) {
      const int j = rd * G + ((rd & 1) ? (G - 1 - k) : k);
      valid = j < 1024;
      const int qb = 127 - (j >> 3), b = (j >> 2) & 1;
      hd = j & 3; tq0 = b * 16384 + qb * 128; qpos0 = qb * 128; kvbase = b * 16384; ntb = 2 * qb + 2; ntw = 2 * qb + 1 + (w >> 1);
    } else {
      const int it = k + (rd - nrd) * G;
      const int bs = it >> 2;
      hd = it & 3; tq0 = NPTOK + bs * 64; qpos0 = 1024; kvbase = NPTOK + bs * 1088; ntb = 17; ntw = (w < 2) ? 17 : 0;
    }
    if (valid) attn_item(p, smem, tq0, qpos0, kvbase, ntb, ntw, hd, lam, stash);
  }
  for (int it = k; it < NITEM; it += G) r3_item(p, smem, it);
}

DI void phase5(const Params& p, char* smem) {
  const int tid = threadIdx.x, lane = tid & 63, w = tid >> 6, r = lane & 31, h = lane >> 5;
  const int wm = w >> 1, wn = w & 1;
  constexpr int MT = NTOK / 128, NT = 8;
  for (int it = blockIdx.x; it < MT * NT; it += gridDim.x) {
    const int mt = it >> 3, nt = it & 7;
    const int m0 = mt * 128, n0 = nt * 128;
    f32x16 acc[2][2];
    gemm128(p.Mix, p.WoutT, 1024, m0, n0, smem, acc);
    const float* xs = m0 < NPTOK ? p.x_prompt : p.x_sample - (size_t)NPTOK * 1024;
#pragma unroll
    for (int i = 0; i < 2; ++i)
#pragma unroll
      for (int j = 0; j < 2; ++j)
#pragma unroll
        for (int e = 0; e < 16; ++e) {
          const size_t o = (size_t)(m0 + wm * 64 + i * 32 + crow(e, h)) * 1024 + n0 + wn * 64 + j * 32 + r;
          p.out[OFF_Y + o] = xs[o] + acc[i][j][e];
        }
  }
}

DI void phase6(const Params& p) {
  const int tid = threadIdx.x, lane = tid & 63, w = tid >> 6;
  for (int it = blockIdx.x; it < NTOK / 4; it += gridDim.x) {
    float* row = p.out + OFF_Y + (size_t)(it * 4 + w) * 1024;
    f32x4 v[4]; float ss = 0.f;
#pragma unroll
    for (int i = 0; i < 4; ++i) { v[i] = *(const f32x4*)(row + i * 256 + lane * 4); ss += v[i][0] * v[i][0] + v[i][1] * v[i][1] + v[i][2] * v[i][2] + v[i][3] * v[i][3]; }
    ss = wave_sum(ss);
    const float sc = rsqrtf(ss * (1.f / 1024.f) + 1e-6f);
#pragma unroll
    for (int i = 0; i < 4; ++i) {
      const f32x4 g = *(const f32x4*)(p.final_g + i * 256 + lane * 4);
      f32x4 o; o[0] = v[i][0] * sc * g[0]; o[1] = v[i][1] * sc * g[1]; o[2] = v[i][2] * sc * g[2]; o[3] = v[i][3] * sc * g[3];
      *(f32x4*)(row + i * 256 + lane * 4) = o;
    }
  }
}

__global__ void __launch_bounds__(256, 2) fwd_megakernel(Params p) {
  __shared__ __attribute__((aligned(16))) char smem[73728];
  cg::grid_group grid = cg::this_grid();
  float* scratch_out = p.out + OFF_Y;
  const int lo = p.phase_lo, hi = p.phase_hi;
  if (lo <= 0 && hi >= 0) phase0(p, smem);
  if (lo <= 0 && hi >= 1) grid.sync();
  if (lo <= 1 && hi >= 1) phase1(p, smem);
  if (lo <= 1 && hi >= 2) grid.sync();
  if (lo <= 2 && hi >= 2) phase2(p, smem, scratch_out);
  if (lo <= 2 && hi >= 3) grid.sync();
  if (lo <= 3 && hi >= 3) phase3(p, scratch_out);
  if (lo <= 3 && hi >= 4) grid.sync();
  if (lo <= 4 && hi >= 4) phase4(p, smem, scratch_out);
  if (lo <= 4 && hi >= 5) grid.sync();
  if (lo <= 5 && hi >= 5) phase5(p, smem);
  if (lo <= 5 && hi >= 6) grid.sync();
  if (lo <= 6 && hi >= 6) phase6(p);
}

extern "C" void kernel_launch(void* const* d_in, const int* in_sizes, int n_in, void* d_out, int out_size, void* d_ws, size_t ws_size,
                              hipStream_t stream) {
  static int grid_blocks = 0;
  if (!grid_blocks) {
    int dev = 0, cus = 0, per_cu = 0;
    hipGetDevice(&dev);
    hipDeviceGetAttribute(&cus, hipDeviceAttributeMultiprocessorCount, dev);
    hipOccupancyMaxActiveBlocksPerMultiprocessor(&per_cu, fwd_megakernel, 256, 0);
    if (per_cu > 2) per_cu = 2;
    if (per_cu < 1) per_cu = 1;
    grid_blocks = cus * per_cu;
  }
  Params p{};
  p.x_prompt = (const float*)d_in[0]; p.x_sample = (const float*)d_in[1]; p.cache_k = (const float*)d_in[2]; p.cache_v = (const float*)d_in[3];
  p.state_h = (const float*)d_in[4]; p.norm_g = (const float*)d_in[5]; p.w_in = (const float*)d_in[6]; p.lambda_qk = (const float*)d_in[7];
  p.subln_g = (const float*)d_in[8]; p.rec_lb = (const float*)d_in[9]; p.rec_norm_g = (const float*)d_in[10]; p.w_out = (const float*)d_in[11];
  p.final_g = (const float*)d_in[12];
  p.out = (float*)d_out;
  char* ws = (char*)d_ws; size_t off = 0;
  auto take = [&](size_t bytes) { char* r = ws + off; off += (bytes + 255) & ~(size_t)255; return r; };
  p.WinT = (u16*)take((size_t)4096 * 1024 * 2);
  p.WoutT = (u16*)take((size_t)1024 * 1024 * 2);
  p.Xn = (u16*)take((size_t)NTOK * 1024 * 2);
  p.SbufT = p.Xn;
  p.Qb = (u16*)take((size_t)NTOK * 512 * 2);
  p.Kall = (u16*)take((size_t)KVROWS * 512 * 2);
  p.Vall = (u16*)take((size_t)KVROWS * 512 * 2);
  p.Za = (u16*)take((size_t)NTOK * 512 * 2);
  p.Qr = (u16*)take((size_t)NTOK * 512 * 2);
  p.Ir = (u16*)take((size_t)NTOK * 512 * 2);
  p.Zr = (u16*)take((size_t)NTOK * 512 * 2);
  p.Mix = (u16*)take((size_t)NTOK * 1024 * 2);
  p.Fr = (float*)take((size_t)NTOK * 512 * 4);
  p.Abuf = (float*)take((size_t)NITEM * 128 * 4);
  p.phase_lo = 0; p.phase_hi = 6;
  if (off > ws_size) { fprintf(stderr, "workspace too small: need %zu have %zu\n", off, ws_size); return; }
  void* args[] = {&p};
  hipError_t e = hipLaunchCooperativeKernel((void*)fwd_megakernel, dim3(grid_blocks), dim3(256), args, 0, stream);
  if (e != hipSuccess) fprintf(stderr, "cooperative launch failed: %s (grid %d)\n", hipGetErrorString(e), grid_blocks);
}
```

```cpp
#include <hip/hip_runtime.h>
#include <hip/hip_cooperative_groups.h>
#include <cstdio>
namespace cg = cooperative_groups;

#define DI __device__ __forceinline__
typedef unsigned short u16;
using bf16x8 = __attribute__((ext_vector_type(8))) short;
using s16x4  = __attribute__((ext_vector_type(4))) short;
using f32x16 = __attribute__((ext_vector_type(16))) float;
using f32x4  = __attribute__((ext_vector_type(4))) float;
using f32x2  = __attribute__((ext_vector_type(2))) float;
using u32x4  = __attribute__((ext_vector_type(4))) unsigned;
using u32x2  = __attribute__((ext_vector_type(2))) unsigned;
typedef __bf16 bf2_t __attribute__((ext_vector_type(2)));

#define MFMA(a, b, c) __builtin_amdgcn_mfma_f32_32x32x16_bf16((a), (b), (c), 0, 0, 0)

static constexpr int NTOK = 33280;
static constexpr int NPTOK = 32768;
static constexpr int KVROWS = 32768 + 8 * 1088;
static constexpr int NITEM = 2080;
static constexpr size_t OFF_Y = 0;
static constexpr size_t OFF_NKP = 34078720;
static constexpr size_t OFF_NVP = 50855936;
static constexpr size_t OFF_NHP = 67633152;
static constexpr size_t OFF_NKS = 67764224;
static constexpr size_t OFF_NVS = 68026368;
static constexpr size_t OFF_NHS = 68288512;

struct Params {
  const float *x_prompt, *x_sample, *cache_k, *cache_v, *state_h, *norm_g, *w_in, *lambda_qk, *subln_g, *rec_lb, *rec_norm_g, *w_out, *final_g;
  float* out;
  u16 *WinT, *WoutT, *Xn, *Qb, *Kall, *Vall, *Za, *Qr, *Ir, *Zr, *Mix, *SbufT;
  float *Fr, *Abuf, *NQ;
  int* counter;
  int phase_lo, phase_hi, rep_mask, pad_;
};

DI unsigned pack2(float a, float b) { f32x2 v = {a, b}; bf2_t r = __builtin_convertvector(v, bf2_t); return __builtin_bit_cast(unsigned, r); }
DI u16 f2bf(float a) { return (u16)(pack2(a, 0.f) & 0xffffu); }
DI float bflo(unsigned u) { return __uint_as_float(u << 16); }
DI float bfhi(unsigned u) { return __uint_as_float(u & 0xffff0000u); }
DI int crow(int e, int h) { return (e & 3) + 8 * (e >> 2) + 4 * h; }
DI float wave_sum(float v) {
#pragma unroll
  for (int o = 32; o >= 1; o >>= 1) v += __shfl_xor(v, o);
  return v;
}
DI float silu_f(float v) { return v / (1.f + __expf(-v)); }
DI s16x4 tr_read(const char* p) {
  return __builtin_amdgcn_ds_read_tr16_b64_v4i16((__attribute__((address_space(3))) s16x4*)(p));
}
DI bf16x8 tr_frag(const char* p0, int stride4) {
  s16x4 lo = tr_read(p0), hi = tr_read(p0 + stride4);
  return __builtin_shufflevector(lo, hi, 0, 1, 2, 3, 4, 5, 6, 7);
}
DI bf16x8 pack8(const f32x16& x, int s) {
  u32x4 p;
  p[0] = pack2(x[8 * s + 0], x[8 * s + 1]);
  p[1] = pack2(x[8 * s + 2], x[8 * s + 3]);
  p[2] = pack2(x[8 * s + 4], x[8 * s + 5]);
  p[3] = pack2(x[8 * s + 6], x[8 * s + 7]);
  return __builtin_bit_cast(bf16x8, p);
}
DI f32x16 zero16() { f32x16 z; for (int i = 0; i < 16; ++i) z[i] = 0.f; return z; }

DI void phase0(const Params& p, char* smem) {
  const int tid = threadIdx.x, lane = tid & 63, w = tid >> 6;
  constexpr int NT_W1 = 16 * 64, NT_W2 = 16 * 16, NT_ROW = NTOK / 4, NT_CACHE = 4096;
  constexpr int total = NT_W1 + NT_W2 + NT_ROW + NT_CACHE;
  float (*tile)[65] = (float (*)[65])smem;
  if (blockIdx.x == 0 && tid == 0) *p.counter = 0;
  for (int it = blockIdx.x; it < total; it += gridDim.x) {
    if (it < NT_W1 + NT_W2) {
      const float* src; u16* dst; int N, kt, nt;
      if (it < NT_W1) { src = p.w_in; dst = p.WinT; N = 4096; kt = it >> 6; nt = it & 63; }
      else { int j = it - NT_W1; src = p.w_out; dst = p.WoutT; N = 1024; kt = j >> 4; nt = j & 15; }
      const int c = tid & 63, r0 = tid >> 6;
      for (int i = 0; i < 16; ++i) { int r = r0 + 4 * i; tile[r][c] = src[(size_t)(kt * 64 + r) * N + nt * 64 + c]; }
      __syncthreads();
      for (int i = 0; i < 16; ++i) { int r = r0 + 4 * i; dst[(size_t)(nt * 64 + r) * 1024 + kt * 64 + c] = f2bf(tile[c][r]); }
      __syncthreads();
    } else if (it < NT_W1 + NT_W2 + NT_ROW) {
      const int row = (it - NT_W1 - NT_W2) * 4 + w;
      const float* src = row < NPTOK ? p.x_prompt + (size_t)row * 1024 : p.x_sample + (size_t)(row - NPTOK) * 1024;
      f32x4 v[4]; float ss = 0.f;
#pragma unroll
      for (int i = 0; i < 4; ++i) { v[i] = *(const f32x4*)(src + i * 256 + lane * 4); ss += v[i][0] * v[i][0] + v[i][1] * v[i][1] + v[i][2] * v[i][2] + v[i][3] * v[i][3]; }
      ss = wave_sum(ss);
      const float sc = rsqrtf(ss * (1.f / 1024.f) + 1e-6f);
#pragma unroll
      for (int i = 0; i < 4; ++i) {
        f32x4 g = *(const f32x4*)(p.norm_g + i * 256 + lane * 4);
        u32x2 o; o[0] = pack2(v[i][0] * sc * g[0], v[i][1] * sc * g[1]); o[1] = pack2(v[i][2] * sc * g[2], v[i][3] * sc * g[3]);
        *(u32x2*)(p.Xn + (size_t)row * 1024 + i * 256 + lane * 4) = o;
      }
    } else {
      const int task = (it - NT_W1 - NT_W2 - NT_ROW) * 4 + w;
      const int which = task >> 13, rr = task & 8191;
      const float* src = (which ? p.cache_v : p.cache_k) + (size_t)rr * 512 + lane * 8;
      u16* dst = (which ? p.Vall : p.Kall) + (size_t)(NPTOK + (rr >> 10) * 1088 + (rr & 1023)) * 512 + lane * 8;
      f32x4 a = *(const f32x4*)src, b = *(const f32x4*)(src + 4);
      u32x4 o; o[0] = pack2(a[0], a[1]); o[1] = pack2(a[2], a[3]); o[2] = pack2(b[0], b[1]); o[3] = pack2(b[2], b[3]);
      *(u32x4*)dst = o;
    }
  }
}

DI void gemm128(const u16* __restrict__ A, const u16* __restrict__ BT, int K, int m0, int n0, char* smem, f32x16 (&acc)[2][2]) {
  const int tid = threadIdx.x, lane = tid & 63, w = tid >> 6, r = lane & 31, h = lane >> 5;
  const int wm = w >> 1, wn = w & 1;
#pragma unroll
  for (int i = 0; i < 2; ++i)
#pragma unroll
    for (int j = 0; j < 2; ++j) acc[i][j] = zero16();
  u32x4 ra[4], rb[4];
  const int KT = K >> 6;
  const int lrow = tid >> 3, lcc = tid & 7;
  const u16* ap = A + (size_t)(m0 + lrow) * K + lcc * 8;
  const u16* bp = BT + (size_t)(n0 + lrow) * K + lcc * 8;
  char* wbase = smem + lrow * 144 + lcc * 16;
#pragma unroll
  for (int i = 0; i < 4; ++i) { ra[i] = *(const u32x4*)(ap + (size_t)i * 32 * K); rb[i] = *(const u32x4*)(bp + (size_t)i * 32 * K); }
#pragma unroll
  for (int i = 0; i < 4; ++i) { *(u32x4*)(wbase + i * 32 * 144) = ra[i]; *(u32x4*)(wbase + 36864 + i * 32 * 144) = rb[i]; }
  __syncthreads();
  for (int kt = 0; kt < KT; ++kt) {
    if (kt + 1 < KT) {
#pragma unroll
      for (int i = 0; i < 4; ++i) { ra[i] = *(const u32x4*)(ap + (size_t)i * 32 * K + (kt + 1) * 64); rb[i] = *(const u32x4*)(bp + (size_t)i * 32 * K + (kt + 1) * 64); }
    }
    const char* as = smem + (kt & 1) * 18432 + (wm * 64 + r) * 144 + h * 16;
    const char* bs = smem + 36864 + (kt & 1) * 18432 + (wn * 64 + r) * 144 + h * 16;
#pragma unroll
    for (int s = 0; s < 4; ++s) {
      bf16x8 a0 = *(const bf16x8*)(as + s * 32), a1 = *(const bf16x8*)(as + 32 * 144 + s * 32);
      bf16x8 b0 = *(const bf16x8*)(bs + s * 32), b1 = *(const bf16x8*)(bs + 32 * 144 + s * 32);
      acc[0][0] = MFMA(a0, b0, acc[0][0]); acc[0][1] = MFMA(a0, b1, acc[0][1]);
      acc[1][0] = MFMA(a1, b0, acc[1][0]); acc[1][1] = MFMA(a1, b1, acc[1][1]);
    }
    if (kt + 1 < KT) {
      char* wb = wbase + ((kt + 1) & 1) * 18432;
#pragma unroll
      for (int i = 0; i < 4; ++i) { *(u32x4*)(wb + i * 32 * 144) = ra[i]; *(u32x4*)(wb + 36864 + i * 32 * 144) = rb[i]; }
    }
    __syncthreads();
  }
}

DI void phase1(const Params& p, char* smem) {
  const int tid = threadIdx.x, lane = tid & 63, w = tid >> 6, r = lane & 31, h = lane >> 5;
  const int wm = w >> 1, wn = w & 1;
  constexpr int MT = NTOK / 128, NT = 32;
  for (int it = blockIdx.x; it < MT * NT; it += gridDim.x) {
    const int mt = it >> 5, nt = it & 31;
    const int m0 = mt * 128, n0 = nt * 128;
    f32x16 acc[2][2];
    gemm128(p.Xn, p.WinT, 1024, m0, n0, smem, acc);
    const int sec = n0 >> 9;
    const bool samp = m0 >= NPTOK;
#pragma unroll
    for (int i = 0; i < 2; ++i)
#pragma unroll
      for (int j = 0; j < 2; ++j) {
        const int cs = (n0 & 511) + wn * 64 + j * 32 + r;
#pragma unroll
        for (int e = 0; e < 16; ++e) {
          const int t = m0 + wm * 64 + i * 32 + crow(e, h);
          const float v = acc[i][j][e];
          const size_t o512 = (size_t)t * 512 + cs;
          if (sec == 0) { p.Qb[o512] = f2bf(v * (0.125f * 1.44269504089f)); }
          else if (sec == 1 || sec == 2) {
            size_t kvr; float* od;
            if (!samp) { kvr = t; od = p.out + (sec == 1 ? OFF_NKP : OFF_NVP) + o512; }
            else { const int ts = t - NPTOK; kvr = NPTOK + (ts >> 6) * 1088 + 1024 + (ts & 63); od = p.out + (sec == 1 ? OFF_NKS : OFF_NVS) + (size_t)ts * 512 + cs; }
            *od = v;
            (sec == 1 ? p.Kall : p.Vall)[kvr * 512 + cs] = f2bf(v);
          }
          else if (sec == 3) { p.Za[o512] = f2bf(silu_f(v)); }
          else if (sec == 4) { p.Qr[o512] = f2bf(silu_f(v)); }
          else if (sec == 5) { p.Fr[o512] = v; }
          else if (sec == 6) { p.Ir[o512] = f2bf(v); }
          else { p.Zr[o512] = f2bf(silu_f(v)); }
        }
      }
  }
}

DI void rec_pre(const Params& p, int tid, int I, float* totS, float (&cum)[32], float (&key)[32], float& lastv) {
  const int d = tid & 127, half = tid >> 7;
  const int hd = I & 3, t0 = (I >> 2) * 64;
  const float r0 = p.rec_lb[hd * 128 + d], r1 = p.rec_lb[512 + hd * 128 + d];
  const float lb = 1.f / (1.f + __expf(r1 - r0));
  const float* fp = p.Fr + (size_t)(t0 + half * 32) * 512 + hd * 128 + d;
  float run = 0.f;
#pragma unroll
  for (int i = 0; i < 32; ++i) {
    float x = fp[(size_t)i * 512];
    x = fminf(fmaxf(x, -30.f), 30.f);
    const float e = __expf(-x), sg = 1.f / (1.f + e);
    run += __logf(lb + (1.f - lb) * sg);
    cum[i] = run; key[i] = (1.f - lb) * e * sg;
  }
  totS[tid] = run;
  __syncthreads();
  const float tot0 = totS[d], tot1 = totS[128 + d];
  if (half) {
#pragma unroll
    for (int i = 0; i < 32; ++i) cum[i] += tot0;
  }
  lastv = tot0 + tot1;
}

DI void phase2(const Params& p, char* smem, float* BbufT) {
  const int tid = threadIdx.x, lane = tid & 63, w = tid >> 6, r = lane & 31, h = lane >> 5;
  const int q = (lane & 15) >> 2, pp = lane & 3, blk = (lane >> 4) & 1;
  const int d = tid & 127, half = tid >> 7;
  char* KdI = smem; char* VrI = smem + 17408; float* totS = (float*)(smem + 60000);
  for (int I = blockIdx.x; I < NITEM; I += gridDim.x) {
    const int hd = I & 3, t0 = (I >> 2) * 64;
    if (I < 2048) {
      const int token = tid & 63, which = tid >> 6;
      const u16* src = (which < 2 ? p.Qb : p.Kall) + (size_t)(t0 + token) * 512 + hd * 128 + (which & 1) * 64;
      float ss = 0.f;
#pragma unroll
      for (int c = 0; c < 8; ++c) {
        const u32x4 v = *(const u32x4*)(src + c * 8);
#pragma unroll
        for (int i = 0; i < 4; ++i) { const float lo = bflo(v[i]), hi = bfhi(v[i]); ss += lo * lo + hi * hi; }
      }
#pragma unroll
      for (int o = 32; o >= 1; o >>= 1) ss = fmaxf(ss, __shfl_xor(ss, o));
      if (lane == 0) p.NQ[I * 4 + which] = sqrtf(ss);
    }
    float cum[32], key[32], lastv;
    rec_pre(p, tid, I, totS, cum, key, lastv);
#pragma unroll
    for (int i = 0; i < 32; ++i) {
      const int t = half * 32 + i;
      *(u16*)(KdI + t * 272 + d * 2) = f2bf(key[i] * __expf(lastv - cum[i]));
    }
#pragma unroll
    for (int i = 0; i < 4; ++i) {
      const int ch = tid + 256 * i, row = ch >> 4, cc = ch & 15;
      *(u32x4*)(VrI + row * 272 + cc * 16) = *(const u32x4*)(p.Ir + (size_t)(t0 + row) * 512 + hd * 128 + cc * 8);
    }
    if (half) p.Abuf[I * 128 + d] = __expf(lastv);
    __syncthreads();
    f32x16 acc[4];
#pragma unroll
    for (int ct = 0; ct < 4; ++ct) acc[ct] = zero16();
#pragma unroll
    for (int ks = 0; ks < 4; ++ks) {
      const int rowoff = (16 * ks + 8 * h + q) * 272 + 32 * blk + 8 * pp;
      bf16x8 a = tr_frag(VrI + rowoff + 64 * w, 4 * 272);
#pragma unroll
      for (int ct = 0; ct < 4; ++ct) {
        bf16x8 b = tr_frag(KdI + rowoff + 64 * ct, 4 * 272);
        acc[ct] = MFMA(a, b, acc[ct]);
      }
    }
    float* ob = BbufT + (size_t)I * 16384;
#pragma unroll
    for (int ct = 0; ct < 4; ++ct)
#pragma unroll
      for (int e = 0; e < 16; ++e) ob[(32 * w + crow(e, h)) * 128 + 32 * ct + r] = acc[ct][e];
    __syncthreads();
  }
}

DI void phase3(const Params& p, const float* BbufT) {
  const int tid = threadIdx.x;
  for (int it = blockIdx.x; it < 256 + 1024; it += gridDim.x) {
    if (it < 256) {
      const int bh = it >> 5, b = bh >> 2, hd = bh & 3;
      const int e2 = (it & 31) * 256 + tid, v = e2 >> 6, d2 = (e2 & 63) * 2;
      float sx = 0.f, sy = 0.f;
      const size_t eo = (size_t)v * 128 + d2;
#pragma unroll 8
      for (int c = 0; c < 256; ++c) {
        const int I = (b * 256 + c) * 4 + hd;
        const f32x2 a = *(const f32x2*)(p.Abuf + I * 128 + d2);
        const f32x2 bv = *(const f32x2*)(BbufT + (size_t)I * 16384 + eo);
        *(unsigned*)(p.SbufT + (size_t)I * 16384 + eo) = pack2(sx, sy);
        sx = a[0] * sx + bv[0]; sy = a[1] * sy + bv[1];
      }
      float* oh = p.out + OFF_NHP + (size_t)(b * 4 + hd) * 16384;
      oh[d2 * 128 + v] = sx; oh[(d2 + 1) * 128 + v] = sy;
    } else {
      const int j = it - 256;
      const int sh = j >> 5, bs = sh >> 2, hd = sh & 3;
      const int e2 = (j & 31) * 256 + tid, v = e2 >> 6, d2 = (e2 & 63) * 2;
      const int I = (512 + bs) * 4 + hd;
      const float* sh0 = p.state_h + (size_t)(bs * 4 + hd) * 16384;
      float sx = sh0[d2 * 128 + v], sy = sh0[(d2 + 1) * 128 + v];
      const size_t eo = (size_t)v * 128 + d2;
      const f32x2 a = *(const f32x2*)(p.Abuf + I * 128 + d2);
      const f32x2 bv = *(const f32x2*)(BbufT + (size_t)I * 16384 + eo);
      *(unsigned*)(p.SbufT + (size_t)I * 16384 + eo) = pack2(sx, sy);
      sx = a[0] * sx + bv[0]; sy = a[1] * sy + bv[1];
      float* oh = p.out + OFF_NHS + (size_t)(bs * 4 + hd) * 16384;
      oh[d2 * 128 + v] = sx; oh[(d2 + 1) * 128 + v] = sy;
    }
  }
}

DI void r3_item(const Params& p, char* smem, int tid, int I) {
  const int lane = tid & 63, w = tid >> 6, r = lane & 31, h = lane >> 5;
  const int q = (lane & 15) >> 2, pp = lane & 3, blk = (lane >> 4) & 1;
  const int d = tid & 127, half = tid >> 7;
  char* QdI = smem; char* KdI = smem + 17408; char* VrI = smem + 34816;
  float* totS = (float*)(smem + 60000); float* ssS = (float*)(smem + 62048);
  const int hd = I & 3, t0 = (I >> 2) * 64;
  {
    float cum[32], key[32], lastv;
    rec_pre(p, tid, I, totS, cum, key, lastv);
    const u16* qp = p.Qr + (size_t)(t0 + half * 32) * 512 + hd * 128 + d;
#pragma unroll
    for (int i = 0; i < 32; ++i) {
      const int t = half * 32 + i;
      const float qv = bflo(qp[(size_t)i * 512]);
      *(u16*)(QdI + t * 272 + d * 2) = f2bf(qv * __expf(cum[i]));
      *(u16*)(KdI + t * 272 + d * 2) = f2bf(key[i] * __expf(-cum[i]));
    }
  }
#pragma unroll
  for (int i = 0; i < 4; ++i) {
    const int ch = tid + 256 * i, row = ch >> 4, cc = ch & 15;
    *(u32x4*)(VrI + row * 272 + cc * 16) = *(const u32x4*)(p.Ir + (size_t)(t0 + row) * 512 + hd * 128 + cc * 8);
  }
  __syncthreads();
  const int tt = w & 1, vh = w >> 1;
  bf16x8 qf[8];
#pragma unroll
  for (int ks = 0; ks < 8; ++ks) qf[ks] = *(const bf16x8*)(QdI + (32 * tt + r) * 272 + ks * 32 + h * 16);
  f32x16 sc[2]; sc[0] = zero16(); sc[1] = zero16();
#pragma unroll
  for (int ks = 0; ks < 8; ++ks) {
    bf16x8 a0 = *(const bf16x8*)(KdI + r * 272 + ks * 32 + h * 16);
    sc[0] = MFMA(a0, qf[ks], sc[0]);
  }
  if (tt == 1) {
#pragma unroll
    for (int ks = 0; ks < 8; ++ks) {
      bf16x8 a1 = *(const bf16x8*)(KdI + (32 + r) * 272 + ks * 32 + h * 16);
      sc[1] = MFMA(a1, qf[ks], sc[1]);
    }
  }
#pragma unroll
  for (int e = 0; e < 16; ++e) {
    const bool keep = crow(e, h) <= r;
    if (tt == 0) { if (!keep) sc[0][e] = 0.f; }
    else { if (!keep) sc[1][e] = 0.f; }
  }
  bf16x8 pf[4];
  pf[0] = pack8(sc[0], 0); pf[1] = pack8(sc[0], 1); pf[2] = pack8(sc[1], 0); pf[3] = pack8(sc[1], 1);
  f32x16 o[2]; o[0] = zero16(); o[1] = zero16();
  const u16* sp = p.SbufT + (size_t)I * 16384;
#pragma unroll
  for (int vi = 0; vi < 2; ++vi) {
    const int vt = 2 * vh + vi;
#pragma unroll
    for (int k4 = 0; k4 < 4; ++k4) {
      if (k4 < 2 || tt == 1) {
        bf16x8 a = tr_frag(VrI + (16 * k4 + 4 * h + q) * 272 + (32 * vt + 16 * blk) * 2 + 8 * pp, 8 * 272);
        o[vi] = MFMA(a, pf[k4], o[vi]);
      }
    }
#pragma unroll
    for (int ks = 0; ks < 8; ++ks) {
      bf16x8 a = *(const bf16x8*)(sp + (size_t)(32 * vt + r) * 128 + ks * 16 + h * 8);
      o[vi] = MFMA(a, qf[ks], o[vi]);
    }
  }
  float ss = 0.f;
#pragma unroll
  for (int vi = 0; vi < 2; ++vi)
#pragma unroll
    for (int e = 0; e < 16; ++e) ss += o[vi][e] * o[vi][e];
  ss += __shfl_xor(ss, 32);
  if (h == 0) ssS[w * 32 + r] = ss;
  __syncthreads();
  const float tot = ssS[tt * 32 + r] + ssS[(tt + 2) * 32 + r];
  const float rs = rsqrtf(tot * (1.f / 128.f) + 1e-6f);
  const int tok = t0 + 32 * tt + r;
#pragma unroll
  for (int vi = 0; vi < 2; ++vi)
#pragma unroll
    for (int g = 0; g < 4; ++g) {
      const int v = 32 * (2 * vh + vi) + 8 * g + 4 * h;
      const f32x4 gg = *(const f32x4*)(p.rec_norm_g + v);
      const u32x2 z = *(const u32x2*)(p.Zr + (size_t)tok * 512 + hd * 128 + v);
      u32x2 ov;
      ov[0] = pack2(o[vi][4 * g + 0] * rs * gg[0] * bflo(z[0]), o[vi][4 * g + 1] * rs * gg[1] * bfhi(z[0]));
      ov[1] = pack2(o[vi][4 * g + 2] * rs * gg[2] * bflo(z[1]), o[vi][4 * g + 3] * rs * gg[3] * bfhi(z[1]));
      *(u32x2*)(p.Mix + (size_t)tok * 1024 + 512 + hd * 128 + v) = ov;
    }
  __syncthreads();
}

template <bool DIAG>
DI void attn_tile_a(const char* ks, const bf16x8 (&qf)[4], f32x16 (&O)[4], bf16x8 (&pf)[4], float& mrun, float& lsum, float sl2, float qrel,
                    int m, int r, int h2) {
  f32x16 S[2];
#pragma unroll
  for (int st = 0; st < 2; ++st) {
    S[st] = zero16();
#pragma unroll
    for (int s = 0; s < 4; ++s) {
      bf16x8 a = *(const bf16x8*)(ks + (32 * st + r) * 272 + m * 128 + s * 32 + h2 * 16);
      S[st] = MFMA(a, qf[s], S[st]);
    }
  }
  float mx = -1e30f;
#pragma unroll
  for (int st = 0; st < 2; ++st)
#pragma unroll
    for (int e = 0; e < 16; ++e) {
      const float cst = (float)(32 * st + (e & 3) + 8 * (e >> 2));
      float sv;
      if (DIAG) sv = fmaf(-sl2, fabsf(qrel - cst), S[st][e]);
      else sv = fmaf(sl2, cst, S[st][e]);
      S[st][e] = sv; mx = fmaxf(mx, sv);
    }
  const float L = DIAG ? 0.f : -sl2 * qrel;
  mx += L;
  mx = fmaxf(mx, __shfl_xor(mx, 32));
  if (__builtin_amdgcn_ballot_w64(mx > mrun + 6.f) != 0) {
    const float mnew = fmaxf(mrun, mx);
    const float alpha = __builtin_amdgcn_exp2f(mrun - mnew);
    mrun = mnew; lsum *= alpha;
#pragma unroll
    for (int vt = 0; vt < 4; ++vt)
#pragma unroll
      for (int e = 0; e < 16; ++e) O[vt][e] *= alpha;
  }
  const float off = L - mrun;
  float rs = 0.f;
#pragma unroll
  for (int st = 0; st < 2; ++st)
#pragma unroll
    for (int e = 0; e < 16; ++e) { const float pv = __builtin_amdgcn_exp2f(S[st][e] + off); S[st][e] = pv; rs += pv; }
  lsum += rs;
  pf[0] = pack8(S[0], 0); pf[1] = pack8(S[0], 1); pf[2] = pack8(S[1], 0); pf[3] = pack8(S[1], 1);
}
DI void attn_tile_b(const char* vs, const bf16x8 (&pf)[4], f32x16 (&O)[4], int h2, int q, int pp, int blk) {
#pragma unroll
  for (int k4 = 0; k4 < 4; ++k4) {
    const char* vb = vs + (16 * k4 + 4 * h2 + q) * 272 + 32 * blk + 8 * pp;
#pragma unroll
    for (int vt = 0; vt < 4; ++vt) {
      bf16x8 a = tr_frag(vb + 64 * vt, 8 * 272);
      O[vt] = MFMA(a, pf[k4], O[vt]);
    }
    __builtin_amdgcn_sched_barrier(0);
  }
}

DI void attn_item(const Params& p, char* smem, int tid, int tq0, int qpos0, int kvbase, int ntb, int hd, float lam, bool can_skip) {
  const int lane = tid & 63, w = tid >> 6, r = lane & 31, h2 = lane >> 5;
  const int q = (lane & 15) >> 2, pp = lane & 3, blk = (lane >> 4) & 1;
  const int qh = w & 1, m = w >> 1;
  const float sl2 = exp2f(-2.f * (float)(hd + 1)) * 1.44269504089f;
  const int qtok = tq0 + 32 * qh + r;
  const float qposf = (float)(qpos0 + 32 * qh + r);
  int kt0w = 0, kt0b = 0;
  if (can_skip) {
    const int I0 = (tq0 >> 6) * 4 + hd;
    const int crk = kvbase >> 6;
    int k0[2];
#pragma unroll
    for (int mm = 0; mm < 2; ++mm) {
      const float QN = p.NQ[I0 * 4 + mm];
      float KN = 0.f;
      for (int c = lane; c < ntb; c += 64) KN = fmaxf(KN, p.NQ[((crk + c) * 4 + hd) * 4 + 2 + mm]);
#pragma unroll
      for (int o = 32; o >= 1; o >>= 1) KN = fmaxf(KN, __shfl_xor(KN, o));
      const float D = (2.02f * QN * KN + 130.f) / sl2;
      const float f = ((float)(qpos0 - 63) - D) * (1.f / 64.f);
      k0[mm] = f < 0.f ? 0 : (int)f + 1;
    }
    kt0w = m ? k0[1] : k0[0];
    kt0b = k0[0] < k0[1] ? k0[0] : k0[1];
  }
  bf16x8 qf[4];
#pragma unroll
  for (int s = 0; s < 4; ++s) qf[s] = *(const bf16x8*)(p.Qb + (size_t)qtok * 512 + hd * 128 + m * 64 + 16 * s + 8 * h2);
  f32x16 O[4];
#pragma unroll
  for (int vt = 0; vt < 4; ++vt) O[vt] = zero16();
  float mrun = -1e30f, lsum = 0.f;
  u32x4 rg[4];
  const int lrow = tid >> 4, lcc = tid & 15;
  const size_t gofs = (size_t)(kvbase + lrow) * 512 + hd * 128 + lcc * 8;
  const u16* kp = p.Kall + gofs;
  const u16* vp = p.Vall + gofs;
  char* kw = smem + lrow * 272 + lcc * 16;
  const int nit = ntb - kt0b;
  {
    const size_t go = (size_t)(ntb - 1) * 64 * 512;
#pragma unroll
    for (int i = 0; i < 4; ++i) rg[i] = *(const u32x4*)(kp + go + (size_t)i * 16 * 512);
#pragma unroll
    for (int i = 0; i < 4; ++i) *(u32x4*)(kw + i * 16 * 272) = rg[i];
#pragma unroll
    for (int i = 0; i < 4; ++i) rg[i] = *(const u32x4*)(vp + go + (size_t)i * 16 * 512);
#pragma unroll
    for (int i = 0; i < 4; ++i) *(u32x4*)(kw + 17408 + i * 16 * 272) = rg[i];
  }
  __syncthreads();
  for (int it = 0; it < nit; ++it) {
    const int kt = ntb - 1 - it;
    const bool has_next = it + 1 < nit;
    const bool active = kt >= kt0w;
    const size_t go = (size_t)(kt - 1) * 64 * 512;
    const char* ks = smem + (it & 1) * 34816;
    char* wb = kw + ((it + 1) & 1) * 34816;
    bf16x8 pf[4];
    if (has_next) {
#pragma unroll
      for (int i = 0; i < 4; ++i) rg[i] = *(const u32x4*)(kp + go + (size_t)i * 16 * 512);
    }
    if (active) {
      const float qrel = qposf - (float)(kt * 64 + 4 * h2);
      if (it == 0) attn_tile_a<true>(ks, qf, O, pf, mrun, lsum, sl2, qrel, m, r, h2);
      else attn_tile_a<false>(ks, qf, O, pf, mrun, lsum, sl2, qrel, m, r, h2);
    }
    if (has_next) {
#pragma unroll
      for (int i = 0; i < 4; ++i) *(u32x4*)(wb + i * 16 * 272) = rg[i];
#pragma unroll
      for (int i = 0; i < 4; ++i) rg[i] = *(const u32x4*)(vp + go + (size_t)i * 16 * 512);
    }
    if (active) attn_tile_b(ks + 17408, pf, O, h2, q, pp, blk);
    if (has_next) {
#pragma unroll
      for (int i = 0; i < 4; ++i) *(u32x4*)(wb + 17408 + i * 16 * 272) = rg[i];
    }
    __syncthreads();
  }
  const float lt = lsum + __shfl_xor(lsum, 32);
  const float inv = 1.f / lt;
  float* exch = (float*)smem + qh * 4096 + lane;
  if (m == 1) {
#pragma unroll
    for (int vt = 0; vt < 4; ++vt)
#pragma unroll
      for (int e = 0; e < 16; ++e) exch[(vt * 16 + e) * 64] = O[vt][e] * inv;
  }
  __syncthreads();
  if (m == 0) {
    float ss = 0.f;
#pragma unroll
    for (int vt = 0; vt < 4; ++vt)
#pragma unroll
      for (int e = 0; e < 16; ++e) { const float ov = O[vt][e] * inv - lam * exch[(vt * 16 + e) * 64]; O[vt][e] = ov; ss += ov * ov; }
    ss += __shfl_xor(ss, 32);
    const float rsn = rsqrtf(ss * (1.f / 128.f) + 1e-6f) * 0.8f;
#pragma unroll
    for (int vt = 0; vt < 4; ++vt)
#pragma unroll
      for (int g = 0; g < 4; ++g) {
        const int v = 32 * vt + 8 * g + 4 * h2;
        const f32x4 gg = *(const f32x4*)(p.subln_g + v);
        const u32x2 z = *(const u32x2*)(p.Za + (size_t)qtok * 512 + hd * 128 + v);
        u32x2 ov;
        ov[0] = pack2(O[vt][4 * g + 0] * rsn * gg[0] * bflo(z[0]), O[vt][4 * g + 1] * rsn * gg[1] * bfhi(z[0]));
        ov[1] = pack2(O[vt][4 * g + 2] * rsn * gg[2] * bflo(z[1]), O[vt][4 * g + 3] * rsn * gg[3] * bfhi(z[1]));
        *(u32x2*)(p.Mix + (size_t)qtok * 1024 + hd * 128 + v) = ov;
      }
  }
  __syncthreads();
}

DI void phase4(const Params& p, char* smem) {
  const int tid = threadIdx.x, lane = tid & 63;
  float lam;
  {
    const float a = p.lambda_qk[lane] * p.lambda_qk[64 + lane];
    const float b = p.lambda_qk[128 + lane] * p.lambda_qk[192 + lane];
    lam = __expf(wave_sum(a)) - __expf(wave_sum(b)) + 0.2f;
  }
  int* sitem = (int*)(smem + 73712);
  constexpr int NPA = 2048, NSA = 32, TOTAL = NPA + NSA + NITEM;
  for (;;) {
    if (tid == 0) *sitem = atomicAdd(p.counter, 1);
    __syncthreads();
    const int item = *sitem;
    __syncthreads();
    if (item >= TOTAL) break;
    int tid_o = tid;
    asm volatile("" : "+v"(tid_o));
    if (item < NPA + NSA) {
      int tq0, qpos0, kvbase, ntb, hd; bool can_skip;
      if (item < NPA) {
        const int qb = 255 - ((item & 511) >> 1), b = item & 1;
        hd = 3 - (item >> 9); tq0 = b * 16384 + qb * 64; qpos0 = qb * 64; kvbase = b * 16384; ntb = qb + 1; can_skip = true;
      } else {
        const int it = item - NPA, bs = it >> 2;
        hd = it & 3; tq0 = NPTOK + bs * 64; qpos0 = 1024; kvbase = NPTOK + bs * 1088; ntb = 17; can_skip = false;
      }
      attn_item(p, smem, tid_o, tq0, qpos0, kvbase, ntb, hd, lam, can_skip);
    } else {
      r3_item(p, smem, tid_o, item - NPA - NSA);
    }
  }
}

DI void phase5(const Params& p, char* smem) {
  const int tid = threadIdx.x, lane = tid & 63, w = tid >> 6, r = lane & 31, h = lane >> 5;
  const int wm = w >> 1, wn = w & 1;
  constexpr int MT = NTOK / 128, NT = 8;
  for (int it = blockIdx.x; it < MT * NT; it += gridDim.x) {
    const int mt = it >> 3, nt = it & 7;
    const int m0 = mt * 128, n0 = nt * 128;
    f32x16 acc[2][2];
    gemm128(p.Mix, p.WoutT, 1024, m0, n0, smem, acc);
    const float* xs = m0 < NPTOK ? p.x_prompt : p.x_sample - (size_t)NPTOK * 1024;
#pragma unroll
    for (int i = 0; i < 2; ++i)
#pragma unroll
      for (int j = 0; j < 2; ++j)
#pragma unroll
        for (int e = 0; e < 16; ++e) {
          const size_t o = (size_t)(m0 + wm * 64 + i * 32 + crow(e, h)) * 1024 + n0 + wn * 64 + j * 32 + r;
          p.out[OFF_Y + o] = xs[o] + acc[i][j][e];
        }
  }
}

DI void phase6(const Params& p) {
  const int tid = threadIdx.x, lane = tid & 63, w = tid >> 6;
  for (int it = blockIdx.x; it < NTOK / 4; it += gridDim.x) {
    float* row = p.out + OFF_Y + (size_t)(it * 4 + w) * 1024;
    f32x4 v[4]; float ss = 0.f;
#pragma unroll
    for (int i = 0; i < 4; ++i) { v[i] = *(const f32x4*)(row + i * 256 + lane * 4); ss += v[i][0] * v[i][0] + v[i][1] * v[i][1] + v[i][2] * v[i][2] + v[i][3] * v[i][3]; }
    ss = wave_sum(ss);
    const float sc = rsqrtf(ss * (1.f / 1024.f) + 1e-6f);
#pragma unroll
    for (int i = 0; i < 4; ++i) {
      const f32x4 g = *(const f32x4*)(p.final_g + i * 256 + lane * 4);
      f32x4 o; o[0] = v[i][0] * sc * g[0]; o[1] = v[i][1] * sc * g[1]; o[2] = v[i][2] * sc * g[2]; o[3] = v[i][3] * sc * g[3];
      *(f32x4*)(row + i * 256 + lane * 4) = o;
    }
  }
}

__global__ void __launch_bounds__(256, 2) fwd_megakernel(Params p) {
  __shared__ __attribute__((aligned(16))) char smem[73728];
  cg::grid_group grid = cg::this_grid();
  float* scratch_out = p.out + OFF_Y;
  const int lo = p.phase_lo, hi = p.phase_hi, rm = p.rep_mask;
  if (lo <= 0 && hi >= 0) phase0(p, smem);
  if (rm & 1) { grid.sync(); phase0(p, smem); }
  if (lo <= 0 && hi >= 1) grid.sync();
  if (lo <= 1 && hi >= 1) phase1(p, smem);
  if (rm & 2) { grid.sync(); phase1(p, smem); }
  if (lo <= 1 && hi >= 2) grid.sync();
  if (lo <= 2 && hi >= 2) phase2(p, smem, scratch_out);
  if (rm & 4) { grid.sync(); phase2(p, smem, scratch_out); }
  if (lo <= 2 && hi >= 3) grid.sync();
  if (lo <= 3 && hi >= 3) phase3(p, scratch_out);
  if (rm & 8) { grid.sync(); phase3(p, scratch_out); }
  if (lo <= 3 && hi >= 4) grid.sync();
  if (lo <= 4 && hi >= 4) phase4(p, smem);
  if (lo <= 4 && hi >= 5) grid.sync();
  if (lo <= 5 && hi >= 5) phase5(p, smem);
  if (rm & 32) { grid.sync(); phase5(p, smem); }
  if (lo <= 5 && hi >= 6) grid.sync();
  if (lo <= 6 && hi >= 6) phase6(p);
}

extern "C" void kernel_launch(void* const* d_in, const int* in_sizes, int n_in, void* d_out, int out_size, void* d_ws, size_t ws_size,
                              hipStream_t stream) {
  static int grid_blocks = 0;
  if (!grid_blocks) {
    int dev = 0, cus = 0, per_cu = 0;
    hipGetDevice(&dev);
    hipDeviceGetAttribute(&cus, hipDeviceAttributeMultiprocessorCount, dev);
    hipOccupancyMaxActiveBlocksPerMultiprocessor(&per_cu, fwd_megakernel, 256, 0);
    if (per_cu > 2) per_cu = 2;
    if (per_cu < 1) per_cu = 1;
    grid_blocks = cus * per_cu;
  }
  Params p{};
  p.x_prompt = (const float*)d_in[0]; p.x_sample = (const float*)d_in[1]; p.cache_k = (const float*)d_in[2]; p.cache_v = (const float*)d_in[3];
  p.state_h = (const float*)d_in[4]; p.norm_g = (const float*)d_in[5]; p.w_in = (const float*)d_in[6]; p.lambda_qk = (const float*)d_in[7];
  p.subln_g = (const float*)d_in[8]; p.rec_lb = (const float*)d_in[9]; p.rec_norm_g = (const float*)d_in[10]; p.w_out = (const float*)d_in[11];
  p.final_g = (const float*)d_in[12];
  p.out = (float*)d_out;
  char* ws = (char*)d_ws; size_t off = 0;
  auto take = [&](size_t bytes) { char* r = ws + off; off += (bytes + 255) & ~(size_t)255; return r; };
  p.WinT = (u16*)take((size_t)4096 * 1024 * 2);
  p.WoutT = (u16*)take((size_t)1024 * 1024 * 2);
  p.Xn = (u16*)take((size_t)NTOK * 1024 * 2);
  p.SbufT = p.Xn;
  p.Qb = (u16*)take((size_t)NTOK * 512 * 2);
  p.Kall = (u16*)take((size_t)KVROWS * 512 * 2);
  p.Vall = (u16*)take((size_t)KVROWS * 512 * 2);
  p.Za = (u16*)take((size_t)NTOK * 512 * 2);
  p.Qr = (u16*)take((size_t)NTOK * 512 * 2);
  p.Ir = (u16*)take((size_t)NTOK * 512 * 2);
  p.Zr = (u16*)take((size_t)NTOK * 512 * 2);
  p.Mix = (u16*)take((size_t)NTOK * 1024 * 2);
  p.Fr = (float*)take((size_t)NTOK * 512 * 4);
  p.Abuf = (float*)take((size_t)NITEM * 128 * 4);
  p.NQ = (float*)take((size_t)NITEM * 4 * 4);
  p.counter = (int*)take(256);
  p.phase_lo = 0; p.phase_hi = 6; p.rep_mask = 0; p.pad_ = 0;
  if (off > ws_size) { fprintf(stderr, "workspace too small: need %zu have %zu\n", off, ws_size); return; }
  void* args[] = {&p};
  hipError_t e = hipLaunchCooperativeKernel((void*)fwd_megakernel, dim3(grid_blocks), dim3(256), args, 0, stream);
  if (e != hipSuccess) fprintf(stderr, "cooperative launch failed: %s (grid %d)\n", hipGetErrorString(e), grid_blocks);
}
```

```cpp
#include <hip/hip_runtime.h>
#include <hip/hip_cooperative_groups.h>
#include <cstdio>
namespace cg = cooperative_groups;

#define DI __device__ __forceinline__
typedef unsigned short u16;
using bf16x8 = __attribute__((ext_vector_type(8))) short;
using s16x4  = __attribute__((ext_vector_type(4))) short;
using f32x16 = __attribute__((ext_vector_type(16))) float;
using f32x4  = __attribute__((ext_vector_type(4))) float;
using f32x2  = __attribute__((ext_vector_type(2))) float;
using u32x4  = __attribute__((ext_vector_type(4))) unsigned;
using u32x2  = __attribute__((ext_vector_type(2))) unsigned;
typedef __bf16 bf2_t __attribute__((ext_vector_type(2)));

#define MFMA(a, b, c) __builtin_amdgcn_mfma_f32_32x32x16_bf16((a), (b), (c), 0, 0, 0)

static constexpr int NTOK = 33280;
static constexpr int NPTOK = 32768;
static constexpr int KVROWS = 32768 + 8 * 1088;
static constexpr int NITEM = 2080;
static constexpr size_t OFF_Y = 0;
static constexpr size_t OFF_NKP = 34078720;
static constexpr size_t OFF_NVP = 50855936;
static constexpr size_t OFF_NHP = 67633152;
static constexpr size_t OFF_NKS = 67764224;
static constexpr size_t OFF_NVS = 68026368;
static constexpr size_t OFF_NHS = 68288512;

struct Params {
  const float *x_prompt, *x_sample, *cache_k, *cache_v, *state_h, *norm_g, *w_in, *lambda_qk, *subln_g, *rec_lb, *rec_norm_g, *w_out, *final_g;
  float* out;
  u16 *WinT, *WoutT, *Xn, *Qb, *Kall, *Vall, *Za, *Qr, *Ir, *Zr, *Mix, *SbufT;
  float *Fr, *Abuf, *NQ;
  int* counter;
  int phase_lo, phase_hi, rep_mask, pad_;
};

DI unsigned pack2(float a, float b) { f32x2 v = {a, b}; bf2_t r = __builtin_convertvector(v, bf2_t); return __builtin_bit_cast(unsigned, r); }
DI u16 f2bf(float a) { return (u16)(pack2(a, 0.f) & 0xffffu); }
DI float bflo(unsigned u) { return __uint_as_float(u << 16); }
DI float bfhi(unsigned u) { return __uint_as_float(u & 0xffff0000u); }
DI int crow(int e, int h) { return (e & 3) + 8 * (e >> 2) + 4 * h; }
DI float wave_sum(float v) {
#pragma unroll
  for (int o = 32; o >= 1; o >>= 1) v += __shfl_xor(v, o);
  return v;
}
DI float silu_f(float v) { return v / (1.f + __expf(-v)); }
DI s16x4 tr_read(const char* p) {
  return __builtin_amdgcn_ds_read_tr16_b64_v4i16((__attribute__((address_space(3))) s16x4*)(p));
}
DI bf16x8 tr_frag(const char* p0, int stride4) {
  s16x4 lo = tr_read(p0), hi = tr_read(p0 + stride4);
  return __builtin_shufflevector(lo, hi, 0, 1, 2, 3, 4, 5, 6, 7);
}
DI bf16x8 pack8(const f32x16& x, int s) {
  u32x4 p;
  p[0] = pack2(x[8 * s + 0], x[8 * s + 1]);
  p[1] = pack2(x[8 * s + 2], x[8 * s + 3]);
  p[2] = pack2(x[8 * s + 4], x[8 * s + 5]);
  p[3] = pack2(x[8 * s + 6], x[8 * s + 7]);
  return __builtin_bit_cast(bf16x8, p);
}
DI f32x16 zero16() { f32x16 z; for (int i = 0; i < 16; ++i) z[i] = 0.f; return z; }

DI void phase0(const Params& p, char* smem) {
  const int tid = threadIdx.x, lane = tid & 63, w = tid >> 6;
  constexpr int NT_W1 = 16 * 64, NT_W2 = 16 * 16, NT_ROW = NTOK / 4, NT_CACHE = 4096;
  constexpr int total = NT_W1 + NT_W2 + NT_ROW + NT_CACHE;
  float (*tile)[65] = (float (*)[65])smem;
  if (blockIdx.x == 0 && tid == 0) *p.counter = 0;
  for (int it = blockIdx.x; it < total; it += gridDim.x) {
    if (it < NT_W1 + NT_W2) {
      const float* src; u16* dst; int N, kt, nt;
      if (it < NT_W1) { src = p.w_in; dst = p.WinT; N = 4096; kt = it >> 6; nt = it & 63; }
      else { int j = it - NT_W1; src = p.w_out; dst = p.WoutT; N = 1024; kt = j >> 4; nt = j & 15; }
      const int c = tid & 63, r0 = tid >> 6;
      for (int i = 0; i < 16; ++i) { int r = r0 + 4 * i; tile[r][c] = src[(size_t)(kt * 64 + r) * N + nt * 64 + c]; }
      __syncthreads();
      if (it < NT_W1) {
        for (int i = 0; i < 16; ++i) { int r = r0 + 4 * i; dst[(size_t)(nt * 64 + r) * 1024 + kt * 64 + c] = f2bf(tile[c][r]); }
      } else {
        for (int i = 0; i < 16; ++i) {
          const int r = r0 + 4 * i, n = nt * 64 + r, k = kt * 64 + c;
          dst[((size_t)((n >> 5) * 64 + (k >> 4)) * 64 + ((k >> 3) & 1) * 32 + (n & 31)) * 8 + (k & 7)] = f2bf(tile[c][r]);
        }
      }
      __syncthreads();
    } else if (it < NT_W1 + NT_W2 + NT_ROW) {
      const int row = (it - NT_W1 - NT_W2) * 4 + w;
      const float* src = row < NPTOK ? p.x_prompt + (size_t)row * 1024 : p.x_sample + (size_t)(row - NPTOK) * 1024;
      f32x4 v[4]; float ss = 0.f;
#pragma unroll
      for (int i = 0; i < 4; ++i) { v[i] = *(const f32x4*)(src + i * 256 + lane * 4); ss += v[i][0] * v[i][0] + v[i][1] * v[i][1] + v[i][2] * v[i][2] + v[i][3] * v[i][3]; }
      ss = wave_sum(ss);
      const float sc = rsqrtf(ss * (1.f / 1024.f) + 1e-6f);
#pragma unroll
      for (int i = 0; i < 4; ++i) {
        f32x4 g = *(const f32x4*)(p.norm_g + i * 256 + lane * 4);
        u32x2 o; o[0] = pack2(v[i][0] * sc * g[0], v[i][1] * sc * g[1]); o[1] = pack2(v[i][2] * sc * g[2], v[i][3] * sc * g[3]);
        *(u32x2*)(p.Xn + (size_t)row * 1024 + i * 256 + lane * 4) = o;
      }
    } else {
      const int task = (it - NT_W1 - NT_W2 - NT_ROW) * 4 + w;
      const int which = task >> 13, rr = task & 8191;
      const float* src = (which ? p.cache_v : p.cache_k) + (size_t)rr * 512 + lane * 8;
      u16* dst = (which ? p.Vall : p.Kall) + (size_t)(NPTOK + (rr >> 10) * 1088 + (rr & 1023)) * 512 + lane * 8;
      f32x4 a = *(const f32x4*)src, b = *(const f32x4*)(src + 4);
      u32x4 o; o[0] = pack2(a[0], a[1]); o[1] = pack2(a[2], a[3]); o[2] = pack2(b[0], b[1]); o[3] = pack2(b[2], b[3]);
      *(u32x4*)dst = o;
    }
  }
}

#define G_LOAD(RA, RB, KT_)                                                                                        \
  {                                                                                                                 \
    _Pragma("unroll") for (int i_ = 0; i_ < 4; ++i_) RA[i_] = *(const u32x4*)(ap + (size_t)i_ * 64 * K + (KT_) * 32); \
    _Pragma("unroll") for (int i_ = 0; i_ < 2; ++i_) RB[i_] = *(const u32x4*)(bp + (size_t)i_ * 64 * K + (KT_) * 32); \
  }
#define G_WRITE(RA, RB, BUF_)                                                                                      \
  {                                                                                                                 \
    _Pragma("unroll") for (int i_ = 0; i_ < 4; ++i_) *(u32x4*)(wbase + (BUF_) * 30720 + i_ * 64 * 80) = RA[i_];          \
    _Pragma("unroll") for (int i_ = 0; i_ < 2; ++i_) *(u32x4*)(wbase + (BUF_) * 30720 + 20480 + i_ * 64 * 80) = RB[i_];  \
  }
#define G_COMPUTE(BUF_)                                                                                            \
  {                                                                                                                 \
    const char* as_ = smem + (BUF_) * 30720 + (wm * 128 + r) * 80 + h * 16;                                         \
    const char* bs_ = smem + (BUF_) * 30720 + 20480 + (wn * 64 + r) * 80 + h * 16;                                  \
    _Pragma("unroll") for (int s_ = 0; s_ < 2; ++s_) {                                                              \
      const bf16x8 b0_ = *(const bf16x8*)(bs_ + s_ * 32), b1_ = *(const bf16x8*)(bs_ + 32 * 80 + s_ * 32);          \
      _Pragma("unroll") for (int i_ = 0; i_ < 4; ++i_) {                                                            \
        const bf16x8 a_ = *(const bf16x8*)(as_ + i_ * 32 * 80 + s_ * 32);                                           \
        acc[i_][0] = MFMA(a_, b0_, acc[i_][0]);                                                                     \
        acc[i_][1] = MFMA(a_, b1_, acc[i_][1]);                                                                     \
      }                                                                                                             \
    }                                                                                                               \
  }
DI void gemm256(const u16* __restrict__ A, const u16* __restrict__ BT, int K, int m0, int n0, char* smem, int tid, f32x16 (&acc)[4][2]) {
  const int lane = tid & 63, w = tid >> 6, r = lane & 31, h = lane >> 5;
  const int wm = w >> 1, wn = w & 1;
#pragma unroll
  for (int i = 0; i < 4; ++i) { acc[i][0] = zero16(); acc[i][1] = zero16(); }
  u32x4 ra0[4], rb0[2], ra1[4], rb1[2];
  const int KT = K >> 5;
  const u16* ap = A + (size_t)(m0 + (tid >> 2)) * K + (tid & 3) * 8;
  const u16* bp = BT + (size_t)(n0 + (tid >> 2)) * K + (tid & 3) * 8;
  char* wbase = smem + (tid >> 2) * 80 + (tid & 3) * 16;
  G_LOAD(ra0, rb0, 0);
  G_LOAD(ra1, rb1, 1);
  G_WRITE(ra0, rb0, 0);
  __syncthreads();
  for (int kt = 0; kt < KT; kt += 2) {
    { const int k2 = kt + 2 < KT ? kt + 2 : KT - 1; G_LOAD(ra0, rb0, k2); }
    __builtin_amdgcn_sched_barrier(0);
    G_COMPUTE(0);
    __builtin_amdgcn_sched_barrier(0);
    G_WRITE(ra1, rb1, 1);
    __syncthreads();
    { const int k3 = kt + 3 < KT ? kt + 3 : KT - 1; G_LOAD(ra1, rb1, k3); }
    __builtin_amdgcn_sched_barrier(0);
    G_COMPUTE(1);
    __builtin_amdgcn_sched_barrier(0);
    G_WRITE(ra0, rb0, 0);
    __syncthreads();
  }
}
struct TileMap {
  int MT, NT, C, NG, NST, st, lb, lin;
  bool xcd;
  DI TileMap(int mt_, int nt_) : MT(mt_), NT(nt_) {
    const int nb = gridDim.x >> 3;
    C = nb >> 3;
    xcd = (gridDim.x & 63) == 0 && C > 0 && (NT % C) == 0;
    NG = xcd ? NT / C : 1;
    NST = ((MT + 7) >> 3) * NG;
    st = blockIdx.x & 7; lb = blockIdx.x >> 3; lin = blockIdx.x;
  }
  DI bool next(int& mt, int& nt) {
    if (!xcd) {
      if (lin >= MT * NT) return false;
      mt = lin / NT; nt = lin - mt * NT; lin += gridDim.x; return true;
    }
    while (st < NST) {
      const int mg = st / NG, ng = st - mg * NG;
      mt = mg * 8 + lb / C; nt = ng * C + lb % C;
      st += 8;
      if (mt < MT) return true;
    }
    return false;
  }
};
DI void stage_half(const f32x16 (&acc)[4][2], float* cs, int half, int wm, int wn, int r, int h) {
  if (wm == half) {
#pragma unroll
    for (int i = 0; i < 4; ++i)
#pragma unroll
      for (int j = 0; j < 2; ++j)
#pragma unroll
        for (int e = 0; e < 16; ++e) cs[(i * 32 + crow(e, h)) * 132 + wn * 64 + j * 32 + r] = acc[i][j][e];
  }
}

DI void phase1(const Params& p, char* smem) {
  const int tid = threadIdx.x, lane = tid & 63, w = tid >> 6, r = lane & 31, h = lane >> 5;
  const int wm = w >> 1, wn = w & 1;
  constexpr int MT = NTOK / 256, NT = 32;
  TileMap tm(MT, NT);
  int mt, nt;
  while (tm.next(mt, nt)) {
    const int m0 = mt * 256, n0 = nt * 128;
    f32x16 acc[4][2];
    gemm256(p.Xn, p.WinT, 1024, m0, n0, smem, tid, acc);
    const int sec = n0 >> 9;
    const bool samp = m0 >= NPTOK;
    float* cs = (float*)smem;
    const int c0 = (tid & 15) * 8, rb = tid >> 4;
    const int csc = (n0 & 511) + c0;
#pragma unroll 1
    for (int half = 0; half < 2; ++half) {
      stage_half(acc, cs, half, wm, wn, r, h);
      __syncthreads();
#pragma unroll 2
      for (int ps = 0; ps < 8; ++ps) {
        const int row = rb + 16 * ps;
        const int t = m0 + half * 128 + row;
        f32x4 va = *(const f32x4*)(cs + row * 132 + c0), vb = *(const f32x4*)(cs + row * 132 + c0 + 4);
        const size_t o512 = (size_t)t * 512 + csc;
        if (sec == 5) { *(f32x4*)(p.Fr + o512) = va; *(f32x4*)(p.Fr + o512 + 4) = vb; }
        else {
          u16* dst;
          if (sec == 0) {
            const float qs = 0.125f * 1.44269504089f;
            va *= qs; vb *= qs; dst = p.Qb + o512;
          } else if (sec == 1 || sec == 2) {
            size_t kvr; float* od;
            if (!samp) { kvr = t; od = p.out + (sec == 1 ? OFF_NKP : OFF_NVP) + o512; }
            else { const int ts = t - NPTOK; kvr = NPTOK + (ts >> 6) * 1088 + 1024 + (ts & 63); od = p.out + (sec == 1 ? OFF_NKS : OFF_NVS) + (size_t)ts * 512 + csc; }
            *(f32x4*)od = va; *(f32x4*)(od + 4) = vb;
            dst = (sec == 1 ? p.Kall : p.Vall) + kvr * 512 + csc;
          } else if (sec == 6) { dst = p.Ir + o512; }
          else {
#pragma unroll
            for (int i = 0; i < 4; ++i) { va[i] = silu_f(va[i]); vb[i] = silu_f(vb[i]); }
            dst = (sec == 3 ? p.Za : (sec == 4 ? p.Qr : p.Zr)) + o512;
          }
          u32x4 o; o[0] = pack2(va[0], va[1]); o[1] = pack2(va[2], va[3]); o[2] = pack2(vb[0], vb[1]); o[3] = pack2(vb[2], vb[3]);
          *(u32x4*)dst = o;
        }
      }
      __syncthreads();
    }
  }
}

DI void rec_pre(const Params& p, int tid, int I, float* totS, float (&cum)[32], float (&key)[32], float& lastv) {
  const int d = tid & 127, half = tid >> 7;
  const int hd = I & 3, t0 = (I >> 2) * 64;
  const float r0 = p.rec_lb[hd * 128 + d], r1 = p.rec_lb[512 + hd * 128 + d];
  const float lb = 1.f / (1.f + __expf(r1 - r0));
  const float* fp = p.Fr + (size_t)(t0 + half * 32) * 512 + hd * 128 + d;
  float run = 0.f;
#pragma unroll
  for (int i = 0; i < 32; ++i) {
    float x = fp[(size_t)i * 512];
    x = fminf(fmaxf(x, -30.f), 30.f);
    const float e = __expf(-x), sg = 1.f / (1.f + e);
    run += __logf(lb + (1.f - lb) * sg);
    cum[i] = run; key[i] = (1.f - lb) * e * sg;
  }
  totS[tid] = run;
  __syncthreads();
  const float tot0 = totS[d], tot1 = totS[128 + d];
  if (half) {
#pragma unroll
    for (int i = 0; i < 32; ++i) cum[i] += tot0;
  }
  lastv = tot0 + tot1;
}

DI void phase2(const Params& p, char* smem, float* BbufT) {
  const int tid = threadIdx.x, lane = tid & 63, w = tid >> 6, r = lane & 31, h = lane >> 5;
  const int q = (lane & 15) >> 2, pp = lane & 3, blk = (lane >> 4) & 1;
  const int d = tid & 127, half = tid >> 7;
  char* KdI = smem; char* VrI = smem + 17408; float* totS = (float*)(smem + 60000);
  for (int I = blockIdx.x; I < NITEM; I += gridDim.x) {
    const int hd = I & 3, t0 = (I >> 2) * 64;
    if (I < 2048) {
      const int token = tid & 63, which = tid >> 6;
      const u16* src = (which < 2 ? p.Qb : p.Kall) + (size_t)(t0 + token) * 512 + hd * 128 + (which & 1) * 64;
      float ss = 0.f;
#pragma unroll
      for (int c = 0; c < 8; ++c) {
        const u32x4 v = *(const u32x4*)(src + c * 8);
#pragma unroll
        for (int i = 0; i < 4; ++i) { const float lo = bflo(v[i]), hi = bfhi(v[i]); ss += lo * lo + hi * hi; }
      }
#pragma unroll
      for (int o = 32; o >= 1; o >>= 1) ss = fmaxf(ss, __shfl_xor(ss, o));
      if (lane == 0) p.NQ[I * 4 + which] = sqrtf(ss);
    }
    float cum[32], key[32], lastv;
    rec_pre(p, tid, I, totS, cum, key, lastv);
#pragma unroll
    for (int i = 0; i < 32; ++i) {
      const int t = half * 32 + i;
      *(u16*)(KdI + t * 272 + d * 2) = f2bf(key[i] * __expf(lastv - cum[i]));
    }
#pragma unroll
    for (int i = 0; i < 4; ++i) {
      const int ch = tid + 256 * i, row = ch >> 4, cc = ch & 15;
      *(u32x4*)(VrI + row * 272 + cc * 16) = *(const u32x4*)(p.Ir + (size_t)(t0 + row) * 512 + hd * 128 + cc * 8);
    }
    if (half) p.Abuf[I * 128 + d] = __expf(lastv);
    __syncthreads();
    f32x16 acc[4];
#pragma unroll
    for (int ct = 0; ct < 4; ++ct) acc[ct] = zero16();
#pragma unroll
    for (int ks = 0; ks < 4; ++ks) {
      const int rowoff = (16 * ks + 8 * h + q) * 272 + 32 * blk + 8 * pp;
      bf16x8 a = tr_frag(VrI + rowoff + 64 * w, 4 * 272);
#pragma unroll
      for (int ct = 0; ct < 4; ++ct) {
        bf16x8 b = tr_frag(KdI + rowoff + 64 * ct, 4 * 272);
        acc[ct] = MFMA(a, b, acc[ct]);
      }
    }
    float* ob = BbufT + (size_t)I * 16384;
#pragma unroll
    for (int ct = 0; ct < 4; ++ct)
#pragma unroll
      for (int e = 0; e < 16; ++e) ob[(32 * w + crow(e, h)) * 128 + 32 * ct + r] = acc[ct][e];
    __syncthreads();
  }
}

DI void phase3(const Params& p, const float* BbufT) {
  const int tid = threadIdx.x;
  for (int it = blockIdx.x; it < 512 + 1024; it += gridDim.x) {
    if (it < 512) {
      const int bh = it >> 6, b = bh >> 2, hd = bh & 3;
      const int e1 = (it & 63) * 256 + tid, v = e1 >> 7, d = e1 & 127;
      float sx = 0.f;
      const size_t eo = (size_t)v * 128 + d;
      const int I0 = (b * 256) * 4 + hd;
      const float* ap = p.Abuf + (size_t)I0 * 128 + d;
      const float* bp = BbufT + (size_t)I0 * 16384 + eo;
      u16* sp = p.SbufT + (size_t)I0 * 16384 + eo;
#pragma unroll 16
      for (int c = 0; c < 256; ++c) {
        const float a = ap[(size_t)c * 4 * 128];
        const float bv = bp[(size_t)c * 4 * 16384];
        sp[(size_t)c * 4 * 16384] = f2bf(sx);
        sx = a * sx + bv;
      }
      p.out[OFF_NHP + (size_t)(b * 4 + hd) * 16384 + d * 128 + v] = sx;
    } else {
      const int j = it - 512;
      const int sh = j >> 5, bs = sh >> 2, hd = sh & 3;
      const int e2 = (j & 31) * 256 + tid, v = e2 >> 6, d2 = (e2 & 63) * 2;
      const int I = (512 + bs) * 4 + hd;
      const float* sh0 = p.state_h + (size_t)(bs * 4 + hd) * 16384;
      float sx = sh0[d2 * 128 + v], sy = sh0[(d2 + 1) * 128 + v];
      const size_t eo = (size_t)v * 128 + d2;
      const f32x2 a = *(const f32x2*)(p.Abuf + I * 128 + d2);
      const f32x2 bv = *(const f32x2*)(BbufT + (size_t)I * 16384 + eo);
      *(unsigned*)(p.SbufT + (size_t)I * 16384 + eo) = pack2(sx, sy);
      sx = a[0] * sx + bv[0]; sy = a[1] * sy + bv[1];
      float* oh = p.out + OFF_NHS + (size_t)(bs * 4 + hd) * 16384;
      oh[d2 * 128 + v] = sx; oh[(d2 + 1) * 128 + v] = sy;
    }
  }
}

DI void r3_item(const Params& p, char* smem, int tid, int I) {
  const int lane = tid & 63, w = tid >> 6, r = lane & 31, h = lane >> 5;
  const int q = (lane & 15) >> 2, pp = lane & 3, blk = (lane >> 4) & 1;
  const int d = tid & 127, half = tid >> 7;
  char* QdI = smem; char* KdI = smem + 17408; char* VrI = smem + 34816;
  float* totS = (float*)(smem + 60000); float* ssS = (float*)(smem + 62048);
  const int hd = I & 3, t0 = (I >> 2) * 64;
  {
    float cum[32], key[32], lastv;
    rec_pre(p, tid, I, totS, cum, key, lastv);
    const u16* qp = p.Qr + (size_t)(t0 + half * 32) * 512 + hd * 128 + d;
#pragma unroll
    for (int i = 0; i < 32; ++i) {
      const int t = half * 32 + i;
      const float qv = bflo(qp[(size_t)i * 512]);
      *(u16*)(QdI + t * 272 + d * 2) = f2bf(qv * __expf(cum[i]));
      *(u16*)(KdI + t * 272 + d * 2) = f2bf(key[i] * __expf(-cum[i]));
    }
  }
#pragma unroll
  for (int i = 0; i < 4; ++i) {
    const int ch = tid + 256 * i, row = ch >> 4, cc = ch & 15;
    *(u32x4*)(VrI + row * 272 + cc * 16) = *(const u32x4*)(p.Ir + (size_t)(t0 + row) * 512 + hd * 128 + cc * 8);
  }
  __syncthreads();
  const int tt = w & 1, vh = w >> 1;
  bf16x8 qf[8];
#pragma unroll
  for (int ks = 0; ks < 8; ++ks) qf[ks] = *(const bf16x8*)(QdI + (32 * tt + r) * 272 + ks * 32 + h * 16);
  f32x16 sc[2]; sc[0] = zero16(); sc[1] = zero16();
#pragma unroll
  for (int ks = 0; ks < 8; ++ks) {
    bf16x8 a0 = *(const bf16x8*)(KdI + r * 272 + ks * 32 + h * 16);
    sc[0] = MFMA(a0, qf[ks], sc[0]);
  }
  if (tt == 1) {
#pragma unroll
    for (int ks = 0; ks < 8; ++ks) {
      bf16x8 a1 = *(const bf16x8*)(KdI + (32 + r) * 272 + ks * 32 + h * 16);
      sc[1] = MFMA(a1, qf[ks], sc[1]);
    }
  }
#pragma unroll
  for (int e = 0; e < 16; ++e) {
    const bool keep = crow(e, h) <= r;
    if (tt == 0) { if (!keep) sc[0][e] = 0.f; }
    else { if (!keep) sc[1][e] = 0.f; }
  }
  bf16x8 pf[4];
  pf[0] = pack8(sc[0], 0); pf[1] = pack8(sc[0], 1); pf[2] = pack8(sc[1], 0); pf[3] = pack8(sc[1], 1);
  f32x16 o[2]; o[0] = zero16(); o[1] = zero16();
  const u16* sp = p.SbufT + (size_t)I * 16384;
#pragma unroll
  for (int vi = 0; vi < 2; ++vi) {
    const int vt = 2 * vh + vi;
#pragma unroll
    for (int k4 = 0; k4 < 4; ++k4) {
      if (k4 < 2 || tt == 1) {
        bf16x8 a = tr_frag(VrI + (16 * k4 + 4 * h + q) * 272 + (32 * vt + 16 * blk) * 2 + 8 * pp, 8 * 272);
        o[vi] = MFMA(a, pf[k4], o[vi]);
      }
    }
#pragma unroll
    for (int ks = 0; ks < 8; ++ks) {
      bf16x8 a = *(const bf16x8*)(sp + (size_t)(32 * vt + r) * 128 + ks * 16 + h * 8);
      o[vi] = MFMA(a, qf[ks], o[vi]);
    }
  }
  float ss = 0.f;
#pragma unroll
  for (int vi = 0; vi < 2; ++vi)
#pragma unroll
    for (int e = 0; e < 16; ++e) ss += o[vi][e] * o[vi][e];
  ss += __shfl_xor(ss, 32);
  if (h == 0) ssS[w * 32 + r] = ss;
  __syncthreads();
  const float tot = ssS[tt * 32 + r] + ssS[(tt + 2) * 32 + r];
  const float rs = rsqrtf(tot * (1.f / 128.f) + 1e-6f);
  const int tok = t0 + 32 * tt + r;
#pragma unroll
  for (int vi = 0; vi < 2; ++vi)
#pragma unroll
    for (int g = 0; g < 4; ++g) {
      const int v = 32 * (2 * vh + vi) + 8 * g + 4 * h;
      const f32x4 gg = *(const f32x4*)(p.rec_norm_g + v);
      const u32x2 z = *(const u32x2*)(p.Zr + (size_t)tok * 512 + hd * 128 + v);
      u32x2 ov;
      ov[0] = pack2(o[vi][4 * g + 0] * rs * gg[0] * bflo(z[0]), o[vi][4 * g + 1] * rs * gg[1] * bfhi(z[0]));
      ov[1] = pack2(o[vi][4 * g + 2] * rs * gg[2] * bflo(z[1]), o[vi][4 * g + 3] * rs * gg[3] * bfhi(z[1]));
      *(u32x2*)(p.Mix + (size_t)tok * 1024 + 512 + hd * 128 + v) = ov;
    }
  __syncthreads();
}

template <bool DIAG>
DI void attn_tile_a(const char* ks, const bf16x8 (&qf)[4], f32x16 (&O)[4], bf16x8 (&pf)[4], float& mrun, float& lsum, float sl2, float qrel,
                    int m, int r, int h2) {
  f32x16 S[2];
#pragma unroll
  for (int st = 0; st < 2; ++st) {
    S[st] = zero16();
#pragma unroll
    for (int s = 0; s < 4; ++s) {
      bf16x8 a = *(const bf16x8*)(ks + (32 * st + r) * 272 + m * 128 + s * 32 + h2 * 16);
      S[st] = MFMA(a, qf[s], S[st]);
    }
  }
  float mx = -1e30f;
#pragma unroll
  for (int st = 0; st < 2; ++st)
#pragma unroll
    for (int e = 0; e < 16; ++e) {
      const float cst = (float)(32 * st + (e & 3) + 8 * (e >> 2));
      float sv;
      if (DIAG) sv = fmaf(-sl2, fabsf(qrel - cst), S[st][e]);
      else sv = fmaf(sl2, cst, S[st][e]);
      S[st][e] = sv; mx = fmaxf(mx, sv);
    }
  const float L = DIAG ? 0.f : -sl2 * qrel;
  mx += L;
  mx = fmaxf(mx, __shfl_xor(mx, 32));
  if (__builtin_amdgcn_ballot_w64(mx > mrun + 6.f) != 0) {
    const float mnew = fmaxf(mrun, mx);
    const float alpha = __builtin_amdgcn_exp2f(mrun - mnew);
    mrun = mnew; lsum *= alpha;
#pragma unroll
    for (int vt = 0; vt < 4; ++vt)
#pragma unroll
      for (int e = 0; e < 16; ++e) O[vt][e] *= alpha;
  }
  const float off = L - mrun;
  float rs = 0.f;
#pragma unroll
  for (int st = 0; st < 2; ++st)
#pragma unroll
    for (int e = 0; e < 16; ++e) { const float pv = __builtin_amdgcn_exp2f(S[st][e] + off); S[st][e] = pv; rs += pv; }
  lsum += rs;
  pf[0] = pack8(S[0], 0); pf[1] = pack8(S[0], 1); pf[2] = pack8(S[1], 0); pf[3] = pack8(S[1], 1);
}
DI void attn_tile_b(const char* vs, const bf16x8 (&pf)[4], f32x16 (&O)[4], int h2, int q, int pp, int blk) {
#pragma unroll
  for (int k4 = 0; k4 < 4; ++k4) {
    const char* vb = vs + (16 * k4 + 4 * h2 + q) * 272 + 32 * blk + 8 * pp;
#pragma unroll
    for (int vt = 0; vt < 4; ++vt) {
      bf16x8 a = tr_frag(vb + 64 * vt, 8 * 272);
      O[vt] = MFMA(a, pf[k4], O[vt]);
    }
    __builtin_amdgcn_sched_barrier(0);
  }
}

DI void attn_item(const Params& p, char* smem, int tid, int tq0, int qpos0, int kvbase, int ntb, int hd, float lam, bool can_skip) {
  const int lane = tid & 63, w = tid >> 6, r = lane & 31, h2 = lane >> 5;
  const int q = (lane & 15) >> 2, pp = lane & 3, blk = (lane >> 4) & 1;
  const int qh = w & 1, m = w >> 1;
  const float sl2 = exp2f(-2.f * (float)(hd + 1)) * 1.44269504089f;
  const int qtok = tq0 + 32 * qh + r;
  const float qposf = (float)(qpos0 + 32 * qh + r);
  int kt0w = 0, kt0b = 0;
  if (can_skip) {
    const int I0 = (tq0 >> 6) * 4 + hd;
    const int crk = kvbase >> 6;
    int k0[2];
#pragma unroll
    for (int mm = 0; mm < 2; ++mm) {
      const float QN = p.NQ[I0 * 4 + mm];
      float KN = 0.f;
      for (int c = lane; c < ntb; c += 64) KN = fmaxf(KN, p.NQ[((crk + c) * 4 + hd) * 4 + 2 + mm]);
#pragma unroll
      for (int o = 32; o >= 1; o >>= 1) KN = fmaxf(KN, __shfl_xor(KN, o));
      const float D = (2.02f * QN * KN + 130.f) / sl2;
      const float f = ((float)(qpos0 - 63) - D) * (1.f / 64.f);
      k0[mm] = f < 0.f ? 0 : (int)f + 1;
    }
    kt0w = m ? k0[1] : k0[0];
    kt0b = k0[0] < k0[1] ? k0[0] : k0[1];
  }
  bf16x8 qf[4];
#pragma unroll
  for (int s = 0; s < 4; ++s) qf[s] = *(const bf16x8*)(p.Qb + (size_t)qtok * 512 + hd * 128 + m * 64 + 16 * s + 8 * h2);
  f32x16 O[4];
#pragma unroll
  for (int vt = 0; vt < 4; ++vt) O[vt] = zero16();
  float mrun = -1e30f, lsum = 0.f;
  u32x4 rk[4], rv[4];
  const int lrow = tid >> 4, lcc = tid & 15;
  const size_t gofs = (size_t)(kvbase + lrow) * 512 + hd * 128 + lcc * 8;
  const u16* kp = p.Kall + gofs;
  const u16* vp = p.Vall + gofs;
  char* kw = smem + lrow * 272 + lcc * 16;
  const int nit = ntb - kt0b;
  {
    const size_t go = (size_t)(ntb - 1) * 64 * 512;
#pragma unroll
    for (int i = 0; i < 4; ++i) { rk[i] = *(const u32x4*)(kp + go + (size_t)i * 16 * 512); rv[i] = *(const u32x4*)(vp + go + (size_t)i * 16 * 512); }
#pragma unroll
    for (int i = 0; i < 4; ++i) { *(u32x4*)(kw + i * 16 * 272) = rk[i]; *(u32x4*)(kw + 17408 + i * 16 * 272) = rv[i]; }
    const int k1 = ntb - 2 > kt0b ? ntb - 2 : kt0b;
    const size_t g1 = (size_t)k1 * 64 * 512;
#pragma unroll
    for (int i = 0; i < 4; ++i) { rk[i] = *(const u32x4*)(kp + g1 + (size_t)i * 16 * 512); rv[i] = *(const u32x4*)(vp + g1 + (size_t)i * 16 * 512); }
  }
  __syncthreads();
  for (int it = 0; it < nit; ++it) {
    const int kt = ntb - 1 - it;
    const bool active = kt >= kt0w;
    const char* ks = smem + (it & 1) * 34816;
    char* wb = kw + ((it + 1) & 1) * 34816;
#pragma unroll
    for (int i = 0; i < 4; ++i) { *(u32x4*)(wb + i * 16 * 272) = rk[i]; *(u32x4*)(wb + 17408 + i * 16 * 272) = rv[i]; }
    {
      const int k2 = kt - 2 > kt0b ? kt - 2 : kt0b;
      const size_t g2 = (size_t)k2 * 64 * 512;
#pragma unroll
      for (int i = 0; i < 4; ++i) { rk[i] = *(const u32x4*)(kp + g2 + (size_t)i * 16 * 512); rv[i] = *(const u32x4*)(vp + g2 + (size_t)i * 16 * 512); }
    }
    __builtin_amdgcn_sched_barrier(0);
    if (active) {
      bf16x8 pf[4];
      const float qrel = qposf - (float)(kt * 64 + 4 * h2);
      if (it == 0) attn_tile_a<true>(ks, qf, O, pf, mrun, lsum, sl2, qrel, m, r, h2);
      else attn_tile_a<false>(ks, qf, O, pf, mrun, lsum, sl2, qrel, m, r, h2);
      attn_tile_b(ks + 17408, pf, O, h2, q, pp, blk);
    }
    __syncthreads();
  }
  const float lt = lsum + __shfl_xor(lsum, 32);
  const float inv = 1.f / lt;
  float* exch = (float*)smem + qh * 4096 + lane;
  if (m == 1) {
#pragma unroll
    for (int vt = 0; vt < 4; ++vt)
#pragma unroll
      for (int e = 0; e < 16; ++e) exch[(vt * 16 + e) * 64] = O[vt][e] * inv;
  }
  __syncthreads();
  if (m == 0) {
    float ss = 0.f;
#pragma unroll
    for (int vt = 0; vt < 4; ++vt)
#pragma unroll
      for (int e = 0; e < 16; ++e) { const float ov = O[vt][e] * inv - lam * exch[(vt * 16 + e) * 64]; O[vt][e] = ov; ss += ov * ov; }
    ss += __shfl_xor(ss, 32);
    const float rsn = rsqrtf(ss * (1.f / 128.f) + 1e-6f) * 0.8f;
#pragma unroll
    for (int vt = 0; vt < 4; ++vt)
#pragma unroll
      for (int g = 0; g < 4; ++g) {
        const int v = 32 * vt + 8 * g + 4 * h2;
        const f32x4 gg = *(const f32x4*)(p.subln_g + v);
        const u32x2 z = *(const u32x2*)(p.Za + (size_t)qtok * 512 + hd * 128 + v);
        u32x2 ov;
        ov[0] = pack2(O[vt][4 * g + 0] * rsn * gg[0] * bflo(z[0]), O[vt][4 * g + 1] * rsn * gg[1] * bfhi(z[0]));
        ov[1] = pack2(O[vt][4 * g + 2] * rsn * gg[2] * bflo(z[1]), O[vt][4 * g + 3] * rsn * gg[3] * bfhi(z[1]));
        *(u32x2*)(p.Mix + (size_t)qtok * 1024 + hd * 128 + v) = ov;
      }
  }
  __syncthreads();
}

DI void phase4(const Params& p, char* smem) {
  const int tid = threadIdx.x, lane = tid & 63;
  float lam;
  {
    const float a = p.lambda_qk[lane] * p.lambda_qk[64 + lane];
    const float b = p.lambda_qk[128 + lane] * p.lambda_qk[192 + lane];
    lam = __expf(wave_sum(a)) - __expf(wave_sum(b)) + 0.2f;
  }
  int* sitem = (int*)(smem + 73712);
  constexpr int NPA = 2048, NSA = 32, TOTAL = NPA + NSA + NITEM;
  for (;;) {
    if (tid == 0) *sitem = atomicAdd(p.counter, 1);
    __syncthreads();
    const int item = *sitem;
    __syncthreads();
    if (item >= TOTAL) break;
    int tid_o = tid;
    asm volatile("" : "+v"(tid_o));
    if (item < NPA + NSA) {
      int tq0, qpos0, kvbase, ntb, hd; bool can_skip;
      if (item < NPA) {
        const int qb = 255 - ((item & 511) >> 1), b = item & 1;
        hd = 3 - (item >> 9); tq0 = b * 16384 + qb * 64; qpos0 = qb * 64; kvbase = b * 16384; ntb = qb + 1; can_skip = true;
      } else {
        const int it = item - NPA, bs = it >> 2;
        hd = it & 3; tq0 = NPTOK + bs * 64; qpos0 = 1024; kvbase = NPTOK + bs * 1088; ntb = 17; can_skip = false;
      }
      attn_item(p, smem, tid_o, tq0, qpos0, kvbase, ntb, hd, lam, can_skip);
    } else {
      r3_item(p, smem, tid_o, item - NPA - NSA);
    }
  }
}

DI void phase5(const Params& p, char* smem) {
  float* wsum = (float*)(smem + 66048);
  for (int strip = blockIdx.x; strip < NTOK / 32; strip += gridDim.x) {
    int tid = threadIdx.x;
    asm volatile("" : "+v"(tid));
    const int lane = tid & 63, w = tid >> 6, r = lane & 31, h = lane >> 5;
    const int m0 = strip * 32;
#pragma unroll
    for (int i = 0; i < 16; ++i) {
      const int ch = tid + 256 * i, row = ch >> 7, cc = ch & 127;
      *(u32x4*)(smem + row * 2064 + cc * 16) = *(const u32x4*)(p.Mix + (size_t)(m0 + row) * 1024 + cc * 8);
    }
    f32x16 acc[8];
#pragma unroll
    for (int j = 0; j < 8; ++j) acc[j] = zero16();
    const u16* bp = p.WoutT + (size_t)(w * 8) * 64 * 512 + lane * 8;
    bf16x8 b0[8], b1[8];
#pragma unroll
    for (int j = 0; j < 8; ++j) { b0[j] = *(const bf16x8*)(bp + (size_t)(j * 64 + 0) * 512); b1[j] = *(const bf16x8*)(bp + (size_t)(j * 64 + 1) * 512); }
    __syncthreads();
    const char* ap = smem + r * 2064 + h * 16;
    for (int ks = 0; ks < 64; ks += 2) {
      {
        const bf16x8 a = *(const bf16x8*)(ap + ks * 32);
#pragma unroll
        for (int j = 0; j < 8; ++j) acc[j] = MFMA(a, b0[j], acc[j]);
        const int k2 = ks + 2 < 64 ? ks + 2 : 63;
#pragma unroll
        for (int j = 0; j < 8; ++j) b0[j] = *(const bf16x8*)(bp + (size_t)(j * 64 + k2) * 512);
      }
      __builtin_amdgcn_sched_barrier(0);
      {
        const bf16x8 a = *(const bf16x8*)(ap + (ks + 1) * 32);
#pragma unroll
        for (int j = 0; j < 8; ++j) acc[j] = MFMA(a, b1[j], acc[j]);
        const int k3 = ks + 3 < 64 ? ks + 3 : 63;
#pragma unroll
        for (int j = 0; j < 8; ++j) b1[j] = *(const bf16x8*)(bp + (size_t)(j * 64 + k3) * 512);
      }
      __builtin_amdgcn_sched_barrier(0);
    }
    const float* xs_u = (m0 < NPTOK ? p.x_prompt : p.x_sample - (size_t)NPTOK * 1024) + (size_t)m0 * 1024;
    const int lane_off = h * 4096 + w * 256 + r;
    float ps[16];
#pragma unroll
    for (int e = 0; e < 16; ++e) ps[e] = 0.f;
#pragma unroll
    for (int j = 0; j < 8; ++j) {
#pragma unroll
      for (int e = 0; e < 16; ++e) {
        const float hv = acc[j][e] + (xs_u + ((e & 3) + 8 * (e >> 2)) * 1024 + j * 32)[lane_off];
        acc[j][e] = hv; ps[e] += hv * hv;
      }
      __builtin_amdgcn_sched_barrier(0);
    }
#pragma unroll
    for (int e = 0; e < 16; ++e) {
#pragma unroll
      for (int o = 16; o >= 1; o >>= 1) ps[e] += __shfl_xor(ps[e], o);
    }
    if (r == 0) {
#pragma unroll
      for (int e = 0; e < 16; ++e) wsum[w * 32 + crow(e, h)] = ps[e];
    }
    __syncthreads();
#pragma unroll
    for (int e = 0; e < 16; ++e) {
      const int rw = crow(e, h);
      ps[e] = rsqrtf((wsum[rw] + wsum[32 + rw] + wsum[64 + rw] + wsum[96 + rw]) * (1.f / 1024.f) + 1e-6f);
    }
    float* yo_u = p.out + OFF_Y + (size_t)m0 * 1024;
#pragma unroll
    for (int j = 0; j < 8; ++j) {
      const float g = (p.final_g + j * 32)[w * 256 + r];
#pragma unroll
      for (int e = 0; e < 16; ++e) (yo_u + ((e & 3) + 8 * (e >> 2)) * 1024 + j * 32)[lane_off] = acc[j][e] * ps[e] * g;
      __builtin_amdgcn_sched_barrier(0);
    }
    __syncthreads();
  }
}

__global__ void __launch_bounds__(256, 2) fwd_megakernel(Params p) {
  __shared__ __attribute__((aligned(16))) char smem[73728];
  cg::grid_group grid = cg::this_grid();
  float* scratch_out = p.out + OFF_Y;
  const int lo = p.phase_lo, hi = p.phase_hi, rm = p.rep_mask;
  if (lo <= 0 && hi >= 0) phase0(p, smem);
  if (rm & 1) { grid.sync(); phase0(p, smem); }
  if (lo <= 0 && hi >= 1) grid.sync();
  if (lo <= 1 && hi >= 1) phase1(p, smem);
  if (rm & 2) { grid.sync(); phase1(p, smem); }
  if (lo <= 1 && hi >= 2) grid.sync();
  if (lo <= 2 && hi >= 2) phase2(p, smem, scratch_out);
  if (rm & 4) { grid.sync(); phase2(p, smem, scratch_out); }
  if (lo <= 2 && hi >= 3) grid.sync();
  if (lo <= 3 && hi >= 3) phase3(p, scratch_out);
  if (rm & 8) { grid.sync(); phase3(p, scratch_out); }
  if (lo <= 3 && hi >= 4) grid.sync();
  if (lo <= 4 && hi >= 4) phase4(p, smem);
  if (lo <= 4 && hi >= 5) grid.sync();
  if (lo <= 5 && hi >= 5) phase5(p, smem);
}

extern "C" void kernel_launch(void* const* d_in, const int* in_sizes, int n_in, void* d_out, int out_size, void* d_ws, size_t ws_size,
                              hipStream_t stream) {
  static int grid_blocks = 0;
  if (!grid_blocks) {
    int dev = 0, cus = 0, per_cu = 0;
    hipGetDevice(&dev);
    hipDeviceGetAttribute(&cus, hipDeviceAttributeMultiprocessorCount, dev);
    hipOccupancyMaxActiveBlocksPerMultiprocessor(&per_cu, fwd_megakernel, 256, 0);
    if (per_cu > 2) per_cu = 2;
    if (per_cu < 1) per_cu = 1;
    grid_blocks = cus * per_cu;
  }
  Params p{};
  p.x_prompt = (const float*)d_in[0]; p.x_sample = (const float*)d_in[1]; p.cache_k = (const float*)d_in[2]; p.cache_v = (const float*)d_in[3];
  p.state_h = (const float*)d_in[4]; p.norm_g = (const float*)d_in[5]; p.w_in = (const float*)d_in[6]; p.lambda_qk = (const float*)d_in[7];
  p.subln_g = (const float*)d_in[8]; p.rec_lb = (const float*)d_in[9]; p.rec_norm_g = (const float*)d_in[10]; p.w_out = (const float*)d_in[11];
  p.final_g = (const float*)d_in[12];
  p.out = (float*)d_out;
  char* ws = (char*)d_ws; size_t off = 0;
  auto take = [&](size_t bytes) { char* r = ws + off; off += (bytes + 255) & ~(size_t)255; return r; };
  p.WinT = (u16*)take((size_t)4096 * 1024 * 2);
  p.WoutT = (u16*)take((size_t)1024 * 1024 * 2);
  p.Xn = (u16*)take((size_t)NTOK * 1024 * 2);
  p.SbufT = p.Xn;
  p.Qb = (u16*)take((size_t)NTOK * 512 * 2);
  p.Kall = (u16*)take((size_t)KVROWS * 512 * 2);
  p.Vall = (u16*)take((size_t)KVROWS * 512 * 2);
  p.Za = (u16*)take((size_t)NTOK * 512 * 2);
  p.Qr = (u16*)take((size_t)NTOK * 512 * 2);
  p.Ir = (u16*)take((size_t)NTOK * 512 * 2);
  p.Zr = (u16*)take((size_t)NTOK * 512 * 2);
  p.Mix = (u16*)take((size_t)NTOK * 1024 * 2);
  p.Fr = (float*)take((size_t)NTOK * 512 * 4);
  p.Abuf = (float*)take((size_t)NITEM * 128 * 4);
  p.NQ = (float*)take((size_t)NITEM * 4 * 4);
  p.counter = (int*)take(256);
  p.phase_lo = 0; p.phase_hi = 6; p.rep_mask = 0; p.pad_ = 0;
  if (off > ws_size) { fprintf(stderr, "workspace too small: need %zu have %zu\n", off, ws_size); return; }
  void* args[] = {&p};
  hipError_t e = hipLaunchCooperativeKernel((void*)fwd_megakernel, dim3(grid_blocks), dim3(256), args, 0, stream);
  if (e != hipSuccess) fprintf(stderr, "cooperative launch failed: %s (grid %d)\n", hipGetErrorString(e), grid_blocks);
}
```

```cpp
#include <hip/hip_runtime.h>
#include <hip/hip_cooperative_groups.h>
#include <cstdio>
namespace cg = cooperative_groups;

#define DI __device__ __forceinline__
typedef unsigned short u16;
using bf16x8 = __attribute__((ext_vector_type(8))) short;
using s16x4  = __attribute__((ext_vector_type(4))) short;
using f32x16 = __attribute__((ext_vector_type(16))) float;
using f32x4  = __attribute__((ext_vector_type(4))) float;
using f32x2  = __attribute__((ext_vector_type(2))) float;
using u32x4  = __attribute__((ext_vector_type(4))) unsigned;
using u32x2  = __attribute__((ext_vector_type(2))) unsigned;
typedef __bf16 bf2_t __attribute__((ext_vector_type(2)));

#define MFMA(a, b, c) __builtin_amdgcn_mfma_f32_32x32x16_bf16((a), (b), (c), 0, 0, 0)

static constexpr int NTOK = 33280;
static constexpr int NPTOK = 32768;
static constexpr int KVROWS = 32768 + 8 * 1088;
static constexpr int NITEM = 2080;
static constexpr size_t OFF_Y = 0;
static constexpr size_t OFF_NKP = 34078720;
static constexpr size_t OFF_NVP = 50855936;
static constexpr size_t OFF_NHP = 67633152;
static constexpr size_t OFF_NKS = 67764224;
static constexpr size_t OFF_NVS = 68026368;
static constexpr size_t OFF_NHS = 68288512;

struct Params {
  const float *x_prompt, *x_sample, *cache_k, *cache_v, *state_h, *norm_g, *w_in, *lambda_qk, *subln_g, *rec_lb, *rec_norm_g, *w_out, *final_g;
  float* out;
  u16 *WinT, *WoutT, *Xn, *Qb, *Kall, *Vall, *Za, *Qr, *Ir, *Zr, *Mix, *SbufT;
  float *Fr, *Abuf, *NQ;
  int* counter;
  int phase_lo, phase_hi, rep_mask, pad_;
};

DI unsigned pack2(float a, float b) { f32x2 v = {a, b}; bf2_t r = __builtin_convertvector(v, bf2_t); return __builtin_bit_cast(unsigned, r); }
DI u16 f2bf(float a) { return (u16)(pack2(a, 0.f) & 0xffffu); }
DI float bflo(unsigned u) { return __uint_as_float(u << 16); }
DI float bfhi(unsigned u) { return __uint_as_float(u & 0xffff0000u); }
DI int crow(int e, int h) { return (e & 3) + 8 * (e >> 2) + 4 * h; }
DI float wave_sum(float v) {
#pragma unroll
  for (int o = 32; o >= 1; o >>= 1) v += __shfl_xor(v, o);
  return v;
}
DI float silu_f(float v) { return v / (1.f + __expf(-v)); }
DI s16x4 tr_read(const char* p) {
  return __builtin_amdgcn_ds_read_tr16_b64_v4i16((__attribute__((address_space(3))) s16x4*)(p));
}
DI bf16x8 tr_frag(const char* p0, int stride4) {
  s16x4 lo = tr_read(p0), hi = tr_read(p0 + stride4);
  return __builtin_shufflevector(lo, hi, 0, 1, 2, 3, 4, 5, 6, 7);
}
DI bf16x8 pack8(const f32x16& x, int s) {
  u32x4 p;
  p[0] = pack2(x[8 * s + 0], x[8 * s + 1]);
  p[1] = pack2(x[8 * s + 2], x[8 * s + 3]);
  p[2] = pack2(x[8 * s + 4], x[8 * s + 5]);
  p[3] = pack2(x[8 * s + 6], x[8 * s + 7]);
  return __builtin_bit_cast(bf16x8, p);
}
DI f32x16 zero16() { f32x16 z; for (int i = 0; i < 16; ++i) z[i] = 0.f; return z; }

DI void phase0(const Params& p, char* smem) {
  const int tid = threadIdx.x, lane = tid & 63, w = tid >> 6;
  constexpr int NT_W1 = 16 * 64, NT_W2 = 16 * 16, NT_ROW = NTOK / 8, NT_CACHE = 2048;
  constexpr int total = NT_W1 + NT_W2 + NT_ROW + NT_CACHE;
  float (*tile)[65] = (float (*)[65])smem;
  if (blockIdx.x == 0 && tid == 0) *p.counter = 0;
  for (int it = blockIdx.x; it < total; it += gridDim.x) {
    if (it < NT_W1 + NT_W2) {
      const float* src; u16* dst; int N, kt, nt;
      if (it < NT_W1) { src = p.w_in; dst = p.WinT; N = 4096; kt = it >> 6; nt = it & 63; }
      else { int j = it - NT_W1; src = p.w_out; dst = p.WoutT; N = 1024; kt = j >> 4; nt = j & 15; }
      const int c = tid & 63, r0 = tid >> 6;
      for (int i = 0; i < 16; ++i) { int r = r0 + 4 * i; tile[r][c] = src[(size_t)(kt * 64 + r) * N + nt * 64 + c]; }
      __syncthreads();
      if (it < NT_W1) {
        for (int i = 0; i < 16; ++i) { int r = r0 + 4 * i; dst[(size_t)(nt * 64 + r) * 1024 + kt * 64 + c] = f2bf(tile[c][r]); }
      } else {
        for (int i = 0; i < 16; ++i) {
          const int r = r0 + 4 * i, n = nt * 64 + r, k = kt * 64 + c;
          dst[((size_t)((n >> 5) * 64 + (k >> 4)) * 64 + ((k >> 3) & 1) * 32 + (n & 31)) * 8 + (k & 7)] = f2bf(tile[c][r]);
        }
      }
      __syncthreads();
    } else if (it < NT_W1 + NT_W2 + NT_ROW) {
      const int row0 = (it - NT_W1 - NT_W2) * 8 + w * 2;
      f32x4 v[2][4]; float ss[2] = {0.f, 0.f};
#pragma unroll
      for (int rr = 0; rr < 2; ++rr) {
        const int row = row0 + rr;
        const float* src = row < NPTOK ? p.x_prompt + (size_t)row * 1024 : p.x_sample + (size_t)(row - NPTOK) * 1024;
#pragma unroll
        for (int i = 0; i < 4; ++i) v[rr][i] = *(const f32x4*)(src + i * 256 + lane * 4);
      }
#pragma unroll
      for (int rr = 0; rr < 2; ++rr) {
#pragma unroll
        for (int i = 0; i < 4; ++i) ss[rr] += v[rr][i][0] * v[rr][i][0] + v[rr][i][1] * v[rr][i][1] + v[rr][i][2] * v[rr][i][2] + v[rr][i][3] * v[rr][i][3];
        ss[rr] = wave_sum(ss[rr]);
      }
#pragma unroll
      for (int rr = 0; rr < 2; ++rr) {
        const float sc = rsqrtf(ss[rr] * (1.f / 1024.f) + 1e-6f);
#pragma unroll
        for (int i = 0; i < 4; ++i) {
          f32x4 g = *(const f32x4*)(p.norm_g + i * 256 + lane * 4);
          u32x2 o; o[0] = pack2(v[rr][i][0] * sc * g[0], v[rr][i][1] * sc * g[1]); o[1] = pack2(v[rr][i][2] * sc * g[2], v[rr][i][3] * sc * g[3]);
          *(u32x2*)(p.Xn + (size_t)(row0 + rr) * 1024 + i * 256 + lane * 4) = o;
        }
      }
    } else {
      const int task0 = (it - NT_W1 - NT_W2 - NT_ROW) * 8 + w * 2;
      f32x4 a[2], b[2];
#pragma unroll
      for (int rr = 0; rr < 2; ++rr) {
        const int task = task0 + rr, which = task >> 13, r8 = task & 8191;
        const float* src = (which ? p.cache_v : p.cache_k) + (size_t)r8 * 512 + lane * 8;
        a[rr] = *(const f32x4*)src; b[rr] = *(const f32x4*)(src + 4);
      }
#pragma unroll
      for (int rr = 0; rr < 2; ++rr) {
        const int task = task0 + rr, which = task >> 13, r8 = task & 8191;
        u16* dst = (which ? p.Vall : p.Kall) + (size_t)(NPTOK + (r8 >> 10) * 1088 + (r8 & 1023)) * 512 + lane * 8;
        u32x4 o; o[0] = pack2(a[rr][0], a[rr][1]); o[1] = pack2(a[rr][2], a[rr][3]); o[2] = pack2(b[rr][0], b[rr][1]); o[3] = pack2(b[rr][2], b[rr][3]);
        *(u32x4*)dst = o;
      }
    }
  }
}

#define G_LOAD(RA, RB, KT_)                                                                                        \
  {                                                                                                                 \
    _Pragma("unroll") for (int i_ = 0; i_ < 4; ++i_) RA[i_] = *(const u32x4*)(ap + (size_t)i_ * 64 * K + (KT_) * 32); \
    _Pragma("unroll") for (int i_ = 0; i_ < 2; ++i_) RB[i_] = *(const u32x4*)(bp + (size_t)i_ * 64 * K + (KT_) * 32); \
  }
#define G_WRITE(RA, RB, BUF_)                                                                                      \
  {                                                                                                                 \
    _Pragma("unroll") for (int i_ = 0; i_ < 4; ++i_) *(u32x4*)(wbase + (BUF_) * 30720 + i_ * 64 * 80) = RA[i_];          \
    _Pragma("unroll") for (int i_ = 0; i_ < 2; ++i_) *(u32x4*)(wbase + (BUF_) * 30720 + 20480 + i_ * 64 * 80) = RB[i_];  \
  }
#define G_COMPUTE(BUF_)                                                                                            \
  {                                                                                                                 \
    const char* as_ = smem + (BUF_) * 30720 + (wm * 128 + r) * 80 + h * 16;                                         \
    const char* bs_ = smem + (BUF_) * 30720 + 20480 + (wn * 64 + r) * 80 + h * 16;                                  \
    _Pragma("unroll") for (int s_ = 0; s_ < 2; ++s_) {                                                              \
      const bf16x8 b0_ = *(const bf16x8*)(bs_ + s_ * 32), b1_ = *(const bf16x8*)(bs_ + 32 * 80 + s_ * 32);          \
      _Pragma("unroll") for (int i_ = 0; i_ < 4; ++i_) {                                                            \
        const bf16x8 a_ = *(const bf16x8*)(as_ + i_ * 32 * 80 + s_ * 32);                                           \
        acc[i_][0] = MFMA(a_, b0_, acc[i_][0]);                                                                     \
        acc[i_][1] = MFMA(a_, b1_, acc[i_][1]);                                                                     \
      }                                                                                                             \
    }                                                                                                               \
  }
DI void gemm256(const u16* __restrict__ A, const u16* __restrict__ BT, int K, int m0, int n0, char* smem, int tid, f32x16 (&acc)[4][2]) {
  const int lane = tid & 63, w = tid >> 6, r = lane & 31, h = lane >> 5;
  const int wm = w >> 1, wn = w & 1;
#pragma unroll
  for (int i = 0; i < 4; ++i) { acc[i][0] = zero16(); acc[i][1] = zero16(); }
  u32x4 ra0[4], rb0[2], ra1[4], rb1[2];
  const int KT = K >> 5;
  const u16* ap = A + (size_t)(m0 + (tid >> 2)) * K + (tid & 3) * 8;
  const u16* bp = BT + (size_t)(n0 + (tid >> 2)) * K + (tid & 3) * 8;
  char* wbase = smem + (tid >> 2) * 80 + (tid & 3) * 16;
  G_LOAD(ra0, rb0, 0);
  G_LOAD(ra1, rb1, 1);
  G_WRITE(ra0, rb0, 0);
  __syncthreads();
  for (int kt = 0; kt < KT; kt += 2) {
    { const int k2 = kt + 2 < KT ? kt + 2 : KT - 1; G_LOAD(ra0, rb0, k2); }
    __builtin_amdgcn_sched_barrier(0);
    G_COMPUTE(0);
    __builtin_amdgcn_sched_barrier(0);
    G_WRITE(ra1, rb1, 1);
    __syncthreads();
    { const int k3 = kt + 3 < KT ? kt + 3 : KT - 1; G_LOAD(ra1, rb1, k3); }
    __builtin_amdgcn_sched_barrier(0);
    G_COMPUTE(1);
    __builtin_amdgcn_sched_barrier(0);
    G_WRITE(ra0, rb0, 0);
    __syncthreads();
  }
}
struct TileMap {
  int MT, NT, C, NG, NST, st, lb, lin;
  bool xcd;
  DI TileMap(int mt_, int nt_) : MT(mt_), NT(nt_) {
    const int nb = gridDim.x >> 3;
    C = nb >> 3;
    xcd = (gridDim.x & 63) == 0 && C > 0 && (NT % C) == 0;
    NG = xcd ? NT / C : 1;
    NST = ((MT + 7) >> 3) * NG;
    st = blockIdx.x & 7; lb = blockIdx.x >> 3; lin = blockIdx.x;
  }
  DI bool next(int& mt, int& nt) {
    if (!xcd) {
      if (lin >= MT * NT) return false;
      mt = lin / NT; nt = lin - mt * NT; lin += gridDim.x; return true;
    }
    while (st < NST) {
      const int mg = st / NG, ng = st - mg * NG;
      mt = mg * 8 + lb / C; nt = ng * C + lb % C;
      st += 8;
      if (mt < MT) return true;
    }
    return false;
  }
};
DI void stage_half(const f32x16 (&acc)[4][2], float* cs, int half, int wm, int wn, int r, int h) {
  if (wm == half) {
#pragma unroll
    for (int i = 0; i < 4; ++i)
#pragma unroll
      for (int j = 0; j < 2; ++j)
#pragma unroll
        for (int e = 0; e < 16; ++e) cs[(i * 32 + crow(e, h)) * 132 + wn * 64 + j * 32 + r] = acc[i][j][e];
  }
}

DI void phase1(const Params& p, char* smem) {
  const int tid = threadIdx.x, lane = tid & 63, w = tid >> 6, r = lane & 31, h = lane >> 5;
  const int wm = w >> 1, wn = w & 1;
  constexpr int MT = NTOK / 256, NT = 32;
  TileMap tm(MT, NT);
  int mt, nt;
  while (tm.next(mt, nt)) {
    const int m0 = mt * 256, n0 = nt * 128;
    f32x16 acc[4][2];
    gemm256(p.Xn, p.WinT, 1024, m0, n0, smem, tid, acc);
    const int sec = n0 >> 9;
    const bool samp = m0 >= NPTOK;
    float* cs = (float*)smem;
    const int c0 = (tid & 15) * 8, rb = tid >> 4;
    const int csc = (n0 & 511) + c0;
#pragma unroll 1
    for (int half = 0; half < 2; ++half) {
      stage_half(acc, cs, half, wm, wn, r, h);
      __syncthreads();
#pragma unroll 2
      for (int ps = 0; ps < 8; ++ps) {
        const int row = rb + 16 * ps;
        const int t = m0 + half * 128 + row;
        f32x4 va = *(const f32x4*)(cs + row * 132 + c0), vb = *(const f32x4*)(cs + row * 132 + c0 + 4);
        const size_t o512 = (size_t)t * 512 + csc;
        if (sec == 5) { *(f32x4*)(p.Fr + o512) = va; *(f32x4*)(p.Fr + o512 + 4) = vb; }
        else {
          u16* dst;
          if (sec == 0) {
            const float qs = 0.125f * 1.44269504089f;
            va *= qs; vb *= qs; dst = p.Qb + o512;
          } else if (sec == 1 || sec == 2) {
            size_t kvr; float* od;
            if (!samp) { kvr = t; od = p.out + (sec == 1 ? OFF_NKP : OFF_NVP) + o512; }
            else { const int ts = t - NPTOK; kvr = NPTOK + (ts >> 6) * 1088 + 1024 + (ts & 63); od = p.out + (sec == 1 ? OFF_NKS : OFF_NVS) + (size_t)ts * 512 + csc; }
            *(f32x4*)od = va; *(f32x4*)(od + 4) = vb;
            dst = (sec == 1 ? p.Kall : p.Vall) + kvr * 512 + csc;
          } else if (sec == 6) { dst = p.Ir + o512; }
          else {
#pragma unroll
            for (int i = 0; i < 4; ++i) { va[i] = silu_f(va[i]); vb[i] = silu_f(vb[i]); }
            dst = (sec == 3 ? p.Za : (sec == 4 ? p.Qr : p.Zr)) + o512;
          }
          u32x4 o; o[0] = pack2(va[0], va[1]); o[1] = pack2(va[2], va[3]); o[2] = pack2(vb[0], vb[1]); o[3] = pack2(vb[2], vb[3]);
          *(u32x4*)dst = o;
        }
      }
      __syncthreads();
    }
  }
}

DI void rec_pre(const Params& p, int tid, int I, float* totS, float (&cum)[32], float (&key)[32], float& lastv) {
  const int d = tid & 127, half = tid >> 7;
  const int hd = I & 3, t0 = (I >> 2) * 64;
  const float r0 = p.rec_lb[hd * 128 + d], r1 = p.rec_lb[512 + hd * 128 + d];
  const float lb = 1.f / (1.f + __expf(r1 - r0));
  const float* fp = p.Fr + (size_t)(t0 + half * 32) * 512 + hd * 128 + d;
  float run = 0.f;
#pragma unroll
  for (int i = 0; i < 32; ++i) {
    float x = fp[(size_t)i * 512];
    x = fminf(fmaxf(x, -30.f), 30.f);
    const float e = __expf(-x), sg = 1.f / (1.f + e);
    run += __logf(lb + (1.f - lb) * sg);
    cum[i] = run; key[i] = (1.f - lb) * e * sg;
  }
  totS[tid] = run;
  __syncthreads();
  const float tot0 = totS[d], tot1 = totS[128 + d];
  if (half) {
#pragma unroll
    for (int i = 0; i < 32; ++i) cum[i] += tot0;
  }
  lastv = tot0 + tot1;
}

DI void phase2(const Params& p, char* smem, float* BbufT) {
  const int tid = threadIdx.x, lane = tid & 63, w = tid >> 6, r = lane & 31, h = lane >> 5;
  const int q = (lane & 15) >> 2, pp = lane & 3, blk = (lane >> 4) & 1;
  const int d = tid & 127, half = tid >> 7;
  char* KdI = smem; char* VrI = smem + 17408; float* totS = (float*)(smem + 60000);
  for (int I = blockIdx.x; I < NITEM; I += gridDim.x) {
    const int hd = I & 3, t0 = (I >> 2) * 64;
    if (I < 2048) {
      const int token = tid & 63, which = tid >> 6;
      const u16* src = (which < 2 ? p.Qb : p.Kall) + (size_t)(t0 + token) * 512 + hd * 128 + (which & 1) * 64;
      float ss = 0.f;
#pragma unroll
      for (int c = 0; c < 8; ++c) {
        const u32x4 v = *(const u32x4*)(src + c * 8);
#pragma unroll
        for (int i = 0; i < 4; ++i) { const float lo = bflo(v[i]), hi = bfhi(v[i]); ss += lo * lo + hi * hi; }
      }
#pragma unroll
      for (int o = 32; o >= 1; o >>= 1) ss = fmaxf(ss, __shfl_xor(ss, o));
      if (lane == 0) p.NQ[I * 4 + which] = sqrtf(ss);
    }
    float cum[32], key[32], lastv;
    rec_pre(p, tid, I, totS, cum, key, lastv);
#pragma unroll
    for (int i = 0; i < 32; ++i) {
      const int t = half * 32 + i;
      *(u16*)(KdI + t * 272 + d * 2) = f2bf(key[i] * __expf(lastv - cum[i]));
    }
#pragma unroll
    for (int i = 0; i < 4; ++i) {
      const int ch = tid + 256 * i, row = ch >> 4, cc = ch & 15;
      *(u32x4*)(VrI + row * 272 + cc * 16) = *(const u32x4*)(p.Ir + (size_t)(t0 + row) * 512 + hd * 128 + cc * 8);
    }
    if (half) p.Abuf[I * 128 + d] = __expf(lastv);
    __syncthreads();
    f32x16 acc[4];
#pragma unroll
    for (int ct = 0; ct < 4; ++ct) acc[ct] = zero16();
#pragma unroll
    for (int ks = 0; ks < 4; ++ks) {
      const int rowoff = (16 * ks + 8 * h + q) * 272 + 32 * blk + 8 * pp;
      bf16x8 a = tr_frag(VrI + rowoff + 64 * w, 4 * 272);
#pragma unroll
      for (int ct = 0; ct < 4; ++ct) {
        bf16x8 b = tr_frag(KdI + rowoff + 64 * ct, 4 * 272);
        acc[ct] = MFMA(a, b, acc[ct]);
      }
    }
    float* ob = BbufT + (size_t)I * 16384;
#pragma unroll
    for (int ct = 0; ct < 4; ++ct)
#pragma unroll
      for (int e = 0; e < 16; ++e) ob[(32 * w + crow(e, h)) * 128 + 32 * ct + r] = acc[ct][e];
    __syncthreads();
  }
}

DI void phase3(const Params& p, const float* BbufT) {
  const int tid = threadIdx.x;
  for (int it = blockIdx.x; it < 512 + 1024; it += gridDim.x) {
    if (it < 512) {
      const int bh = it >> 6, b = bh >> 2, hd = bh & 3;
      const int e1 = (it & 63) * 256 + tid, v = e1 >> 7, d = e1 & 127;
      float sx = 0.f;
      const size_t eo = (size_t)v * 128 + d;
      const int I0 = (b * 256) * 4 + hd;
      const float* ap = p.Abuf + (size_t)I0 * 128 + d;
      const float* bp = BbufT + (size_t)I0 * 16384 + eo;
      u16* sp = p.SbufT + (size_t)I0 * 16384 + eo;
#pragma unroll 16
      for (int c = 0; c < 256; ++c) {
        const float a = ap[(size_t)c * 4 * 128];
        const float bv = bp[(size_t)c * 4 * 16384];
        sp[(size_t)c * 4 * 16384] = f2bf(sx);
        sx = a * sx + bv;
      }
      p.out[OFF_NHP + (size_t)(b * 4 + hd) * 16384 + d * 128 + v] = sx;
    } else {
      const int j = it - 512;
      const int sh = j >> 5, bs = sh >> 2, hd = sh & 3;
      const int e2 = (j & 31) * 256 + tid, v = e2 >> 6, d2 = (e2 & 63) * 2;
      const int I = (512 + bs) * 4 + hd;
      const float* sh0 = p.state_h + (size_t)(bs * 4 + hd) * 16384;
      float sx = sh0[d2 * 128 + v], sy = sh0[(d2 + 1) * 128 + v];
      const size_t eo = (size_t)v * 128 + d2;
      const f32x2 a = *(const f32x2*)(p.Abuf + I * 128 + d2);
      const f32x2 bv = *(const f32x2*)(BbufT + (size_t)I * 16384 + eo);
      *(unsigned*)(p.SbufT + (size_t)I * 16384 + eo) = pack2(sx, sy);
      sx = a[0] * sx + bv[0]; sy = a[1] * sy + bv[1];
      float* oh = p.out + OFF_NHS + (size_t)(bs * 4 + hd) * 16384;
      oh[d2 * 128 + v] = sx; oh[(d2 + 1) * 128 + v] = sy;
    }
  }
}

DI void r3_item(const Params& p, char* smem, int tid, int I) {
  const int lane = tid & 63, w = tid >> 6, r = lane & 31, h = lane >> 5;
  const int q = (lane & 15) >> 2, pp = lane & 3, blk = (lane >> 4) & 1;
  const int d = tid & 127, half = tid >> 7;
  char* QdI = smem; char* KdI = smem + 17408; char* VrI = smem + 34816;
  float* totS = (float*)(smem + 60000); float* ssS = (float*)(smem + 62048);
  const int hd = I & 3, t0 = (I >> 2) * 64;
  {
    float cum[32], key[32], lastv;
    rec_pre(p, tid, I, totS, cum, key, lastv);
    const u16* qp = p.Qr + (size_t)(t0 + half * 32) * 512 + hd * 128 + d;
#pragma unroll
    for (int i = 0; i < 32; ++i) {
      const int t = half * 32 + i;
      const float qv = bflo(qp[(size_t)i * 512]);
      *(u16*)(QdI + t * 272 + d * 2) = f2bf(qv * __expf(cum[i]));
      *(u16*)(KdI + t * 272 + d * 2) = f2bf(key[i] * __expf(-cum[i]));
    }
  }
#pragma unroll
  for (int i = 0; i < 4; ++i) {
    const int ch = tid + 256 * i, row = ch >> 4, cc = ch & 15;
    *(u32x4*)(VrI + row * 272 + cc * 16) = *(const u32x4*)(p.Ir + (size_t)(t0 + row) * 512 + hd * 128 + cc * 8);
  }
  __syncthreads();
  const int tt = w & 1, vh = w >> 1;
  bf16x8 qf[8];
#pragma unroll
  for (int ks = 0; ks < 8; ++ks) qf[ks] = *(const bf16x8*)(QdI + (32 * tt + r) * 272 + ks * 32 + h * 16);
  f32x16 sc[2]; sc[0] = zero16(); sc[1] = zero16();
#pragma unroll
  for (int ks = 0; ks < 8; ++ks) {
    bf16x8 a0 = *(const bf16x8*)(KdI + r * 272 + ks * 32 + h * 16);
    sc[0] = MFMA(a0, qf[ks], sc[0]);
  }
  if (tt == 1) {
#pragma unroll
    for (int ks = 0; ks < 8; ++ks) {
      bf16x8 a1 = *(const bf16x8*)(KdI + (32 + r) * 272 + ks * 32 + h * 16);
      sc[1] = MFMA(a1, qf[ks], sc[1]);
    }
  }
#pragma unroll
  for (int e = 0; e < 16; ++e) {
    const bool keep = crow(e, h) <= r;
    if (tt == 0) { if (!keep) sc[0][e] = 0.f; }
    else { if (!keep) sc[1][e] = 0.f; }
  }
  bf16x8 pf[4];
  pf[0] = pack8(sc[0], 0); pf[1] = pack8(sc[0], 1); pf[2] = pack8(sc[1], 0); pf[3] = pack8(sc[1], 1);
  f32x16 o[2]; o[0] = zero16(); o[1] = zero16();
  const u16* sp = p.SbufT + (size_t)I * 16384;
#pragma unroll
  for (int vi = 0; vi < 2; ++vi) {
    const int vt = 2 * vh + vi;
#pragma unroll
    for (int k4 = 0; k4 < 4; ++k4) {
      if (k4 < 2 || tt == 1) {
        bf16x8 a = tr_frag(VrI + (16 * k4 + 4 * h + q) * 272 + (32 * vt + 16 * blk) * 2 + 8 * pp, 8 * 272);
        o[vi] = MFMA(a, pf[k4], o[vi]);
      }
    }
#pragma unroll
    for (int ks = 0; ks < 8; ++ks) {
      bf16x8 a = *(const bf16x8*)(sp + (size_t)(32 * vt + r) * 128 + ks * 16 + h * 8);
      o[vi] = MFMA(a, qf[ks], o[vi]);
    }
  }
  float ss = 0.f;
#pragma unroll
  for (int vi = 0; vi < 2; ++vi)
#pragma unroll
    for (int e = 0; e < 16; ++e) ss += o[vi][e] * o[vi][e];
  ss += __shfl_xor(ss, 32);
  if (h == 0) ssS[w * 32 + r] = ss;
  __syncthreads();
  const float tot = ssS[tt * 32 + r] + ssS[(tt + 2) * 32 + r];
  const float rs = rsqrtf(tot * (1.f / 128.f) + 1e-6f);
  const int tok = t0 + 32 * tt + r;
#pragma unroll
  for (int vi = 0; vi < 2; ++vi)
#pragma unroll
    for (int g = 0; g < 4; ++g) {
      const int v = 32 * (2 * vh + vi) + 8 * g + 4 * h;
      const f32x4 gg = *(const f32x4*)(p.rec_norm_g + v);
      const u32x2 z = *(const u32x2*)(p.Zr + (size_t)tok * 512 + hd * 128 + v);
      u32x2 ov;
      ov[0] = pack2(o[vi][4 * g + 0] * rs * gg[0] * bflo(z[0]), o[vi][4 * g + 1] * rs * gg[1] * bfhi(z[0]));
      ov[1] = pack2(o[vi][4 * g + 2] * rs * gg[2] * bflo(z[1]), o[vi][4 * g + 3] * rs * gg[3] * bfhi(z[1]));
      *(u32x2*)(p.Mix + (size_t)tok * 1024 + 512 + hd * 128 + v) = ov;
    }
  __syncthreads();
}

template <bool DIAG>
DI void attn_tile_a(const char* ks, const bf16x8 (&qf)[4], f32x16 (&O)[4], bf16x8 (&pf)[4], float& mrun, float& lsum, float sl2, float qrel,
                    int m, int r, int h2) {
  f32x16 S[2];
#pragma unroll
  for (int st = 0; st < 2; ++st) {
    S[st] = zero16();
#pragma unroll
    for (int s = 0; s < 4; ++s) {
      bf16x8 a = *(const bf16x8*)(ks + (32 * st + r) * 272 + m * 128 + s * 32 + h2 * 16);
      S[st] = MFMA(a, qf[s], S[st]);
    }
  }
  float mx = -1e30f;
#pragma unroll
  for (int st = 0; st < 2; ++st)
#pragma unroll
    for (int e = 0; e < 16; ++e) {
      const float cst = (float)(32 * st + (e & 3) + 8 * (e >> 2));
      float sv;
      if (DIAG) sv = fmaf(-sl2, fabsf(qrel - cst), S[st][e]);
      else sv = fmaf(sl2, cst, S[st][e]);
      S[st][e] = sv; mx = fmaxf(mx, sv);
    }
  const float L = DIAG ? 0.f : -sl2 * qrel;
  mx += L;
  mx = fmaxf(mx, __shfl_xor(mx, 32));
  if (__builtin_amdgcn_ballot_w64(mx > mrun + 6.f) != 0) {
    const float mnew = fmaxf(mrun, mx);
    const float alpha = __builtin_amdgcn_exp2f(mrun - mnew);
    mrun = mnew; lsum *= alpha;
#pragma unroll
    for (int vt = 0; vt < 4; ++vt)
#pragma unroll
      for (int e = 0; e < 16; ++e) O[vt][e] *= alpha;
  }
  const float off = L - mrun;
  float rs = 0.f;
#pragma unroll
  for (int st = 0; st < 2; ++st)
#pragma unroll
    for (int e = 0; e < 16; ++e) { const float pv = __builtin_amdgcn_exp2f(S[st][e] + off); S[st][e] = pv; rs += pv; }
  lsum += rs;
  pf[0] = pack8(S[0], 0); pf[1] = pack8(S[0], 1); pf[2] = pack8(S[1], 0); pf[3] = pack8(S[1], 1);
}
template <bool DIAG>
DI void attn_tile_f(const char* ks, const bf16x8 (&qf)[4], bf16x8 (&pf)[4], float& lsum, float sl2, float qrel, float mref, int m, int r, int h2) {
  f32x16 S[2];
  const float offL = -sl2 * qrel - mref;
#pragma unroll
  for (int st = 0; st < 2; ++st) {
#pragma unroll
    for (int e = 0; e < 16; ++e) {
      const float cst = (float)(32 * st + (e & 3) + 8 * (e >> 2));
      S[st][e] = DIAG ? (-sl2 * fabsf(qrel - cst) - mref) : fmaf(sl2, cst, offL);
    }
#pragma unroll
    for (int s = 0; s < 4; ++s) {
      bf16x8 a = *(const bf16x8*)(ks + (32 * st + r) * 272 + m * 128 + s * 32 + h2 * 16);
      S[st] = MFMA(a, qf[s], S[st]);
    }
  }
  float rs = 0.f;
#pragma unroll
  for (int st = 0; st < 2; ++st)
#pragma unroll
    for (int e = 0; e < 16; ++e) { const float pv = __builtin_amdgcn_exp2f(S[st][e]); S[st][e] = pv; rs += pv; }
  lsum += rs;
  pf[0] = pack8(S[0], 0); pf[1] = pack8(S[0], 1); pf[2] = pack8(S[1], 0); pf[3] = pack8(S[1], 1);
}
DI void attn_tile_b(const char* vs, const bf16x8 (&pf)[4], f32x16 (&O)[4], int h2, int q, int pp, int blk) {
  const char* vb = vs + (4 * h2 + q) * 320 + 32 * blk + 8 * pp;
  bf16x8 a0[4], a1[4];
#pragma unroll
  for (int vt = 0; vt < 4; ++vt) a0[vt] = tr_frag(vb + 64 * vt, 8 * 320);
  __builtin_amdgcn_sched_barrier(0);
#pragma unroll
  for (int vt = 0; vt < 4; ++vt) a1[vt] = tr_frag(vb + 16 * 320 + 64 * vt, 8 * 320);
#pragma unroll
  for (int vt = 0; vt < 4; ++vt) O[vt] = MFMA(a0[vt], pf[0], O[vt]);
  __builtin_amdgcn_sched_barrier(0);
#pragma unroll
  for (int vt = 0; vt < 4; ++vt) a0[vt] = tr_frag(vb + 32 * 320 + 64 * vt, 8 * 320);
#pragma unroll
  for (int vt = 0; vt < 4; ++vt) O[vt] = MFMA(a1[vt], pf[1], O[vt]);
  __builtin_amdgcn_sched_barrier(0);
#pragma unroll
  for (int vt = 0; vt < 4; ++vt) a1[vt] = tr_frag(vb + 48 * 320 + 64 * vt, 8 * 320);
#pragma unroll
  for (int vt = 0; vt < 4; ++vt) O[vt] = MFMA(a0[vt], pf[2], O[vt]);
  __builtin_amdgcn_sched_barrier(0);
#pragma unroll
  for (int vt = 0; vt < 4; ++vt) O[vt] = MFMA(a1[vt], pf[3], O[vt]);
}

DI void attn_item(const Params& p, char* smem, int tid, int tq0, int qpos0, int kvbase, int ntb, int hd, float lam, bool can_skip) {
  const int lane = tid & 63, w = tid >> 6, r = lane & 31, h2 = lane >> 5;
  const int q = (lane & 15) >> 2, pp = lane & 3, blk = (lane >> 4) & 1;
  const int qh = w & 1, m = w >> 1;
  const float sl2 = exp2f(-2.f * (float)(hd + 1)) * 1.44269504089f;
  const int qtok = tq0 + 32 * qh + r;
  const float qposf = (float)(qpos0 + 32 * qh + r);
  int kt0w = 0, kt0b = 0;
  bool fast = false; float kn_w = 0.f;
  if (can_skip) {
    float qnv[2], knv[2];
    const int I0 = (tq0 >> 6) * 4 + hd;
    const int crk = kvbase >> 6;
    int k0[2];
#pragma unroll
    for (int mm = 0; mm < 2; ++mm) {
      const float QN = p.NQ[I0 * 4 + mm];
      float KN = 0.f;
      for (int c = lane; c < ntb; c += 64) KN = fmaxf(KN, p.NQ[((crk + c) * 4 + hd) * 4 + 2 + mm]);
#pragma unroll
      for (int o = 32; o >= 1; o >>= 1) KN = fmaxf(KN, __shfl_xor(KN, o));
      qnv[mm] = QN; knv[mm] = KN;
      const float D = (2.02f * QN * KN + 130.f) / sl2;
      const float f = ((float)(qpos0 - 63) - D) * (1.f / 64.f);
      k0[mm] = f < 0.f ? 0 : (int)f + 1;
    }
    kt0w = m ? k0[1] : k0[0];
    kt0b = k0[0] < k0[1] ? k0[0] : k0[1];
    kn_w = m ? knv[1] : knv[0];
    fast = 2.02f * (m ? qnv[1] : qnv[0]) * kn_w < 60.f;
  }
  bf16x8 qf[4];
#pragma unroll
  for (int s = 0; s < 4; ++s) qf[s] = *(const bf16x8*)(p.Qb + (size_t)qtok * 512 + hd * 128 + m * 64 + 16 * s + 8 * h2);
  float mref = 0.f;
  if (fast) {
    float qq = 0.f;
#pragma unroll
    for (int s = 0; s < 4; ++s) {
      const u32x4 u = __builtin_bit_cast(u32x4, qf[s]);
#pragma unroll
      for (int i = 0; i < 4; ++i) { const float lo = bflo(u[i]), hi = bfhi(u[i]); qq += lo * lo + hi * hi; }
    }
    qq += __shfl_xor(qq, 32);
    mref = sqrtf(qq) * kn_w * 1.01f + 0.5f;
  }
  f32x16 O[4];
#pragma unroll
  for (int vt = 0; vt < 4; ++vt) O[vt] = zero16();
  float mrun = -1e30f, lsum = 0.f;
  u32x4 rk[4], rv[4];
  const int lrow = tid >> 4, lcc = tid & 15;
  const size_t gofs = (size_t)(kvbase + lrow) * 512 + hd * 128 + lcc * 8;
  const u16* kp = p.Kall + gofs;
  const u16* vp = p.Vall + gofs;
  char* kw = smem + lrow * 272 + lcc * 16;
  char* vw = smem + 17408 + lrow * 320 + lcc * 16;
  const int nit = ntb - kt0b;
  {
    const size_t go = (size_t)(fast ? kt0b : ntb - 1) * 64 * 512;
#pragma unroll
    for (int i = 0; i < 4; ++i) { rk[i] = *(const u32x4*)(kp + go + (size_t)i * 16 * 512); rv[i] = *(const u32x4*)(vp + go + (size_t)i * 16 * 512); }
#pragma unroll
    for (int i = 0; i < 4; ++i) { *(u32x4*)(kw + i * 16 * 272) = rk[i]; *(u32x4*)(vw + i * 16 * 320) = rv[i]; }
    const int k1 = fast ? (kt0b + 1 < ntb ? kt0b + 1 : ntb - 1) : (ntb - 2 > kt0b ? ntb - 2 : kt0b);
    const size_t g1 = (size_t)k1 * 64 * 512;
#pragma unroll
    for (int i = 0; i < 4; ++i) { rk[i] = *(const u32x4*)(kp + g1 + (size_t)i * 16 * 512); rv[i] = *(const u32x4*)(vp + g1 + (size_t)i * 16 * 512); }
  }
  __syncthreads();
  if (fast) {
    for (int it = 0; it < nit; ++it) {
      const int kt = kt0b + it;
      const bool active = kt >= kt0w;
      const char* ks = smem + (it & 1) * 37888;
      char* wb = kw + ((it + 1) & 1) * 37888;
      char* wbv = vw + ((it + 1) & 1) * 37888;
  #pragma unroll
      for (int i = 0; i < 4; ++i) { *(u32x4*)(wb + i * 16 * 272) = rk[i]; *(u32x4*)(wbv + i * 16 * 320) = rv[i]; }
      {
        const int k2 = kt + 2 < ntb ? kt + 2 : ntb - 1;
        const size_t g2 = (size_t)k2 * 64 * 512;
  #pragma unroll
        for (int i = 0; i < 4; ++i) { rk[i] = *(const u32x4*)(kp + g2 + (size_t)i * 16 * 512); rv[i] = *(const u32x4*)(vp + g2 + (size_t)i * 16 * 512); }
      }
      __builtin_amdgcn_sched_barrier(0);
      if (active) {
        bf16x8 pf[4];
        const float qrel = qposf - (float)(kt * 64 + 4 * h2);
        if (it == nit - 1) attn_tile_f<true>(ks, qf, pf, lsum, sl2, qrel, mref, m, r, h2);
        else attn_tile_f<false>(ks, qf, pf, lsum, sl2, qrel, mref, m, r, h2);
        attn_tile_b(ks + 17408, pf, O, h2, q, pp, blk);
      }
      __syncthreads();
    }
  } else {
    for (int it = 0; it < nit; ++it) {
      const int kt = ntb - 1 - it;
      const bool active = kt >= kt0w;
      const char* ks = smem + (it & 1) * 37888;
      char* wb = kw + ((it + 1) & 1) * 37888;
      char* wbv = vw + ((it + 1) & 1) * 37888;
  #pragma unroll
      for (int i = 0; i < 4; ++i) { *(u32x4*)(wb + i * 16 * 272) = rk[i]; *(u32x4*)(wbv + i * 16 * 320) = rv[i]; }
      {
        const int k2 = kt - 2 > kt0b ? kt - 2 : kt0b;
        const size_t g2 = (size_t)k2 * 64 * 512;
  #pragma unroll
        for (int i = 0; i < 4; ++i) { rk[i] = *(const u32x4*)(kp + g2 + (size_t)i * 16 * 512); rv[i] = *(const u32x4*)(vp + g2 + (size_t)i * 16 * 512); }
      }
      __builtin_amdgcn_sched_barrier(0);
      if (active) {
        bf16x8 pf[4];
        const float qrel = qposf - (float)(kt * 64 + 4 * h2);
        if (it == 0) attn_tile_a<true>(ks, qf, O, pf, mrun, lsum, sl2, qrel, m, r, h2);
        else attn_tile_a<false>(ks, qf, O, pf, mrun, lsum, sl2, qrel, m, r, h2);
        attn_tile_b(ks + 17408, pf, O, h2, q, pp, blk);
      }
      __syncthreads();
    }
  }
  const float lt = lsum + __shfl_xor(lsum, 32);
  const float inv = 1.f / lt;
  float* exch = (float*)smem + qh * 4096 + lane;
  if (m == 1) {
#pragma unroll
    for (int vt = 0; vt < 4; ++vt)
#pragma unroll
      for (int e = 0; e < 16; ++e) exch[(vt * 16 + e) * 64] = O[vt][e] * inv;
  }
  __syncthreads();
  if (m == 0) {
    float ss = 0.f;
#pragma unroll
    for (int vt = 0; vt < 4; ++vt)
#pragma unroll
      for (int e = 0; e < 16; ++e) { const float ov = O[vt][e] * inv - lam * exch[(vt * 16 + e) * 64]; O[vt][e] = ov; ss += ov * ov; }
    ss += __shfl_xor(ss, 32);
    const float rsn = rsqrtf(ss * (1.f / 128.f) + 1e-6f) * 0.8f;
#pragma unroll
    for (int vt = 0; vt < 4; ++vt)
#pragma unroll
      for (int g = 0; g < 4; ++g) {
        const int v = 32 * vt + 8 * g + 4 * h2;
        const f32x4 gg = *(const f32x4*)(p.subln_g + v);
        const u32x2 z = *(const u32x2*)(p.Za + (size_t)qtok * 512 + hd * 128 + v);
        u32x2 ov;
        ov[0] = pack2(O[vt][4 * g + 0] * rsn * gg[0] * bflo(z[0]), O[vt][4 * g + 1] * rsn * gg[1] * bfhi(z[0]));
        ov[1] = pack2(O[vt][4 * g + 2] * rsn * gg[2] * bflo(z[1]), O[vt][4 * g + 3] * rsn * gg[3] * bfhi(z[1]));
        *(u32x2*)(p.Mix + (size_t)qtok * 1024 + hd * 128 + v) = ov;
      }
  }
  __syncthreads();
}

DI void phase4(const Params& p, char* smem) {
  const int tid = threadIdx.x, lane = tid & 63;
  float lam;
  {
    const float a = p.lambda_qk[lane] * p.lambda_qk[64 + lane];
    const float b = p.lambda_qk[128 + lane] * p.lambda_qk[192 + lane];
    lam = __expf(wave_sum(a)) - __expf(wave_sum(b)) + 0.2f;
  }
  int* sitem = (int*)(smem + 76784);
  constexpr int NPA = 2048, NSA = 32, TOTAL = NPA + NSA + NITEM;
  for (;;) {
    if (tid == 0) *sitem = atomicAdd(p.counter, 1);
    __syncthreads();
    const int item = *sitem;
    __syncthreads();
    if (item >= TOTAL) break;
    int tid_o = tid;
    asm volatile("" : "+v"(tid_o));
    if (item < NPA + NSA) {
      int tq0, qpos0, kvbase, ntb, hd; bool can_skip;
      if (item < NPA) {
        const int qb = 255 - ((item & 511) >> 1), b = item & 1;
        hd = 3 - (item >> 9); tq0 = b * 16384 + qb * 64; qpos0 = qb * 64; kvbase = b * 16384; ntb = qb + 1; can_skip = true;
      } else {
        const int it = item - NPA, bs = it >> 2;
        hd = it & 3; tq0 = NPTOK + bs * 64; qpos0 = 1024; kvbase = NPTOK + bs * 1088; ntb = 17; can_skip = false;
      }
      attn_item(p, smem, tid_o, tq0, qpos0, kvbase, ntb, hd, lam, can_skip);
    } else {
      r3_item(p, smem, tid_o, item - NPA - NSA);
    }
  }
}

DI void phase5(const Params& p, char* smem) {
  float* wsum = (float*)(smem + 66048);
  for (int strip = blockIdx.x; strip < NTOK / 32; strip += gridDim.x) {
    int tid = threadIdx.x;
    asm volatile("" : "+v"(tid));
    const int lane = tid & 63, w = tid >> 6, r = lane & 31, h = lane >> 5;
    const int m0 = strip * 32;
#pragma unroll
    for (int i = 0; i < 16; ++i) {
      const int ch = tid + 256 * i, row = ch >> 7, cc = ch & 127;
      *(u32x4*)(smem + row * 2064 + cc * 16) = *(const u32x4*)(p.Mix + (size_t)(m0 + row) * 1024 + cc * 8);
    }
    f32x16 acc[8];
#pragma unroll
    for (int j = 0; j < 8; ++j) acc[j] = zero16();
    const u16* bp = p.WoutT + (size_t)(w * 8) * 64 * 512 + lane * 8;
    bf16x8 b0[8], b1[8];
#pragma unroll
    for (int j = 0; j < 8; ++j) { b0[j] = *(const bf16x8*)(bp + (size_t)(j * 64 + 0) * 512); b1[j] = *(const bf16x8*)(bp + (size_t)(j * 64 + 1) * 512); }
    __syncthreads();
    const char* ap = smem + r * 2064 + h * 16;
    for (int ks = 0; ks < 64; ks += 2) {
      {
        const bf16x8 a = *(const bf16x8*)(ap + ks * 32);
#pragma unroll
        for (int j = 0; j < 8; ++j) acc[j] = MFMA(a, b0[j], acc[j]);
        const int k2 = ks + 2 < 64 ? ks + 2 : 63;
#pragma unroll
        for (int j = 0; j < 8; ++j) b0[j] = *(const bf16x8*)(bp + (size_t)(j * 64 + k2) * 512);
      }
      __builtin_amdgcn_sched_barrier(0);
      {
        const bf16x8 a = *(const bf16x8*)(ap + (ks + 1) * 32);
#pragma unroll
        for (int j = 0; j < 8; ++j) acc[j] = MFMA(a, b1[j], acc[j]);
        const int k3 = ks + 3 < 64 ? ks + 3 : 63;
#pragma unroll
        for (int j = 0; j < 8; ++j) b1[j] = *(const bf16x8*)(bp + (size_t)(j * 64 + k3) * 512);
      }
      __builtin_amdgcn_sched_barrier(0);
    }
    const float* xs_u = (m0 < NPTOK ? p.x_prompt : p.x_sample - (size_t)NPTOK * 1024) + (size_t)m0 * 1024;
    const int lane_off = h * 4096 + w * 256 + r;
    float ps[16];
#pragma unroll
    for (int e = 0; e < 16; ++e) ps[e] = 0.f;
#pragma unroll
    for (int j = 0; j < 8; ++j) {
#pragma unroll
      for (int e = 0; e < 16; ++e) {
        const float hv = acc[j][e] + (xs_u + ((e & 3) + 8 * (e >> 2)) * 1024 + j * 32)[lane_off];
        acc[j][e] = hv; ps[e] += hv * hv;
      }
      __builtin_amdgcn_sched_barrier(0);
    }
#pragma unroll
    for (int e = 0; e < 16; ++e) {
#pragma unroll
      for (int o = 16; o >= 1; o >>= 1) ps[e] += __shfl_xor(ps[e], o);
    }
    if (r == 0) {
#pragma unroll
      for (int e = 0; e < 16; ++e) wsum[w * 32 + crow(e, h)] = ps[e];
    }
    __syncthreads();
#pragma unroll
    for (int e = 0; e < 16; ++e) {
      const int rw = crow(e, h);
      ps[e] = rsqrtf((wsum[rw] + wsum[32 + rw] + wsum[64 + rw] + wsum[96 + rw]) * (1.f / 1024.f) + 1e-6f);
    }
    float* yo_u = p.out + OFF_Y + (size_t)m0 * 1024;
#pragma unroll
    for (int j = 0; j < 8; ++j) {
      const float g = (p.final_g + j * 32)[w * 256 + r];
#pragma unroll
      for (int e = 0; e < 16; ++e) (yo_u + ((e & 3) + 8 * (e >> 2)) * 1024 + j * 32)[lane_off] = acc[j][e] * ps[e] * g;
      __builtin_amdgcn_sched_barrier(0);
    }
    __syncthreads();
  }
}

__global__ void __launch_bounds__(256, 2) fwd_megakernel(Params p) {
  __shared__ __attribute__((aligned(16))) char smem[76800];
  cg::grid_group grid = cg::this_grid();
  float* scratch_out = p.out + OFF_Y;
  const int lo = p.phase_lo, hi = p.phase_hi, rm = p.rep_mask;
  if (lo <= 0 && hi >= 0) phase0(p, smem);
  if (rm & 1) { grid.sync(); phase0(p, smem); }
  if (lo <= 0 && hi >= 1) grid.sync();
  if (lo <= 1 && hi >= 1) phase1(p, smem);
  if (rm & 2) { grid.sync(); phase1(p, smem); }
  if (lo <= 1 && hi >= 2) grid.sync();
  if (lo <= 2 && hi >= 2) phase2(p, smem, scratch_out);
  if (rm & 4) { grid.sync(); phase2(p, smem, scratch_out); }
  if (lo <= 2 && hi >= 3) grid.sync();
  if (lo <= 3 && hi >= 3) phase3(p, scratch_out);
  if (rm & 8) { grid.sync(); phase3(p, scratch_out); }
  if (lo <= 3 && hi >= 4) grid.sync();
  if (lo <= 4 && hi >= 4) phase4(p, smem);
  if (lo <= 4 && hi >= 5) grid.sync();
  if (lo <= 5 && hi >= 5) phase5(p, smem);
}

extern "C" void kernel_launch(void* const* d_in, const int* in_sizes, int n_in, void* d_out, int out_size, void* d_ws, size_t ws_size,
                              hipStream_t stream) {
  static int grid_blocks = 0;
  if (!grid_blocks) {
    int dev = 0, cus = 0, per_cu = 0;
    hipGetDevice(&dev);
    hipDeviceGetAttribute(&cus, hipDeviceAttributeMultiprocessorCount, dev);
    hipOccupancyMaxActiveBlocksPerMultiprocessor(&per_cu, fwd_megakernel, 256, 0);
    if (per_cu > 2) per_cu = 2;
    if (per_cu < 1) per_cu = 1;
    grid_blocks = cus * per_cu;
  }
  Params p{};
  p.x_prompt = (const float*)d_in[0]; p.x_sample = (const float*)d_in[1]; p.cache_k = (const float*)d_in[2]; p.cache_v = (const float*)d_in[3];
  p.state_h = (const float*)d_in[4]; p.norm_g = (const float*)d_in[5]; p.w_in = (const float*)d_in[6]; p.lambda_qk = (const float*)d_in[7];
  p.subln_g = (const float*)d_in[8]; p.rec_lb = (const float*)d_in[9]; p.rec_norm_g = (const float*)d_in[10]; p.w_out = (const float*)d_in[11];
  p.final_g = (const float*)d_in[12];
  p.out = (float*)d_out;
  char* ws = (char*)d_ws; size_t off = 0;
  auto take = [&](size_t bytes) { char* r = ws + off; off += (bytes + 255) & ~(size_t)255; return r; };
  p.WinT = (u16*)take((size_t)4096 * 1024 * 2);
  p.WoutT = (u16*)take((size_t)1024 * 1024 * 2);
  p.Xn = (u16*)take((size_t)NTOK * 1024 * 2);
  p.SbufT = p.Xn;
  p.Qb = (u16*)take((size_t)NTOK * 512 * 2);
  p.Kall = (u16*)take((size_t)KVROWS * 512 * 2);
  p.Vall = (u16*)take((size_t)KVROWS * 512 * 2);
  p.Za = (u16*)take((size_t)NTOK * 512 * 2);
  p.Qr = (u16*)take((size_t)NTOK * 512 * 2);
  p.Ir = (u16*)take((size_t)NTOK * 512 * 2);
  p.Zr = (u16*)take((size_t)NTOK * 512 * 2);
  p.Mix = (u16*)take((size_t)NTOK * 1024 * 2);
  p.Fr = (float*)take((size_t)NTOK * 512 * 4);
  p.Abuf = (float*)take((size_t)NITEM * 128 * 4);
  p.NQ = (float*)take((size_t)NITEM * 4 * 4);
  p.counter = (int*)take(256);
  p.phase_lo = 0; p.phase_hi = 6; p.rep_mask = 0; p.pad_ = 0;
  if (off > ws_size) { fprintf(stderr, "workspace too small: need %zu have %zu\n", off, ws_size); return; }
  void* args[] = {&p};
  hipError_t e = hipLaunchCooperativeKernel((void*)fwd_megakernel, dim3(grid_blocks), dim3(256), args, 0, stream);
  if (e != hipSuccess) fprintf(stderr, "cooperative launch failed: %s (grid %d)\n", hipGetErrorString(e), grid_blocks);
}
```

```cpp
#include <hip/hip_runtime.h>
#include <hip/hip_cooperative_groups.h>
#include <cstdio>
namespace cg = cooperative_groups;

#define DI __device__ __forceinline__
typedef unsigned short u16;
using bf16x8 = __attribute__((ext_vector_type(8))) short;
using s16x4  = __attribute__((ext_vector_type(4))) short;
using f32x16 = __attribute__((ext_vector_type(16))) float;
using f32x4  = __attribute__((ext_vector_type(4))) float;
using f32x2  = __attribute__((ext_vector_type(2))) float;
using u32x4  = __attribute__((ext_vector_type(4))) unsigned;
using u32x2  = __attribute__((ext_vector_type(2))) unsigned;
typedef __bf16 bf2_t __attribute__((ext_vector_type(2)));

#define MFMA(a, b, c) __builtin_amdgcn_mfma_f32_32x32x16_bf16((a), (b), (c), 0, 0, 0)

static constexpr int NTOK = 33280;
static constexpr int NPTOK = 32768;
static constexpr int KVROWS = 32768 + 8 * 1088;
static constexpr int NITEM = 2080;
static constexpr size_t OFF_Y = 0;
static constexpr size_t OFF_NKP = 34078720;
static constexpr size_t OFF_NVP = 50855936;
static constexpr size_t OFF_NHP = 67633152;
static constexpr size_t OFF_NKS = 67764224;
static constexpr size_t OFF_NVS = 68026368;
static constexpr size_t OFF_NHS = 68288512;

struct Params {
  const float *x_prompt, *x_sample, *cache_k, *cache_v, *state_h, *norm_g, *w_in, *lambda_qk, *subln_g, *rec_lb, *rec_norm_g, *w_out, *final_g;
  float* out;
  u16 *WinT, *WoutT, *Xn, *Qb, *Kall, *Vall, *Za, *Qr, *Ir, *Zr, *Mix, *SbufT;
  float *Fr, *Abuf, *NQ;
  int* counter;
  int phase_lo, phase_hi, rep_mask, pad_;
};

DI unsigned pack2(float a, float b) { f32x2 v = {a, b}; bf2_t r = __builtin_convertvector(v, bf2_t); return __builtin_bit_cast(unsigned, r); }
DI u16 f2bf(float a) { return (u16)(pack2(a, 0.f) & 0xffffu); }
DI float bflo(unsigned u) { return __uint_as_float(u << 16); }
DI float bfhi(unsigned u) { return __uint_as_float(u & 0xffff0000u); }
DI int crow(int e, int h) { return (e & 3) + 8 * (e >> 2) + 4 * h; }
DI float wave_sum(float v) {
#pragma unroll
  for (int o = 32; o >= 1; o >>= 1) v += __shfl_xor(v, o);
  return v;
}
DI float silu_f(float v) { return v / (1.f + __expf(-v)); }
DI s16x4 tr_read(const char* p) {
  return __builtin_amdgcn_ds_read_tr16_b64_v4i16((__attribute__((address_space(3))) s16x4*)(p));
}
DI bf16x8 tr_frag(const char* p0, int stride4) {
  s16x4 lo = tr_read(p0), hi = tr_read(p0 + stride4);
  return __builtin_shufflevector(lo, hi, 0, 1, 2, 3, 4, 5, 6, 7);
}
DI bf16x8 pack8(const f32x16& x, int s) {
  u32x4 p;
  p[0] = pack2(x[8 * s + 0], x[8 * s + 1]);
  p[1] = pack2(x[8 * s + 2], x[8 * s + 3]);
  p[2] = pack2(x[8 * s + 4], x[8 * s + 5]);
  p[3] = pack2(x[8 * s + 6], x[8 * s + 7]);
  return __builtin_bit_cast(bf16x8, p);
}
DI f32x16 zero16() { f32x16 z; for (int i = 0; i < 16; ++i) z[i] = 0.f; return z; }

DI void phase0(const Params& p, char* smem) {
  const int tid = threadIdx.x, lane = tid & 63, w = tid >> 6;
  constexpr int NT_W1 = 16 * 64, NT_W2 = 16 * 16, NT_ROW = NTOK / 8, NT_CACHE = 2048;
  constexpr int total = NT_W1 + NT_W2 + NT_ROW + NT_CACHE;
  float (*tile)[65] = (float (*)[65])smem;
  if (blockIdx.x == 0 && tid == 0) *p.counter = 0;
  for (int it = blockIdx.x; it < total; it += gridDim.x) {
    if (it < NT_W1 + NT_W2) {
      const float* src; u16* dst; int N, kt, nt;
      if (it < NT_W1) { src = p.w_in; dst = p.WinT; N = 4096; kt = it >> 6; nt = it & 63; }
      else { int j = it - NT_W1; src = p.w_out; dst = p.WoutT; N = 1024; kt = j >> 4; nt = j & 15; }
      const int c = tid & 63, r0 = tid >> 6;
      for (int i = 0; i < 16; ++i) { int r = r0 + 4 * i; tile[r][c] = src[(size_t)(kt * 64 + r) * N + nt * 64 + c]; }
      __syncthreads();
      if (it < NT_W1) {
        for (int i = 0; i < 16; ++i) { int r = r0 + 4 * i; dst[(size_t)(nt * 64 + r) * 1024 + kt * 64 + c] = f2bf(tile[c][r]); }
      } else {
        for (int i = 0; i < 16; ++i) {
          const int r = r0 + 4 * i, n = nt * 64 + r, k = kt * 64 + c;
          dst[((size_t)((n >> 5) * 64 + (k >> 4)) * 64 + ((k >> 3) & 1) * 32 + (n & 31)) * 8 + (k & 7)] = f2bf(tile[c][r]);
        }
      }
      __syncthreads();
    } else if (it < NT_W1 + NT_W2 + NT_ROW) {
      const int row0 = (it - NT_W1 - NT_W2) * 8 + w * 2;
      f32x4 v[2][4]; float ss[2] = {0.f, 0.f};
#pragma unroll
      for (int rr = 0; rr < 2; ++rr) {
        const int row = row0 + rr;
        const float* src = row < NPTOK ? p.x_prompt + (size_t)row * 1024 : p.x_sample + (size_t)(row - NPTOK) * 1024;
#pragma unroll
        for (int i = 0; i < 4; ++i) v[rr][i] = *(const f32x4*)(src + i * 256 + lane * 4);
      }
#pragma unroll
      for (int rr = 0; rr < 2; ++rr) {
#pragma unroll
        for (int i = 0; i < 4; ++i) ss[rr] += v[rr][i][0] * v[rr][i][0] + v[rr][i][1] * v[rr][i][1] + v[rr][i][2] * v[rr][i][2] + v[rr][i][3] * v[rr][i][3];
        ss[rr] = wave_sum(ss[rr]);
      }
#pragma unroll
      for (int rr = 0; rr < 2; ++rr) {
        const float sc = rsqrtf(ss[rr] * (1.f / 1024.f) + 1e-6f);
#pragma unroll
        for (int i = 0; i < 4; ++i) {
          f32x4 g = *(const f32x4*)(p.norm_g + i * 256 + lane * 4);
          u32x2 o; o[0] = pack2(v[rr][i][0] * sc * g[0], v[rr][i][1] * sc * g[1]); o[1] = pack2(v[rr][i][2] * sc * g[2], v[rr][i][3] * sc * g[3]);
          *(u32x2*)(p.Xn + (size_t)(row0 + rr) * 1024 + i * 256 + lane * 4) = o;
        }
      }
    } else {
      const int task0 = (it - NT_W1 - NT_W2 - NT_ROW) * 8 + w * 2;
      f32x4 a[2], b[2];
#pragma unroll
      for (int rr = 0; rr < 2; ++rr) {
        const int task = task0 + rr, which = task >> 13, r8 = task & 8191;
        const float* src = (which ? p.cache_v : p.cache_k) + (size_t)r8 * 512 + lane * 8;
        a[rr] = *(const f32x4*)src; b[rr] = *(const f32x4*)(src + 4);
      }
#pragma unroll
      for (int rr = 0; rr < 2; ++rr) {
        const int task = task0 + rr, which = task >> 13, r8 = task & 8191;
        u16* dst = (which ? p.Vall : p.Kall) + (size_t)(NPTOK + (r8 >> 10) * 1088 + (r8 & 1023)) * 512 + lane * 8;
        u32x4 o; o[0] = pack2(a[rr][0], a[rr][1]); o[1] = pack2(a[rr][2], a[rr][3]); o[2] = pack2(b[rr][0], b[rr][1]); o[3] = pack2(b[rr][2], b[rr][3]);
        *(u32x4*)dst = o;
      }
    }
  }
}

#define G_LOAD(RA, RB, KT_)                                                                                        \
  {                                                                                                                 \
    _Pragma("unroll") for (int i_ = 0; i_ < 4; ++i_) RA[i_] = *(const u32x4*)(ap + (size_t)i_ * 64 * K + (KT_) * 32); \
    _Pragma("unroll") for (int i_ = 0; i_ < 2; ++i_) RB[i_] = *(const u32x4*)(bp + (size_t)i_ * 64 * K + (KT_) * 32); \
  }
#define G_WRITE(RA, RB, BUF_)                                                                                      \
  {                                                                                                                 \
    _Pragma("unroll") for (int i_ = 0; i_ < 4; ++i_) *(u32x4*)(wbase + (BUF_) * 30720 + i_ * 64 * 80) = RA[i_];          \
    _Pragma("unroll") for (int i_ = 0; i_ < 2; ++i_) *(u32x4*)(wbase + (BUF_) * 30720 + 20480 + i_ * 64 * 80) = RB[i_];  \
  }
#define G_COMPUTE(BUF_)                                                                                            \
  {                                                                                                                 \
    const char* as_ = smem + (BUF_) * 30720 + (wm * 128 + r) * 80 + h * 16;                                         \
    const char* bs_ = smem + (BUF_) * 30720 + 20480 + (wn * 64 + r) * 80 + h * 16;                                  \
    _Pragma("unroll") for (int s_ = 0; s_ < 2; ++s_) {                                                              \
      const bf16x8 b0_ = *(const bf16x8*)(bs_ + s_ * 32), b1_ = *(const bf16x8*)(bs_ + 32 * 80 + s_ * 32);          \
      _Pragma("unroll") for (int i_ = 0; i_ < 4; ++i_) {                                                            \
        const bf16x8 a_ = *(const bf16x8*)(as_ + i_ * 32 * 80 + s_ * 32);                                           \
        acc[i_][0] = MFMA(a_, b0_, acc[i_][0]);                                                                     \
        acc[i_][1] = MFMA(a_, b1_, acc[i_][1]);                                                                     \
      }                                                                                                             \
    }                                                                                                               \
  }
DI void gemm256(const u16* __restrict__ A, const u16* __restrict__ BT, int K, int m0, int n0, char* smem, int tid, f32x16 (&acc)[4][2]) {
  const int lane = tid & 63, w = tid >> 6, r = lane & 31, h = lane >> 5;
  const int wm = w >> 1, wn = w & 1;
#pragma unroll
  for (int i = 0; i < 4; ++i) { acc[i][0] = zero16(); acc[i][1] = zero16(); }
  u32x4 ra0[4], rb0[2], ra1[4], rb1[2];
  const int KT = K >> 5;
  const u16* ap = A + (size_t)(m0 + (tid >> 2)) * K + (tid & 3) * 8;
  const u16* bp = BT + (size_t)(n0 + (tid >> 2)) * K + (tid & 3) * 8;
  char* wbase = smem + (tid >> 2) * 80 + (tid & 3) * 16;
  G_LOAD(ra0, rb0, 0);
  G_LOAD(ra1, rb1, 1);
  G_WRITE(ra0, rb0, 0);
  __syncthreads();
  for (int kt = 0; kt < KT; kt += 2) {
    { const int k2 = kt + 2 < KT ? kt + 2 : KT - 1; G_LOAD(ra0, rb0, k2); }
    __builtin_amdgcn_sched_barrier(0);
    G_COMPUTE(0);
    __builtin_amdgcn_sched_barrier(0);
    G_WRITE(ra1, rb1, 1);
    __syncthreads();
    { const int k3 = kt + 3 < KT ? kt + 3 : KT - 1; G_LOAD(ra1, rb1, k3); }
    __builtin_amdgcn_sched_barrier(0);
    G_COMPUTE(1);
    __builtin_amdgcn_sched_barrier(0);
    G_WRITE(ra0, rb0, 0);
    __syncthreads();
  }
}
struct TileMap {
  int MT, NT, C, NG, NST, st, lb, lin;
  bool xcd;
  DI TileMap(int mt_, int nt_) : MT(mt_), NT(nt_) {
    const int nb = gridDim.x >> 3;
    C = nb >> 3;
    xcd = (gridDim.x & 63) == 0 && C > 0 && (NT % C) == 0;
    NG = xcd ? NT / C : 1;
    NST = ((MT + 7) >> 3) * NG;
    st = blockIdx.x & 7; lb = blockIdx.x >> 3; lin = blockIdx.x;
  }
  DI bool next(int& mt, int& nt) {
    if (!xcd) {
      if (lin >= MT * NT) return false;
      mt = lin / NT; nt = lin - mt * NT; lin += gridDim.x; return true;
    }
    while (st < NST) {
      const int mg = st / NG, ng = st - mg * NG;
      mt = mg * 8 + lb / C; nt = ng * C + lb % C;
      st += 8;
      if (mt < MT) return true;
    }
    return false;
  }
};
DI void stage_half(const f32x16 (&acc)[4][2], float* cs, int half, int wm, int wn, int r, int h) {
  if (wm == half) {
#pragma unroll
    for (int i = 0; i < 4; ++i)
#pragma unroll
      for (int j = 0; j < 2; ++j)
#pragma unroll
        for (int e = 0; e < 16; ++e) cs[(i * 32 + crow(e, h)) * 132 + wn * 64 + j * 32 + r] = acc[i][j][e];
  }
}

DI void phase1(const Params& p, char* smem) {
  const int tid = threadIdx.x, lane = tid & 63, w = tid >> 6, r = lane & 31, h = lane >> 5;
  const int wm = w >> 1, wn = w & 1;
  constexpr int MT = NTOK / 256, NT = 32;
  TileMap tm(MT, NT);
  int mt, nt;
  while (tm.next(mt, nt)) {
    const int m0 = mt * 256, n0 = nt * 128;
    f32x16 acc[4][2];
    gemm256(p.Xn, p.WinT, 1024, m0, n0, smem, tid, acc);
    const int sec = n0 >> 9;
    const bool samp = m0 >= NPTOK;
    float* cs = (float*)smem;
    const int c0 = (tid & 15) * 8, rb = tid >> 4;
    const int csc = (n0 & 511) + c0;
#pragma unroll 1
    for (int half = 0; half < 2; ++half) {
      stage_half(acc, cs, half, wm, wn, r, h);
      __syncthreads();
#pragma unroll 2
      for (int ps = 0; ps < 8; ++ps) {
        const int row = rb + 16 * ps;
        const int t = m0 + half * 128 + row;
        f32x4 va = *(const f32x4*)(cs + row * 132 + c0), vb = *(const f32x4*)(cs + row * 132 + c0 + 4);
        const size_t o512 = (size_t)t * 512 + csc;
        if (sec == 5) { __builtin_nontemporal_store(va, (f32x4*)(p.Fr + o512)); __builtin_nontemporal_store(vb, (f32x4*)(p.Fr + o512 + 4)); }
        else {
          u16* dst;
          if (sec == 0) {
            const float qs = 0.125f * 1.44269504089f;
            va *= qs; vb *= qs; dst = p.Qb + o512;
          } else if (sec == 1 || sec == 2) {
            size_t kvr; float* od;
            if (!samp) { kvr = t; od = p.out + (sec == 1 ? OFF_NKP : OFF_NVP) + o512; }
            else { const int ts = t - NPTOK; kvr = NPTOK + (ts >> 6) * 1088 + 1024 + (ts & 63); od = p.out + (sec == 1 ? OFF_NKS : OFF_NVS) + (size_t)ts * 512 + csc; }
            __builtin_nontemporal_store(va, (f32x4*)od); __builtin_nontemporal_store(vb, (f32x4*)(od + 4));
            dst = (sec == 1 ? p.Kall : p.Vall) + kvr * 512 + csc;
          } else if (sec == 6) { dst = p.Ir + o512; }
          else {
#pragma unroll
            for (int i = 0; i < 4; ++i) { va[i] = silu_f(va[i]); vb[i] = silu_f(vb[i]); }
            dst = (sec == 3 ? p.Za : (sec == 4 ? p.Qr : p.Zr)) + o512;
          }
          u32x4 o; o[0] = pack2(va[0], va[1]); o[1] = pack2(va[2], va[3]); o[2] = pack2(vb[0], vb[1]); o[3] = pack2(vb[2], vb[3]);
          __builtin_nontemporal_store(o, (u32x4*)dst);
        }
      }
      __syncthreads();
    }
  }
}

DI void rec_pre(const Params& p, int tid, int I, float* totS, float (&cum)[32], float (&key)[32], float& lastv) {
  const int d = tid & 127, half = tid >> 7;
  const int hd = I & 3, t0 = (I >> 2) * 64;
  const float r0 = p.rec_lb[hd * 128 + d], r1 = p.rec_lb[512 + hd * 128 + d];
  const float lb = 1.f / (1.f + __expf(r1 - r0));
  const float* fp = p.Fr + (size_t)(t0 + half * 32) * 512 + hd * 128 + d;
  float run = 0.f;
#pragma unroll
  for (int i = 0; i < 32; ++i) {
    float x = fp[(size_t)i * 512];
    x = fminf(fmaxf(x, -30.f), 30.f);
    const float e = __expf(-x), sg = 1.f / (1.f + e);
    run += __logf(lb + (1.f - lb) * sg);
    cum[i] = run; key[i] = (1.f - lb) * e * sg;
  }
  totS[tid] = run;
  __syncthreads();
  const float tot0 = totS[d], tot1 = totS[128 + d];
  if (half) {
#pragma unroll
    for (int i = 0; i < 32; ++i) cum[i] += tot0;
  }
  lastv = tot0 + tot1;
}

DI void phase2(const Params& p, char* smem, u16* BbufT) {
  const int tid = threadIdx.x, lane = tid & 63, w = tid >> 6, r = lane & 31, h = lane >> 5;
  const int q = (lane & 15) >> 2, pp = lane & 3, blk = (lane >> 4) & 1;
  const int d = tid & 127, half = tid >> 7;
  char* KdI = smem; char* VrI = smem + 17408; float* totS = (float*)(smem + 60000);
  for (int I = blockIdx.x; I < NITEM; I += gridDim.x) {
    const int hd = I & 3, t0 = (I >> 2) * 64;
    if (I < 2048) {
      const int token = tid & 63, which = tid >> 6;
      const u16* src = (which < 2 ? p.Qb : p.Kall) + (size_t)(t0 + token) * 512 + hd * 128 + (which & 1) * 64;
      float ss = 0.f;
#pragma unroll
      for (int c = 0; c < 8; ++c) {
        const u32x4 v = *(const u32x4*)(src + c * 8);
#pragma unroll
        for (int i = 0; i < 4; ++i) { const float lo = bflo(v[i]), hi = bfhi(v[i]); ss += lo * lo + hi * hi; }
      }
#pragma unroll
      for (int o = 32; o >= 1; o >>= 1) ss = fmaxf(ss, __shfl_xor(ss, o));
      if (lane == 0) p.NQ[I * 4 + which] = sqrtf(ss);
    }
    float cum[32], key[32], lastv;
    rec_pre(p, tid, I, totS, cum, key, lastv);
#pragma unroll
    for (int i = 0; i < 32; ++i) {
      const int t = half * 32 + i;
      *(u16*)(KdI + t * 272 + d * 2) = f2bf(key[i] * __expf(lastv - cum[i]));
    }
#pragma unroll
    for (int i = 0; i < 4; ++i) {
      const int ch = tid + 256 * i, row = ch >> 4, cc = ch & 15;
      *(u32x4*)(VrI + row * 272 + cc * 16) = *(const u32x4*)(p.Ir + (size_t)(t0 + row) * 512 + hd * 128 + cc * 8);
    }
    if (half) p.Abuf[I * 128 + d] = __expf(lastv);
    __syncthreads();
    f32x16 acc[4];
#pragma unroll
    for (int ct = 0; ct < 4; ++ct) acc[ct] = zero16();
#pragma unroll
    for (int ks = 0; ks < 4; ++ks) {
      const int rowoff = (16 * ks + 8 * h + q) * 272 + 32 * blk + 8 * pp;
      bf16x8 a = tr_frag(VrI + rowoff + 64 * w, 4 * 272);
#pragma unroll
      for (int ct = 0; ct < 4; ++ct) {
        bf16x8 b = tr_frag(KdI + rowoff + 64 * ct, 4 * 272);
        acc[ct] = MFMA(a, b, acc[ct]);
      }
    }
    u16* ob = BbufT + (size_t)I * 16384;
#pragma unroll
    for (int ct = 0; ct < 4; ++ct)
#pragma unroll
      for (int e = 0; e < 16; ++e) ob[(32 * w + crow(e, h)) * 128 + 32 * ct + r] = f2bf(acc[ct][e]);
    __syncthreads();
  }
}

DI void phase3(const Params& p, const u16* BbufT) {
  const int tid = threadIdx.x;
  for (int it = blockIdx.x; it < 512 + 1024; it += gridDim.x) {
    if (it < 512) {
      const int bh = it >> 6, b = bh >> 2, hd = bh & 3;
      const int e1 = (it & 63) * 256 + tid, v = e1 >> 7, d = e1 & 127;
      float sx = 0.f;
      const size_t eo = (size_t)v * 128 + d;
      const int I0 = (b * 256) * 4 + hd;
      const float* ap = p.Abuf + (size_t)I0 * 128 + d;
      const u16* bp = BbufT + (size_t)I0 * 16384 + eo;
      u16* sp = p.SbufT + (size_t)I0 * 16384 + eo;
#pragma unroll 16
      for (int c = 0; c < 256; ++c) {
        const float a = ap[(size_t)c * 4 * 128];
        const float bv = bflo(bp[(size_t)c * 4 * 16384]);
        sp[(size_t)c * 4 * 16384] = f2bf(sx);
        sx = a * sx + bv;
      }
      p.out[OFF_NHP + (size_t)(b * 4 + hd) * 16384 + d * 128 + v] = sx;
    } else {
      const int j = it - 512;
      const int sh = j >> 5, bs = sh >> 2, hd = sh & 3;
      const int e2 = (j & 31) * 256 + tid, v = e2 >> 6, d2 = (e2 & 63) * 2;
      const int I = (512 + bs) * 4 + hd;
      const float* sh0 = p.state_h + (size_t)(bs * 4 + hd) * 16384;
      float sx = sh0[d2 * 128 + v], sy = sh0[(d2 + 1) * 128 + v];
      const size_t eo = (size_t)v * 128 + d2;
      const f32x2 a = *(const f32x2*)(p.Abuf + I * 128 + d2);
      const unsigned bw = *(const unsigned*)(BbufT + (size_t)I * 16384 + eo);
      *(unsigned*)(p.SbufT + (size_t)I * 16384 + eo) = pack2(sx, sy);
      sx = a[0] * sx + bflo(bw); sy = a[1] * sy + bfhi(bw);
      float* oh = p.out + OFF_NHS + (size_t)(bs * 4 + hd) * 16384;
      oh[d2 * 128 + v] = sx; oh[(d2 + 1) * 128 + v] = sy;
    }
  }
}

DI void r3_item(const Params& p, char* smem, int tid, int I) {
  const int lane = tid & 63, w = tid >> 6, r = lane & 31, h = lane >> 5;
  const int q = (lane & 15) >> 2, pp = lane & 3, blk = (lane >> 4) & 1;
  const int d = tid & 127, half = tid >> 7;
  char* QdI = smem; char* KdI = smem + 17408; char* VrI = smem + 34816;
  float* totS = (float*)(smem + 60000); float* ssS = (float*)(smem + 62048);
  const int hd = I & 3, t0 = (I >> 2) * 64;
  {
    float cum[32], key[32], lastv;
    rec_pre(p, tid, I, totS, cum, key, lastv);
    const u16* qp = p.Qr + (size_t)(t0 + half * 32) * 512 + hd * 128 + d;
#pragma unroll
    for (int i = 0; i < 32; ++i) {
      const int t = half * 32 + i;
      const float qv = bflo(qp[(size_t)i * 512]);
      *(u16*)(QdI + t * 272 + d * 2) = f2bf(qv * __expf(cum[i]));
      *(u16*)(KdI + t * 272 + d * 2) = f2bf(key[i] * __expf(-cum[i]));
    }
  }
#pragma unroll
  for (int i = 0; i < 4; ++i) {
    const int ch = tid + 256 * i, row = ch >> 4, cc = ch & 15;
    *(u32x4*)(VrI + row * 272 + cc * 16) = *(const u32x4*)(p.Ir + (size_t)(t0 + row) * 512 + hd * 128 + cc * 8);
  }
  __syncthreads();
  const int tt = w & 1, vh = w >> 1;
  bf16x8 qf[8];
#pragma unroll
  for (int ks = 0; ks < 8; ++ks) qf[ks] = *(const bf16x8*)(QdI + (32 * tt + r) * 272 + ks * 32 + h * 16);
  f32x16 sc[2]; sc[0] = zero16(); sc[1] = zero16();
#pragma unroll
  for (int ks = 0; ks < 8; ++ks) {
    bf16x8 a0 = *(const bf16x8*)(KdI + r * 272 + ks * 32 + h * 16);
    sc[0] = MFMA(a0, qf[ks], sc[0]);
  }
  if (tt == 1) {
#pragma unroll
    for (int ks = 0; ks < 8; ++ks) {
      bf16x8 a1 = *(const bf16x8*)(KdI + (32 + r) * 272 + ks * 32 + h * 16);
      sc[1] = MFMA(a1, qf[ks], sc[1]);
    }
  }
#pragma unroll
  for (int e = 0; e < 16; ++e) {
    const bool keep = crow(e, h) <= r;
    if (tt == 0) { if (!keep) sc[0][e] = 0.f; }
    else { if (!keep) sc[1][e] = 0.f; }
  }
  bf16x8 pf[4];
  pf[0] = pack8(sc[0], 0); pf[1] = pack8(sc[0], 1); pf[2] = pack8(sc[1], 0); pf[3] = pack8(sc[1], 1);
  f32x16 o[2]; o[0] = zero16(); o[1] = zero16();
  const u16* sp = p.SbufT + (size_t)I * 16384;
#pragma unroll
  for (int vi = 0; vi < 2; ++vi) {
    const int vt = 2 * vh + vi;
#pragma unroll
    for (int k4 = 0; k4 < 4; ++k4) {
      if (k4 < 2 || tt == 1) {
        bf16x8 a = tr_frag(VrI + (16 * k4 + 4 * h + q) * 272 + (32 * vt + 16 * blk) * 2 + 8 * pp, 8 * 272);
        o[vi] = MFMA(a, pf[k4], o[vi]);
      }
    }
#pragma unroll
    for (int ks = 0; ks < 8; ++ks) {
      bf16x8 a = *(const bf16x8*)(sp + (size_t)(32 * vt + r) * 128 + ks * 16 + h * 8);
      o[vi] = MFMA(a, qf[ks], o[vi]);
    }
  }
  float ss = 0.f;
#pragma unroll
  for (int vi = 0; vi < 2; ++vi)
#pragma unroll
    for (int e = 0; e < 16; ++e) ss += o[vi][e] * o[vi][e];
  ss += __shfl_xor(ss, 32);
  if (h == 0) ssS[w * 32 + r] = ss;
  __syncthreads();
  const float tot = ssS[tt * 32 + r] + ssS[(tt + 2) * 32 + r];
  const float rs = rsqrtf(tot * (1.f / 128.f) + 1e-6f);
  const int tok = t0 + 32 * tt + r;
#pragma unroll
  for (int vi = 0; vi < 2; ++vi)
#pragma unroll
    for (int g = 0; g < 4; ++g) {
      const int v = 32 * (2 * vh + vi) + 8 * g + 4 * h;
      const f32x4 gg = *(const f32x4*)(p.rec_norm_g + v);
      const u32x2 z = *(const u32x2*)(p.Zr + (size_t)tok * 512 + hd * 128 + v);
      u32x2 ov;
      ov[0] = pack2(o[vi][4 * g + 0] * rs * gg[0] * bflo(z[0]), o[vi][4 * g + 1] * rs * gg[1] * bfhi(z[0]));
      ov[1] = pack2(o[vi][4 * g + 2] * rs * gg[2] * bflo(z[1]), o[vi][4 * g + 3] * rs * gg[3] * bfhi(z[1]));
      *(u32x2*)(p.Mix + (size_t)tok * 1024 + 512 + hd * 128 + v) = ov;
    }
  __syncthreads();
}

template <bool DIAG>
DI void attn_tile_a(const char* ks, const bf16x8 (&qf)[4], f32x16 (&O)[4], bf16x8 (&pf)[4], float& mrun, float& lsum, float sl2, float qrel,
                    int m, int r, int h2) {
  f32x16 S[2];
#pragma unroll
  for (int st = 0; st < 2; ++st) {
    S[st] = zero16();
#pragma unroll
    for (int s = 0; s < 4; ++s) {
      bf16x8 a = *(const bf16x8*)(ks + (32 * st + r) * 272 + m * 128 + s * 32 + h2 * 16);
      S[st] = MFMA(a, qf[s], S[st]);
    }
  }
  float mx = -1e30f;
#pragma unroll
  for (int st = 0; st < 2; ++st)
#pragma unroll
    for (int e = 0; e < 16; ++e) {
      const float cst = (float)(32 * st + (e & 3) + 8 * (e >> 2));
      float sv;
      if (DIAG) sv = fmaf(-sl2, fabsf(qrel - cst), S[st][e]);
      else sv = fmaf(sl2, cst, S[st][e]);
      S[st][e] = sv; mx = fmaxf(mx, sv);
    }
  const float L = DIAG ? 0.f : -sl2 * qrel;
  mx += L;
  mx = fmaxf(mx, __shfl_xor(mx, 32));
  if (__builtin_amdgcn_ballot_w64(mx > mrun + 6.f) != 0) {
    const float mnew = fmaxf(mrun, mx);
    const float alpha = __builtin_amdgcn_exp2f(mrun - mnew);
    mrun = mnew; lsum *= alpha;
#pragma unroll
    for (int vt = 0; vt < 4; ++vt)
#pragma unroll
      for (int e = 0; e < 16; ++e) O[vt][e] *= alpha;
  }
  const float off = L - mrun;
  float rs = 0.f;
#pragma unroll
  for (int st = 0; st < 2; ++st)
#pragma unroll
    for (int e = 0; e < 16; ++e) { const float pv = __builtin_amdgcn_exp2f(S[st][e] + off); S[st][e] = pv; rs += pv; }
  lsum += rs;
  pf[0] = pack8(S[0], 0); pf[1] = pack8(S[0], 1); pf[2] = pack8(S[1], 0); pf[3] = pack8(S[1], 1);
}
template <bool DIAG>
DI void attn_tile_f(const char* ks, const bf16x8 (&qf)[4], bf16x8 (&pf)[4], float& lsum, float sl2, float qrel, float mref, int m, int r, int h2) {
  f32x16 S[2];
  const float offL = -sl2 * qrel - mref;
#pragma unroll
  for (int st = 0; st < 2; ++st) {
#pragma unroll
    for (int e = 0; e < 16; ++e) {
      const float cst = (float)(32 * st + (e & 3) + 8 * (e >> 2));
      S[st][e] = DIAG ? (-sl2 * fabsf(qrel - cst) - mref) : fmaf(sl2, cst, offL);
    }
#pragma unroll
    for (int s = 0; s < 4; ++s) {
      bf16x8 a = *(const bf16x8*)(ks + (32 * st + r) * 272 + m * 128 + s * 32 + h2 * 16);
      S[st] = MFMA(a, qf[s], S[st]);
    }
  }
  float rs = 0.f;
#pragma unroll
  for (int st = 0; st < 2; ++st)
#pragma unroll
    for (int e = 0; e < 16; ++e) { const float pv = __builtin_amdgcn_exp2f(S[st][e]); S[st][e] = pv; rs += pv; }
  lsum += rs;
  pf[0] = pack8(S[0], 0); pf[1] = pack8(S[0], 1); pf[2] = pack8(S[1], 0); pf[3] = pack8(S[1], 1);
}
DI void attn_tile_b(const char* vs, const bf16x8 (&pf)[4], f32x16 (&O)[4], int h2, int q, int pp, int blk) {
  const char* vb = vs + (4 * h2 + q) * 320 + 32 * blk + 8 * pp;
  bf16x8 a0[4], a1[4];
#pragma unroll
  for (int vt = 0; vt < 4; ++vt) a0[vt] = tr_frag(vb + 64 * vt, 8 * 320);
  __builtin_amdgcn_sched_barrier(0);
#pragma unroll
  for (int vt = 0; vt < 4; ++vt) a1[vt] = tr_frag(vb + 16 * 320 + 64 * vt, 8 * 320);
#pragma unroll
  for (int vt = 0; vt < 4; ++vt) O[vt] = MFMA(a0[vt], pf[0], O[vt]);
  __builtin_amdgcn_sched_barrier(0);
#pragma unroll
  for (int vt = 0; vt < 4; ++vt) a0[vt] = tr_frag(vb + 32 * 320 + 64 * vt, 8 * 320);
#pragma unroll
  for (int vt = 0; vt < 4; ++vt) O[vt] = MFMA(a1[vt], pf[1], O[vt]);
  __builtin_amdgcn_sched_barrier(0);
#pragma unroll
  for (int vt = 0; vt < 4; ++vt) a1[vt] = tr_frag(vb + 48 * 320 + 64 * vt, 8 * 320);
#pragma unroll
  for (int vt = 0; vt < 4; ++vt) O[vt] = MFMA(a0[vt], pf[2], O[vt]);
  __builtin_amdgcn_sched_barrier(0);
#pragma unroll
  for (int vt = 0; vt < 4; ++vt) O[vt] = MFMA(a1[vt], pf[3], O[vt]);
}

DI void attn_item(const Params& p, char* smem, int tid, int tq0, int qpos0, int kvbase, int ntb, int hd, float lam, bool can_skip) {
  const int lane = tid & 63, w = tid >> 6, r = lane & 31, h2 = lane >> 5;
  const int q = (lane & 15) >> 2, pp = lane & 3, blk = (lane >> 4) & 1;
  const int qh = w & 1, m = w >> 1;
  const float sl2 = exp2f(-2.f * (float)(hd + 1)) * 1.44269504089f;
  const int qtok = tq0 + 32 * qh + r;
  const float qposf = (float)(qpos0 + 32 * qh + r);
  int kt0w = 0, kt0b = 0;
  bool fast = false; float kn_w = 0.f;
  if (can_skip) {
    float qnv[2], knv[2];
    const int I0 = (tq0 >> 6) * 4 + hd;
    const int crk = kvbase >> 6;
    int k0[2];
#pragma unroll
    for (int mm = 0; mm < 2; ++mm) {
      const float QN = p.NQ[I0 * 4 + mm];
      float KN = 0.f;
      for (int c = lane; c < ntb; c += 64) KN = fmaxf(KN, p.NQ[((crk + c) * 4 + hd) * 4 + 2 + mm]);
#pragma unroll
      for (int o = 32; o >= 1; o >>= 1) KN = fmaxf(KN, __shfl_xor(KN, o));
      qnv[mm] = QN; knv[mm] = KN;
      const float D = (2.02f * QN * KN + 66.f) / sl2;
      const float f = ((float)(qpos0 - 63) - D) * (1.f / 64.f);
      k0[mm] = f < 0.f ? 0 : (int)f + 1;
    }
    kt0w = m ? k0[1] : k0[0];
    kt0b = k0[0] < k0[1] ? k0[0] : k0[1];
    kn_w = m ? knv[1] : knv[0];
    fast = 2.02f * (m ? qnv[1] : qnv[0]) * kn_w < 60.f;
  }
  bf16x8 qf[4];
#pragma unroll
  for (int s = 0; s < 4; ++s) qf[s] = *(const bf16x8*)(p.Qb + (size_t)qtok * 512 + hd * 128 + m * 64 + 16 * s + 8 * h2);
  float mref = 0.f;
  if (fast) {
    float qq = 0.f;
#pragma unroll
    for (int s = 0; s < 4; ++s) {
      const u32x4 u = __builtin_bit_cast(u32x4, qf[s]);
#pragma unroll
      for (int i = 0; i < 4; ++i) { const float lo = bflo(u[i]), hi = bfhi(u[i]); qq += lo * lo + hi * hi; }
    }
    qq += __shfl_xor(qq, 32);
    mref = sqrtf(qq) * kn_w * 1.01f + 0.5f;
  }
  f32x16 O[4];
#pragma unroll
  for (int vt = 0; vt < 4; ++vt) O[vt] = zero16();
  float mrun = -1e30f, lsum = 0.f;
  u32x4 rk[4], rv[4];
  const int lrow = tid >> 4, lcc = tid & 15;
  const size_t gofs = (size_t)(kvbase + lrow) * 512 + hd * 128 + lcc * 8;
  const u16* kp = p.Kall + gofs;
  const u16* vp = p.Vall + gofs;
  char* kw = smem + lrow * 272 + lcc * 16;
  char* vw = smem + 17408 + lrow * 320 + lcc * 16;
  const int nit = ntb - kt0b;
  {
    const size_t go = (size_t)(fast ? kt0b : ntb - 1) * 64 * 512;
#pragma unroll
    for (int i = 0; i < 4; ++i) { rk[i] = *(const u32x4*)(kp + go + (size_t)i * 16 * 512); rv[i] = *(const u32x4*)(vp + go + (size_t)i * 16 * 512); }
#pragma unroll
    for (int i = 0; i < 4; ++i) { *(u32x4*)(kw + i * 16 * 272) = rk[i]; *(u32x4*)(vw + i * 16 * 320) = rv[i]; }
    const int k1 = fast ? (kt0b + 1 < ntb ? kt0b + 1 : ntb - 1) : (ntb - 2 > kt0b ? ntb - 2 : kt0b);
    const size_t g1 = (size_t)k1 * 64 * 512;
#pragma unroll
    for (int i = 0; i < 4; ++i) { rk[i] = *(const u32x4*)(kp + g1 + (size_t)i * 16 * 512); rv[i] = *(const u32x4*)(vp + g1 + (size_t)i * 16 * 512); }
  }
  __syncthreads();
  if (fast) {
    for (int it = 0; it < nit; ++it) {
      const int kt = kt0b + it;
      const bool active = kt >= kt0w;
      const char* ks = smem + (it & 1) * 37888;
      char* wb = kw + ((it + 1) & 1) * 37888;
      char* wbv = vw + ((it + 1) & 1) * 37888;
  #pragma unroll
      for (int i = 0; i < 4; ++i) { *(u32x4*)(wb + i * 16 * 272) = rk[i]; *(u32x4*)(wbv + i * 16 * 320) = rv[i]; }
      {
        const int k2 = kt + 2 < ntb ? kt + 2 : ntb - 1;
        const size_t g2 = (size_t)k2 * 64 * 512;
  #pragma unroll
        for (int i = 0; i < 4; ++i) { rk[i] = *(const u32x4*)(kp + g2 + (size_t)i * 16 * 512); rv[i] = *(const u32x4*)(vp + g2 + (size_t)i * 16 * 512); }
      }
      __builtin_amdgcn_sched_barrier(0);
      if (active) {
        bf16x8 pf[4];
        const float qrel = qposf - (float)(kt * 64 + 4 * h2);
        if (it == nit - 1) attn_tile_f<true>(ks, qf, pf, lsum, sl2, qrel, mref, m, r, h2);
        else attn_tile_f<false>(ks, qf, pf, lsum, sl2, qrel, mref, m, r, h2);
        attn_tile_b(ks + 17408, pf, O, h2, q, pp, blk);
      }
      __syncthreads();
    }
  } else {
    for (int it = 0; it < nit; ++it) {
      const int kt = ntb - 1 - it;
      const bool active = kt >= kt0w;
      const char* ks = smem + (it & 1) * 37888;
      char* wb = kw + ((it + 1) & 1) * 37888;
      char* wbv = vw + ((it + 1) & 1) * 37888;
  #pragma unroll
      for (int i = 0; i < 4; ++i) { *(u32x4*)(wb + i * 16 * 272) = rk[i]; *(u32x4*)(wbv + i * 16 * 320) = rv[i]; }
      {
        const int k2 = kt - 2 > kt0b ? kt - 2 : kt0b;
        const size_t g2 = (size_t)k2 * 64 * 512;
  #pragma unroll
        for (int i = 0; i < 4; ++i) { rk[i] = *(const u32x4*)(kp + g2 + (size_t)i * 16 * 512); rv[i] = *(const u32x4*)(vp + g2 + (size_t)i * 16 * 512); }
      }
      __builtin_amdgcn_sched_barrier(0);
      if (active) {
        bf16x8 pf[4];
        const float qrel = qposf - (float)(kt * 64 + 4 * h2);
        if (it == 0) attn_tile_a<true>(ks, qf, O, pf, mrun, lsum, sl2, qrel, m, r, h2);
        else attn_tile_a<false>(ks, qf, O, pf, mrun, lsum, sl2, qrel, m, r, h2);
        attn_tile_b(ks + 17408, pf, O, h2, q, pp, blk);
      }
      __syncthreads();
    }
  }
  const float lt = lsum + __shfl_xor(lsum, 32);
  const float inv = 1.f / lt;
  float* exch = (float*)smem + qh * 4096 + lane;
  if (m == 1) {
#pragma unroll
    for (int vt = 0; vt < 4; ++vt)
#pragma unroll
      for (int e = 0; e < 16; ++e) exch[(vt * 16 + e) * 64] = O[vt][e] * inv;
  }
  __syncthreads();
  if (m == 0) {
    float ss = 0.f;
#pragma unroll
    for (int vt = 0; vt < 4; ++vt)
#pragma unroll
      for (int e = 0; e < 16; ++e) { const float ov = O[vt][e] * inv - lam * exch[(vt * 16 + e) * 64]; O[vt][e] = ov; ss += ov * ov; }
    ss += __shfl_xor(ss, 32);
    const float rsn = rsqrtf(ss * (1.f / 128.f) + 1e-6f) * 0.8f;
#pragma unroll
    for (int vt = 0; vt < 4; ++vt)
#pragma unroll
      for (int g = 0; g < 4; ++g) {
        const int v = 32 * vt + 8 * g + 4 * h2;
        const f32x4 gg = *(const f32x4*)(p.subln_g + v);
        const u32x2 z = *(const u32x2*)(p.Za + (size_t)qtok * 512 + hd * 128 + v);
        u32x2 ov;
        ov[0] = pack2(O[vt][4 * g + 0] * rsn * gg[0] * bflo(z[0]), O[vt][4 * g + 1] * rsn * gg[1] * bfhi(z[0]));
        ov[1] = pack2(O[vt][4 * g + 2] * rsn * gg[2] * bflo(z[1]), O[vt][4 * g + 3] * rsn * gg[3] * bfhi(z[1]));
        *(u32x2*)(p.Mix + (size_t)qtok * 1024 + hd * 128 + v) = ov;
      }
  }
  __syncthreads();
}

DI void phase4(const Params& p, char* smem) {
  const int tid = threadIdx.x, lane = tid & 63;
  float lam;
  {
    const float a = p.lambda_qk[lane] * p.lambda_qk[64 + lane];
    const float b = p.lambda_qk[128 + lane] * p.lambda_qk[192 + lane];
    lam = __expf(wave_sum(a)) - __expf(wave_sum(b)) + 0.2f;
  }
  int* sitem = (int*)(smem + 76784);
  constexpr int NPA = 2048, NSA = 32, TOTAL = NPA + NSA + NITEM;
  for (;;) {
    if (tid == 0) *sitem = atomicAdd(p.counter, 1);
    __syncthreads();
    const int item = *sitem;
    __syncthreads();
    if (item >= TOTAL) break;
    int tid_o = tid;
    asm volatile("" : "+v"(tid_o));
    if (item < NPA + NSA) {
      int tq0, qpos0, kvbase, ntb, hd; bool can_skip;
      if (item < NPA) {
        const int qb = 255 - ((item & 511) >> 1), b = item & 1;
        hd = 3 - (item >> 9); tq0 = b * 16384 + qb * 64; qpos0 = qb * 64; kvbase = b * 16384; ntb = qb + 1; can_skip = true;
      } else {
        const int it = item - NPA, bs = it >> 2;
        hd = it & 3; tq0 = NPTOK + bs * 64; qpos0 = 1024; kvbase = NPTOK + bs * 1088; ntb = 17; can_skip = false;
      }
      attn_item(p, smem, tid_o, tq0, qpos0, kvbase, ntb, hd, lam, can_skip);
    } else {
      r3_item(p, smem, tid_o, item - NPA - NSA);
    }
  }
}

DI void phase5(const Params& p, char* smem) {
  float* wsum = (float*)(smem + 66048);
  for (int strip = blockIdx.x; strip < NTOK / 32; strip += gridDim.x) {
    int tid = threadIdx.x;
    asm volatile("" : "+v"(tid));
    const int lane = tid & 63, w = tid >> 6, r = lane & 31, h = lane >> 5;
    const int m0 = strip * 32;
#pragma unroll
    for (int i = 0; i < 16; ++i) {
      const int ch = tid + 256 * i, row = ch >> 7, cc = ch & 127;
      *(u32x4*)(smem + row * 2064 + cc * 16) = __builtin_nontemporal_load((const u32x4*)(p.Mix + (size_t)(m0 + row) * 1024 + cc * 8));
    }
    f32x16 acc[8];
#pragma unroll
    for (int j = 0; j < 8; ++j) acc[j] = zero16();
    const u16* bp = p.WoutT + (size_t)(w * 8) * 64 * 512 + lane * 8;
    bf16x8 b0[8], b1[8];
#pragma unroll
    for (int j = 0; j < 8; ++j) { b0[j] = *(const bf16x8*)(bp + (size_t)(j * 64 + 0) * 512); b1[j] = *(const bf16x8*)(bp + (size_t)(j * 64 + 1) * 512); }
    __syncthreads();
    const char* ap = smem + r * 2064 + h * 16;
    for (int ks = 0; ks < 64; ks += 2) {
      {
        const bf16x8 a = *(const bf16x8*)(ap + ks * 32);
#pragma unroll
        for (int j = 0; j < 8; ++j) acc[j] = MFMA(a, b0[j], acc[j]);
        const int k2 = ks + 2 < 64 ? ks + 2 : 63;
#pragma unroll
        for (int j = 0; j < 8; ++j) b0[j] = *(const bf16x8*)(bp + (size_t)(j * 64 + k2) * 512);
      }
      __builtin_amdgcn_sched_barrier(0);
      {
        const bf16x8 a = *(const bf16x8*)(ap + (ks + 1) * 32);
#pragma unroll
        for (int j = 0; j < 8; ++j) acc[j] = MFMA(a, b1[j], acc[j]);
        const int k3 = ks + 3 < 64 ? ks + 3 : 63;
#pragma unroll
        for (int j = 0; j < 8; ++j) b1[j] = *(const bf16x8*)(bp + (size_t)(j * 64 + k3) * 512);
      }
      __builtin_amdgcn_sched_barrier(0);
    }
    const float* xs_u = (m0 < NPTOK ? p.x_prompt : p.x_sample - (size_t)NPTOK * 1024) + (size_t)m0 * 1024;
    const int lane_off = h * 4096 + w * 256 + r;
    float ps[16];
#pragma unroll
    for (int e = 0; e < 16; ++e) ps[e] = 0.f;
#pragma unroll
    for (int j = 0; j < 8; ++j) {
#pragma unroll
      for (int e = 0; e < 16; ++e) {
        const float hv = acc[j][e] + __builtin_nontemporal_load((xs_u + ((e & 3) + 8 * (e >> 2)) * 1024 + j * 32) + lane_off);
        acc[j][e] = hv; ps[e] += hv * hv;
      }
      __builtin_amdgcn_sched_barrier(0);
    }
#pragma unroll
    for (int e = 0; e < 16; ++e) {
#pragma unroll
      for (int o = 16; o >= 1; o >>= 1) ps[e] += __shfl_xor(ps[e], o);
    }
    if (r == 0) {
#pragma unroll
      for (int e = 0; e < 16; ++e) wsum[w * 32 + crow(e, h)] = ps[e];
    }
    __syncthreads();
#pragma unroll
    for (int e = 0; e < 16; ++e) {
      const int rw = crow(e, h);
      ps[e] = rsqrtf((wsum[rw] + wsum[32 + rw] + wsum[64 + rw] + wsum[96 + rw]) * (1.f / 1024.f) + 1e-6f);
    }
    float* yo_u = p.out + OFF_Y + (size_t)m0 * 1024;
#pragma unroll
    for (int j = 0; j < 8; ++j) {
      const float g = (p.final_g + j * 32)[w * 256 + r];
#pragma unroll
      for (int e = 0; e < 16; ++e) __builtin_nontemporal_store(acc[j][e] * ps[e] * g, (yo_u + ((e & 3) + 8 * (e >> 2)) * 1024 + j * 32) + lane_off);
      __builtin_amdgcn_sched_barrier(0);
    }
    __syncthreads();
  }
}

__global__ void __launch_bounds__(256, 2) fwd_megakernel(Params p) {
  __shared__ __attribute__((aligned(16))) char smem[76800];
  cg::grid_group grid = cg::this_grid();
  float* scratch_out = p.out + OFF_Y;
  const int lo = p.phase_lo, hi = p.phase_hi, rm = p.rep_mask;
  if (lo <= 0 && hi >= 0) phase0(p, smem);
  if (rm & 1) { grid.sync(); phase0(p, smem); }
  if (lo <= 0 && hi >= 1) grid.sync();
  if (lo <= 1 && hi >= 1) phase1(p, smem);
  if (rm & 2) { grid.sync(); phase1(p, smem); }
  if (lo <= 1 && hi >= 2) grid.sync();
  if (lo <= 2 && hi >= 2) phase2(p, smem, (u16*)scratch_out);
  if (rm & 4) { grid.sync(); phase2(p, smem, (u16*)scratch_out); }
  if (lo <= 2 && hi >= 3) grid.sync();
  if (lo <= 3 && hi >= 3) phase3(p, (const u16*)scratch_out);
  if (rm & 8) { grid.sync(); phase3(p, (const u16*)scratch_out); }
  if (lo <= 3 && hi >= 4) grid.sync();
  if (lo <= 4 && hi >= 4) phase4(p, smem);
  if (lo <= 4 && hi >= 5) grid.sync();
  if (lo <= 5 && hi >= 5) phase5(p, smem);
}

extern "C" void kernel_launch(void* const* d_in, const int* in_sizes, int n_in, void* d_out, int out_size, void* d_ws, size_t ws_size,
                              hipStream_t stream) {
  static int grid_blocks = 0;
  if (!grid_blocks) {
    int dev = 0, cus = 0, per_cu = 0;
    hipGetDevice(&dev);
    hipDeviceGetAttribute(&cus, hipDeviceAttributeMultiprocessorCount, dev);
    hipOccupancyMaxActiveBlocksPerMultiprocessor(&per_cu, fwd_megakernel, 256, 0);
    if (per_cu > 2) per_cu = 2;
    if (per_cu < 1) per_cu = 1;
    grid_blocks = cus * per_cu;
  }
  Params p{};
  p.x_prompt = (const float*)d_in[0]; p.x_sample = (const float*)d_in[1]; p.cache_k = (const float*)d_in[2]; p.cache_v = (const float*)d_in[3];
  p.state_h = (const float*)d_in[4]; p.norm_g = (const float*)d_in[5]; p.w_in = (const float*)d_in[6]; p.lambda_qk = (const float*)d_in[7];
  p.subln_g = (const float*)d_in[8]; p.rec_lb = (const float*)d_in[9]; p.rec_norm_g = (const float*)d_in[10]; p.w_out = (const float*)d_in[11];
  p.final_g = (const float*)d_in[12];
  p.out = (float*)d_out;
  char* ws = (char*)d_ws; size_t off = 0;
  auto take = [&](size_t bytes) { char* r = ws + off; off += (bytes + 255) & ~(size_t)255; return r; };
  p.WinT = (u16*)take((size_t)4096 * 1024 * 2);
  p.WoutT = (u16*)take((size_t)1024 * 1024 * 2);
  p.Xn = (u16*)take((size_t)NTOK * 1024 * 2);
  p.SbufT = p.Xn;
  p.Qb = (u16*)take((size_t)NTOK * 512 * 2);
  p.Kall = (u16*)take((size_t)KVROWS * 512 * 2);
  p.Vall = (u16*)take((size_t)KVROWS * 512 * 2);
  p.Za = (u16*)take((size_t)NTOK * 512 * 2);
  p.Qr = (u16*)take((size_t)NTOK * 512 * 2);
  p.Ir = (u16*)take((size_t)NTOK * 512 * 2);
  p.Zr = (u16*)take((size_t)NTOK * 512 * 2);
  p.Mix = (u16*)take((size_t)NTOK * 1024 * 2);
  p.Fr = (float*)take((size_t)NTOK * 512 * 4);
  p.Abuf = (float*)take((size_t)NITEM * 128 * 4);
  p.NQ = (float*)take((size_t)NITEM * 4 * 4);
  p.counter = (int*)take(256);
  p.phase_lo = 0; p.phase_hi = 6; p.rep_mask = 0; p.pad_ = 0;
  if (off > ws_size) { fprintf(stderr, "workspace too small: need %zu have %zu\n", off, ws_size); return; }
  void* args[] = {&p};
  hipError_t e = hipLaunchCooperativeKernel((void*)fwd_megakernel, dim3(grid_blocks), dim3(256), args, 0, stream);
  if (e != hipSuccess) fprintf(stderr, "cooperative launch failed: %s (grid %d)\n", hipGetErrorString(e), grid_blocks);
}
```

```cpp
#include <hip/hip_runtime.h>
#include <hip/hip_cooperative_groups.h>
#include <cstdio>
namespace cg = cooperative_groups;

#define DI __device__ __forceinline__
typedef unsigned short u16;
using bf16x8 = __attribute__((ext_vector_type(8))) short;
using s16x4  = __attribute__((ext_vector_type(4))) short;
using f32x16 = __attribute__((ext_vector_type(16))) float;
using f32x4  = __attribute__((ext_vector_type(4))) float;
using f32x2  = __attribute__((ext_vector_type(2))) float;
using u32x4  = __attribute__((ext_vector_type(4))) unsigned;
using u32x2  = __attribute__((ext_vector_type(2))) unsigned;
typedef __bf16 bf2_t __attribute__((ext_vector_type(2)));

#define MFMA(a, b, c) __builtin_amdgcn_mfma_f32_32x32x16_bf16((a), (b), (c), 0, 0, 0)

static constexpr int NTOK = 33280;
static constexpr int NPTOK = 32768;
static constexpr int KVROWS = 32768 + 8 * 1088;
static constexpr int NITEM = 2080;
static constexpr size_t OFF_Y = 0;
static constexpr size_t OFF_NKP = 34078720;
static constexpr size_t OFF_NVP = 50855936;
static constexpr size_t OFF_NHP = 67633152;
static constexpr size_t OFF_NKS = 67764224;
static constexpr size_t OFF_NVS = 68026368;
static constexpr size_t OFF_NHS = 68288512;

struct Params {
  const float *x_prompt, *x_sample, *cache_k, *cache_v, *state_h, *norm_g, *w_in, *lambda_qk, *subln_g, *rec_lb, *rec_norm_g, *w_out, *final_g;
  float* out;
  u16 *WinT, *WoutT, *Xn, *Qb, *Kall, *Vall, *Za, *Qr, *Ir, *Zr, *Mix, *SbufT;
  float *Fr, *Abuf, *NQ;
  int* counter;
  int phase_lo, phase_hi, rep_mask, pad_;
};

DI unsigned pack2(float a, float b) { f32x2 v = {a, b}; bf2_t r = __builtin_convertvector(v, bf2_t); return __builtin_bit_cast(unsigned, r); }
DI u16 f2bf(float a) { return (u16)(pack2(a, 0.f) & 0xffffu); }
DI float bflo(unsigned u) { return __uint_as_float(u << 16); }
DI float bfhi(unsigned u) { return __uint_as_float(u & 0xffff0000u); }
DI int crow(int e, int h) { return (e & 3) + 8 * (e >> 2) + 4 * h; }
DI float wave_sum(float v) {
#pragma unroll
  for (int o = 32; o >= 1; o >>= 1) v += __shfl_xor(v, o);
  return v;
}
DI float silu_f(float v) { return v / (1.f + __expf(-v)); }
DI s16x4 tr_read(const char* p) {
  return __builtin_amdgcn_ds_read_tr16_b64_v4i16((__attribute__((address_space(3))) s16x4*)(p));
}
DI bf16x8 tr_frag(const char* p0, int stride4) {
  s16x4 lo = tr_read(p0), hi = tr_read(p0 + stride4);
  return __builtin_shufflevector(lo, hi, 0, 1, 2, 3, 4, 5, 6, 7);
}
DI bf16x8 pack8(const f32x16& x, int s) {
  u32x4 p;
  p[0] = pack2(x[8 * s + 0], x[8 * s + 1]);
  p[1] = pack2(x[8 * s + 2], x[8 * s + 3]);
  p[2] = pack2(x[8 * s + 4], x[8 * s + 5]);
  p[3] = pack2(x[8 * s + 6], x[8 * s + 7]);
  return __builtin_bit_cast(bf16x8, p);
}
DI f32x16 zero16() { f32x16 z; for (int i = 0; i < 16; ++i) z[i] = 0.f; return z; }

DI void phase0(const Params& p, char* smem) {
  const int tid = threadIdx.x, lane = tid & 63, w = tid >> 6;
  constexpr int NT_W1 = 16 * 64, NT_W2 = 16 * 16, NT_ROW = NTOK / 8, NT_CACHE = 2048;
  constexpr int total = NT_W1 + NT_W2 + NT_ROW + NT_CACHE;
  float (*tile)[65] = (float (*)[65])smem;
  if (blockIdx.x == 0 && tid == 0) *p.counter = 0;
  for (int it = blockIdx.x; it < total; it += gridDim.x) {
    if (it < NT_W1 + NT_W2) {
      const float* src; u16* dst; int N, kt, nt;
      if (it < NT_W1) { src = p.w_in; dst = p.WinT; N = 4096; kt = it >> 6; nt = it & 63; }
      else { int j = it - NT_W1; src = p.w_out; dst = p.WoutT; N = 1024; kt = j >> 4; nt = j & 15; }
      const int c = tid & 63, r0 = tid >> 6;
      for (int i = 0; i < 16; ++i) { int r = r0 + 4 * i; tile[r][c] = src[(size_t)(kt * 64 + r) * N + nt * 64 + c]; }
      __syncthreads();
      if (it < NT_W1) {
        for (int i = 0; i < 16; ++i) { int r = r0 + 4 * i; dst[(size_t)(nt * 64 + r) * 1024 + kt * 64 + c] = f2bf(tile[c][r]); }
      } else {
        for (int i = 0; i < 16; ++i) {
          const int r = r0 + 4 * i, n = nt * 64 + r, k = kt * 64 + c;
          dst[((size_t)((n >> 5) * 64 + (k >> 4)) * 64 + ((k >> 3) & 1) * 32 + (n & 31)) * 8 + (k & 7)] = f2bf(tile[c][r]);
        }
      }
      __syncthreads();
    } else if (it < NT_W1 + NT_W2 + NT_ROW) {
      const int row0 = (it - NT_W1 - NT_W2) * 8 + w * 2;
      f32x4 v[2][4]; float ss[2] = {0.f, 0.f};
#pragma unroll
      for (int rr = 0; rr < 2; ++rr) {
        const int row = row0 + rr;
        const float* src = row < NPTOK ? p.x_prompt + (size_t)row * 1024 : p.x_sample + (size_t)(row - NPTOK) * 1024;
#pragma unroll
        for (int i = 0; i < 4; ++i) v[rr][i] = *(const f32x4*)(src + i * 256 + lane * 4);
      }
#pragma unroll
      for (int rr = 0; rr < 2; ++rr) {
#pragma unroll
        for (int i = 0; i < 4; ++i) ss[rr] += v[rr][i][0] * v[rr][i][0] + v[rr][i][1] * v[rr][i][1] + v[rr][i][2] * v[rr][i][2] + v[rr][i][3] * v[rr][i][3];
        ss[rr] = wave_sum(ss[rr]);
      }
#pragma unroll
      for (int rr = 0; rr < 2; ++rr) {
        const float sc = rsqrtf(ss[rr] * (1.f / 1024.f) + 1e-6f);
#pragma unroll
        for (int i = 0; i < 4; ++i) {
          f32x4 g = *(const f32x4*)(p.norm_g + i * 256 + lane * 4);
          u32x2 o; o[0] = pack2(v[rr][i][0] * sc * g[0], v[rr][i][1] * sc * g[1]); o[1] = pack2(v[rr][i][2] * sc * g[2], v[rr][i][3] * sc * g[3]);
          *(u32x2*)(p.Xn + (size_t)(row0 + rr) * 1024 + i * 256 + lane * 4) = o;
        }
      }
    } else {
      const int task0 = (it - NT_W1 - NT_W2 - NT_ROW) * 8 + w * 2;
      f32x4 a[2], b[2];
#pragma unroll
      for (int rr = 0; rr < 2; ++rr) {
        const int task = task0 + rr, which = task >> 13, r8 = task & 8191;
        const float* src = (which ? p.cache_v : p.cache_k) + (size_t)r8 * 512 + lane * 8;
        a[rr] = *(const f32x4*)src; b[rr] = *(const f32x4*)(src + 4);
      }
#pragma unroll
      for (int rr = 0; rr < 2; ++rr) {
        const int task = task0 + rr, which = task >> 13, r8 = task & 8191;
        u16* dst = (which ? p.Vall : p.Kall) + (size_t)(NPTOK + (r8 >> 10) * 1088 + (r8 & 1023)) * 512 + lane * 8;
        u32x4 o; o[0] = pack2(a[rr][0], a[rr][1]); o[1] = pack2(a[rr][2], a[rr][3]); o[2] = pack2(b[rr][0], b[rr][1]); o[3] = pack2(b[rr][2], b[rr][3]);
        *(u32x4*)dst = o;
      }
    }
  }
}

DI void gemm256(const u16* __restrict__ A, const u16* __restrict__ BT, int K, int m0, int n0, char* smem, int tid, f32x16 (&acc)[4][2]) {
  const int lane = tid & 63, w = tid >> 6, r = lane & 31, h = lane >> 5;
  const int wm = w >> 1, wn = w & 1;
#pragma unroll
  for (int i = 0; i < 4; ++i) { acc[i][0] = zero16(); acc[i][1] = zero16(); }
  u32x4 ra[8], rb[4];
  const int KT = K >> 6;
  const u16* ap = A + (size_t)(m0 + (tid >> 3)) * K + (tid & 7) * 8;
  const u16* bp = BT + (size_t)(n0 + (tid >> 3)) * K + (tid & 7) * 8;
  char* wbase = smem + (tid >> 3) * 144 + (tid & 7) * 16;
  const char* as_ = smem + (wm * 128 + r) * 144 + h * 16;
  const char* bs_ = smem + 36864 + (wn * 64 + r) * 144 + h * 16;
#pragma unroll
  for (int i = 0; i < 8; ++i) ra[i] = *(const u32x4*)(ap + (size_t)i * 32 * K);
#pragma unroll
  for (int i = 0; i < 4; ++i) rb[i] = *(const u32x4*)(bp + (size_t)i * 32 * K);
#pragma unroll
  for (int i = 0; i < 8; ++i) *(u32x4*)(wbase + i * 32 * 144) = ra[i];
#pragma unroll
  for (int i = 0; i < 4; ++i) *(u32x4*)(wbase + 36864 + i * 32 * 144) = rb[i];
  __syncthreads();
  for (int kt = 0; kt < KT; ++kt) {
    const int k1 = kt + 1 < KT ? kt + 1 : KT - 1;
#pragma unroll
    for (int i = 0; i < 8; ++i) ra[i] = *(const u32x4*)(ap + (size_t)i * 32 * K + k1 * 64);
#pragma unroll
    for (int i = 0; i < 4; ++i) rb[i] = *(const u32x4*)(bp + (size_t)i * 32 * K + k1 * 64);
    __builtin_amdgcn_sched_barrier(0);
#pragma unroll
    for (int s = 0; s < 4; ++s) {
      const bf16x8 b0 = *(const bf16x8*)(bs_ + s * 32), b1 = *(const bf16x8*)(bs_ + 32 * 144 + s * 32);
#pragma unroll
      for (int i = 0; i < 4; ++i) {
        const bf16x8 a = *(const bf16x8*)(as_ + i * 32 * 144 + s * 32);
        acc[i][0] = MFMA(a, b0, acc[i][0]);
        acc[i][1] = MFMA(a, b1, acc[i][1]);
      }
    }
    __builtin_amdgcn_sched_barrier(0);
    __syncthreads();
#pragma unroll
    for (int i = 0; i < 8; ++i) *(u32x4*)(wbase + i * 32 * 144) = ra[i];
#pragma unroll
    for (int i = 0; i < 4; ++i) *(u32x4*)(wbase + 36864 + i * 32 * 144) = rb[i];
    __syncthreads();
  }
}
struct TileMap {
  int MT, NT, C, NG, NST, st, lb, lin;
  bool xcd;
  DI TileMap(int mt_, int nt_) : MT(mt_), NT(nt_) {
    const int nb = gridDim.x >> 3;
    C = nb >> 3;
    xcd = (gridDim.x & 63) == 0 && C > 0 && (NT % C) == 0;
    NG = xcd ? NT / C : 1;
    NST = ((MT + 7) >> 3) * NG;
    st = blockIdx.x & 7; lb = blockIdx.x >> 3; lin = blockIdx.x;
  }
  DI bool next(int& mt, int& nt) {
    if (!xcd) {
      if (lin >= MT * NT) return false;
      mt = lin / NT; nt = lin - mt * NT; lin += gridDim.x; return true;
    }
    while (st < NST) {
      const int mg = st / NG, ng = st - mg * NG;
      mt = mg * 8 + lb / C; nt = ng * C + lb % C;
      st += 8;
      if (mt < MT) return true;
    }
    return false;
  }
};
DI void stage_half(const f32x16 (&acc)[4][2], float* cs, int half, int wm, int wn, int r, int h) {
  if (wm == half) {
#pragma unroll
    for (int i = 0; i < 4; ++i)
#pragma unroll
      for (int j = 0; j < 2; ++j)
#pragma unroll
        for (int e = 0; e < 16; ++e) cs[(i * 32 + crow(e, h)) * 132 + wn * 64 + j * 32 + r] = acc[i][j][e];
  }
}

DI void phase1(const Params& p, char* smem) {
  const int tid = threadIdx.x, lane = tid & 63, w = tid >> 6, r = lane & 31, h = lane >> 5;
  const int wm = w >> 1, wn = w & 1;
  constexpr int MT = NTOK / 256, NT = 32;
  TileMap tm(MT, NT);
  int mt, nt;
  while (tm.next(mt, nt)) {
    const int m0 = mt * 256, n0 = nt * 128;
    f32x16 acc[4][2];
    gemm256(p.Xn, p.WinT, 1024, m0, n0, smem, tid, acc);
    const int sec = n0 >> 9;
    const bool samp = m0 >= NPTOK;
    float* cs = (float*)smem;
    const int c0 = (tid & 15) * 8, rb = tid >> 4;
    const int csc = (n0 & 511) + c0;
#pragma unroll 1
    for (int half = 0; half < 2; ++half) {
      stage_half(acc, cs, half, wm, wn, r, h);
      __syncthreads();
#pragma unroll 2
      for (int ps = 0; ps < 8; ++ps) {
        const int row = rb + 16 * ps;
        const int t = m0 + half * 128 + row;
        f32x4 va = *(const f32x4*)(cs + row * 132 + c0), vb = *(const f32x4*)(cs + row * 132 + c0 + 4);
        const size_t o512 = (size_t)t * 512 + csc;
        if (sec == 5) { __builtin_nontemporal_store(va, (f32x4*)(p.Fr + o512)); __builtin_nontemporal_store(vb, (f32x4*)(p.Fr + o512 + 4)); }
        else {
          u16* dst;
          if (sec == 0) {
            const float qs = 0.125f * 1.44269504089f;
            va *= qs; vb *= qs; dst = p.Qb + o512;
          } else if (sec == 1 || sec == 2) {
            size_t kvr; float* od;
            if (!samp) { kvr = t; od = p.out + (sec == 1 ? OFF_NKP : OFF_NVP) + o512; }
            else { const int ts = t - NPTOK; kvr = NPTOK + (ts >> 6) * 1088 + 1024 + (ts & 63); od = p.out + (sec == 1 ? OFF_NKS : OFF_NVS) + (size_t)ts * 512 + csc; }
            __builtin_nontemporal_store(va, (f32x4*)od); __builtin_nontemporal_store(vb, (f32x4*)(od + 4));
            dst = (sec == 1 ? p.Kall : p.Vall) + kvr * 512 + csc;
          } else if (sec == 6) { dst = p.Ir + o512; }
          else {
#pragma unroll
            for (int i = 0; i < 4; ++i) { va[i] = silu_f(va[i]); vb[i] = silu_f(vb[i]); }
            dst = (sec == 3 ? p.Za : (sec == 4 ? p.Qr : p.Zr)) + o512;
          }
          u32x4 o; o[0] = pack2(va[0], va[1]); o[1] = pack2(va[2], va[3]); o[2] = pack2(vb[0], vb[1]); o[3] = pack2(vb[2], vb[3]);
          __builtin_nontemporal_store(o, (u32x4*)dst);
        }
      }
      __syncthreads();
    }
  }
}

DI void rec_pre(const Params& p, int tid, int I, float* totS, float (&cum)[32], float (&key)[32], float& lastv) {
  const int d = tid & 127, half = tid >> 7;
  const int hd = I & 3, t0 = (I >> 2) * 64;
  const float r0 = p.rec_lb[hd * 128 + d], r1 = p.rec_lb[512 + hd * 128 + d];
  const float lb = 1.f / (1.f + __expf(r1 - r0));
  const float* fp = p.Fr + (size_t)(t0 + half * 32) * 512 + hd * 128 + d;
  float run = 0.f;
#pragma unroll
  for (int i = 0; i < 32; ++i) {
    float x = fp[(size_t)i * 512];
    x = fminf(fmaxf(x, -30.f), 30.f);
    const float e = __expf(-x), sg = 1.f / (1.f + e);
    run += __logf(lb + (1.f - lb) * sg);
    cum[i] = run; key[i] = (1.f - lb) * e * sg;
  }
  totS[tid] = run;
  __syncthreads();
  const float tot0 = totS[d], tot1 = totS[128 + d];
  if (half) {
#pragma unroll
    for (int i = 0; i < 32; ++i) cum[i] += tot0;
  }
  lastv = tot0 + tot1;
}

DI void phase2(const Params& p, char* smem, u16* BbufT) {
  const int tid = threadIdx.x, lane = tid & 63, w = tid >> 6, r = lane & 31, h = lane >> 5;
  const int q = (lane & 15) >> 2, pp = lane & 3, blk = (lane >> 4) & 1;
  const int d = tid & 127, half = tid >> 7;
  char* KdI = smem; char* VrI = smem + 17408; float* totS = (float*)(smem + 60000);
  for (int I = blockIdx.x; I < NITEM; I += gridDim.x) {
    const int hd = I & 3, t0 = (I >> 2) * 64;
    if (I < 2048) {
      const int token = tid & 63, which = tid >> 6;
      const u16* src = (which < 2 ? p.Qb : p.Kall) + (size_t)(t0 + token) * 512 + hd * 128 + (which & 1) * 64;
      float ss = 0.f;
#pragma unroll
      for (int c = 0; c < 8; ++c) {
        const u32x4 v = *(const u32x4*)(src + c * 8);
#pragma unroll
        for (int i = 0; i < 4; ++i) { const float lo = bflo(v[i]), hi = bfhi(v[i]); ss += lo * lo + hi * hi; }
      }
#pragma unroll
      for (int o = 32; o >= 1; o >>= 1) ss = fmaxf(ss, __shfl_xor(ss, o));
      if (lane == 0) p.NQ[I * 4 + which] = sqrtf(ss);
    }
    float cum[32], key[32], lastv;
    rec_pre(p, tid, I, totS, cum, key, lastv);
#pragma unroll
    for (int i = 0; i < 32; ++i) {
      const int t = half * 32 + i;
      *(u16*)(KdI + t * 272 + d * 2) = f2bf(key[i] * __expf(lastv - cum[i]));
    }
#pragma unroll
    for (int i = 0; i < 4; ++i) {
      const int ch = tid + 256 * i, row = ch >> 4, cc = ch & 15;
      *(u32x4*)(VrI + row * 272 + cc * 16) = *(const u32x4*)(p.Ir + (size_t)(t0 + row) * 512 + hd * 128 + cc * 8);
    }
    if (half) p.Abuf[I * 128 + d] = __expf(lastv);
    __syncthreads();
    f32x16 acc[4];
#pragma unroll
    for (int ct = 0; ct < 4; ++ct) acc[ct] = zero16();
#pragma unroll
    for (int ks = 0; ks < 4; ++ks) {
      const int rowoff = (16 * ks + 8 * h + q) * 272 + 32 * blk + 8 * pp;
      bf16x8 a = tr_frag(VrI + rowoff + 64 * w, 4 * 272);
#pragma unroll
      for (int ct = 0; ct < 4; ++ct) {
        bf16x8 b = tr_frag(KdI + rowoff + 64 * ct, 4 * 272);
        acc[ct] = MFMA(a, b, acc[ct]);
      }
    }
    u16* ob = BbufT + (size_t)I * 16384;
#pragma unroll
    for (int ct = 0; ct < 4; ++ct)
#pragma unroll
      for (int e = 0; e < 16; ++e) ob[(32 * w + crow(e, h)) * 128 + 32 * ct + r] = f2bf(acc[ct][e]);
    __syncthreads();
  }
}

DI void phase3(const Params& p, const u16* BbufT) {
  const int tid = threadIdx.x;
  for (int it = blockIdx.x; it < 512 + 1024; it += gridDim.x) {
    if (it < 512) {
      const int bh = it >> 6, b = bh >> 2, hd = bh & 3;
      const int e1 = (it & 63) * 256 + tid, v = e1 >> 7, d = e1 & 127;
      float sx = 0.f;
      const size_t eo = (size_t)v * 128 + d;
      const int I0 = (b * 256) * 4 + hd;
      const float* ap = p.Abuf + (size_t)I0 * 128 + d;
      const u16* bp = BbufT + (size_t)I0 * 16384 + eo;
      u16* sp = p.SbufT + (size_t)I0 * 16384 + eo;
#pragma unroll 16
      for (int c = 0; c < 256; ++c) {
        const float a = ap[(size_t)c * 4 * 128];
        const float bv = bflo(bp[(size_t)c * 4 * 16384]);
        sp[(size_t)c * 4 * 16384] = f2bf(sx);
        sx = a * sx + bv;
      }
      p.out[OFF_NHP + (size_t)(b * 4 + hd) * 16384 + d * 128 + v] = sx;
    } else {
      const int j = it - 512;
      const int sh = j >> 5, bs = sh >> 2, hd = sh & 3;
      const int e2 = (j & 31) * 256 + tid, v = e2 >> 6, d2 = (e2 & 63) * 2;
      const int I = (512 + bs) * 4 + hd;
      const float* sh0 = p.state_h + (size_t)(bs * 4 + hd) * 16384;
      float sx = sh0[d2 * 128 + v], sy = sh0[(d2 + 1) * 128 + v];
      const size_t eo = (size_t)v * 128 + d2;
      const f32x2 a = *(const f32x2*)(p.Abuf + I * 128 + d2);
      const unsigned bw = *(const unsigned*)(BbufT + (size_t)I * 16384 + eo);
      *(unsigned*)(p.SbufT + (size_t)I * 16384 + eo) = pack2(sx, sy);
      sx = a[0] * sx + bflo(bw); sy = a[1] * sy + bfhi(bw);
      float* oh = p.out + OFF_NHS + (size_t)(bs * 4 + hd) * 16384;
      oh[d2 * 128 + v] = sx; oh[(d2 + 1) * 128 + v] = sy;
    }
  }
}

DI void r3_item(const Params& p, char* smem, int tid, int I) {
  const int lane = tid & 63, w = tid >> 6, r = lane & 31, h = lane >> 5;
  const int q = (lane & 15) >> 2, pp = lane & 3, blk = (lane >> 4) & 1;
  const int d = tid & 127, half = tid >> 7;
  char* QdI = smem; char* KdI = smem + 17408; char* VrI = smem + 34816;
  float* totS = (float*)(smem + 60000); float* ssS = (float*)(smem + 62048);
  const int hd = I & 3, t0 = (I >> 2) * 64;
  {
    float cum[32], key[32], lastv;
    rec_pre(p, tid, I, totS, cum, key, lastv);
    const u16* qp = p.Qr + (size_t)(t0 + half * 32) * 512 + hd * 128 + d;
#pragma unroll
    for (int i = 0; i < 32; ++i) {
      const int t = half * 32 + i;
      const float qv = bflo(qp[(size_t)i * 512]);
      *(u16*)(QdI + t * 272 + d * 2) = f2bf(qv * __expf(cum[i]));
      *(u16*)(KdI + t * 272 + d * 2) = f2bf(key[i] * __expf(-cum[i]));
    }
  }
#pragma unroll
  for (int i = 0; i < 4; ++i) {
    const int ch = tid + 256 * i, row = ch >> 4, cc = ch & 15;
    *(u32x4*)(VrI + row * 272 + cc * 16) = *(const u32x4*)(p.Ir + (size_t)(t0 + row) * 512 + hd * 128 + cc * 8);
  }
  __syncthreads();
  const int tt = w & 1, vh = w >> 1;
  bf16x8 qf[8];
#pragma unroll
  for (int ks = 0; ks < 8; ++ks) qf[ks] = *(const bf16x8*)(QdI + (32 * tt + r) * 272 + ks * 32 + h * 16);
  f32x16 sc[2]; sc[0] = zero16(); sc[1] = zero16();
#pragma unroll
  for (int ks = 0; ks < 8; ++ks) {
    bf16x8 a0 = *(const bf16x8*)(KdI + r * 272 + ks * 32 + h * 16);
    sc[0] = MFMA(a0, qf[ks], sc[0]);
  }
  if (tt == 1) {
#pragma unroll
    for (int ks = 0; ks < 8; ++ks) {
      bf16x8 a1 = *(const bf16x8*)(KdI + (32 + r) * 272 + ks * 32 + h * 16);
      sc[1] = MFMA(a1, qf[ks], sc[1]);
    }
  }
#pragma unroll
  for (int e = 0; e < 16; ++e) {
    const bool keep = crow(e, h) <= r;
    if (tt == 0) { if (!keep) sc[0][e] = 0.f; }
    else { if (!keep) sc[1][e] = 0.f; }
  }
  bf16x8 pf[4];
  pf[0] = pack8(sc[0], 0); pf[1] = pack8(sc[0], 1); pf[2] = pack8(sc[1], 0); pf[3] = pack8(sc[1], 1);
  f32x16 o[2]; o[0] = zero16(); o[1] = zero16();
  const u16* sp = p.SbufT + (size_t)I * 16384;
#pragma unroll
  for (int vi = 0; vi < 2; ++vi) {
    const int vt = 2 * vh + vi;
#pragma unroll
    for (int k4 = 0; k4 < 4; ++k4) {
      if (k4 < 2 || tt == 1) {
        bf16x8 a = tr_frag(VrI + (16 * k4 + 4 * h + q) * 272 + (32 * vt + 16 * blk) * 2 + 8 * pp, 8 * 272);
        o[vi] = MFMA(a, pf[k4], o[vi]);
      }
    }
#pragma unroll
    for (int ks = 0; ks < 8; ++ks) {
      bf16x8 a = *(const bf16x8*)(sp + (size_t)(32 * vt + r) * 128 + ks * 16 + h * 8);
      o[vi] = MFMA(a, qf[ks], o[vi]);
    }
  }
  float ss = 0.f;
#pragma unroll
  for (int vi = 0; vi < 2; ++vi)
#pragma unroll
    for (int e = 0; e < 16; ++e) ss += o[vi][e] * o[vi][e];
  ss += __shfl_xor(ss, 32);
  if (h == 0) ssS[w * 32 + r] = ss;
  __syncthreads();
  const float tot = ssS[tt * 32 + r] + ssS[(tt + 2) * 32 + r];
  const float rs = rsqrtf(tot * (1.f / 128.f) + 1e-6f);
  const int tok = t0 + 32 * tt + r;
#pragma unroll
  for (int vi = 0; vi < 2; ++vi)
#pragma unroll
    for (int g = 0; g < 4; ++g) {
      const int v = 32 * (2 * vh + vi) + 8 * g + 4 * h;
      const f32x4 gg = *(const f32x4*)(p.rec_norm_g + v);
      const u32x2 z = *(const u32x2*)(p.Zr + (size_t)tok * 512 + hd * 128 + v);
      u32x2 ov;
      ov[0] = pack2(o[vi][4 * g + 0] * rs * gg[0] * bflo(z[0]), o[vi][4 * g + 1] * rs * gg[1] * bfhi(z[0]));
      ov[1] = pack2(o[vi][4 * g + 2] * rs * gg[2] * bflo(z[1]), o[vi][4 * g + 3] * rs * gg[3] * bfhi(z[1]));
      *(u32x2*)(p.Mix + (size_t)tok * 1024 + 512 + hd * 128 + v) = ov;
    }
  __syncthreads();
}

template <bool DIAG>
DI void attn_tile_a(const char* ks, const bf16x8 (&qf)[4], f32x16 (&O)[4], bf16x8 (&pf)[4], float& mrun, float& lsum, float sl2, float qrel,
                    int m, int r, int h2) {
  f32x16 S[2];
#pragma unroll
  for (int st = 0; st < 2; ++st) {
    S[st] = zero16();
#pragma unroll
    for (int s = 0; s < 4; ++s) {
      bf16x8 a = *(const bf16x8*)(ks + (32 * st + r) * 272 + m * 128 + s * 32 + h2 * 16);
      S[st] = MFMA(a, qf[s], S[st]);
    }
  }
  float mx = -1e30f;
#pragma unroll
  for (int st = 0; st < 2; ++st)
#pragma unroll
    for (int e = 0; e < 16; ++e) {
      const float cst = (float)(32 * st + (e & 3) + 8 * (e >> 2));
      float sv;
      if (DIAG) sv = fmaf(-sl2, fabsf(qrel - cst), S[st][e]);
      else sv = fmaf(sl2, cst, S[st][e]);
      S[st][e] = sv; mx = fmaxf(mx, sv);
    }
  const float L = DIAG ? 0.f : -sl2 * qrel;
  mx += L;
  mx = fmaxf(mx, __shfl_xor(mx, 32));
  if (__builtin_amdgcn_ballot_w64(mx > mrun + 6.f) != 0) {
    const float mnew = fmaxf(mrun, mx);
    const float alpha = __builtin_amdgcn_exp2f(mrun - mnew);
    mrun = mnew; lsum *= alpha;
#pragma unroll
    for (int vt = 0; vt < 4; ++vt)
#pragma unroll
      for (int e = 0; e < 16; ++e) O[vt][e] *= alpha;
  }
  const float off = L - mrun;
  float rs = 0.f;
#pragma unroll
  for (int st = 0; st < 2; ++st)
#pragma unroll
    for (int e = 0; e < 16; ++e) { const float pv = __builtin_amdgcn_exp2f(S[st][e] + off); S[st][e] = pv; rs += pv; }
  lsum += rs;
  pf[0] = pack8(S[0], 0); pf[1] = pack8(S[0], 1); pf[2] = pack8(S[1], 0); pf[3] = pack8(S[1], 1);
}
template <bool DIAG>
DI void attn_tile_f(const char* ks, const bf16x8 (&qf)[4], bf16x8 (&pf)[4], float& lsum, float sl2, float qrel, float mref, int m, int r, int h2) {
  f32x16 S[2];
  const float offL = -sl2 * qrel - mref;
#pragma unroll
  for (int st = 0; st < 2; ++st) {
#pragma unroll
    for (int e = 0; e < 16; ++e) {
      const float cst = (float)(32 * st + (e & 3) + 8 * (e >> 2));
      S[st][e] = DIAG ? (-sl2 * fabsf(qrel - cst) - mref) : fmaf(sl2, cst, offL);
    }
#pragma unroll
    for (int s = 0; s < 4; ++s) {
      bf16x8 a = *(const bf16x8*)(ks + (32 * st + r) * 272 + m * 128 + s * 32 + h2 * 16);
      S[st] = MFMA(a, qf[s], S[st]);
    }
  }
  float rs = 0.f;
#pragma unroll
  for (int st = 0; st < 2; ++st)
#pragma unroll
    for (int e = 0; e < 16; ++e) { const float pv = __builtin_amdgcn_exp2f(S[st][e]); S[st][e] = pv; rs += pv; }
  lsum += rs;
  pf[0] = pack8(S[0], 0); pf[1] = pack8(S[0], 1); pf[2] = pack8(S[1], 0); pf[3] = pack8(S[1], 1);
}
DI void attn_tile_b(const char* vs, const bf16x8 (&pf)[4], f32x16 (&O)[4], int h2, int q, int pp, int blk) {
  const char* vb = vs + (4 * h2 + q) * 320 + 32 * blk + 8 * pp;
  bf16x8 a0[4], a1[4];
#pragma unroll
  for (int vt = 0; vt < 4; ++vt) a0[vt] = tr_frag(vb + 64 * vt, 8 * 320);
  __builtin_amdgcn_sched_barrier(0);
#pragma unroll
  for (int vt = 0; vt < 4; ++vt) a1[vt] = tr_frag(vb + 16 * 320 + 64 * vt, 8 * 320);
#pragma unroll
  for (int vt = 0; vt < 4; ++vt) O[vt] = MFMA(a0[vt], pf[0], O[vt]);
  __builtin_amdgcn_sched_barrier(0);
#pragma unroll
  for (int vt = 0; vt < 4; ++vt) a0[vt] = tr_frag(vb + 32 * 320 + 64 * vt, 8 * 320);
#pragma unroll
  for (int vt = 0; vt < 4; ++vt) O[vt] = MFMA(a1[vt], pf[1], O[vt]);
  __builtin_amdgcn_sched_barrier(0);
#pragma unroll
  for (int vt = 0; vt < 4; ++vt) a1[vt] = tr_frag(vb + 48 * 320 + 64 * vt, 8 * 320);
#pragma unroll
  for (int vt = 0; vt < 4; ++vt) O[vt] = MFMA(a0[vt], pf[2], O[vt]);
  __builtin_amdgcn_sched_barrier(0);
#pragma unroll
  for (int vt = 0; vt < 4; ++vt) O[vt] = MFMA(a1[vt], pf[3], O[vt]);
}

DI void attn_item(const Params& p, char* smem, int tid, int tq0, int qpos0, int kvbase, int ntb, int hd, float lam, bool can_skip) {
  const int lane = tid & 63, w = tid >> 6, r = lane & 31, h2 = lane >> 5;
  const int q = (lane & 15) >> 2, pp = lane & 3, blk = (lane >> 4) & 1;
  const int qh = w & 1, m = w >> 1;
  const float sl2 = exp2f(-2.f * (float)(hd + 1)) * 1.44269504089f;
  const int qtok = tq0 + 32 * qh + r;
  const float qposf = (float)(qpos0 + 32 * qh + r);
  int kt0w = 0, kt0b = 0;
  bool fast = false; float kn_w = 0.f;
  if (can_skip) {
    float qnv[2], knv[2];
    const int I0 = (tq0 >> 6) * 4 + hd;
    const int crk = kvbase >> 6;
    int k0[2];
#pragma unroll
    for (int mm = 0; mm < 2; ++mm) {
      const float QN = p.NQ[I0 * 4 + mm];
      float KN = 0.f;
      for (int c = lane; c < ntb; c += 64) KN = fmaxf(KN, p.NQ[((crk + c) * 4 + hd) * 4 + 2 + mm]);
#pragma unroll
      for (int o = 32; o >= 1; o >>= 1) KN = fmaxf(KN, __shfl_xor(KN, o));
      qnv[mm] = QN; knv[mm] = KN;
      const float D = (2.02f * QN * KN + 66.f) / sl2;
      const float f = ((float)(qpos0 - 63) - D) * (1.f / 64.f);
      k0[mm] = f < 0.f ? 0 : (int)f + 1;
    }
    kt0w = m ? k0[1] : k0[0];
    kt0b = k0[0] < k0[1] ? k0[0] : k0[1];
    kn_w = m ? knv[1] : knv[0];
    fast = 2.02f * (m ? qnv[1] : qnv[0]) * kn_w < 60.f;
  }
  bf16x8 qf[4];
#pragma unroll
  for (int s = 0; s < 4; ++s) qf[s] = *(const bf16x8*)(p.Qb + (size_t)qtok * 512 + hd * 128 + m * 64 + 16 * s + 8 * h2);
  float mref = 0.f;
  if (fast) {
    float qq = 0.f;
#pragma unroll
    for (int s = 0; s < 4; ++s) {
      const u32x4 u = __builtin_bit_cast(u32x4, qf[s]);
#pragma unroll
      for (int i = 0; i < 4; ++i) { const float lo = bflo(u[i]), hi = bfhi(u[i]); qq += lo * lo + hi * hi; }
    }
    qq += __shfl_xor(qq, 32);
    mref = sqrtf(qq) * kn_w * 1.01f + 0.5f;
  }
  f32x16 O[4];
#pragma unroll
  for (int vt = 0; vt < 4; ++vt) O[vt] = zero16();
  float mrun = -1e30f, lsum = 0.f;
  u32x4 rk[4], rv[4];
  const int lrow = tid >> 4, lcc = tid & 15;
  const size_t gofs = (size_t)(kvbase + lrow) * 512 + hd * 128 + lcc * 8;
  const u16* kp = p.Kall + gofs;
  const u16* vp = p.Vall + gofs;
  char* kw = smem + lrow * 272 + lcc * 16;
  char* vw = smem + 17408 + lrow * 320 + lcc * 16;
  const int nit = ntb - kt0b;
  {
    const size_t go = (size_t)(fast ? kt0b : ntb - 1) * 64 * 512;
#pragma unroll
    for (int i = 0; i < 4; ++i) { rk[i] = *(const u32x4*)(kp + go + (size_t)i * 16 * 512); rv[i] = *(const u32x4*)(vp + go + (size_t)i * 16 * 512); }
#pragma unroll
    for (int i = 0; i < 4; ++i) { *(u32x4*)(kw + i * 16 * 272) = rk[i]; *(u32x4*)(vw + i * 16 * 320) = rv[i]; }
    const int k1 = fast ? (kt0b + 1 < ntb ? kt0b + 1 : ntb - 1) : (ntb - 2 > kt0b ? ntb - 2 : kt0b);
    const size_t g1 = (size_t)k1 * 64 * 512;
#pragma unroll
    for (int i = 0; i < 4; ++i) { rk[i] = *(const u32x4*)(kp + g1 + (size_t)i * 16 * 512); rv[i] = *(const u32x4*)(vp + g1 + (size_t)i * 16 * 512); }
  }
  __syncthreads();
  if (fast) {
    for (int it = 0; it < nit; ++it) {
      const int kt = kt0b + it;
      const bool active = kt >= kt0w;
      const char* ks = smem + (it & 1) * 37888;
      char* wb = kw + ((it + 1) & 1) * 37888;
      char* wbv = vw + ((it + 1) & 1) * 37888;
  #pragma unroll
      for (int i = 0; i < 4; ++i) { *(u32x4*)(wb + i * 16 * 272) = rk[i]; *(u32x4*)(wbv + i * 16 * 320) = rv[i]; }
      {
        const int k2 = kt + 2 < ntb ? kt + 2 : ntb - 1;
        const size_t g2 = (size_t)k2 * 64 * 512;
  #pragma unroll
        for (int i = 0; i < 4; ++i) { rk[i] = *(const u32x4*)(kp + g2 + (size_t)i * 16 * 512); rv[i] = *(const u32x4*)(vp + g2 + (size_t)i * 16 * 512); }
      }
      __builtin_amdgcn_sched_barrier(0);
      if (active) {
        bf16x8 pf[4];
        const float qrel = qposf - (float)(kt * 64 + 4 * h2);
        if (it == nit - 1) attn_tile_f<true>(ks, qf, pf, lsum, sl2, qrel, mref, m, r, h2);
        else attn_tile_f<false>(ks, qf, pf, lsum, sl2, qrel, mref, m, r, h2);
        attn_tile_b(ks + 17408, pf, O, h2, q, pp, blk);
      }
      __syncthreads();
    }
  } else {
    for (int it = 0; it < nit; ++it) {
      const int kt = ntb - 1 - it;
      const bool active = kt >= kt0w;
      const char* ks = smem + (it & 1) * 37888;
      char* wb = kw + ((it + 1) & 1) * 37888;
      char* wbv = vw + ((it + 1) & 1) * 37888;
  #pragma unroll
      for (int i = 0; i < 4; ++i) { *(u32x4*)(wb + i * 16 * 272) = rk[i]; *(u32x4*)(wbv + i * 16 * 320) = rv[i]; }
      {
        const int k2 = kt - 2 > kt0b ? kt - 2 : kt0b;
        const size_t g2 = (size_t)k2 * 64 * 512;
  #pragma unroll
        for (int i = 0; i < 4; ++i) { rk[i] = *(const u32x4*)(kp + g2 + (size_t)i * 16 * 512); rv[i] = *(const u32x4*)(vp + g2 + (size_t)i * 16 * 512); }
      }
      __builtin_amdgcn_sched_barrier(0);
      if (active) {
        bf16x8 pf[4];
        const float qrel = qposf - (float)(kt * 64 + 4 * h2);
        if (it == 0) attn_tile_a<true>(ks, qf, O, pf, mrun, lsum, sl2, qrel, m, r, h2);
        else attn_tile_a<false>(ks, qf, O, pf, mrun, lsum, sl2, qrel, m, r, h2);
        attn_tile_b(ks + 17408, pf, O, h2, q, pp, blk);
      }
      __syncthreads();
    }
  }
  const float lt = lsum + __shfl_xor(lsum, 32);
  const float inv = 1.f / lt;
  float* exch = (float*)smem + qh * 4096 + lane;
  if (m == 1) {
#pragma unroll
    for (int vt = 0; vt < 4; ++vt)
#pragma unroll
      for (int e = 0; e < 16; ++e) exch[(vt * 16 + e) * 64] = O[vt][e] * inv;
  }
  __syncthreads();
  if (m == 0) {
    float ss = 0.f;
#pragma unroll
    for (int vt = 0; vt < 4; ++vt)
#pragma unroll
      for (int e = 0; e < 16; ++e) { const float ov = O[vt][e] * inv - lam * exch[(vt * 16 + e) * 64]; O[vt][e] = ov; ss += ov * ov; }
    ss += __shfl_xor(ss, 32);
    const float rsn = rsqrtf(ss * (1.f / 128.f) + 1e-6f) * 0.8f;
#pragma unroll
    for (int vt = 0; vt < 4; ++vt)
#pragma unroll
      for (int g = 0; g < 4; ++g) {
        const int v = 32 * vt + 8 * g + 4 * h2;
        const f32x4 gg = *(const f32x4*)(p.subln_g + v);
        const u32x2 z = *(const u32x2*)(p.Za + (size_t)qtok * 512 + hd * 128 + v);
        u32x2 ov;
        ov[0] = pack2(O[vt][4 * g + 0] * rsn * gg[0] * bflo(z[0]), O[vt][4 * g + 1] * rsn * gg[1] * bfhi(z[0]));
        ov[1] = pack2(O[vt][4 * g + 2] * rsn * gg[2] * bflo(z[1]), O[vt][4 * g + 3] * rsn * gg[3] * bfhi(z[1]));
        *(u32x2*)(p.Mix + (size_t)qtok * 1024 + hd * 128 + v) = ov;
      }
  }
  __syncthreads();
}

DI void phase4(const Params& p, char* smem) {
  const int tid = threadIdx.x, lane = tid & 63;
  float lam;
  {
    const float a = p.lambda_qk[lane] * p.lambda_qk[64 + lane];
    const float b = p.lambda_qk[128 + lane] * p.lambda_qk[192 + lane];
    lam = __expf(wave_sum(a)) - __expf(wave_sum(b)) + 0.2f;
  }
  int* sitem = (int*)(smem + 76784);
  constexpr int NPA = 2048, NSA = 32, TOTAL = NPA + NSA + NITEM;
  for (;;) {
    if (tid == 0) *sitem = atomicAdd(p.counter, 1);
    __syncthreads();
    const int item = *sitem;
    __syncthreads();
    if (item >= TOTAL) break;
    int tid_o = tid;
    asm volatile("" : "+v"(tid_o));
    if (item < NPA + NSA) {
      int tq0, qpos0, kvbase, ntb, hd; bool can_skip;
      if (item < NPA) {
        const int qb = 255 - ((item & 511) >> 1), b = item & 1;
        hd = 3 - (item >> 9); tq0 = b * 16384 + qb * 64; qpos0 = qb * 64; kvbase = b * 16384; ntb = qb + 1; can_skip = true;
      } else {
        const int it = item - NPA, bs = it >> 2;
        hd = it & 3; tq0 = NPTOK + bs * 64; qpos0 = 1024; kvbase = NPTOK + bs * 1088; ntb = 17; can_skip = false;
      }
      attn_item(p, smem, tid_o, tq0, qpos0, kvbase, ntb, hd, lam, can_skip);
    } else {
      r3_item(p, smem, tid_o, item - NPA - NSA);
    }
  }
}

DI void phase5(const Params& p, char* smem) {
  float* wsum = (float*)(smem + 66048);
  for (int strip = blockIdx.x; strip < NTOK / 32; strip += gridDim.x) {
    int tid = threadIdx.x;
    asm volatile("" : "+v"(tid));
    const int lane = tid & 63, w = tid >> 6, r = lane & 31, h = lane >> 5;
    const int m0 = strip * 32;
#pragma unroll
    for (int i = 0; i < 16; ++i) {
      const int ch = tid + 256 * i, row = ch >> 7, cc = ch & 127;
      *(u32x4*)(smem + row * 2064 + cc * 16) = __builtin_nontemporal_load((const u32x4*)(p.Mix + (size_t)(m0 + row) * 1024 + cc * 8));
    }
    f32x16 acc[8];
#pragma unroll
    for (int j = 0; j < 8; ++j) acc[j] = zero16();
    const u16* bp = p.WoutT + (size_t)(w * 8) * 64 * 512 + lane * 8;
    bf16x8 b0[8], b1[8];
#pragma unroll
    for (int j = 0; j < 8; ++j) { b0[j] = *(const bf16x8*)(bp + (size_t)(j * 64 + 0) * 512); b1[j] = *(const bf16x8*)(bp + (size_t)(j * 64 + 1) * 512); }
    __syncthreads();
    const char* ap = smem + r * 2064 + h * 16;
    for (int ks = 0; ks < 64; ks += 2) {
      {
        const bf16x8 a = *(const bf16x8*)(ap + ks * 32);
#pragma unroll
        for (int j = 0; j < 8; ++j) acc[j] = MFMA(a, b0[j], acc[j]);
        const int k2 = ks + 2 < 64 ? ks + 2 : 63;
#pragma unroll
        for (int j = 0; j < 8; ++j) b0[j] = *(const bf16x8*)(bp + (size_t)(j * 64 + k2) * 512);
      }
      __builtin_amdgcn_sched_barrier(0);
      {
        const bf16x8 a = *(const bf16x8*)(ap + (ks + 1) * 32);
#pragma unroll
        for (int j = 0; j < 8; ++j) acc[j] = MFMA(a, b1[j], acc[j]);
        const int k3 = ks + 3 < 64 ? ks + 3 : 63;
#pragma unroll
        for (int j = 0; j < 8; ++j) b1[j] = *(const bf16x8*)(bp + (size_t)(j * 64 + k3) * 512);
      }
      __builtin_amdgcn_sched_barrier(0);
    }
    const float* xs_u = (m0 < NPTOK ? p.x_prompt : p.x_sample - (size_t)NPTOK * 1024) + (size_t)m0 * 1024;
    const int lane_off = h * 4096 + w * 256 + r;
    float ps[16];
#pragma unroll
    for (int e = 0; e < 16; ++e) ps[e] = 0.f;
#pragma unroll
    for (int j = 0; j < 8; ++j) {
#pragma unroll
      for (int e = 0; e < 16; ++e) {
        const float hv = acc[j][e] + __builtin_nontemporal_load((xs_u + ((e & 3) + 8 * (e >> 2)) * 1024 + j * 32) + lane_off);
        acc[j][e] = hv; ps[e] += hv * hv;
      }
      __builtin_amdgcn_sched_barrier(0);
    }
#pragma unroll
    for (int e = 0; e < 16; ++e) {
#pragma unroll
      for (int o = 16; o >= 1; o >>= 1) ps[e] += __shfl_xor(ps[e], o);
    }
    if (r == 0) {
#pragma unroll
      for (int e = 0; e < 16; ++e) wsum[w * 32 + crow(e, h)] = ps[e];
    }
    __syncthreads();
#pragma unroll
    for (int e = 0; e < 16; ++e) {
      const int rw = crow(e, h);
      ps[e] = rsqrtf((wsum[rw] + wsum[32 + rw] + wsum[64 + rw] + wsum[96 + rw]) * (1.f / 1024.f) + 1e-6f);
    }
    float* yo_u = p.out + OFF_Y + (size_t)m0 * 1024;
#pragma unroll
    for (int j = 0; j < 8; ++j) {
      const float g = (p.final_g + j * 32)[w * 256 + r];
#pragma unroll
      for (int e = 0; e < 16; ++e) __builtin_nontemporal_store(acc[j][e] * ps[e] * g, (yo_u + ((e & 3) + 8 * (e >> 2)) * 1024 + j * 32) + lane_off);
      __builtin_amdgcn_sched_barrier(0);
    }
    __syncthreads();
  }
}

__global__ void __launch_bounds__(256, 2) fwd_megakernel(Params p) {
  __shared__ __attribute__((aligned(16))) char smem[76800];
  cg::grid_group grid = cg::this_grid();
  float* scratch_out = p.out + OFF_Y;
  const int lo = p.phase_lo, hi = p.phase_hi, rm = p.rep_mask;
  if (lo <= 0 && hi >= 0) phase0(p, smem);
  if (rm & 1) { grid.sync(); phase0(p, smem); }
  if (lo <= 0 && hi >= 1) grid.sync();
  if (lo <= 1 && hi >= 1) phase1(p, smem);
  if (rm & 2) { grid.sync(); phase1(p, smem); }
  if (lo <= 1 && hi >= 2) grid.sync();
  if (lo <= 2 && hi >= 2) phase2(p, smem, (u16*)scratch_out);
  if (rm & 4) { grid.sync(); phase2(p, smem, (u16*)scratch_out); }
  if (lo <= 2 && hi >= 3) grid.sync();
  if (lo <= 3 && hi >= 3) phase3(p, (const u16*)scratch_out);
  if (rm & 8) { grid.sync(); phase3(p, (const u16*)scratch_out); }
  if (lo <= 3 && hi >= 4) grid.sync();
  if (lo <= 4 && hi >= 4) phase4(p, smem);
  if (lo <= 4 && hi >= 5) grid.sync();
  if (lo <= 5 && hi >= 5) phase5(p, smem);
}

extern "C" void kernel_launch(void* const* d_in, const int* in_sizes, int n_in, void* d_out, int out_size, void* d_ws, size_t ws_size,
                              hipStream_t stream) {
  static int grid_blocks = 0;
  if (!grid_blocks) {
    int dev = 0, cus = 0, per_cu = 0;
    hipGetDevice(&dev);
    hipDeviceGetAttribute(&cus, hipDeviceAttributeMultiprocessorCount, dev);
    hipOccupancyMaxActiveBlocksPerMultiprocessor(&per_cu, fwd_megakernel, 256, 0);
    if (per_cu > 2) per_cu = 2;
    if (per_cu < 1) per_cu = 1;
    grid_blocks = cus * per_cu;
  }
  Params p{};
  p.x_prompt = (const float*)d_in[0]; p.x_sample = (const float*)d_in[1]; p.cache_k = (const float*)d_in[2]; p.cache_v = (const float*)d_in[3];
  p.state_h = (const float*)d_in[4]; p.norm_g = (const float*)d_in[5]; p.w_in = (const float*)d_in[6]; p.lambda_qk = (const float*)d_in[7];
  p.subln_g = (const float*)d_in[8]; p.rec_lb = (const float*)d_in[9]; p.rec_norm_g = (const float*)d_in[10]; p.w_out = (const float*)d_in[11];
  p.final_g = (const float*)d_in[12];
  p.out = (float*)d_out;
  char* ws = (char*)d_ws; size_t off = 0;
  auto take = [&](size_t bytes) { char* r = ws + off; off += (bytes + 255) & ~(size_t)255; return r; };
  p.WinT = (u16*)take((size_t)4096 * 1024 * 2);
  p.WoutT = (u16*)take((size_t)1024 * 1024 * 2);
  p.Xn = (u16*)take((size_t)NTOK * 1024 * 2);
  p.SbufT = p.Xn;
  p.Qb = (u16*)take((size_t)NTOK * 512 * 2);
  p.Kall = (u16*)take((size_t)KVROWS * 512 * 2);
  p.Vall = (u16*)take((size_t)KVROWS * 512 * 2);
  p.Za = (u16*)take((size_t)NTOK * 512 * 2);
  p.Qr = (u16*)take((size_t)NTOK * 512 * 2);
  p.Ir = (u16*)take((size_t)NTOK * 512 * 2);
  p.Zr = (u16*)take((size_t)NTOK * 512 * 2);
  p.Mix = (u16*)take((size_t)NTOK * 1024 * 2);
  p.Fr = (float*)take((size_t)NTOK * 512 * 4);
  p.Abuf = (float*)take((size_t)NITEM * 128 * 4);
  p.NQ = (float*)take((size_t)NITEM * 4 * 4);
  p.counter = (int*)take(256);
  p.phase_lo = 0; p.phase_hi = 6; p.rep_mask = 0; p.pad_ = 0;
  if (off > ws_size) { fprintf(stderr, "workspace too small: need %zu have %zu\n", off, ws_size); return; }
  void* args[] = {&p};
  hipError_t e = hipLaunchCooperativeKernel((void*)fwd_megakernel, dim3(grid_blocks), dim3(256), args, 0, stream);
  if (e != hipSuccess) fprintf(stderr, "cooperative launch failed: %s (grid %d)\n", hipGetErrorString(e), grid_blocks);
}
```

```cpp
#include <hip/hip_runtime.h>
#include <hip/hip_cooperative_groups.h>
#include <cstdio>
namespace cg = cooperative_groups;

#define DI __device__ __forceinline__
typedef unsigned short u16;
using bf16x8 = __attribute__((ext_vector_type(8))) short;
using s16x4  = __attribute__((ext_vector_type(4))) short;
using f32x16 = __attribute__((ext_vector_type(16))) float;
using f32x4  = __attribute__((ext_vector_type(4))) float;
using f32x2  = __attribute__((ext_vector_type(2))) float;
using u32x4  = __attribute__((ext_vector_type(4))) unsigned;
using u32x2  = __attribute__((ext_vector_type(2))) unsigned;
typedef __bf16 bf2_t __attribute__((ext_vector_type(2)));

#define MFMA(a, b, c) __builtin_amdgcn_mfma_f32_32x32x16_bf16((a), (b), (c), 0, 0, 0)

static constexpr int NTOK = 33280;
static constexpr int NPTOK = 32768;
static constexpr int KVROWS = 32768 + 8 * 1088;
static constexpr int NITEM = 2080;
static constexpr size_t OFF_Y = 0;
static constexpr size_t OFF_NKP = 34078720;
static constexpr size_t OFF_NVP = 50855936;
static constexpr size_t OFF_NHP = 67633152;
static constexpr size_t OFF_NKS = 67764224;
static constexpr size_t OFF_NVS = 68026368;
static constexpr size_t OFF_NHS = 68288512;

struct Params {
  const float *x_prompt, *x_sample, *cache_k, *cache_v, *state_h, *norm_g, *w_in, *lambda_qk, *subln_g, *rec_lb, *rec_norm_g, *w_out, *final_g;
  float* out;
  u16 *WinT, *WoutT, *Xn, *Qb, *Kall, *Vall, *Za, *Qr, *Ir, *Zr, *Mix, *SbufT;
  float *Fr, *Abuf, *NQ;
  int* counter;
  int phase_lo, phase_hi, rep_mask, pad_;
};

DI unsigned pack2(float a, float b) { f32x2 v = {a, b}; bf2_t r = __builtin_convertvector(v, bf2_t); return __builtin_bit_cast(unsigned, r); }
DI u16 f2bf(float a) { return (u16)(pack2(a, 0.f) & 0xffffu); }
DI float bflo(unsigned u) { return __uint_as_float(u << 16); }
DI float bfhi(unsigned u) { return __uint_as_float(u & 0xffff0000u); }
DI int crow(int e, int h) { return (e & 3) + 8 * (e >> 2) + 4 * h; }
DI float wave_sum(float v) {
#pragma unroll
  for (int o = 32; o >= 1; o >>= 1) v += __shfl_xor(v, o);
  return v;
}
DI float silu_f(float v) { return v / (1.f + __expf(-v)); }
DI s16x4 tr_read(const char* p) {
  return __builtin_amdgcn_ds_read_tr16_b64_v4i16((__attribute__((address_space(3))) s16x4*)(p));
}
DI bf16x8 tr_frag(const char* p0, int stride4) {
  s16x4 lo = tr_read(p0), hi = tr_read(p0 + stride4);
  return __builtin_shufflevector(lo, hi, 0, 1, 2, 3, 4, 5, 6, 7);
}
DI bf16x8 pack8(const f32x16& x, int s) {
  u32x4 p;
  p[0] = pack2(x[8 * s + 0], x[8 * s + 1]);
  p[1] = pack2(x[8 * s + 2], x[8 * s + 3]);
  p[2] = pack2(x[8 * s + 4], x[8 * s + 5]);
  p[3] = pack2(x[8 * s + 6], x[8 * s + 7]);
  return __builtin_bit_cast(bf16x8, p);
}
DI f32x16 zero16() { f32x16 z; for (int i = 0; i < 16; ++i) z[i] = 0.f; return z; }

DI void phase0(const Params& p, char* smem) {
  const int tid = threadIdx.x, lane = tid & 63, w = tid >> 6;
  constexpr int NT_W1 = 16 * 64, NT_W2 = 16 * 16, NT_ROW = NTOK / 8, NT_CACHE = 2048;
  constexpr int total = NT_W1 + NT_W2 + NT_ROW + NT_CACHE;
  float (*tile)[65] = (float (*)[65])smem;
  if (blockIdx.x == 0 && tid == 0) *p.counter = 0;
  for (int it = blockIdx.x; it < total; it += gridDim.x) {
    if (it < NT_W1 + NT_W2) {
      const float* src; u16* dst; int N, kt, nt;
      if (it < NT_W1) { src = p.w_in; dst = p.WinT; N = 4096; kt = it >> 6; nt = it & 63; }
      else { int j = it - NT_W1; src = p.w_out; dst = p.WoutT; N = 1024; kt = j >> 4; nt = j & 15; }
      const int c = tid & 63, r0 = tid >> 6;
      for (int i = 0; i < 16; ++i) { int r = r0 + 4 * i; tile[r][c] = src[(size_t)(kt * 64 + r) * N + nt * 64 + c]; }
      __syncthreads();
      if (it < NT_W1) {
        for (int i = 0; i < 16; ++i) { int r = r0 + 4 * i; dst[(size_t)(nt * 64 + r) * 1024 + kt * 64 + c] = f2bf(tile[c][r]); }
      } else {
        for (int i = 0; i < 16; ++i) {
          const int r = r0 + 4 * i, n = nt * 64 + r, k = kt * 64 + c;
          dst[((size_t)((n >> 5) * 64 + (k >> 4)) * 64 + ((k >> 3) & 1) * 32 + (n & 31)) * 8 + (k & 7)] = f2bf(tile[c][r]);
        }
      }
      __syncthreads();
    } else if (it < NT_W1 + NT_W2 + NT_ROW) {
      const int row0 = (it - NT_W1 - NT_W2) * 8 + w * 2;
      f32x4 v[2][4]; float ss[2] = {0.f, 0.f};
#pragma unroll
      for (int rr = 0; rr < 2; ++rr) {
        const int row = row0 + rr;
        const float* src = row < NPTOK ? p.x_prompt + (size_t)row * 1024 : p.x_sample + (size_t)(row - NPTOK) * 1024;
#pragma unroll
        for (int i = 0; i < 4; ++i) v[rr][i] = *(const f32x4*)(src + i * 256 + lane * 4);
      }
#pragma unroll
      for (int rr = 0; rr < 2; ++rr) {
#pragma unroll
        for (int i = 0; i < 4; ++i) ss[rr] += v[rr][i][0] * v[rr][i][0] + v[rr][i][1] * v[rr][i][1] + v[rr][i][2] * v[rr][i][2] + v[rr][i][3] * v[rr][i][3];
        ss[rr] = wave_sum(ss[rr]);
      }
#pragma unroll
      for (int rr = 0; rr < 2; ++rr) {
        const float sc = rsqrtf(ss[rr] * (1.f / 1024.f) + 1e-6f);
#pragma unroll
        for (int i = 0; i < 4; ++i) {
          f32x4 g = *(const f32x4*)(p.norm_g + i * 256 + lane * 4);
          u32x2 o; o[0] = pack2(v[rr][i][0] * sc * g[0], v[rr][i][1] * sc * g[1]); o[1] = pack2(v[rr][i][2] * sc * g[2], v[rr][i][3] * sc * g[3]);
          *(u32x2*)(p.Xn + (size_t)(row0 + rr) * 1024 + i * 256 + lane * 4) = o;
        }
      }
    } else {
      const int task0 = (it - NT_W1 - NT_W2 - NT_ROW) * 8 + w * 2;
      f32x4 a[2], b[2];
#pragma unroll
      for (int rr = 0; rr < 2; ++rr) {
        const int task = task0 + rr, which = task >> 13, r8 = task & 8191;
        const float* src = (which ? p.cache_v : p.cache_k) + (size_t)r8 * 512 + lane * 8;
        a[rr] = *(const f32x4*)src; b[rr] = *(const f32x4*)(src + 4);
      }
#pragma unroll
      for (int rr = 0; rr < 2; ++rr) {
        const int task = task0 + rr, which = task >> 13, r8 = task & 8191;
        u16* dst = (which ? p.Vall : p.Kall) + (size_t)(NPTOK + (r8 >> 10) * 1088 + (r8 & 1023)) * 512 + lane * 8;
        u32x4 o; o[0] = pack2(a[rr][0], a[rr][1]); o[1] = pack2(a[rr][2], a[rr][3]); o[2] = pack2(b[rr][0], b[rr][1]); o[3] = pack2(b[rr][2], b[rr][3]);
        *(u32x4*)dst = o;
      }
    }
  }
}

DI void gemm256(const u16* __restrict__ A, const u16* __restrict__ BT, int K, int m0, int n0, char* smem, int tid, f32x16 (&acc)[4][2]) {
  const int lane = tid & 63, w = tid >> 6, r = lane & 31, h = lane >> 5;
  const int wm = w >> 1, wn = w & 1;
#pragma unroll
  for (int i = 0; i < 4; ++i) { acc[i][0] = zero16(); acc[i][1] = zero16(); }
  u32x4 ra[8], rb[4];
  const int KT = K >> 6;
  const u16* ap = A + (size_t)(m0 + (tid >> 3)) * K + (tid & 7) * 8;
  const u16* bp = BT + (size_t)(n0 + (tid >> 3)) * K + (tid & 7) * 8;
  char* wbase = smem + (tid >> 3) * 144 + (tid & 7) * 16;
  const char* as_ = smem + (wm * 128 + r) * 144 + h * 16;
  const char* bs_ = smem + 36864 + (wn * 64 + r) * 144 + h * 16;
#pragma unroll
  for (int i = 0; i < 8; ++i) ra[i] = *(const u32x4*)(ap + (size_t)i * 32 * K);
#pragma unroll
  for (int i = 0; i < 4; ++i) rb[i] = *(const u32x4*)(bp + (size_t)i * 32 * K);
#pragma unroll
  for (int i = 0; i < 8; ++i) *(u32x4*)(wbase + i * 32 * 144) = ra[i];
#pragma unroll
  for (int i = 0; i < 4; ++i) *(u32x4*)(wbase + 36864 + i * 32 * 144) = rb[i];
  __syncthreads();
  for (int kt = 0; kt < KT; ++kt) {
    const int k1 = kt + 1 < KT ? kt + 1 : KT - 1;
#pragma unroll
    for (int i = 0; i < 8; ++i) ra[i] = *(const u32x4*)(ap + (size_t)i * 32 * K + k1 * 64);
#pragma unroll
    for (int i = 0; i < 4; ++i) rb[i] = *(const u32x4*)(bp + (size_t)i * 32 * K + k1 * 64);
    __builtin_amdgcn_sched_barrier(0);
#pragma unroll
    for (int s = 0; s < 4; ++s) {
      const bf16x8 b0 = *(const bf16x8*)(bs_ + s * 32), b1 = *(const bf16x8*)(bs_ + 32 * 144 + s * 32);
#pragma unroll
      for (int i = 0; i < 4; ++i) {
        const bf16x8 a = *(const bf16x8*)(as_ + i * 32 * 144 + s * 32);
        acc[i][0] = MFMA(a, b0, acc[i][0]);
        acc[i][1] = MFMA(a, b1, acc[i][1]);
      }
    }
    __builtin_amdgcn_sched_barrier(0);
    __syncthreads();
#pragma unroll
    for (int i = 0; i < 8; ++i) *(u32x4*)(wbase + i * 32 * 144) = ra[i];
#pragma unroll
    for (int i = 0; i < 4; ++i) *(u32x4*)(wbase + 36864 + i * 32 * 144) = rb[i];
    __syncthreads();
  }
}
struct TileMap {
  int MT, NT, C, NG, NST, st, lb, lin;
  bool xcd;
  DI TileMap(int mt_, int nt_) : MT(mt_), NT(nt_) {
    const int nb = gridDim.x >> 3;
    C = nb >> 3;
    xcd = (gridDim.x & 63) == 0 && C > 0 && (NT % C) == 0;
    NG = xcd ? NT / C : 1;
    NST = ((MT + 7) >> 3) * NG;
    st = blockIdx.x & 7; lb = blockIdx.x >> 3; lin = blockIdx.x;
  }
  DI bool next(int& mt, int& nt) {
    if (!xcd) {
      if (lin >= MT * NT) return false;
      mt = lin / NT; nt = lin - mt * NT; lin += gridDim.x; return true;
    }
    while (st < NST) {
      const int mg = st / NG, ng = st - mg * NG;
      mt = mg * 8 + lb / C; nt = ng * C + lb % C;
      st += 8;
      if (mt < MT) return true;
    }
    return false;
  }
};
DI void stage_half(const f32x16 (&acc)[4][2], float* cs, int half, int wm, int wn, int r, int h) {
  if (wm == half) {
#pragma unroll
    for (int i = 0; i < 4; ++i)
#pragma unroll
      for (int j = 0; j < 2; ++j)
#pragma unroll
        for (int e = 0; e < 16; ++e) cs[(i * 32 + crow(e, h)) * 132 + wn * 64 + j * 32 + r] = acc[i][j][e];
  }
}

DI void phase1(const Params& p, char* smem) {
  const int tid = threadIdx.x, lane = tid & 63, w = tid >> 6, r = lane & 31, h = lane >> 5;
  const int wm = w >> 1, wn = w & 1;
  constexpr int MT = NTOK / 256, NT = 32;
  TileMap tm(MT, NT);
  int mt, nt;
  while (tm.next(mt, nt)) {
    const int m0 = mt * 256, n0 = nt * 128;
    f32x16 acc[4][2];
    gemm256(p.Xn, p.WinT, 1024, m0, n0, smem, tid, acc);
    const int sec = n0 >> 9;
    const bool samp = m0 >= NPTOK;
    float* cs = (float*)smem;
    const int c0 = (tid & 15) * 8, rb = tid >> 4;
    const int csc = (n0 & 511) + c0;
#pragma unroll 1
    for (int half = 0; half < 2; ++half) {
      stage_half(acc, cs, half, wm, wn, r, h);
      __syncthreads();
#pragma unroll 2
      for (int ps = 0; ps < 8; ++ps) {
        const int row = rb + 16 * ps;
        const int t = m0 + half * 128 + row;
        f32x4 va = *(const f32x4*)(cs + row * 132 + c0), vb = *(const f32x4*)(cs + row * 132 + c0 + 4);
        const size_t o512 = (size_t)t * 512 + csc;
        if (sec == 5) { __builtin_nontemporal_store(va, (f32x4*)(p.Fr + o512)); __builtin_nontemporal_store(vb, (f32x4*)(p.Fr + o512 + 4)); }
        else {
          u16* dst;
          if (sec == 0) {
            const float qs = 0.125f * 1.44269504089f;
            va *= qs; vb *= qs; dst = p.Qb + o512;
          } else if (sec == 1 || sec == 2) {
            size_t kvr; float* od;
            if (!samp) { kvr = t; od = p.out + (sec == 1 ? OFF_NKP : OFF_NVP) + o512; }
            else { const int ts = t - NPTOK; kvr = NPTOK + (ts >> 6) * 1088 + 1024 + (ts & 63); od = p.out + (sec == 1 ? OFF_NKS : OFF_NVS) + (size_t)ts * 512 + csc; }
            __builtin_nontemporal_store(va, (f32x4*)od); __builtin_nontemporal_store(vb, (f32x4*)(od + 4));
            dst = (sec == 1 ? p.Kall : p.Vall) + kvr * 512 + csc;
          } else if (sec == 6) { dst = p.Ir + o512; }
          else {
#pragma unroll
            for (int i = 0; i < 4; ++i) { va[i] = silu_f(va[i]); vb[i] = silu_f(vb[i]); }
            dst = (sec == 3 ? p.Za : (sec == 4 ? p.Qr : p.Zr)) + o512;
          }
          u32x4 o; o[0] = pack2(va[0], va[1]); o[1] = pack2(va[2], va[3]); o[2] = pack2(vb[0], vb[1]); o[3] = pack2(vb[2], vb[3]);
          __builtin_nontemporal_store(o, (u32x4*)dst);
        }
      }
      __syncthreads();
    }
  }
}

DI void rec_pre(const Params& p, int tid, int I, float* totS, float (&cum)[32], float (&key)[32], float& lastv) {
  const int d = tid & 127, half = tid >> 7;
  const int hd = I & 3, t0 = (I >> 2) * 64;
  const float r0 = p.rec_lb[hd * 128 + d], r1 = p.rec_lb[512 + hd * 128 + d];
  const float lb = 1.f / (1.f + __expf(r1 - r0));
  const float* fp = p.Fr + (size_t)(t0 + half * 32) * 512 + hd * 128 + d;
  float run = 0.f;
#pragma unroll
  for (int i = 0; i < 32; ++i) {
    float x = fp[(size_t)i * 512];
    x = fminf(fmaxf(x, -30.f), 30.f);
    const float e = __expf(-x), sg = 1.f / (1.f + e);
    run += __logf(lb + (1.f - lb) * sg);
    cum[i] = run; key[i] = (1.f - lb) * e * sg;
  }
  totS[tid] = run;
  __syncthreads();
  const float tot0 = totS[d], tot1 = totS[128 + d];
  if (half) {
#pragma unroll
    for (int i = 0; i < 32; ++i) cum[i] += tot0;
  }
  lastv = tot0 + tot1;
}

DI void phase2(const Params& p, char* smem, u16* BbufT) {
  const int tid = threadIdx.x, lane = tid & 63, w = tid >> 6, r = lane & 31, h = lane >> 5;
  const int q = (lane & 15) >> 2, pp = lane & 3, blk = (lane >> 4) & 1;
  const int d = tid & 127, half = tid >> 7;
  char* KdI = smem; char* VrI = smem + 17408; float* totS = (float*)(smem + 60000);
  for (int I = blockIdx.x; I < NITEM; I += gridDim.x) {
    const int hd = I & 3, t0 = (I >> 2) * 64;
    if (I < 2048) {
      const int token = tid & 63, which = tid >> 6;
      const u16* src = (which < 2 ? p.Qb : p.Kall) + (size_t)(t0 + token) * 512 + hd * 128 + (which & 1) * 64;
      float ss = 0.f;
#pragma unroll
      for (int c = 0; c < 8; ++c) {
        const u32x4 v = *(const u32x4*)(src + c * 8);
#pragma unroll
        for (int i = 0; i < 4; ++i) { const float lo = bflo(v[i]), hi = bfhi(v[i]); ss += lo * lo + hi * hi; }
      }
#pragma unroll
      for (int o = 32; o >= 1; o >>= 1) ss = fmaxf(ss, __shfl_xor(ss, o));
      if (lane == 0) p.NQ[I * 4 + which] = sqrtf(ss);
    }
    float cum[32], key[32], lastv;
    rec_pre(p, tid, I, totS, cum, key, lastv);
#pragma unroll
    for (int i = 0; i < 32; ++i) {
      const int t = half * 32 + i;
      *(u16*)(KdI + t * 272 + d * 2) = f2bf(key[i] * __expf(lastv - cum[i]));
    }
#pragma unroll
    for (int i = 0; i < 4; ++i) {
      const int ch = tid + 256 * i, row = ch >> 4, cc = ch & 15;
      *(u32x4*)(VrI + row * 272 + cc * 16) = *(const u32x4*)(p.Ir + (size_t)(t0 + row) * 512 + hd * 128 + cc * 8);
    }
    if (half) p.Abuf[I * 128 + d] = __expf(lastv);
    __syncthreads();
    f32x16 acc[4];
#pragma unroll
    for (int ct = 0; ct < 4; ++ct) acc[ct] = zero16();
#pragma unroll
    for (int ks = 0; ks < 4; ++ks) {
      const int rowoff = (16 * ks + 8 * h + q) * 272 + 32 * blk + 8 * pp;
      bf16x8 a = tr_frag(VrI + rowoff + 64 * w, 4 * 272);
#pragma unroll
      for (int ct = 0; ct < 4; ++ct) {
        bf16x8 b = tr_frag(KdI + rowoff + 64 * ct, 4 * 272);
        acc[ct] = MFMA(a, b, acc[ct]);
      }
    }
    u16* ob = BbufT + (size_t)I * 16384;
#pragma unroll
    for (int ct = 0; ct < 4; ++ct)
#pragma unroll
      for (int e = 0; e < 16; ++e) ob[(32 * w + crow(e, h)) * 128 + 32 * ct + r] = f2bf(acc[ct][e]);
    __syncthreads();
  }
}

DI void phase3(const Params& p, const u16* BbufT) {
  const int tid = threadIdx.x;
  for (int it = blockIdx.x; it < 512 + 1024; it += gridDim.x) {
    if (it < 512) {
      const int bh = it >> 6, b = bh >> 2, hd = bh & 3;
      const int e1 = (it & 63) * 256 + tid, v = e1 >> 7, d = e1 & 127;
      float sx = 0.f;
      const size_t eo = (size_t)v * 128 + d;
      const int I0 = (b * 256) * 4 + hd;
      const float* ap = p.Abuf + (size_t)I0 * 128 + d;
      const u16* bp = BbufT + (size_t)I0 * 16384 + eo;
      u16* sp = p.SbufT + (size_t)I0 * 16384 + eo;
      for (int c0 = 0; c0 < 256; c0 += 16) {
        float av[16]; u16 bw[16];
#pragma unroll
        for (int i = 0; i < 16; ++i) { av[i] = ap[(size_t)(c0 + i) * 4 * 128]; bw[i] = bp[(size_t)(c0 + i) * 4 * 16384]; }
#pragma unroll
        for (int i = 0; i < 16; ++i) {
          sp[(size_t)(c0 + i) * 4 * 16384] = f2bf(sx);
          sx = av[i] * sx + bflo(bw[i]);
        }
      }
      p.out[OFF_NHP + (size_t)(b * 4 + hd) * 16384 + d * 128 + v] = sx;
    } else {
      const int j = it - 512;
      const int sh = j >> 5, bs = sh >> 2, hd = sh & 3;
      const int e2 = (j & 31) * 256 + tid, v = e2 >> 6, d2 = (e2 & 63) * 2;
      const int I = (512 + bs) * 4 + hd;
      const float* sh0 = p.state_h + (size_t)(bs * 4 + hd) * 16384;
      float sx = sh0[d2 * 128 + v], sy = sh0[(d2 + 1) * 128 + v];
      const size_t eo = (size_t)v * 128 + d2;
      const f32x2 a = *(const f32x2*)(p.Abuf + I * 128 + d2);
      const unsigned bw = *(const unsigned*)(BbufT + (size_t)I * 16384 + eo);
      *(unsigned*)(p.SbufT + (size_t)I * 16384 + eo) = pack2(sx, sy);
      sx = a[0] * sx + bflo(bw); sy = a[1] * sy + bfhi(bw);
      float* oh = p.out + OFF_NHS + (size_t)(bs * 4 + hd) * 16384;
      oh[d2 * 128 + v] = sx; oh[(d2 + 1) * 128 + v] = sy;
    }
  }
}

DI void r3_item(const Params& p, char* smem, int tid, int I) {
  const int lane = tid & 63, w = tid >> 6, r = lane & 31, h = lane >> 5;
  const int q = (lane & 15) >> 2, pp = lane & 3, blk = (lane >> 4) & 1;
  const int d = tid & 127, half = tid >> 7;
  char* QdI = smem; char* KdI = smem + 17408; char* VrI = smem + 34816;
  float* totS = (float*)(smem + 60000); float* ssS = (float*)(smem + 62048);
  const int hd = I & 3, t0 = (I >> 2) * 64;
  {
    float cum[32], key[32], lastv;
    rec_pre(p, tid, I, totS, cum, key, lastv);
    const u16* qp = p.Qr + (size_t)(t0 + half * 32) * 512 + hd * 128 + d;
#pragma unroll
    for (int i = 0; i < 32; ++i) {
      const int t = half * 32 + i;
      const float qv = bflo(qp[(size_t)i * 512]);
      *(u16*)(QdI + t * 272 + d * 2) = f2bf(qv * __expf(cum[i]));
      *(u16*)(KdI + t * 272 + d * 2) = f2bf(key[i] * __expf(-cum[i]));
    }
  }
#pragma unroll
  for (int i = 0; i < 4; ++i) {
    const int ch = tid + 256 * i, row = ch >> 4, cc = ch & 15;
    *(u32x4*)(VrI + row * 272 + cc * 16) = *(const u32x4*)(p.Ir + (size_t)(t0 + row) * 512 + hd * 128 + cc * 8);
  }
  __syncthreads();
  const int tt = w & 1, vh = w >> 1;
  bf16x8 qf[8];
#pragma unroll
  for (int ks = 0; ks < 8; ++ks) qf[ks] = *(const bf16x8*)(QdI + (32 * tt + r) * 272 + ks * 32 + h * 16);
  f32x16 sc[2]; sc[0] = zero16(); sc[1] = zero16();
#pragma unroll
  for (int ks = 0; ks < 8; ++ks) {
    bf16x8 a0 = *(const bf16x8*)(KdI + r * 272 + ks * 32 + h * 16);
    sc[0] = MFMA(a0, qf[ks], sc[0]);
  }
  if (tt == 1) {
#pragma unroll
    for (int ks = 0; ks < 8; ++ks) {
      bf16x8 a1 = *(const bf16x8*)(KdI + (32 + r) * 272 + ks * 32 + h * 16);
      sc[1] = MFMA(a1, qf[ks], sc[1]);
    }
  }
#pragma unroll
  for (int e = 0; e < 16; ++e) {
    const bool keep = crow(e, h) <= r;
    if (tt == 0) { if (!keep) sc[0][e] = 0.f; }
    else { if (!keep) sc[1][e] = 0.f; }
  }
  bf16x8 pf[4];
  pf[0] = pack8(sc[0], 0); pf[1] = pack8(sc[0], 1); pf[2] = pack8(sc[1], 0); pf[3] = pack8(sc[1], 1);
  f32x16 o[2]; o[0] = zero16(); o[1] = zero16();
  const u16* sp = p.SbufT + (size_t)I * 16384;
#pragma unroll
  for (int vi = 0; vi < 2; ++vi) {
    const int vt = 2 * vh + vi;
#pragma unroll
    for (int k4 = 0; k4 < 4; ++k4) {
      if (k4 < 2 || tt == 1) {
        bf16x8 a = tr_frag(VrI + (16 * k4 + 4 * h + q) * 272 + (32 * vt + 16 * blk) * 2 + 8 * pp, 8 * 272);
        o[vi] = MFMA(a, pf[k4], o[vi]);
      }
    }
#pragma unroll
    for (int ks = 0; ks < 8; ++ks) {
      bf16x8 a = *(const bf16x8*)(sp + (size_t)(32 * vt + r) * 128 + ks * 16 + h * 8);
      o[vi] = MFMA(a, qf[ks], o[vi]);
    }
  }
  float ss = 0.f;
#pragma unroll
  for (int vi = 0; vi < 2; ++vi)
#pragma unroll
    for (int e = 0; e < 16; ++e) ss += o[vi][e] * o[vi][e];
  ss += __shfl_xor(ss, 32);
  if (h == 0) ssS[w * 32 + r] = ss;
  __syncthreads();
  const float tot = ssS[tt * 32 + r] + ssS[(tt + 2) * 32 + r];
  const float rs = rsqrtf(tot * (1.f / 128.f) + 1e-6f);
  const int tok = t0 + 32 * tt + r;
#pragma unroll
  for (int vi = 0; vi < 2; ++vi)
#pragma unroll
    for (int g = 0; g < 4; ++g) {
      const int v = 32 * (2 * vh + vi) + 8 * g + 4 * h;
      const f32x4 gg = *(const f32x4*)(p.rec_norm_g + v);
      const u32x2 z = *(const u32x2*)(p.Zr + (size_t)tok * 512 + hd * 128 + v);
      u32x2 ov;
      ov[0] = pack2(o[vi][4 * g + 0] * rs * gg[0] * bflo(z[0]), o[vi][4 * g + 1] * rs * gg[1] * bfhi(z[0]));
      ov[1] = pack2(o[vi][4 * g + 2] * rs * gg[2] * bflo(z[1]), o[vi][4 * g + 3] * rs * gg[3] * bfhi(z[1]));
      *(u32x2*)(p.Mix + (size_t)tok * 1024 + 512 + hd * 128 + v) = ov;
    }
  __syncthreads();
}

template <bool DIAG>
DI void attn_tile_a(const char* ks, const bf16x8 (&qf)[4], f32x16 (&O)[4], bf16x8 (&pf)[4], float& mrun, float& lsum, float sl2, float qrel,
                    int m, int r, int h2) {
  f32x16 S[2];
#pragma unroll
  for (int st = 0; st < 2; ++st) {
    S[st] = zero16();
#pragma unroll
    for (int s = 0; s < 4; ++s) {
      bf16x8 a = *(const bf16x8*)(ks + (32 * st + r) * 272 + m * 128 + s * 32 + h2 * 16);
      S[st] = MFMA(a, qf[s], S[st]);
    }
  }
  float mx = -1e30f;
#pragma unroll
  for (int st = 0; st < 2; ++st)
#pragma unroll
    for (int e = 0; e < 16; ++e) {
      const float cst = (float)(32 * st + (e & 3) + 8 * (e >> 2));
      float sv;
      if (DIAG) sv = fmaf(-sl2, fabsf(qrel - cst), S[st][e]);
      else sv = fmaf(sl2, cst, S[st][e]);
      S[st][e] = sv; mx = fmaxf(mx, sv);
    }
  const float L = DIAG ? 0.f : -sl2 * qrel;
  mx += L;
  mx = fmaxf(mx, __shfl_xor(mx, 32));
  if (__builtin_amdgcn_ballot_w64(mx > mrun + 6.f) != 0) {
    const float mnew = fmaxf(mrun, mx);
    const float alpha = __builtin_amdgcn_exp2f(mrun - mnew);
    mrun = mnew; lsum *= alpha;
#pragma unroll
    for (int vt = 0; vt < 4; ++vt)
#pragma unroll
      for (int e = 0; e < 16; ++e) O[vt][e] *= alpha;
  }
  const float off = L - mrun;
  float rs = 0.f;
#pragma unroll
  for (int st = 0; st < 2; ++st)
#pragma unroll
    for (int e = 0; e < 16; ++e) { const float pv = __builtin_amdgcn_exp2f(S[st][e] + off); S[st][e] = pv; rs += pv; }
  lsum += rs;
  pf[0] = pack8(S[0], 0); pf[1] = pack8(S[0], 1); pf[2] = pack8(S[1], 0); pf[3] = pack8(S[1], 1);
}
template <bool DIAG>
DI void attn_tile_f(const char* ks, const bf16x8 (&qf)[4], bf16x8 (&pf)[4], float& lsum, float sl2, float qrel, float mref, int m, int r, int h2) {
  f32x16 S[2];
  const float offL = -sl2 * qrel - mref;
#pragma unroll
  for (int st = 0; st < 2; ++st) {
#pragma unroll
    for (int e = 0; e < 16; ++e) {
      const float cst = (float)(32 * st + (e & 3) + 8 * (e >> 2));
      S[st][e] = DIAG ? (-sl2 * fabsf(qrel - cst) - mref) : fmaf(sl2, cst, offL);
    }
#pragma unroll
    for (int s = 0; s < 4; ++s) {
      bf16x8 a = *(const bf16x8*)(ks + (32 * st + r) * 272 + m * 128 + s * 32 + h2 * 16);
      S[st] = MFMA(a, qf[s], S[st]);
    }
  }
  float rs = 0.f;
#pragma unroll
  for (int st = 0; st < 2; ++st)
#pragma unroll
    for (int e = 0; e < 16; ++e) { const float pv = __builtin_amdgcn_exp2f(S[st][e]); S[st][e] = pv; rs += pv; }
  lsum += rs;
  pf[0] = pack8(S[0], 0); pf[1] = pack8(S[0], 1); pf[2] = pack8(S[1], 0); pf[3] = pack8(S[1], 1);
}
DI void attn_tile_b(const char* vs, const bf16x8 (&pf)[4], f32x16 (&O)[4], int h2, int q, int pp, int blk) {
  const char* vb = vs + (4 * h2 + q) * 320 + 32 * blk + 8 * pp;
  bf16x8 a0[4], a1[4];
#pragma unroll
  for (int vt = 0; vt < 4; ++vt) a0[vt] = tr_frag(vb + 64 * vt, 8 * 320);
  __builtin_amdgcn_sched_barrier(0);
#pragma unroll
  for (int vt = 0; vt < 4; ++vt) a1[vt] = tr_frag(vb + 16 * 320 + 64 * vt, 8 * 320);
#pragma unroll
  for (int vt = 0; vt < 4; ++vt) O[vt] = MFMA(a0[vt], pf[0], O[vt]);
  __builtin_amdgcn_sched_barrier(0);
#pragma unroll
  for (int vt = 0; vt < 4; ++vt) a0[vt] = tr_frag(vb + 32 * 320 + 64 * vt, 8 * 320);
#pragma unroll
  for (int vt = 0; vt < 4; ++vt) O[vt] = MFMA(a1[vt], pf[1], O[vt]);
  __builtin_amdgcn_sched_barrier(0);
#pragma unroll
  for (int vt = 0; vt < 4; ++vt) a1[vt] = tr_frag(vb + 48 * 320 + 64 * vt, 8 * 320);
#pragma unroll
  for (int vt = 0; vt < 4; ++vt) O[vt] = MFMA(a0[vt], pf[2], O[vt]);
  __builtin_amdgcn_sched_barrier(0);
#pragma unroll
  for (int vt = 0; vt < 4; ++vt) O[vt] = MFMA(a1[vt], pf[3], O[vt]);
}

DI void attn_item(const Params& p, char* smem, int tid, int tq0, int qpos0, int kvbase, int ntb, int hd, float lam, bool can_skip) {
  const int lane = tid & 63, w = tid >> 6, r = lane & 31, h2 = lane >> 5;
  const int q = (lane & 15) >> 2, pp = lane & 3, blk = (lane >> 4) & 1;
  const int qh = w & 1, m = w >> 1;
  const float sl2 = exp2f(-2.f * (float)(hd + 1)) * 1.44269504089f;
  const int qtok = tq0 + 32 * qh + r;
  const float qposf = (float)(qpos0 + 32 * qh + r);
  int kt0w = 0, kt0b = 0;
  bool fast = false; float kn_w = 0.f;
  if (can_skip) {
    float qnv[2], knv[2];
    const int I0 = (tq0 >> 6) * 4 + hd;
    const int crk = kvbase >> 6;
    int k0[2];
#pragma unroll
    for (int mm = 0; mm < 2; ++mm) {
      const float QN = p.NQ[I0 * 4 + mm];
      float KN = 0.f;
      for (int c = lane; c < ntb; c += 64) KN = fmaxf(KN, p.NQ[((crk + c) * 4 + hd) * 4 + 2 + mm]);
#pragma unroll
      for (int o = 32; o >= 1; o >>= 1) KN = fmaxf(KN, __shfl_xor(KN, o));
      qnv[mm] = QN; knv[mm] = KN;
      const float D = (2.02f * QN * KN + 66.f) / sl2;
      const float f = ((float)(qpos0 - 63) - D) * (1.f / 64.f);
      k0[mm] = f < 0.f ? 0 : (int)f + 1;
    }
    kt0w = m ? k0[1] : k0[0];
    kt0b = k0[0] < k0[1] ? k0[0] : k0[1];
    kn_w = m ? knv[1] : knv[0];
    fast = 2.02f * (m ? qnv[1] : qnv[0]) * kn_w < 60.f;
  }
  bf16x8 qf[4];
#pragma unroll
  for (int s = 0; s < 4; ++s) qf[s] = *(const bf16x8*)(p.Qb + (size_t)qtok * 512 + hd * 128 + m * 64 + 16 * s + 8 * h2);
  float mref = 0.f;
  if (fast) {
    float qq = 0.f;
#pragma unroll
    for (int s = 0; s < 4; ++s) {
      const u32x4 u = __builtin_bit_cast(u32x4, qf[s]);
#pragma unroll
      for (int i = 0; i < 4; ++i) { const float lo = bflo(u[i]), hi = bfhi(u[i]); qq += lo * lo + hi * hi; }
    }
    qq += __shfl_xor(qq, 32);
    mref = sqrtf(qq) * kn_w * 1.01f + 0.5f;
  }
  f32x16 O[4];
#pragma unroll
  for (int vt = 0; vt < 4; ++vt) O[vt] = zero16();
  float mrun = -1e30f, lsum = 0.f;
  u32x4 rk[4], rv[4];
  const int lrow = tid >> 4, lcc = tid & 15;
  const size_t gofs = (size_t)(kvbase + lrow) * 512 + hd * 128 + lcc * 8;
  const u16* kp = p.Kall + gofs;
  const u16* vp = p.Vall + gofs;
  char* kw = smem + lrow * 272 + lcc * 16;
  char* vw = smem + 17408 + lrow * 320 + lcc * 16;
  const int nit = ntb - kt0b;
  {
    const size_t go = (size_t)(fast ? kt0b : ntb - 1) * 64 * 512;
#pragma unroll
    for (int i = 0; i < 4; ++i) { rk[i] = *(const u32x4*)(kp + go + (size_t)i * 16 * 512); rv[i] = *(const u32x4*)(vp + go + (size_t)i * 16 * 512); }
#pragma unroll
    for (int i = 0; i < 4; ++i) { *(u32x4*)(kw + i * 16 * 272) = rk[i]; *(u32x4*)(vw + i * 16 * 320) = rv[i]; }
    const int k1 = fast ? (kt0b + 1 < ntb ? kt0b + 1 : ntb - 1) : (ntb - 2 > kt0b ? ntb - 2 : kt0b);
    const size_t g1 = (size_t)k1 * 64 * 512;
#pragma unroll
    for (int i = 0; i < 4; ++i) { rk[i] = *(const u32x4*)(kp + g1 + (size_t)i * 16 * 512); rv[i] = *(const u32x4*)(vp + g1 + (size_t)i * 16 * 512); }
  }
  __syncthreads();
  if (fast) {
    for (int it = 0; it < nit; ++it) {
      const int kt = kt0b + it;
      const bool active = kt >= kt0w;
      const char* ks = smem + (it & 1) * 37888;
      char* wb = kw + ((it + 1) & 1) * 37888;
      char* wbv = vw + ((it + 1) & 1) * 37888;
  #pragma unroll
      for (int i = 0; i < 4; ++i) { *(u32x4*)(wb + i * 16 * 272) = rk[i]; *(u32x4*)(wbv + i * 16 * 320) = rv[i]; }
      {
        const int k2 = kt + 2 < ntb ? kt + 2 : ntb - 1;
        const size_t g2 = (size_t)k2 * 64 * 512;
  #pragma unroll
        for (int i = 0; i < 4; ++i) { rk[i] = *(const u32x4*)(kp + g2 + (size_t)i * 16 * 512); rv[i] = *(const u32x4*)(vp + g2 + (size_t)i * 16 * 512); }
      }
      __builtin_amdgcn_sched_barrier(0);
      if (active) {
        bf16x8 pf[4];
        const float qrel = qposf - (float)(kt * 64 + 4 * h2);
        if (it == nit - 1) attn_tile_f<true>(ks, qf, pf, lsum, sl2, qrel, mref, m, r, h2);
        else attn_tile_f<false>(ks, qf, pf, lsum, sl2, qrel, mref, m, r, h2);
        attn_tile_b(ks + 17408, pf, O, h2, q, pp, blk);
      }
      __syncthreads();
    }
  } else {
    for (int it = 0; it < nit; ++it) {
      const int kt = ntb - 1 - it;
      const bool active = kt >= kt0w;
      const char* ks = smem + (it & 1) * 37888;
      char* wb = kw + ((it + 1) & 1) * 37888;
      char* wbv = vw + ((it + 1) & 1) * 37888;
  #pragma unroll
      for (int i = 0; i < 4; ++i) { *(u32x4*)(wb + i * 16 * 272) = rk[i]; *(u32x4*)(wbv + i * 16 * 320) = rv[i]; }
      {
        const int k2 = kt - 2 > kt0b ? kt - 2 : kt0b;
        const size_t g2 = (size_t)k2 * 64 * 512;
  #pragma unroll
        for (int i = 0; i < 4; ++i) { rk[i] = *(const u32x4*)(kp + g2 + (size_t)i * 16 * 512); rv[i] = *(const u32x4*)(vp + g2 + (size_t)i * 16 * 512); }
      }
      __builtin_amdgcn_sched_barrier(0);
      if (active) {
        bf16x8 pf[4];
        const float qrel = qposf - (float)(kt * 64 + 4 * h2);
        if (it == 0) attn_tile_a<true>(ks, qf, O, pf, mrun, lsum, sl2, qrel, m, r, h2);
        else attn_tile_a<false>(ks, qf, O, pf, mrun, lsum, sl2, qrel, m, r, h2);
        attn_tile_b(ks + 17408, pf, O, h2, q, pp, blk);
      }
      __syncthreads();
    }
  }
  const float lt = lsum + __shfl_xor(lsum, 32);
  const float inv = 1.f / lt;
  float* exch = (float*)smem + qh * 4096 + lane;
  if (m == 1) {
#pragma unroll
    for (int vt = 0; vt < 4; ++vt)
#pragma unroll
      for (int e = 0; e < 16; ++e) exch[(vt * 16 + e) * 64] = O[vt][e] * inv;
  }
  __syncthreads();
  if (m == 0) {
    float ss = 0.f;
#pragma unroll
    for (int vt = 0; vt < 4; ++vt)
#pragma unroll
      for (int e = 0; e < 16; ++e) { const float ov = O[vt][e] * inv - lam * exch[(vt * 16 + e) * 64]; O[vt][e] = ov; ss += ov * ov; }
    ss += __shfl_xor(ss, 32);
    const float rsn = rsqrtf(ss * (1.f / 128.f) + 1e-6f) * 0.8f;
#pragma unroll
    for (int vt = 0; vt < 4; ++vt)
#pragma unroll
      for (int g = 0; g < 4; ++g) {
        const int v = 32 * vt + 8 * g + 4 * h2;
        const f32x4 gg = *(const f32x4*)(p.subln_g + v);
        const u32x2 z = *(const u32x2*)(p.Za + (size_t)qtok * 512 + hd * 128 + v);
        u32x2 ov;
        ov[0] = pack2(O[vt][4 * g + 0] * rsn * gg[0] * bflo(z[0]), O[vt][4 * g + 1] * rsn * gg[1] * bfhi(z[0]));
        ov[1] = pack2(O[vt][4 * g + 2] * rsn * gg[2] * bflo(z[1]), O[vt][4 * g + 3] * rsn * gg[3] * bfhi(z[1]));
        *(u32x2*)(p.Mix + (size_t)qtok * 1024 + hd * 128 + v) = ov;
      }
  }
  __syncthreads();
}

DI void phase4(const Params& p, char* smem) {
  const int tid = threadIdx.x, lane = tid & 63;
  float lam;
  {
    const float a = p.lambda_qk[lane] * p.lambda_qk[64 + lane];
    const float b = p.lambda_qk[128 + lane] * p.lambda_qk[192 + lane];
    lam = __expf(wave_sum(a)) - __expf(wave_sum(b)) + 0.2f;
  }
  int* sitem = (int*)(smem + 76784);
  constexpr int NPA = 2048, NSA = 32, TOTAL = NPA + NSA + NITEM;
  for (;;) {
    if (tid == 0) *sitem = atomicAdd(p.counter, 1);
    __syncthreads();
    const int item = *sitem;
    __syncthreads();
    if (item >= TOTAL) break;
    int tid_o = tid;
    asm volatile("" : "+v"(tid_o));
    if (item < NPA + NSA) {
      int tq0, qpos0, kvbase, ntb, hd; bool can_skip;
      if (item < NPA) {
        const int qb = 255 - ((item & 511) >> 1), b = item & 1;
        hd = 3 - (item >> 9); tq0 = b * 16384 + qb * 64; qpos0 = qb * 64; kvbase = b * 16384; ntb = qb + 1; can_skip = true;
      } else {
        const int it = item - NPA, bs = it >> 2;
        hd = it & 3; tq0 = NPTOK + bs * 64; qpos0 = 1024; kvbase = NPTOK + bs * 1088; ntb = 17; can_skip = false;
      }
      attn_item(p, smem, tid_o, tq0, qpos0, kvbase, ntb, hd, lam, can_skip);
    } else {
      r3_item(p, smem, tid_o, item - NPA - NSA);
    }
  }
}

DI void phase5(const Params& p, char* smem) {
  float* wsum = (float*)(smem + 66048);
  for (int strip = blockIdx.x; strip < NTOK / 32; strip += gridDim.x) {
    int tid = threadIdx.x;
    asm volatile("" : "+v"(tid));
    const int lane = tid & 63, w = tid >> 6, r = lane & 31, h = lane >> 5;
    const int m0 = strip * 32;
#pragma unroll
    for (int i = 0; i < 16; ++i) {
      const int ch = tid + 256 * i, row = ch >> 7, cc = ch & 127;
      *(u32x4*)(smem + row * 2064 + cc * 16) = __builtin_nontemporal_load((const u32x4*)(p.Mix + (size_t)(m0 + row) * 1024 + cc * 8));
    }
    f32x16 acc[8];
#pragma unroll
    for (int j = 0; j < 8; ++j) acc[j] = zero16();
    const u16* bp = p.WoutT + (size_t)(w * 8) * 64 * 512 + lane * 8;
    bf16x8 b0[8], b1[8];
#pragma unroll
    for (int j = 0; j < 8; ++j) { b0[j] = *(const bf16x8*)(bp + (size_t)(j * 64 + 0) * 512); b1[j] = *(const bf16x8*)(bp + (size_t)(j * 64 + 1) * 512); }
    __syncthreads();
    const char* ap = smem + r * 2064 + h * 16;
    for (int ks = 0; ks < 64; ks += 2) {
      {
        const bf16x8 a = *(const bf16x8*)(ap + ks * 32);
#pragma unroll
        for (int j = 0; j < 8; ++j) acc[j] = MFMA(a, b0[j], acc[j]);
        const int k2 = ks + 2 < 64 ? ks + 2 : 63;
#pragma unroll
        for (int j = 0; j < 8; ++j) b0[j] = *(const bf16x8*)(bp + (size_t)(j * 64 + k2) * 512);
      }
      __builtin_amdgcn_sched_barrier(0);
      {
        const bf16x8 a = *(const bf16x8*)(ap + (ks + 1) * 32);
#pragma unroll
        for (int j = 0; j < 8; ++j) acc[j] = MFMA(a, b1[j], acc[j]);
        const int k3 = ks + 3 < 64 ? ks + 3 : 63;
#pragma unroll
        for (int j = 0; j < 8; ++j) b1[j] = *(const bf16x8*)(bp + (size_t)(j * 64 + k3) * 512);
      }
      __builtin_amdgcn_sched_barrier(0);
    }
    const float* xs_u = (m0 < NPTOK ? p.x_prompt : p.x_sample - (size_t)NPTOK * 1024) + (size_t)m0 * 1024;
    const int lane_off = h * 4096 + w * 256 + r;
    float ps[16];
#pragma unroll
    for (int e = 0; e < 16; ++e) ps[e] = 0.f;
#pragma unroll
    for (int j = 0; j < 8; ++j) {
#pragma unroll
      for (int e = 0; e < 16; ++e) {
        const float hv = acc[j][e] + __builtin_nontemporal_load((xs_u + ((e & 3) + 8 * (e >> 2)) * 1024 + j * 32) + lane_off);
        acc[j][e] = hv; ps[e] += hv * hv;
      }
      __builtin_amdgcn_sched_barrier(0);
    }
#pragma unroll
    for (int e = 0; e < 16; ++e) {
#pragma unroll
      for (int o = 16; o >= 1; o >>= 1) ps[e] += __shfl_xor(ps[e], o);
    }
    if (r == 0) {
#pragma unroll
      for (int e = 0; e < 16; ++e) wsum[w * 32 + crow(e, h)] = ps[e];
    }
    __syncthreads();
#pragma unroll
    for (int e = 0; e < 16; ++e) {
      const int rw = crow(e, h);
      ps[e] = rsqrtf((wsum[rw] + wsum[32 + rw] + wsum[64 + rw] + wsum[96 + rw]) * (1.f / 1024.f) + 1e-6f);
    }
    float* yo_u = p.out + OFF_Y + (size_t)m0 * 1024;
#pragma unroll
    for (int j = 0; j < 8; ++j) {
      const float g = (p.final_g + j * 32)[w * 256 + r];
#pragma unroll
      for (int e = 0; e < 16; ++e) __builtin_nontemporal_store(acc[j][e] * ps[e] * g, (yo_u + ((e & 3) + 8 * (e >> 2)) * 1024 + j * 32) + lane_off);
      __builtin_amdgcn_sched_barrier(0);
    }
    __syncthreads();
  }
}

__global__ void __launch_bounds__(256, 2) fwd_megakernel(Params p) {
  __shared__ __attribute__((aligned(16))) char smem[76800];
  cg::grid_group grid = cg::this_grid();
  float* scratch_out = p.out + OFF_Y;
  const int lo = p.phase_lo, hi = p.phase_hi, rm = p.rep_mask;
  if (lo <= 0 && hi >= 0) phase0(p, smem);
  if (rm & 1) { grid.sync(); phase0(p, smem); }
  if (lo <= 0 && hi >= 1) grid.sync();
  if (lo <= 1 && hi >= 1) phase1(p, smem);
  if (rm & 2) { grid.sync(); phase1(p, smem); }
  if (lo <= 1 && hi >= 2) grid.sync();
  if (lo <= 2 && hi >= 2) phase2(p, smem, (u16*)scratch_out);
  if (rm & 4) { grid.sync(); phase2(p, smem, (u16*)scratch_out); }
  if (lo <= 2 && hi >= 3) grid.sync();
  if (lo <= 3 && hi >= 3) phase3(p, (const u16*)scratch_out);
  if (rm & 8) { grid.sync(); phase3(p, (const u16*)scratch_out); }
  if (lo <= 3 && hi >= 4) grid.sync();
  if (lo <= 4 && hi >= 4) phase4(p, smem);
  if (lo <= 4 && hi >= 5) grid.sync();
  if (lo <= 5 && hi >= 5) phase5(p, smem);
}

extern "C" void kernel_launch(void* const* d_in, const int* in_sizes, int n_in, void* d_out, int out_size, void* d_ws, size_t ws_size,
                              hipStream_t stream) {
  static int grid_blocks = 0;
  if (!grid_blocks) {
    int dev = 0, cus = 0, per_cu = 0;
    hipGetDevice(&dev);
    hipDeviceGetAttribute(&cus, hipDeviceAttributeMultiprocessorCount, dev);
    hipOccupancyMaxActiveBlocksPerMultiprocessor(&per_cu, fwd_megakernel, 256, 0);
    if (per_cu > 2) per_cu = 2;
    if (per_cu < 1) per_cu = 1;
    grid_blocks = cus * per_cu;
  }
  Params p{};
  p.x_prompt = (const float*)d_in[0]; p.x_sample = (const float*)d_in[1]; p.cache_k = (const float*)d_in[2]; p.cache_v = (const float*)d_in[3];
  p.state_h = (const float*)d_in[4]; p.norm_g = (const float*)d_in[5]; p.w_in = (const float*)d_in[6]; p.lambda_qk = (const float*)d_in[7];
  p.subln_g = (const float*)d_in[8]; p.rec_lb = (const float*)d_in[9]; p.rec_norm_g = (const float*)d_in[10]; p.w_out = (const float*)d_in[11];
  p.final_g = (const float*)d_in[12];
  p.out = (float*)d_out;
  char* ws = (char*)d_ws; size_t off = 0;
  auto take = [&](size_t bytes) { char* r = ws + off; off += (bytes + 255) & ~(size_t)255; return r; };
  p.WinT = (u16*)take((size_t)4096 * 1024 * 2);
  p.WoutT = (u16*)take((size_t)1024 * 1024 * 2);
  p.Xn = (u16*)take((size_t)NTOK * 1024 * 2);
  p.SbufT = p.Xn;
  p.Qb = (u16*)take((size_t)NTOK * 512 * 2);
  p.Kall = (u16*)take((size_t)KVROWS * 512 * 2);
  p.Vall = (u16*)take((size_t)KVROWS * 512 * 2);
  p.Za = (u16*)take((size_t)NTOK * 512 * 2);
  p.Qr = (u16*)take((size_t)NTOK * 512 * 2);
  p.Ir = (u16*)take((size_t)NTOK * 512 * 2);
  p.Zr = (u16*)take((size_t)NTOK * 512 * 2);
  p.Mix = (u16*)take((size_t)NTOK * 1024 * 2);
  p.Fr = (float*)take((size_t)NTOK * 512 * 4);
  p.Abuf = (float*)take((size_t)NITEM * 128 * 4);
  p.NQ = (float*)take((size_t)NITEM * 4 * 4);
  p.counter = (int*)take(256);
  p.phase_lo = 0; p.phase_hi = 6; p.rep_mask = 0; p.pad_ = 0;
  if (off > ws_size) { fprintf(stderr, "workspace too small: need %zu have %zu\n", off, ws_size); return; }
  void* args[] = {&p};
  hipError_t e = hipLaunchCooperativeKernel((void*)fwd_megakernel, dim3(grid_blocks), dim3(256), args, 0, stream);
  if (e != hipSuccess) fprintf(stderr, "cooperative launch failed: %s (grid %d)\n", hipGetErrorString(e), grid_blocks);
}
```

```cpp
#include <hip/hip_runtime.h>
#include <hip/hip_cooperative_groups.h>
#include <cstdio>
namespace cg = cooperative_groups;

#define DI __device__ __forceinline__
typedef unsigned short u16;
using bf16x8 = __attribute__((ext_vector_type(8))) short;
using s16x4  = __attribute__((ext_vector_type(4))) short;
using f32x16 = __attribute__((ext_vector_type(16))) float;
using f32x4  = __attribute__((ext_vector_type(4))) float;
using f32x2  = __attribute__((ext_vector_type(2))) float;
using u32x4  = __attribute__((ext_vector_type(4))) unsigned;
using u32x2  = __attribute__((ext_vector_type(2))) unsigned;
typedef __bf16 bf2_t __attribute__((ext_vector_type(2)));

#define MFMA(a, b, c) __builtin_amdgcn_mfma_f32_32x32x16_bf16((a), (b), (c), 0, 0, 0)

static constexpr int NTOK = 33280;
static constexpr int NPTOK = 32768;
static constexpr int KVROWS = 32768 + 8 * 1088;
static constexpr int NITEM = 2080;
static constexpr size_t OFF_Y = 0;
static constexpr size_t OFF_NKP = 34078720;
static constexpr size_t OFF_NVP = 50855936;
static constexpr size_t OFF_NHP = 67633152;
static constexpr size_t OFF_NKS = 67764224;
static constexpr size_t OFF_NVS = 68026368;
static constexpr size_t OFF_NHS = 68288512;

struct Params {
  const float *x_prompt, *x_sample, *cache_k, *cache_v, *state_h, *norm_g, *w_in, *lambda_qk, *subln_g, *rec_lb, *rec_norm_g, *w_out, *final_g;
  float* out;
  u16 *WinT, *WoutT, *Xn, *Qb, *Kall, *Vall, *Za, *Qr, *Ir, *Zr, *Mix, *SbufT;
  float *Fr, *Abuf, *NQ;
  int* counter;
  int phase_lo, phase_hi, rep_mask, pad_;
};

DI unsigned pack2(float a, float b) { f32x2 v = {a, b}; bf2_t r = __builtin_convertvector(v, bf2_t); return __builtin_bit_cast(unsigned, r); }
DI u16 f2bf(float a) { return (u16)(pack2(a, 0.f) & 0xffffu); }
DI float bflo(unsigned u) { return __uint_as_float(u << 16); }
DI float bfhi(unsigned u) { return __uint_as_float(u & 0xffff0000u); }
DI int crow(int e, int h) { return (e & 3) + 8 * (e >> 2) + 4 * h; }
DI float wave_sum(float v) {
#pragma unroll
  for (int o = 32; o >= 1; o >>= 1) v += __shfl_xor(v, o);
  return v;
}
DI float silu_f(float v) { return v / (1.f + __expf(-v)); }
DI s16x4 tr_read(const char* p) {
  return __builtin_amdgcn_ds_read_tr16_b64_v4i16((__attribute__((address_space(3))) s16x4*)(p));
}
DI bf16x8 tr_frag(const char* p0, int stride4) {
  s16x4 lo = tr_read(p0), hi = tr_read(p0 + stride4);
  return __builtin_shufflevector(lo, hi, 0, 1, 2, 3, 4, 5, 6, 7);
}
DI bf16x8 pack8(const f32x16& x, int s) {
  u32x4 p;
  p[0] = pack2(x[8 * s + 0], x[8 * s + 1]);
  p[1] = pack2(x[8 * s + 2], x[8 * s + 3]);
  p[2] = pack2(x[8 * s + 4], x[8 * s + 5]);
  p[3] = pack2(x[8 * s + 6], x[8 * s + 7]);
  return __builtin_bit_cast(bf16x8, p);
}
DI f32x16 zero16() { f32x16 z; for (int i = 0; i < 16; ++i) z[i] = 0.f; return z; }

DI void phase0(const Params& p, char* smem) {
  const int tid = threadIdx.x, lane = tid & 63, w = tid >> 6;
  constexpr int NT_W1 = 16 * 64, NT_W2 = 16 * 16, NT_ROW = NTOK / 16, NT_CACHE = 1024;
  constexpr int total = NT_W1 + NT_W2 + NT_ROW + NT_CACHE;
  float (*tile)[65] = (float (*)[65])smem;
  if (blockIdx.x == 0 && tid == 0) *p.counter = 0;
  for (int it = blockIdx.x; it < total; it += gridDim.x) {
    if (it < NT_W1 + NT_W2) {
      const float* src; u16* dst; int N, kt, nt;
      if (it < NT_W1) { src = p.w_in; dst = p.WinT; N = 4096; kt = it >> 6; nt = it & 63; }
      else { int j = it - NT_W1; src = p.w_out; dst = p.WoutT; N = 1024; kt = j >> 4; nt = j & 15; }
      const int c = tid & 63, r0 = tid >> 6;
      for (int i = 0; i < 8; ++i) { int r = r0 + 8 * i; tile[r][c] = src[(size_t)(kt * 64 + r) * N + nt * 64 + c]; }
      __syncthreads();
      if (it < NT_W1) {
        for (int i = 0; i < 8; ++i) { int r = r0 + 8 * i; dst[(size_t)(nt * 64 + r) * 1024 + kt * 64 + c] = f2bf(tile[c][r]); }
      } else {
        for (int i = 0; i < 8; ++i) {
          const int r = r0 + 8 * i, n = nt * 64 + r, k = kt * 64 + c;
          dst[((size_t)((n >> 5) * 64 + (k >> 4)) * 64 + ((k >> 3) & 1) * 32 + (n & 31)) * 8 + (k & 7)] = f2bf(tile[c][r]);
        }
      }
      __syncthreads();
    } else if (it < NT_W1 + NT_W2 + NT_ROW) {
      const int row0 = (it - NT_W1 - NT_W2) * 16 + w * 2;
      f32x4 v[2][4]; float ss[2] = {0.f, 0.f};
#pragma unroll
      for (int rr = 0; rr < 2; ++rr) {
        const int row = row0 + rr;
        const float* src = row < NPTOK ? p.x_prompt + (size_t)row * 1024 : p.x_sample + (size_t)(row - NPTOK) * 1024;
#pragma unroll
        for (int i = 0; i < 4; ++i) v[rr][i] = *(const f32x4*)(src + i * 256 + lane * 4);
      }
#pragma unroll
      for (int rr = 0; rr < 2; ++rr) {
#pragma unroll
        for (int i = 0; i < 4; ++i) ss[rr] += v[rr][i][0] * v[rr][i][0] + v[rr][i][1] * v[rr][i][1] + v[rr][i][2] * v[rr][i][2] + v[rr][i][3] * v[rr][i][3];
        ss[rr] = wave_sum(ss[rr]);
      }
#pragma unroll
      for (int rr = 0; rr < 2; ++rr) {
        const float sc = rsqrtf(ss[rr] * (1.f / 1024.f) + 1e-6f);
#pragma unroll
        for (int i = 0; i < 4; ++i) {
          f32x4 g = *(const f32x4*)(p.norm_g + i * 256 + lane * 4);
          u32x2 o; o[0] = pack2(v[rr][i][0] * sc * g[0], v[rr][i][1] * sc * g[1]); o[1] = pack2(v[rr][i][2] * sc * g[2], v[rr][i][3] * sc * g[3]);
          *(u32x2*)(p.Xn + (size_t)(row0 + rr) * 1024 + i * 256 + lane * 4) = o;
        }
      }
    } else {
      const int task0 = (it - NT_W1 - NT_W2 - NT_ROW) * 16 + w * 2;
      f32x4 a[2], b[2];
#pragma unroll
      for (int rr = 0; rr < 2; ++rr) {
        const int task = task0 + rr, which = task >> 13, r8 = task & 8191;
        const float* src = (which ? p.cache_v : p.cache_k) + (size_t)r8 * 512 + lane * 8;
        a[rr] = *(const f32x4*)src; b[rr] = *(const f32x4*)(src + 4);
      }
#pragma unroll
      for (int rr = 0; rr < 2; ++rr) {
        const int task = task0 + rr, which = task >> 13, r8 = task & 8191;
        u16* dst = (which ? p.Vall : p.Kall) + (size_t)(NPTOK + (r8 >> 10) * 1088 + (r8 & 1023)) * 512 + lane * 8;
        u32x4 o; o[0] = pack2(a[rr][0], a[rr][1]); o[1] = pack2(a[rr][2], a[rr][3]); o[2] = pack2(b[rr][0], b[rr][1]); o[3] = pack2(b[rr][2], b[rr][3]);
        *(u32x4*)dst = o;
      }
    }
  }
}

#define G_LOAD(RA, RB, KT_)                                                                                        \
  {                                                                                                                 \
    _Pragma("unroll") for (int i_ = 0; i_ < 4; ++i_) RA[i_] = *(const u32x4*)((ap + (size_t)i_ * 64 * K + (KT_) * 64) + loff); \
    _Pragma("unroll") for (int i_ = 0; i_ < 4; ++i_) RB[i_] = *(const u32x4*)((bp + (size_t)i_ * 64 * K + (KT_) * 64) + loff); \
  }
#define G_WRITE(RA, RB, BUF_)                                                                                      \
  {                                                                                                                 \
    _Pragma("unroll") for (int i_ = 0; i_ < 4; ++i_) *(u32x4*)(wbase + (BUF_) * 73728 + i_ * 64 * 144) = RA[i_];         \
    _Pragma("unroll") for (int i_ = 0; i_ < 4; ++i_) *(u32x4*)(wbase + (BUF_) * 73728 + 36864 + i_ * 64 * 144) = RB[i_]; \
  }
#define G_COMPUTE(BUF_)                                                                                            \
  {                                                                                                                 \
    const char* as_ = smem + (BUF_) * 73728 + (wm * 128 + r) * 144 + h * 16;                                        \
    const char* bs_ = smem + (BUF_) * 73728 + 36864 + (wn * 64 + r) * 144 + h * 16;                                 \
    _Pragma("unroll") for (int s_ = 0; s_ < 4; ++s_) {                                                              \
      const bf16x8 b0_ = *(const bf16x8*)(bs_ + s_ * 32), b1_ = *(const bf16x8*)(bs_ + 32 * 144 + s_ * 32);         \
      _Pragma("unroll") for (int i_ = 0; i_ < 4; ++i_) {                                                            \
        const bf16x8 a_ = *(const bf16x8*)(as_ + i_ * 32 * 144 + s_ * 32);                                          \
        acc[i_][0] = MFMA(a_, b0_, acc[i_][0]);                                                                     \
        acc[i_][1] = MFMA(a_, b1_, acc[i_][1]);                                                                     \
      }                                                                                                             \
    }                                                                                                               \
  }
DI void gemm256(const u16* __restrict__ A, const u16* __restrict__ BT, int K, int m0, int n0, char* smem, int tid, f32x16 (&acc)[4][2]) {
  const int lane = tid & 63, w = tid >> 6, r = lane & 31, h = lane >> 5;
  const int wm = w >> 2, wn = w & 3;
#pragma unroll
  for (int i = 0; i < 4; ++i) { acc[i][0] = zero16(); acc[i][1] = zero16(); }
  u32x4 ra0[4], rb0[4], ra1[4], rb1[4];
  const int KT = K >> 6;
  const u16* ap = A + (size_t)m0 * K;
  const u16* bp = BT + (size_t)n0 * K;
  const int loff = (tid >> 3) * K + (tid & 7) * 8;
  char* wbase = smem + (tid >> 3) * 144 + (tid & 7) * 16;
  G_LOAD(ra0, rb0, 0);
  G_LOAD(ra1, rb1, 1);
  G_WRITE(ra0, rb0, 0);
  __syncthreads();
  for (int kt = 0; kt < KT; kt += 2) {
    { const int k2 = kt + 2 < KT ? kt + 2 : KT - 1; G_LOAD(ra0, rb0, k2); }
    __builtin_amdgcn_sched_barrier(0);
    G_COMPUTE(0);
    __builtin_amdgcn_sched_barrier(0);
    G_WRITE(ra1, rb1, 1);
    __syncthreads();
    { const int k3 = kt + 3 < KT ? kt + 3 : KT - 1; G_LOAD(ra1, rb1, k3); }
    __builtin_amdgcn_sched_barrier(0);
    G_COMPUTE(1);
    __builtin_amdgcn_sched_barrier(0);
    G_WRITE(ra0, rb0, 0);
    __syncthreads();
  }
}
struct TileMap {
  int MT, NT, C, NG, NST, st, lb, lin;
  bool xcd;
  DI TileMap(int mt_, int nt_) : MT(mt_), NT(nt_) {
    const int nb = gridDim.x >> 3;
    C = nb >> 3;
    xcd = (gridDim.x & 63) == 0 && C > 0 && (NT % C) == 0;
    NG = xcd ? NT / C : 1;
    NST = ((MT + 7) >> 3) * NG;
    st = blockIdx.x & 7; lb = blockIdx.x >> 3; lin = blockIdx.x;
  }
  DI bool next(int& mt, int& nt) {
    if (!xcd) {
      if (lin >= MT * NT) return false;
      mt = lin / NT; nt = lin - mt * NT; lin += gridDim.x; return true;
    }
    while (st < NST) {
      const int mg = st / NG, ng = st - mg * NG;
      mt = mg * 8 + lb / C; nt = ng * C + lb % C;
      st += 8;
      if (mt < MT) return true;
    }
    return false;
  }
};
DI void stage_half(const f32x16 (&acc)[4][2], float* cs, int half, int wm, int wn, int r, int h) {
  if (wm == half) {
#pragma unroll
    for (int i = 0; i < 4; ++i)
#pragma unroll
      for (int j = 0; j < 2; ++j)
#pragma unroll
        for (int e = 0; e < 16; ++e) cs[(i * 32 + crow(e, h)) * 260 + wn * 64 + j * 32 + r] = acc[i][j][e];
  }
}

DI void phase1(const Params& p, char* smem) {
  constexpr int MT = NTOK / 256, NT = 16;
  TileMap tm(MT, NT);
  int mt, nt;
  while (tm.next(mt, nt)) {
    const int m0 = mt * 256, n0 = nt * 256;
    f32x16 acc[4][2];
    {
      int tg = threadIdx.x;
      asm volatile("" : "+v"(tg));
      gemm256(p.Xn, p.WinT, 1024, m0, n0, smem, tg, acc);
    }
    int tid = threadIdx.x;
    asm volatile("" : "+v"(tid));
    const int lane = tid & 63, w = tid >> 6, r = lane & 31, h = lane >> 5;
    const int wm = w >> 2, wn = w & 3;
    const int sec = n0 >> 9;
    const bool samp = m0 >= NPTOK;
    float* cs = (float*)smem;
    const int c0 = (tid & 31) * 8, rb = tid >> 5;
    const int csc = (n0 & 511) + c0;
#pragma unroll 1
    for (int half = 0; half < 2; ++half) {
      stage_half(acc, cs, half, wm, wn, r, h);
      __syncthreads();
#pragma unroll 2
      for (int ps = 0; ps < 8; ++ps) {
        const int row = rb + 16 * ps;
        const int t = m0 + half * 128 + row;
        f32x4 va = *(const f32x4*)(cs + row * 260 + c0), vb = *(const f32x4*)(cs + row * 260 + c0 + 4);
        const size_t o512 = (size_t)t * 512 + csc;
        if (sec == 5) { __builtin_nontemporal_store(va, (f32x4*)(p.Fr + o512)); __builtin_nontemporal_store(vb, (f32x4*)(p.Fr + o512 + 4)); }
        else {
          u16* dst;
          if (sec == 0) {
            const float qs = 0.125f * 1.44269504089f;
            va *= qs; vb *= qs; dst = p.Qb + o512;
          } else if (sec == 1 || sec == 2) {
            size_t kvr; float* od;
            if (!samp) { kvr = t; od = p.out + (sec == 1 ? OFF_NKP : OFF_NVP) + o512; }
            else { const int ts = t - NPTOK; kvr = NPTOK + (ts >> 6) * 1088 + 1024 + (ts & 63); od = p.out + (sec == 1 ? OFF_NKS : OFF_NVS) + (size_t)ts * 512 + csc; }
            __builtin_nontemporal_store(va, (f32x4*)od); __builtin_nontemporal_store(vb, (f32x4*)(od + 4));
            dst = (sec == 1 ? p.Kall : p.Vall) + kvr * 512 + csc;
          } else if (sec == 6) { dst = p.Ir + o512; }
          else {
#pragma unroll
            for (int i = 0; i < 4; ++i) { va[i] = silu_f(va[i]); vb[i] = silu_f(vb[i]); }
            dst = (sec == 3 ? p.Za : (sec == 4 ? p.Qr : p.Zr)) + o512;
          }
          u32x4 o; o[0] = pack2(va[0], va[1]); o[1] = pack2(va[2], va[3]); o[2] = pack2(vb[0], vb[1]); o[3] = pack2(vb[2], vb[3]);
          __builtin_nontemporal_store(o, (u32x4*)dst);
        }
      }
      __syncthreads();
    }
  }
}

DI void rec_pre(const Params& p, int tid, int I, float* totS, float (&cum)[32], float (&key)[32], float& lastv) {
  const int d = tid & 127, half = tid >> 7;
  const int hd = I & 3, t0 = (I >> 2) * 64;
  const float r0 = p.rec_lb[hd * 128 + d], r1 = p.rec_lb[512 + hd * 128 + d];
  const float lb = 1.f / (1.f + __expf(r1 - r0));
  const float* fp = p.Fr + (size_t)(t0 + half * 32) * 512 + hd * 128 + d;
  float run = 0.f;
#pragma unroll
  for (int i = 0; i < 32; ++i) {
    float x = fp[(size_t)i * 512];
    x = fminf(fmaxf(x, -30.f), 30.f);
    const float e = __expf(-x), sg = 1.f / (1.f + e);
    run += __logf(lb + (1.f - lb) * sg);
    cum[i] = run; key[i] = (1.f - lb) * e * sg;
  }
  totS[tid] = run;
  __syncthreads();
  const float tot0 = totS[d], tot1 = totS[128 + d];
  if (half) {
#pragma unroll
    for (int i = 0; i < 32; ++i) cum[i] += tot0;
  }
  lastv = tot0 + tot1;
}

DI void phase2(const Params& p, char* smem0, u16* BbufT) {
  const int hf = threadIdx.x >> 8;
  const int tid = threadIdx.x & 255, lane = tid & 63, w = tid >> 6, r = lane & 31, h = lane >> 5;
  const int q = (lane & 15) >> 2, pp = lane & 3, blk = (lane >> 4) & 1;
  const int d = tid & 127, half = tid >> 7;
  char* smem = smem0 + hf * 65536;
  char* KdI = smem; char* VrI = smem + 17408; float* totS = (float*)(smem + 60000);
  for (int I = blockIdx.x * 2 + hf; I < NITEM; I += gridDim.x * 2) {
    const int hd = I & 3, t0 = (I >> 2) * 64;
    if (I < 2048) {
      const int token = tid & 63, which = tid >> 6;
      const u16* src = (which < 2 ? p.Qb : p.Kall) + (size_t)(t0 + token) * 512 + hd * 128 + (which & 1) * 64;
      float ss = 0.f;
#pragma unroll
      for (int c = 0; c < 8; ++c) {
        const u32x4 v = *(const u32x4*)(src + c * 8);
#pragma unroll
        for (int i = 0; i < 4; ++i) { const float lo = bflo(v[i]), hi = bfhi(v[i]); ss += lo * lo + hi * hi; }
      }
#pragma unroll
      for (int o = 32; o >= 1; o >>= 1) ss = fmaxf(ss, __shfl_xor(ss, o));
      if (lane == 0) p.NQ[I * 4 + which] = sqrtf(ss);
    }
    float cum[32], key[32], lastv;
    rec_pre(p, tid, I, totS, cum, key, lastv);
#pragma unroll
    for (int i = 0; i < 32; ++i) {
      const int t = half * 32 + i;
      *(u16*)(KdI + t * 272 + d * 2) = f2bf(key[i] * __expf(lastv - cum[i]));
    }
#pragma unroll
    for (int i = 0; i < 4; ++i) {
      const int ch = tid + 256 * i, row = ch >> 4, cc = ch & 15;
      *(u32x4*)(VrI + row * 272 + cc * 16) = *(const u32x4*)(p.Ir + (size_t)(t0 + row) * 512 + hd * 128 + cc * 8);
    }
    if (half) p.Abuf[I * 128 + d] = __expf(lastv);
    __syncthreads();
    f32x16 acc[4];
#pragma unroll
    for (int ct = 0; ct < 4; ++ct) acc[ct] = zero16();
#pragma unroll
    for (int ks = 0; ks < 4; ++ks) {
      const int rowoff = (16 * ks + 8 * h + q) * 272 + 32 * blk + 8 * pp;
      bf16x8 a = tr_frag(VrI + rowoff + 64 * w, 4 * 272);
#pragma unroll
      for (int ct = 0; ct < 4; ++ct) {
        bf16x8 b = tr_frag(KdI + rowoff + 64 * ct, 4 * 272);
        acc[ct] = MFMA(a, b, acc[ct]);
      }
    }
    u16* ob = BbufT + (size_t)I * 16384;
#pragma unroll
    for (int ct = 0; ct < 4; ++ct)
#pragma unroll
      for (int e = 0; e < 16; ++e) ob[(32 * w + crow(e, h)) * 128 + 32 * ct + r] = f2bf(acc[ct][e]);
    __syncthreads();
  }
}

DI void phase3(const Params& p, const u16* BbufT) {
  const int tid = threadIdx.x & 255;
  for (int it = blockIdx.x * 2 + (threadIdx.x >> 8); it < 512 + 1024; it += gridDim.x * 2) {
    if (it < 512) {
      const int bh = it >> 6, b = bh >> 2, hd = bh & 3;
      const int e1 = (it & 63) * 256 + tid, v = e1 >> 7, d = e1 & 127;
      float sx = 0.f;
      const size_t eo = (size_t)v * 128 + d;
      const int I0 = (b * 256) * 4 + hd;
      const float* ap = p.Abuf + (size_t)I0 * 128 + d;
      const u16* bp = BbufT + (size_t)I0 * 16384 + eo;
      u16* sp = p.SbufT + (size_t)I0 * 16384 + eo;
      for (int c0 = 0; c0 < 256; c0 += 16) {
        float av[16]; u16 bw[16];
#pragma unroll
        for (int i = 0; i < 16; ++i) { av[i] = ap[(size_t)(c0 + i) * 4 * 128]; bw[i] = bp[(size_t)(c0 + i) * 4 * 16384]; }
#pragma unroll
        for (int i = 0; i < 16; ++i) {
          sp[(size_t)(c0 + i) * 4 * 16384] = f2bf(sx);
          sx = av[i] * sx + bflo(bw[i]);
        }
      }
      p.out[OFF_NHP + (size_t)(b * 4 + hd) * 16384 + d * 128 + v] = sx;
    } else {
      const int j = it - 512;
      const int sh = j >> 5, bs = sh >> 2, hd = sh & 3;
      const int e2 = (j & 31) * 256 + tid, v = e2 >> 6, d2 = (e2 & 63) * 2;
      const int I = (512 + bs) * 4 + hd;
      const float* sh0 = p.state_h + (size_t)(bs * 4 + hd) * 16384;
      float sx = sh0[d2 * 128 + v], sy = sh0[(d2 + 1) * 128 + v];
      const size_t eo = (size_t)v * 128 + d2;
      const f32x2 a = *(const f32x2*)(p.Abuf + I * 128 + d2);
      const unsigned bw = *(const unsigned*)(BbufT + (size_t)I * 16384 + eo);
      *(unsigned*)(p.SbufT + (size_t)I * 16384 + eo) = pack2(sx, sy);
      sx = a[0] * sx + bflo(bw); sy = a[1] * sy + bfhi(bw);
      float* oh = p.out + OFF_NHS + (size_t)(bs * 4 + hd) * 16384;
      oh[d2 * 128 + v] = sx; oh[(d2 + 1) * 128 + v] = sy;
    }
  }
}

DI void r3_item(const Params& p, char* smem, int tid, int I) {
  const int lane = tid & 63, w = tid >> 6, r = lane & 31, h = lane >> 5;
  const int q = (lane & 15) >> 2, pp = lane & 3, blk = (lane >> 4) & 1;
  const int d = tid & 127, half = tid >> 7;
  char* QdI = smem; char* KdI = smem + 17408; char* VrI = smem + 34816;
  float* totS = (float*)(smem + 60000); float* ssS = (float*)(smem + 62048);
  const int hd = I & 3, t0 = (I >> 2) * 64;
  {
    float cum[32], key[32], lastv;
    rec_pre(p, tid, I, totS, cum, key, lastv);
    const u16* qp = p.Qr + (size_t)(t0 + half * 32) * 512 + hd * 128 + d;
#pragma unroll
    for (int i = 0; i < 32; ++i) {
      const int t = half * 32 + i;
      const float qv = bflo(qp[(size_t)i * 512]);
      *(u16*)(QdI + t * 272 + d * 2) = f2bf(qv * __expf(cum[i]));
      *(u16*)(KdI + t * 272 + d * 2) = f2bf(key[i] * __expf(-cum[i]));
    }
  }
#pragma unroll
  for (int i = 0; i < 4; ++i) {
    const int ch = tid + 256 * i, row = ch >> 4, cc = ch & 15;
    *(u32x4*)(VrI + row * 272 + cc * 16) = *(const u32x4*)(p.Ir + (size_t)(t0 + row) * 512 + hd * 128 + cc * 8);
  }
  __syncthreads();
  const int tt = w & 1, vh = w >> 1;
  bf16x8 qf[8];
#pragma unroll
  for (int ks = 0; ks < 8; ++ks) qf[ks] = *(const bf16x8*)(QdI + (32 * tt + r) * 272 + ks * 32 + h * 16);
  f32x16 sc[2]; sc[0] = zero16(); sc[1] = zero16();
#pragma unroll
  for (int ks = 0; ks < 8; ++ks) {
    bf16x8 a0 = *(const bf16x8*)(KdI + r * 272 + ks * 32 + h * 16);
    sc[0] = MFMA(a0, qf[ks], sc[0]);
  }
  if (tt == 1) {
#pragma unroll
    for (int ks = 0; ks < 8; ++ks) {
      bf16x8 a1 = *(const bf16x8*)(KdI + (32 + r) * 272 + ks * 32 + h * 16);
      sc[1] = MFMA(a1, qf[ks], sc[1]);
    }
  }
#pragma unroll
  for (int e = 0; e < 16; ++e) {
    const bool keep = crow(e, h) <= r;
    if (tt == 0) { if (!keep) sc[0][e] = 0.f; }
    else { if (!keep) sc[1][e] = 0.f; }
  }
  bf16x8 pf[4];
  pf[0] = pack8(sc[0], 0); pf[1] = pack8(sc[0], 1); pf[2] = pack8(sc[1], 0); pf[3] = pack8(sc[1], 1);
  f32x16 o[2]; o[0] = zero16(); o[1] = zero16();
  const u16* sp = p.SbufT + (size_t)I * 16384;
#pragma unroll
  for (int vi = 0; vi < 2; ++vi) {
    const int vt = 2 * vh + vi;
#pragma unroll
    for (int k4 = 0; k4 < 4; ++k4) {
      if (k4 < 2 || tt == 1) {
        bf16x8 a = tr_frag(VrI + (16 * k4 + 4 * h + q) * 272 + (32 * vt + 16 * blk) * 2 + 8 * pp, 8 * 272);
        o[vi] = MFMA(a, pf[k4], o[vi]);
      }
    }
#pragma unroll
    for (int ks = 0; ks < 8; ++ks) {
      bf16x8 a = *(const bf16x8*)(sp + (size_t)(32 * vt + r) * 128 + ks * 16 + h * 8);
      o[vi] = MFMA(a, qf[ks], o[vi]);
    }
  }
  float ss = 0.f;
#pragma unroll
  for (int vi = 0; vi < 2; ++vi)
#pragma unroll
    for (int e = 0; e < 16; ++e) ss += o[vi][e] * o[vi][e];
  ss += __shfl_xor(ss, 32);
  if (h == 0) ssS[w * 32 + r] = ss;
  __syncthreads();
  const float tot = ssS[tt * 32 + r] + ssS[(tt + 2) * 32 + r];
  const float rs = rsqrtf(tot * (1.f / 128.f) + 1e-6f);
  const int tok = t0 + 32 * tt + r;
#pragma unroll
  for (int vi = 0; vi < 2; ++vi)
#pragma unroll
    for (int g = 0; g < 4; ++g) {
      const int v = 32 * (2 * vh + vi) + 8 * g + 4 * h;
      const f32x4 gg = *(const f32x4*)(p.rec_norm_g + v);
      const u32x2 z = *(const u32x2*)(p.Zr + (size_t)tok * 512 + hd * 128 + v);
      u32x2 ov;
      ov[0] = pack2(o[vi][4 * g + 0] * rs * gg[0] * bflo(z[0]), o[vi][4 * g + 1] * rs * gg[1] * bfhi(z[0]));
      ov[1] = pack2(o[vi][4 * g + 2] * rs * gg[2] * bflo(z[1]), o[vi][4 * g + 3] * rs * gg[3] * bfhi(z[1]));
      *(u32x2*)(p.Mix + (size_t)tok * 1024 + 512 + hd * 128 + v) = ov;
    }
  __syncthreads();
}

template <bool DIAG>
DI void attn_tile_a(const char* ks, const bf16x8 (&qf)[4], f32x16 (&O)[4], bf16x8 (&pf)[4], float& mrun, float& lsum, float sl2, float qrel,
                    int m, int r, int h2) {
  f32x16 S[2];
#pragma unroll
  for (int st = 0; st < 2; ++st) {
    S[st] = zero16();
#pragma unroll
    for (int s = 0; s < 4; ++s) {
      bf16x8 a = *(const bf16x8*)(ks + (32 * st + r) * 272 + m * 128 + s * 32 + h2 * 16);
      S[st] = MFMA(a, qf[s], S[st]);
    }
  }
  float mx = -1e30f;
#pragma unroll
  for (int st = 0; st < 2; ++st)
#pragma unroll
    for (int e = 0; e < 16; ++e) {
      const float cst = (float)(32 * st + (e & 3) + 8 * (e >> 2));
      float sv;
      if (DIAG) sv = fmaf(-sl2, fabsf(qrel - cst), S[st][e]);
      else sv = fmaf(sl2, cst, S[st][e]);
      S[st][e] = sv; mx = fmaxf(mx, sv);
    }
  const float L = DIAG ? 0.f : -sl2 * qrel;
  mx += L;
  mx = fmaxf(mx, __shfl_xor(mx, 32));
  if (__builtin_amdgcn_ballot_w64(mx > mrun + 6.f) != 0) {
    const float mnew = fmaxf(mrun, mx);
    const float alpha = __builtin_amdgcn_exp2f(mrun - mnew);
    mrun = mnew; lsum *= alpha;
#pragma unroll
    for (int vt = 0; vt < 4; ++vt)
#pragma unroll
      for (int e = 0; e < 16; ++e) O[vt][e] *= alpha;
  }
  const float off = L - mrun;
  float rs = 0.f;
#pragma unroll
  for (int st = 0; st < 2; ++st)
#pragma unroll
    for (int e = 0; e < 16; ++e) { const float pv = __builtin_amdgcn_exp2f(S[st][e] + off); S[st][e] = pv; rs += pv; }
  lsum += rs;
  pf[0] = pack8(S[0], 0); pf[1] = pack8(S[0], 1); pf[2] = pack8(S[1], 0); pf[3] = pack8(S[1], 1);
}
template <bool DIAG>
DI void attn_tile_f(const char* ks, const bf16x8 (&qf)[4], bf16x8 (&pf)[4], float& lsum, float sl2, float qrel, float mref, int m, int r, int h2) {
  f32x16 S[2];
  const float offL = -sl2 * qrel - mref;
#pragma unroll
  for (int st = 0; st < 2; ++st) {
#pragma unroll
    for (int e = 0; e < 16; ++e) {
      const float cst = (float)(32 * st + (e & 3) + 8 * (e >> 2));
      S[st][e] = DIAG ? (-sl2 * fabsf(qrel - cst) - mref) : fmaf(sl2, cst, offL);
    }
#pragma unroll
    for (int s = 0; s < 4; ++s) {
      bf16x8 a = *(const bf16x8*)(ks + (32 * st + r) * 272 + m * 128 + s * 32 + h2 * 16);
      S[st] = MFMA(a, qf[s], S[st]);
    }
  }
  float rs = 0.f;
#pragma unroll
  for (int st = 0; st < 2; ++st)
#pragma unroll
    for (int e = 0; e < 16; ++e) { const float pv = __builtin_amdgcn_exp2f(S[st][e]); S[st][e] = pv; rs += pv; }
  lsum += rs;
  pf[0] = pack8(S[0], 0); pf[1] = pack8(S[0], 1); pf[2] = pack8(S[1], 0); pf[3] = pack8(S[1], 1);
}
DI void attn_tile_b(const char* vs, const bf16x8 (&pf)[4], f32x16 (&O)[4], int h2, int q, int pp, int blk) {
  const char* vb = vs + (4 * h2 + q) * 320 + 32 * blk + 8 * pp;
  bf16x8 a0[4], a1[4];
#pragma unroll
  for (int vt = 0; vt < 4; ++vt) a0[vt] = tr_frag(vb + 64 * vt, 8 * 320);
  __builtin_amdgcn_sched_barrier(0);
#pragma unroll
  for (int vt = 0; vt < 4; ++vt) a1[vt] = tr_frag(vb + 16 * 320 + 64 * vt, 8 * 320);
#pragma unroll
  for (int vt = 0; vt < 4; ++vt) O[vt] = MFMA(a0[vt], pf[0], O[vt]);
  __builtin_amdgcn_sched_barrier(0);
#pragma unroll
  for (int vt = 0; vt < 4; ++vt) a0[vt] = tr_frag(vb + 32 * 320 + 64 * vt, 8 * 320);
#pragma unroll
  for (int vt = 0; vt < 4; ++vt) O[vt] = MFMA(a1[vt], pf[1], O[vt]);
  __builtin_amdgcn_sched_barrier(0);
#pragma unroll
  for (int vt = 0; vt < 4; ++vt) a1[vt] = tr_frag(vb + 48 * 320 + 64 * vt, 8 * 320);
#pragma unroll
  for (int vt = 0; vt < 4; ++vt) O[vt] = MFMA(a0[vt], pf[2], O[vt]);
  __builtin_amdgcn_sched_barrier(0);
#pragma unroll
  for (int vt = 0; vt < 4; ++vt) O[vt] = MFMA(a1[vt], pf[3], O[vt]);
}

DI void attn_item(const Params& p, char* smem, int tid, int tq0, int qpos0, int kvbase, int ntb, int hd, float lam, bool can_skip, int nq) {
  const int lane = tid & 63, w = tid >> 6, r = lane & 31, h2 = lane >> 5;
  const int q = (lane & 15) >> 2, pp = lane & 3, blk = (lane >> 4) & 1;
  const int qg = w & 3, m = w >> 2, ch = qg >> 1;
  const bool wact = qg < nq;
  const float sl2 = exp2f(-2.f * (float)(hd + 1)) * 1.44269504089f;
  const int qtok = tq0 + 32 * qg + r;
  const float qposf = (float)(qpos0 + 32 * qg + r);
  const int ntw = can_skip ? ntb - 1 + ch : ntb;
  int kt0w = 0, kt0b = 0;
  bool fast = false; float kn_w = 0.f;
  if (can_skip) {
    const int I0 = (tq0 >> 6) * 4 + hd;
    const int crk = kvbase >> 6;
    fast = true; kt0b = ntb;
#pragma unroll
    for (int mm = 0; mm < 2; ++mm) {
      float KN = 0.f;
      for (int c = lane; c < ntb; c += 64) KN = fmaxf(KN, p.NQ[((crk + c) * 4 + hd) * 4 + 2 + mm]);
#pragma unroll
      for (int o = 32; o >= 1; o >>= 1) KN = fmaxf(KN, __shfl_xor(KN, o));
#pragma unroll
      for (int cc = 0; cc < 2; ++cc) {
        const float QN = p.NQ[(I0 + 4 * cc) * 4 + mm];
        const float D = (2.02f * QN * KN + 66.f) / sl2;
        const float f = ((float)(qpos0 + 64 * cc - 63) - D) * (1.f / 64.f);
        const int k0 = f < 0.f ? 0 : (int)f + 1;
        kt0b = k0 < kt0b ? k0 : kt0b;
        fast = fast && (2.02f * QN * KN < 60.f);
        if (mm == m && cc == ch) { kt0w = k0; kn_w = KN; }
      }
    }
  }
  bf16x8 qf[4];
  if (wact) {
#pragma unroll
    for (int s = 0; s < 4; ++s) qf[s] = *(const bf16x8*)(p.Qb + (size_t)qtok * 512 + hd * 128 + m * 64 + 16 * s + 8 * h2);
  } else {
#pragma unroll
    for (int s = 0; s < 4; ++s) qf[s] = (bf16x8){0, 0, 0, 0, 0, 0, 0, 0};
  }
  float mref = 0.f;
  if (fast) {
    float qq = 0.f;
#pragma unroll
    for (int s = 0; s < 4; ++s) {
      const u32x4 u = __builtin_bit_cast(u32x4, qf[s]);
#pragma unroll
      for (int i = 0; i < 4; ++i) { const float lo = bflo(u[i]), hi = bfhi(u[i]); qq += lo * lo + hi * hi; }
    }
    qq += __shfl_xor(qq, 32);
    mref = sqrtf(qq) * kn_w * 1.01f + 0.5f;
  }
  f32x16 O[4];
#pragma unroll
  for (int vt = 0; vt < 4; ++vt) O[vt] = zero16();
  float mrun = -1e30f, lsum = 0.f;
  u32x4 rk[2], rv[2];
  const int lrow = tid >> 4, lcc = tid & 15;
  const size_t gofs = (size_t)(kvbase + lrow) * 512 + hd * 128 + lcc * 8;
  const u16* kp = p.Kall + gofs;
  const u16* vp = p.Vall + gofs;
  char* kw = smem + lrow * 272 + lcc * 16;
  char* vw = smem + 17408 + lrow * 320 + lcc * 16;
  const int nit = ntb - kt0b;
  {
    const size_t go = (size_t)(fast ? kt0b : ntb - 1) * 64 * 512;
#pragma unroll
    for (int i = 0; i < 2; ++i) { rk[i] = *(const u32x4*)(kp + go + (size_t)i * 32 * 512); rv[i] = *(const u32x4*)(vp + go + (size_t)i * 32 * 512); }
#pragma unroll
    for (int i = 0; i < 2; ++i) { *(u32x4*)(kw + i * 32 * 272) = rk[i]; *(u32x4*)(vw + i * 32 * 320) = rv[i]; }
    const int k1 = fast ? (kt0b + 1 < ntb ? kt0b + 1 : ntb - 1) : (ntb - 2 > kt0b ? ntb - 2 : kt0b);
    const size_t g1 = (size_t)k1 * 64 * 512;
#pragma unroll
    for (int i = 0; i < 2; ++i) { rk[i] = *(const u32x4*)(kp + g1 + (size_t)i * 32 * 512); rv[i] = *(const u32x4*)(vp + g1 + (size_t)i * 32 * 512); }
  }
  __syncthreads();
  if (fast) {
    for (int it = 0; it < nit; ++it) {
      const int kt = kt0b + it;
      const bool active = wact && kt >= kt0w && kt < ntw;
      const char* ks = smem + (it & 1) * 37888;
      char* wb = kw + ((it + 1) & 1) * 37888;
      char* wbv = vw + ((it + 1) & 1) * 37888;
#pragma unroll
      for (int i = 0; i < 2; ++i) { *(u32x4*)(wb + i * 32 * 272) = rk[i]; *(u32x4*)(wbv + i * 32 * 320) = rv[i]; }
      {
        const int k2 = kt + 2 < ntb ? kt + 2 : ntb - 1;
        const size_t g2 = (size_t)k2 * 64 * 512;
#pragma unroll
        for (int i = 0; i < 2; ++i) { rk[i] = *(const u32x4*)(kp + g2 + (size_t)i * 32 * 512); rv[i] = *(const u32x4*)(vp + g2 + (size_t)i * 32 * 512); }
      }
      __builtin_amdgcn_sched_barrier(0);
      if (active) {
        bf16x8 pf[4];
        const float qrel = qposf - (float)(kt * 64 + 4 * h2);
        if (kt == ntw - 1) attn_tile_f<true>(ks, qf, pf, lsum, sl2, qrel, mref, m, r, h2);
        else attn_tile_f<false>(ks, qf, pf, lsum, sl2, qrel, mref, m, r, h2);
        attn_tile_b(ks + 17408, pf, O, h2, q, pp, blk);
      }
      __syncthreads();
    }
  } else {
    for (int it = 0; it < nit; ++it) {
      const int kt = ntb - 1 - it;
      const bool active = wact && kt >= kt0w && kt < ntw;
      const char* ks = smem + (it & 1) * 37888;
      char* wb = kw + ((it + 1) & 1) * 37888;
      char* wbv = vw + ((it + 1) & 1) * 37888;
#pragma unroll
      for (int i = 0; i < 2; ++i) { *(u32x4*)(wb + i * 32 * 272) = rk[i]; *(u32x4*)(wbv + i * 32 * 320) = rv[i]; }
      {
        const int k2 = kt - 2 > kt0b ? kt - 2 : kt0b;
        const size_t g2 = (size_t)k2 * 64 * 512;
#pragma unroll
        for (int i = 0; i < 2; ++i) { rk[i] = *(const u32x4*)(kp + g2 + (size_t)i * 32 * 512); rv[i] = *(const u32x4*)(vp + g2 + (size_t)i * 32 * 512); }
      }
      __builtin_amdgcn_sched_barrier(0);
      if (active) {
        bf16x8 pf[4];
        const float qrel = qposf - (float)(kt * 64 + 4 * h2);
        if (kt == ntw - 1) attn_tile_a<true>(ks, qf, O, pf, mrun, lsum, sl2, qrel, m, r, h2);
        else attn_tile_a<false>(ks, qf, O, pf, mrun, lsum, sl2, qrel, m, r, h2);
        attn_tile_b(ks + 17408, pf, O, h2, q, pp, blk);
      }
      __syncthreads();
    }
  }
  const float lt = lsum + __shfl_xor(lsum, 32);
  const float inv = wact ? 1.f / lt : 0.f;
  float* exch = (float*)smem + qg * 4096 + lane;
  if (m == 1) {
#pragma unroll
    for (int vt = 0; vt < 4; ++vt)
#pragma unroll
      for (int e = 0; e < 16; ++e) exch[(vt * 16 + e) * 64] = O[vt][e] * inv;
  }
  __syncthreads();
  if (m == 0 && wact) {
    float ss = 0.f;
#pragma unroll
    for (int vt = 0; vt < 4; ++vt)
#pragma unroll
      for (int e = 0; e < 16; ++e) { const float ov = O[vt][e] * inv - lam * exch[(vt * 16 + e) * 64]; O[vt][e] = ov; ss += ov * ov; }
    ss += __shfl_xor(ss, 32);
    const float rsn = rsqrtf(ss * (1.f / 128.f) + 1e-6f) * 0.8f;
#pragma unroll
    for (int vt = 0; vt < 4; ++vt)
#pragma unroll
      for (int g = 0; g < 4; ++g) {
        const int v = 32 * vt + 8 * g + 4 * h2;
        const f32x4 gg = *(const f32x4*)(p.subln_g + v);
        const u32x2 z = *(const u32x2*)(p.Za + (size_t)qtok * 512 + hd * 128 + v);
        u32x2 ov;
        ov[0] = pack2(O[vt][4 * g + 0] * rsn * gg[0] * bflo(z[0]), O[vt][4 * g + 1] * rsn * gg[1] * bfhi(z[0]));
        ov[1] = pack2(O[vt][4 * g + 2] * rsn * gg[2] * bflo(z[1]), O[vt][4 * g + 3] * rsn * gg[3] * bfhi(z[1]));
        *(u32x2*)(p.Mix + (size_t)qtok * 1024 + hd * 128 + v) = ov;
      }
  }
  __syncthreads();
}

DI void phase4(const Params& p, char* smem) {
  const int tid = threadIdx.x, lane = tid & 63;
  float lam;
  {
    const float a = p.lambda_qk[lane] * p.lambda_qk[64 + lane];
    const float b = p.lambda_qk[128 + lane] * p.lambda_qk[192 + lane];
    lam = __expf(wave_sum(a)) - __expf(wave_sum(b)) + 0.2f;
  }
  int* sitem = (int*)(smem + 153584);
  constexpr int NPA = 1024, NSA = 32, TOTAL = NPA + NSA + NITEM / 2;
  for (;;) {
    if (tid == 0) *sitem = atomicAdd(p.counter, 1);
    __syncthreads();
    const int item = *sitem;
    __syncthreads();
    if (item >= TOTAL) break;
    int tid_o = tid;
    asm volatile("" : "+v"(tid_o));
    if (item < NPA + NSA) {
      int tq0, qpos0, kvbase, ntb, hd, nq; bool can_skip;
      if (item < NPA) {
        const int qb = 127 - ((item & 255) >> 1), b = item & 1;
        hd = 3 - (item >> 8); tq0 = b * 16384 + qb * 128; qpos0 = qb * 128; kvbase = b * 16384; ntb = 2 * qb + 2; can_skip = true; nq = 4;
      } else {
        const int it = item - NPA, bs = it >> 2;
        hd = it & 3; tq0 = NPTOK + bs * 64; qpos0 = 1024; kvbase = NPTOK + bs * 1088; ntb = 17; can_skip = false; nq = 2;
      }
      attn_item(p, smem, tid_o, tq0, qpos0, kvbase, ntb, hd, lam, can_skip, nq);
    } else {
      const int hf = tid_o >> 8;
      r3_item(p, smem + hf * 65536, tid_o & 255, (item - NPA - NSA) * 2 + hf);
    }
  }
}

DI void phase5(const Params& p, char* smem) {
  float* wsum = (float*)(smem + 132096);
  for (int strip = blockIdx.x; strip < NTOK / 64; strip += gridDim.x) {
    int tid = threadIdx.x;
    asm volatile("" : "+v"(tid));
    const int lane = tid & 63, w = tid >> 6, r = lane & 31, h = lane >> 5;
    const int m0 = strip * 64;
    {
      const u16* gb = p.Mix + (size_t)m0 * 1024;
      const int loff = (tid >> 7) * 1024 + (tid & 127) * 8;
      char* lw = smem + (tid >> 7) * 2064 + (tid & 127) * 16;
#pragma unroll
      for (int i = 0; i < 16; ++i)
        *(u32x4*)(lw + i * 4 * 2064) = __builtin_nontemporal_load((const u32x4*)((gb + i * 4096) + loff));
    }
    f32x16 acc[2][4];
#pragma unroll
    for (int i = 0; i < 2; ++i)
#pragma unroll
      for (int j = 0; j < 4; ++j) acc[i][j] = zero16();
    const u16* bp = p.WoutT + (size_t)(w * 4) * 64 * 512 + lane * 8;
    bf16x8 b[2][4];
#pragma unroll
    for (int u = 0; u < 2; ++u)
#pragma unroll
      for (int j = 0; j < 4; ++j) b[u][j] = *(const bf16x8*)(bp + (size_t)(j * 64 + u) * 512);
    __syncthreads();
    const char* ap = smem + r * 2064 + h * 16;
    for (int ks0 = 0; ks0 < 64; ks0 += 2) {
#pragma unroll
      for (int u = 0; u < 2; ++u) {
        const int ks = ks0 + u;
        const bf16x8 a0 = *(const bf16x8*)(ap + ks * 32), a1 = *(const bf16x8*)(ap + 32 * 2064 + ks * 32);
#pragma unroll
        for (int j = 0; j < 4; ++j) { acc[0][j] = MFMA(a0, b[u][j], acc[0][j]); acc[1][j] = MFMA(a1, b[u][j], acc[1][j]); }
        const int kn = ks + 2 < 64 ? ks + 2 : 63;
#pragma unroll
        for (int j = 0; j < 4; ++j) b[u][j] = *(const bf16x8*)(bp + (size_t)(j * 64 + kn) * 512);
        __builtin_amdgcn_sched_barrier(0);
      }
    }
    const float* xs_u = (m0 < NPTOK ? p.x_prompt : p.x_sample - (size_t)NPTOK * 1024) + (size_t)m0 * 1024;
    const int lane_off = h * 4096 + w * 128 + r;
#pragma unroll
    for (int i = 0; i < 2; ++i) {
      float ps[16];
#pragma unroll
      for (int e = 0; e < 16; ++e) ps[e] = 0.f;
#pragma unroll
      for (int j = 0; j < 4; ++j) {
#pragma unroll
        for (int e = 0; e < 16; ++e) {
          const float hv = acc[i][j][e] + __builtin_nontemporal_load((xs_u + (i * 32 + (e & 3) + 8 * (e >> 2)) * 1024 + j * 32) + lane_off);
          acc[i][j][e] = hv; ps[e] += hv * hv;
        }
        __builtin_amdgcn_sched_barrier(0);
      }
#pragma unroll
      for (int e = 0; e < 16; ++e) {
#pragma unroll
        for (int o = 16; o >= 1; o >>= 1) ps[e] += __shfl_xor(ps[e], o);
      }
      if (r == 0) {
#pragma unroll
        for (int e = 0; e < 16; ++e) wsum[w * 64 + i * 32 + crow(e, h)] = ps[e];
      }
      __builtin_amdgcn_sched_barrier(0);
    }
    __syncthreads();
    float* yo_u = p.out + OFF_Y + (size_t)m0 * 1024;
#pragma unroll
    for (int i = 0; i < 2; ++i) {
      float sc[16];
#pragma unroll
      for (int e = 0; e < 16; ++e) {
        const int rw = i * 32 + crow(e, h);
        float t = 0.f;
#pragma unroll
        for (int k = 0; k < 8; ++k) t += wsum[k * 64 + rw];
        sc[e] = rsqrtf(t * (1.f / 1024.f) + 1e-6f);
      }
#pragma unroll
      for (int j = 0; j < 4; ++j) {
        const float g = (p.final_g + j * 32)[w * 128 + r];
#pragma unroll
        for (int e = 0; e < 16; ++e)
          __builtin_nontemporal_store(acc[i][j][e] * sc[e] * g, (yo_u + (i * 32 + (e & 3) + 8 * (e >> 2)) * 1024 + j * 32) + lane_off);
        __builtin_amdgcn_sched_barrier(0);
      }
    }
    __syncthreads();
  }
}

__global__ void __launch_bounds__(512, 2) fwd_megakernel(Params p) {
  __shared__ __attribute__((aligned(16))) char smem[153600];
  cg::grid_group grid = cg::this_grid();
  float* scratch_out = p.out + OFF_Y;
  const int lo = p.phase_lo, hi = p.phase_hi, rm = p.rep_mask;
  if (lo <= 0 && hi >= 0) phase0(p, smem);
  if (lo <= 0 && hi >= 1) grid.sync();
  if (lo <= 1 && hi >= 1) phase1(p, smem);
  if (lo <= 1 && hi >= 2) grid.sync();
  if (lo <= 2 && hi >= 2) phase2(p, smem, (u16*)scratch_out);
  if (lo <= 2 && hi >= 3) grid.sync();
  if (lo <= 3 && hi >= 3) phase3(p, (const u16*)scratch_out);
  if (lo <= 3 && hi >= 4) grid.sync();
  if (lo <= 4 && hi >= 4) phase4(p, smem);
  if (lo <= 4 && hi >= 5) grid.sync();
  if (lo <= 5 && hi >= 5) phase5(p, smem);
}

extern "C" void kernel_launch(void* const* d_in, const int* in_sizes, int n_in, void* d_out, int out_size, void* d_ws, size_t ws_size,
                              hipStream_t stream) {
  static int grid_blocks = 0;
  if (!grid_blocks) {
    int dev = 0, cus = 0, per_cu = 0;
    hipGetDevice(&dev);
    hipDeviceGetAttribute(&cus, hipDeviceAttributeMultiprocessorCount, dev);
    hipOccupancyMaxActiveBlocksPerMultiprocessor(&per_cu, fwd_megakernel, 512, 0);
    if (per_cu > 1) per_cu = 1;
    if (per_cu < 1) per_cu = 1;
    grid_blocks = cus * per_cu;
  }
  Params p{};
  p.x_prompt = (const float*)d_in[0]; p.x_sample = (const float*)d_in[1]; p.cache_k = (const float*)d_in[2]; p.cache_v = (const float*)d_in[3];
  p.state_h = (const float*)d_in[4]; p.norm_g = (const float*)d_in[5]; p.w_in = (const float*)d_in[6]; p.lambda_qk = (const float*)d_in[7];
  p.subln_g = (const float*)d_in[8]; p.rec_lb = (const float*)d_in[9]; p.rec_norm_g = (const float*)d_in[10]; p.w_out = (const float*)d_in[11];
  p.final_g = (const float*)d_in[12];
  p.out = (float*)d_out;
  char* ws = (char*)d_ws; size_t off = 0;
  auto take = [&](size_t bytes) { char* r = ws + off; off += (bytes + 255) & ~(size_t)255; return r; };
  p.WinT = (u16*)take((size_t)4096 * 1024 * 2);
  p.WoutT = (u16*)take((size_t)1024 * 1024 * 2);
  p.Xn = (u16*)take((size_t)NTOK * 1024 * 2);
  p.SbufT = p.Xn;
  p.Qb = (u16*)take((size_t)NTOK * 512 * 2);
  p.Kall = (u16*)take((size_t)KVROWS * 512 * 2);
  p.Vall = (u16*)take((size_t)KVROWS * 512 * 2);
  p.Za = (u16*)take((size_t)NTOK * 512 * 2);
  p.Qr = (u16*)take((size_t)NTOK * 512 * 2);
  p.Ir = (u16*)take((size_t)NTOK * 512 * 2);
  p.Zr = (u16*)take((size_t)NTOK * 512 * 2);
  p.Mix = (u16*)take((size_t)NTOK * 1024 * 2);
  p.Fr = (float*)take((size_t)NTOK * 512 * 4);
  p.Abuf = (float*)take((size_t)NITEM * 128 * 4);
  p.NQ = (float*)take((size_t)NITEM * 4 * 4);
  p.counter = (int*)take(256);
  p.phase_lo = 0; p.phase_hi = 6; p.rep_mask = 0; p.pad_ = 0;
  if (off > ws_size) { fprintf(stderr, "workspace too small: need %zu have %zu\n", off, ws_size); return; }
  void* args[] = {&p};
  hipError_t e = hipLaunchCooperativeKernel((void*)fwd_megakernel, dim3(grid_blocks), dim3(512), args, 0, stream);
  if (e != hipSuccess) fprintf(stderr, "cooperative launch failed: %s (grid %d)\n", hipGetErrorString(e), grid_blocks);
}
```

```cpp
#include <hip/hip_runtime.h>
#include <hip/hip_cooperative_groups.h>
#include <cstdio>
namespace cg = cooperative_groups;

#define DI __device__ __forceinline__
typedef unsigned short u16;
using bf16x8 = __attribute__((ext_vector_type(8))) short;
using s16x4  = __attribute__((ext_vector_type(4))) short;
using f32x16 = __attribute__((ext_vector_type(16))) float;
using f32x4  = __attribute__((ext_vector_type(4))) float;
using f32x2  = __attribute__((ext_vector_type(2))) float;
using u32x4  = __attribute__((ext_vector_type(4))) unsigned;
using u32x2  = __attribute__((ext_vector_type(2))) unsigned;
typedef __bf16 bf2_t __attribute__((ext_vector_type(2)));

#define MFMA(a, b, c) __builtin_amdgcn_mfma_f32_32x32x16_bf16((a), (b), (c), 0, 0, 0)

static constexpr int NTOK = 33280;
static constexpr int NPTOK = 32768;
static constexpr int KVROWS = 32768 + 8 * 1088;
static constexpr int NITEM = 2080;
static constexpr size_t OFF_Y = 0;
static constexpr size_t OFF_NKP = 34078720;
static constexpr size_t OFF_NVP = 50855936;
static constexpr size_t OFF_NHP = 67633152;
static constexpr size_t OFF_NKS = 67764224;
static constexpr size_t OFF_NVS = 68026368;
static constexpr size_t OFF_NHS = 68288512;

struct Params {
  const float *x_prompt, *x_sample, *cache_k, *cache_v, *state_h, *norm_g, *w_in, *lambda_qk, *subln_g, *rec_lb, *rec_norm_g, *w_out, *final_g;
  float* out;
  u16 *WinT, *WoutT, *Xn, *Qb, *Kall, *Vall, *Za, *Qr, *Ir, *Zr, *Mix, *SbufT;
  float *Fr, *Abuf, *NQ;
  int* counter;
  int phase_lo, phase_hi, rep_mask, pad_;
};

DI unsigned pack2(float a, float b) { f32x2 v = {a, b}; bf2_t r = __builtin_convertvector(v, bf2_t); return __builtin_bit_cast(unsigned, r); }
DI u16 f2bf(float a) { return (u16)(pack2(a, 0.f) & 0xffffu); }
DI float bflo(unsigned u) { return __uint_as_float(u << 16); }
DI float bfhi(unsigned u) { return __uint_as_float(u & 0xffff0000u); }
DI int crow(int e, int h) { return (e & 3) + 8 * (e >> 2) + 4 * h; }
DI float wave_sum(float v) {
#pragma unroll
  for (int o = 32; o >= 1; o >>= 1) v += __shfl_xor(v, o);
  return v;
}
DI float silu_f(float v) { return v / (1.f + __expf(-v)); }
DI s16x4 tr_read(const char* p) {
  return __builtin_amdgcn_ds_read_tr16_b64_v4i16((__attribute__((address_space(3))) s16x4*)(p));
}
DI bf16x8 tr_frag(const char* p0, int stride4) {
  s16x4 lo = tr_read(p0), hi = tr_read(p0 + stride4);
  return __builtin_shufflevector(lo, hi, 0, 1, 2, 3, 4, 5, 6, 7);
}
DI bf16x8 pack8(const f32x16& x, int s) {
  u32x4 p;
  p[0] = pack2(x[8 * s + 0], x[8 * s + 1]);
  p[1] = pack2(x[8 * s + 2], x[8 * s + 3]);
  p[2] = pack2(x[8 * s + 4], x[8 * s + 5]);
  p[3] = pack2(x[8 * s + 6], x[8 * s + 7]);
  return __builtin_bit_cast(bf16x8, p);
}
DI f32x16 zero16() { f32x16 z; for (int i = 0; i < 16; ++i) z[i] = 0.f; return z; }

DI void phase0(const Params& p, char* smem) {
  const int tid = threadIdx.x, lane = tid & 63, w = tid >> 6;
  constexpr int NT_W1 = 16 * 64, NT_W2 = 16 * 16, NT_ROW = NTOK / 16, NT_CACHE = 1024;
  constexpr int total = NT_W1 + NT_W2 + NT_ROW + NT_CACHE;
  float (*tile)[65] = (float (*)[65])smem;
  if (blockIdx.x == 0 && tid == 0) *p.counter = 0;
  for (int it = blockIdx.x; it < total; it += gridDim.x) {
    if (it < NT_W1 + NT_W2) {
      const float* src; u16* dst; int N, kt, nt;
      if (it < NT_W1) { src = p.w_in; dst = p.WinT; N = 4096; kt = it >> 6; nt = it & 63; }
      else { int j = it - NT_W1; src = p.w_out; dst = p.WoutT; N = 1024; kt = j >> 4; nt = j & 15; }
      const int c = tid & 63, r0 = tid >> 6;
      for (int i = 0; i < 8; ++i) { int r = r0 + 8 * i; tile[r][c] = src[(size_t)(kt * 64 + r) * N + nt * 64 + c]; }
      __syncthreads();
      if (it < NT_W1) {
        for (int i = 0; i < 8; ++i) { int r = r0 + 8 * i; dst[(size_t)(nt * 64 + r) * 1024 + kt * 64 + c] = f2bf(tile[c][r]); }
      } else {
        for (int i = 0; i < 8; ++i) {
          const int r = r0 + 8 * i, n = nt * 64 + r, k = kt * 64 + c;
          dst[((size_t)((n >> 5) * 64 + (k >> 4)) * 64 + ((k >> 3) & 1) * 32 + (n & 31)) * 8 + (k & 7)] = f2bf(tile[c][r]);
        }
      }
      __syncthreads();
    } else if (it < NT_W1 + NT_W2 + NT_ROW) {
      const int row0 = (it - NT_W1 - NT_W2) * 16 + w * 2;
      f32x4 v[2][4]; float ss[2] = {0.f, 0.f};
#pragma unroll
      for (int rr = 0; rr < 2; ++rr) {
        const int row = row0 + rr;
        const float* src = row < NPTOK ? p.x_prompt + (size_t)row * 1024 : p.x_sample + (size_t)(row - NPTOK) * 1024;
#pragma unroll
        for (int i = 0; i < 4; ++i) v[rr][i] = *(const f32x4*)(src + i * 256 + lane * 4);
      }
#pragma unroll
      for (int rr = 0; rr < 2; ++rr) {
#pragma unroll
        for (int i = 0; i < 4; ++i) ss[rr] += v[rr][i][0] * v[rr][i][0] + v[rr][i][1] * v[rr][i][1] + v[rr][i][2] * v[rr][i][2] + v[rr][i][3] * v[rr][i][3];
        ss[rr] = wave_sum(ss[rr]);
      }
#pragma unroll
      for (int rr = 0; rr < 2; ++rr) {
        const float sc = rsqrtf(ss[rr] * (1.f / 1024.f) + 1e-6f);
#pragma unroll
        for (int i = 0; i < 4; ++i) {
          f32x4 g = *(const f32x4*)(p.norm_g + i * 256 + lane * 4);
          u32x2 o; o[0] = pack2(v[rr][i][0] * sc * g[0], v[rr][i][1] * sc * g[1]); o[1] = pack2(v[rr][i][2] * sc * g[2], v[rr][i][3] * sc * g[3]);
          *(u32x2*)(p.Xn + (size_t)(row0 + rr) * 1024 + i * 256 + lane * 4) = o;
        }
      }
    } else {
      const int task0 = (it - NT_W1 - NT_W2 - NT_ROW) * 16 + w * 2;
      f32x4 a[2], b[2];
#pragma unroll
      for (int rr = 0; rr < 2; ++rr) {
        const int task = task0 + rr, which = task >> 13, r8 = task & 8191;
        const float* src = (which ? p.cache_v : p.cache_k) + (size_t)r8 * 512 + lane * 8;
        a[rr] = *(const f32x4*)src; b[rr] = *(const f32x4*)(src + 4);
      }
#pragma unroll
      for (int rr = 0; rr < 2; ++rr) {
        const int task = task0 + rr, which = task >> 13, r8 = task & 8191;
        u16* dst = (which ? p.Vall : p.Kall) + (size_t)(NPTOK + (r8 >> 10) * 1088 + (r8 & 1023)) * 512 + lane * 8;
        u32x4 o; o[0] = pack2(a[rr][0], a[rr][1]); o[1] = pack2(a[rr][2], a[rr][3]); o[2] = pack2(b[rr][0], b[rr][1]); o[3] = pack2(b[rr][2], b[rr][3]);
        *(u32x4*)dst = o;
      }
    }
  }
}

#define G_LOAD(RA, RB, KT_)                                                                                        \
  {                                                                                                                 \
    _Pragma("unroll") for (int i_ = 0; i_ < 4; ++i_) RA[i_] = *(const u32x4*)((ap + (size_t)i_ * 64 * K + (KT_) * 64) + loff); \
    _Pragma("unroll") for (int i_ = 0; i_ < 4; ++i_) RB[i_] = *(const u32x4*)((bp + (size_t)i_ * 64 * K + (KT_) * 64) + loff); \
  }
#define G_WRITE(RA, RB, BUF_)                                                                                      \
  {                                                                                                                 \
    _Pragma("unroll") for (int i_ = 0; i_ < 4; ++i_) *(u32x4*)(wbase + (BUF_) * 73728 + i_ * 64 * 144) = RA[i_];         \
    _Pragma("unroll") for (int i_ = 0; i_ < 4; ++i_) *(u32x4*)(wbase + (BUF_) * 73728 + 36864 + i_ * 64 * 144) = RB[i_]; \
  }
#define G_FRAGS(FA, FB, S_)                                                                                        \
  {                                                                                                                 \
    _Pragma("unroll") for (int i_ = 0; i_ < 4; ++i_) FA[i_] = *(const bf16x8*)(as_ + i_ * 32 * 144 + (S_) * 32);      \
    FB[0] = *(const bf16x8*)(bs_ + (S_) * 32); FB[1] = *(const bf16x8*)(bs_ + 32 * 144 + (S_) * 32);                \
  }
#define G_MFMA8(FA, FB)                                                                                            \
  {                                                                                                                 \
    _Pragma("unroll") for (int i_ = 0; i_ < 4; ++i_) {                                                              \
      acc[i_][0] = MFMA(FA[i_], FB[0], acc[i_][0]);                                                                 \
      acc[i_][1] = MFMA(FA[i_], FB[1], acc[i_][1]);                                                                 \
    }                                                                                                               \
  }
#define G_COMPUTE(BUF_)                                                                                            \
  {                                                                                                                 \
    const char* as_ = smem + (BUF_) * 73728 + (wm * 128 + r) * 144 + h * 16;                                        \
    const char* bs_ = smem + (BUF_) * 73728 + 36864 + (wn * 64 + r) * 144 + h * 16;                                 \
    bf16x8 fa0[4], fb0[2], fa1[4], fb1[2];                                                                          \
    G_FRAGS(fa0, fb0, 0);                                                                                           \
    G_FRAGS(fa1, fb1, 1); __builtin_amdgcn_sched_barrier(0); G_MFMA8(fa0, fb0); __builtin_amdgcn_sched_barrier(0);  \
    G_FRAGS(fa0, fb0, 2); __builtin_amdgcn_sched_barrier(0); G_MFMA8(fa1, fb1); __builtin_amdgcn_sched_barrier(0);  \
    G_FRAGS(fa1, fb1, 3); __builtin_amdgcn_sched_barrier(0); G_MFMA8(fa0, fb0); __builtin_amdgcn_sched_barrier(0);  \
    G_MFMA8(fa1, fb1);                                                                                              \
  }
DI void gemm256(const u16* __restrict__ A, const u16* __restrict__ BT, int K, int m0, int n0, char* smem, int tid, f32x16 (&acc)[4][2]) {
  const int lane = tid & 63, w = tid >> 6, r = lane & 31, h = lane >> 5;
  const int wm = w >> 2, wn = w & 3;
#pragma unroll
  for (int i = 0; i < 4; ++i) { acc[i][0] = zero16(); acc[i][1] = zero16(); }
  u32x4 ra0[4], rb0[4];
  const int KT = K >> 6;
  const u16* ap = A + (size_t)m0 * K;
  const u16* bp = BT + (size_t)n0 * K;
  const int loff = (tid >> 3) * K + (tid & 7) * 8;
  char* wbase = smem + (tid >> 3) * 144 + (tid & 7) * 16;
  G_LOAD(ra0, rb0, 0);
  G_WRITE(ra0, rb0, 0);
  __syncthreads();
  for (int kt = 0; kt < KT; kt += 2) {
    { const int k1 = kt + 1 < KT ? kt + 1 : KT - 1; G_LOAD(ra0, rb0, k1); }
    __builtin_amdgcn_sched_barrier(0);
    G_COMPUTE(0);
    __builtin_amdgcn_sched_barrier(0);
    G_WRITE(ra0, rb0, 1);
    __syncthreads();
    { const int k2 = kt + 2 < KT ? kt + 2 : KT - 1; G_LOAD(ra0, rb0, k2); }
    __builtin_amdgcn_sched_barrier(0);
    G_COMPUTE(1);
    __builtin_amdgcn_sched_barrier(0);
    G_WRITE(ra0, rb0, 0);
    __syncthreads();
  }
}
struct TileMap {
  int MT, NT, C, NG, NST, st, lb, lin;
  bool xcd;
  DI TileMap(int mt_, int nt_) : MT(mt_), NT(nt_) {
    const int nb = gridDim.x >> 3;
    C = nb >> 3;
    xcd = (gridDim.x & 63) == 0 && C > 0 && (NT % C) == 0;
    NG = xcd ? NT / C : 1;
    NST = ((MT + 7) >> 3) * NG;
    st = blockIdx.x & 7; lb = blockIdx.x >> 3; lin = blockIdx.x;
  }
  DI bool next(int& mt, int& nt) {
    if (!xcd) {
      if (lin >= MT * NT) return false;
      mt = lin / NT; nt = lin - mt * NT; lin += gridDim.x; return true;
    }
    while (st < NST) {
      const int mg = st / NG, ng = st - mg * NG;
      mt = mg * 8 + lb / C; nt = ng * C + lb % C;
      st += 8;
      if (mt < MT) return true;
    }
    return false;
  }
};
DI void stage_half(const f32x16 (&acc)[4][2], float* cs, int half, int wm, int wn, int r, int h) {
  if (wm == half) {
#pragma unroll
    for (int i = 0; i < 4; ++i)
#pragma unroll
      for (int j = 0; j < 2; ++j)
#pragma unroll
        for (int e = 0; e < 16; ++e) cs[(i * 32 + crow(e, h)) * 260 + wn * 64 + j * 32 + r] = acc[i][j][e];
  }
}

DI void phase1(const Params& p, char* smem) {
  constexpr int MT = NTOK / 256, NT = 16;
  TileMap tm(MT, NT);
  int mt, nt;
  while (tm.next(mt, nt)) {
    const int m0 = mt * 256, n0 = nt * 256;
    f32x16 acc[4][2];
    {
      int tg = threadIdx.x;
      asm volatile("" : "+v"(tg));
      gemm256(p.Xn, p.WinT, 1024, m0, n0, smem, tg, acc);
    }
    int tid = threadIdx.x;
    asm volatile("" : "+v"(tid));
    const int lane = tid & 63, w = tid >> 6, r = lane & 31, h = lane >> 5;
    const int wm = w >> 2, wn = w & 3;
    const int sec = n0 >> 9;
    const bool samp = m0 >= NPTOK;
    float* cs = (float*)smem;
    const int c0 = (tid & 31) * 8, rb = tid >> 5;
    const int csc = (n0 & 511) + c0;
#pragma unroll 1
    for (int half = 0; half < 2; ++half) {
      stage_half(acc, cs, half, wm, wn, r, h);
      __syncthreads();
#pragma unroll 2
      for (int ps = 0; ps < 8; ++ps) {
        const int row = rb + 16 * ps;
        const int t = m0 + half * 128 + row;
        f32x4 va = *(const f32x4*)(cs + row * 260 + c0), vb = *(const f32x4*)(cs + row * 260 + c0 + 4);
        const size_t o512 = (size_t)t * 512 + csc;
        if (sec == 5) { __builtin_nontemporal_store(va, (f32x4*)(p.Fr + o512)); __builtin_nontemporal_store(vb, (f32x4*)(p.Fr + o512 + 4)); }
        else {
          u16* dst;
          if (sec == 0) {
            const float qs = 0.125f * 1.44269504089f;
            va *= qs; vb *= qs; dst = p.Qb + o512;
          } else if (sec == 1 || sec == 2) {
            size_t kvr; float* od;
            if (!samp) { kvr = t; od = p.out + (sec == 1 ? OFF_NKP : OFF_NVP) + o512; }
            else { const int ts = t - NPTOK; kvr = NPTOK + (ts >> 6) * 1088 + 1024 + (ts & 63); od = p.out + (sec == 1 ? OFF_NKS : OFF_NVS) + (size_t)ts * 512 + csc; }
            __builtin_nontemporal_store(va, (f32x4*)od); __builtin_nontemporal_store(vb, (f32x4*)(od + 4));
            dst = (sec == 1 ? p.Kall : p.Vall) + kvr * 512 + csc;
          } else if (sec == 6) { dst = p.Ir + o512; }
          else {
#pragma unroll
            for (int i = 0; i < 4; ++i) { va[i] = silu_f(va[i]); vb[i] = silu_f(vb[i]); }
            dst = (sec == 3 ? p.Za : (sec == 4 ? p.Qr : p.Zr)) + o512;
          }
          u32x4 o; o[0] = pack2(va[0], va[1]); o[1] = pack2(va[2], va[3]); o[2] = pack2(vb[0], vb[1]); o[3] = pack2(vb[2], vb[3]);
          __builtin_nontemporal_store(o, (u32x4*)dst);
        }
      }
      __syncthreads();
    }
  }
}

DI void rec_pre(const Params& p, int tid, int I, float* totS, float (&cum)[32], float (&key)[32], float& lastv) {
  const int d = tid & 127, half = tid >> 7;
  const int hd = I & 3, t0 = (I >> 2) * 64;
  const float r0 = p.rec_lb[hd * 128 + d], r1 = p.rec_lb[512 + hd * 128 + d];
  const float lb = 1.f / (1.f + __expf(r1 - r0));
  const float* fp = p.Fr + (size_t)(t0 + half * 32) * 512 + hd * 128 + d;
  float run = 0.f;
#pragma unroll
  for (int i = 0; i < 32; ++i) {
    float x = fp[(size_t)i * 512];
    x = fminf(fmaxf(x, -30.f), 30.f);
    const float e = __expf(-x), sg = 1.f / (1.f + e);
    run += __logf(lb + (1.f - lb) * sg);
    cum[i] = run; key[i] = (1.f - lb) * e * sg;
  }
  totS[tid] = run;
  __syncthreads();
  const float tot0 = totS[d], tot1 = totS[128 + d];
  if (half) {
#pragma unroll
    for (int i = 0; i < 32; ++i) cum[i] += tot0;
  }
  lastv = tot0 + tot1;
}

DI void phase2(const Params& p, char* smem0, u16* BbufT) {
  const int hf = threadIdx.x >> 8;
  const int tid = threadIdx.x & 255, lane = tid & 63, w = tid >> 6, r = lane & 31, h = lane >> 5;
  const int q = (lane & 15) >> 2, pp = lane & 3, blk = (lane >> 4) & 1;
  const int d = tid & 127, half = tid >> 7;
  char* smem = smem0 + hf * 65536;
  char* KdI = smem; char* VrI = smem + 17408; float* totS = (float*)(smem + 60000);
  for (int I = blockIdx.x * 2 + hf; I < NITEM; I += gridDim.x * 2) {
    const int hd = I & 3, t0 = (I >> 2) * 64;
    if (I < 2048) {
      const int token = tid & 63, which = tid >> 6;
      const u16* src = (which < 2 ? p.Qb : p.Kall) + (size_t)(t0 + token) * 512 + hd * 128 + (which & 1) * 64;
      float ss = 0.f;
#pragma unroll
      for (int c = 0; c < 8; ++c) {
        const u32x4 v = *(const u32x4*)(src + c * 8);
#pragma unroll
        for (int i = 0; i < 4; ++i) { const float lo = bflo(v[i]), hi = bfhi(v[i]); ss += lo * lo + hi * hi; }
      }
#pragma unroll
      for (int o = 32; o >= 1; o >>= 1) ss = fmaxf(ss, __shfl_xor(ss, o));
      if (lane == 0) p.NQ[I * 4 + which] = sqrtf(ss);
    }
    float cum[32], key[32], lastv;
    rec_pre(p, tid, I, totS, cum, key, lastv);
#pragma unroll
    for (int i = 0; i < 32; ++i) {
      const int t = half * 32 + i;
      *(u16*)(KdI + t * 272 + d * 2) = f2bf(key[i] * __expf(lastv - cum[i]));
    }
#pragma unroll
    for (int i = 0; i < 4; ++i) {
      const int ch = tid + 256 * i, row = ch >> 4, cc = ch & 15;
      *(u32x4*)(VrI + row * 272 + cc * 16) = *(const u32x4*)(p.Ir + (size_t)(t0 + row) * 512 + hd * 128 + cc * 8);
    }
    if (half) p.Abuf[I * 128 + d] = __expf(lastv);
    __syncthreads();
    f32x16 acc[4];
#pragma unroll
    for (int ct = 0; ct < 4; ++ct) acc[ct] = zero16();
#pragma unroll
    for (int ks = 0; ks < 4; ++ks) {
      const int rowoff = (16 * ks + 8 * h + q) * 272 + 32 * blk + 8 * pp;
      bf16x8 a = tr_frag(VrI + rowoff + 64 * w, 4 * 272);
#pragma unroll
      for (int ct = 0; ct < 4; ++ct) {
        bf16x8 b = tr_frag(KdI + rowoff + 64 * ct, 4 * 272);
        acc[ct] = MFMA(a, b, acc[ct]);
      }
    }
    u16* ob = BbufT + (size_t)I * 16384;
#pragma unroll
    for (int ct = 0; ct < 4; ++ct)
#pragma unroll
      for (int e = 0; e < 16; ++e) ob[(32 * w + crow(e, h)) * 128 + 32 * ct + r] = f2bf(acc[ct][e]);
    __syncthreads();
  }
}

DI void phase3(const Params& p, const u16* BbufT) {
  const int tid = threadIdx.x & 255;
  for (int it = blockIdx.x * 2 + (threadIdx.x >> 8); it < 512 + 1024; it += gridDim.x * 2) {
    if (it < 512) {
      const int bh = it >> 6, b = bh >> 2, hd = bh & 3;
      const int e1 = (it & 63) * 256 + tid, v = e1 >> 7, d = e1 & 127;
      float sx = 0.f;
      const size_t eo = (size_t)v * 128 + d;
      const int I0 = (b * 256) * 4 + hd;
      const float* ap = p.Abuf + (size_t)I0 * 128 + d;
      const u16* bp = BbufT + (size_t)I0 * 16384 + eo;
      u16* sp = p.SbufT + (size_t)I0 * 16384 + eo;
      for (int c0 = 0; c0 < 256; c0 += 16) {
        float av[16]; u16 bw[16];
#pragma unroll
        for (int i = 0; i < 16; ++i) { av[i] = ap[(size_t)(c0 + i) * 4 * 128]; bw[i] = bp[(size_t)(c0 + i) * 4 * 16384]; }
#pragma unroll
        for (int i = 0; i < 16; ++i) {
          sp[(size_t)(c0 + i) * 4 * 16384] = f2bf(sx);
          sx = av[i] * sx + bflo(bw[i]);
        }
      }
      p.out[OFF_NHP + (size_t)(b * 4 + hd) * 16384 + d * 128 + v] = sx;
    } else {
      const int j = it - 512;
      const int sh = j >> 5, bs = sh >> 2, hd = sh & 3;
      const int e2 = (j & 31) * 256 + tid, v = e2 >> 6, d2 = (e2 & 63) * 2;
      const int I = (512 + bs) * 4 + hd;
      const float* sh0 = p.state_h + (size_t)(bs * 4 + hd) * 16384;
      float sx = sh0[d2 * 128 + v], sy = sh0[(d2 + 1) * 128 + v];
      const size_t eo = (size_t)v * 128 + d2;
      const f32x2 a = *(const f32x2*)(p.Abuf + I * 128 + d2);
      const unsigned bw = *(const unsigned*)(BbufT + (size_t)I * 16384 + eo);
      *(unsigned*)(p.SbufT + (size_t)I * 16384 + eo) = pack2(sx, sy);
      sx = a[0] * sx + bflo(bw); sy = a[1] * sy + bfhi(bw);
      float* oh = p.out + OFF_NHS + (size_t)(bs * 4 + hd) * 16384;
      oh[d2 * 128 + v] = sx; oh[(d2 + 1) * 128 + v] = sy;
    }
  }
}

DI void r3_item(const Params& p, char* smem, int tid, int I) {
  const int lane = tid & 63, w = tid >> 6, r = lane & 31, h = lane >> 5;
  const int q = (lane & 15) >> 2, pp = lane & 3, blk = (lane >> 4) & 1;
  const int d = tid & 127, half = tid >> 7;
  char* QdI = smem; char* KdI = smem + 17408; char* VrI = smem + 34816;
  float* totS = (float*)(smem + 60000); float* ssS = (float*)(smem + 62048);
  const int hd = I & 3, t0 = (I >> 2) * 64;
  {
    float cum[32], key[32], lastv;
    rec_pre(p, tid, I, totS, cum, key, lastv);
    const u16* qp = p.Qr + (size_t)(t0 + half * 32) * 512 + hd * 128 + d;
#pragma unroll
    for (int i = 0; i < 32; ++i) {
      const int t = half * 32 + i;
      const float qv = bflo(qp[(size_t)i * 512]);
      *(u16*)(QdI + t * 272 + d * 2) = f2bf(qv * __expf(cum[i]));
      *(u16*)(KdI + t * 272 + d * 2) = f2bf(key[i] * __expf(-cum[i]));
    }
  }
#pragma unroll
  for (int i = 0; i < 4; ++i) {
    const int ch = tid + 256 * i, row = ch >> 4, cc = ch & 15;
    *(u32x4*)(VrI + row * 272 + cc * 16) = *(const u32x4*)(p.Ir + (size_t)(t0 + row) * 512 + hd * 128 + cc * 8);
  }
  __syncthreads();
  const int tt = w & 1, vh = w >> 1;
  bf16x8 qf[8];
#pragma unroll
  for (int ks = 0; ks < 8; ++ks) qf[ks] = *(const bf16x8*)(QdI + (32 * tt + r) * 272 + ks * 32 + h * 16);
  f32x16 sc[2]; sc[0] = zero16(); sc[1] = zero16();
#pragma unroll
  for (int ks = 0; ks < 8; ++ks) {
    bf16x8 a0 = *(const bf16x8*)(KdI + r * 272 + ks * 32 + h * 16);
    sc[0] = MFMA(a0, qf[ks], sc[0]);
  }
  if (tt == 1) {
#pragma unroll
    for (int ks = 0; ks < 8; ++ks) {
      bf16x8 a1 = *(const bf16x8*)(KdI + (32 + r) * 272 + ks * 32 + h * 16);
      sc[1] = MFMA(a1, qf[ks], sc[1]);
    }
  }
#pragma unroll
  for (int e = 0; e < 16; ++e) {
    const bool keep = crow(e, h) <= r;
    if (tt == 0) { if (!keep) sc[0][e] = 0.f; }
    else { if (!keep) sc[1][e] = 0.f; }
  }
  bf16x8 pf[4];
  pf[0] = pack8(sc[0], 0); pf[1] = pack8(sc[0], 1); pf[2] = pack8(sc[1], 0); pf[3] = pack8(sc[1], 1);
  f32x16 o[2]; o[0] = zero16(); o[1] = zero16();
  const u16* sp = p.SbufT + (size_t)I * 16384;
#pragma unroll
  for (int vi = 0; vi < 2; ++vi) {
    const int vt = 2 * vh + vi;
#pragma unroll
    for (int k4 = 0; k4 < 4; ++k4) {
      if (k4 < 2 || tt == 1) {
        bf16x8 a = tr_frag(VrI + (16 * k4 + 4 * h + q) * 272 + (32 * vt + 16 * blk) * 2 + 8 * pp, 8 * 272);
        o[vi] = MFMA(a, pf[k4], o[vi]);
      }
    }
#pragma unroll
    for (int ks = 0; ks < 8; ++ks) {
      bf16x8 a = *(const bf16x8*)(sp + (size_t)(32 * vt + r) * 128 + ks * 16 + h * 8);
      o[vi] = MFMA(a, qf[ks], o[vi]);
    }
  }
  float ss = 0.f;
#pragma unroll
  for (int vi = 0; vi < 2; ++vi)
#pragma unroll
    for (int e = 0; e < 16; ++e) ss += o[vi][e] * o[vi][e];
  ss += __shfl_xor(ss, 32);
  if (h == 0) ssS[w * 32 + r] = ss;
  __syncthreads();
  const float tot = ssS[tt * 32 + r] + ssS[(tt + 2) * 32 + r];
  const float rs = rsqrtf(tot * (1.f / 128.f) + 1e-6f);
  const int tok = t0 + 32 * tt + r;
#pragma unroll
  for (int vi = 0; vi < 2; ++vi)
#pragma unroll
    for (int g = 0; g < 4; ++g) {
      const int v = 32 * (2 * vh + vi) + 8 * g + 4 * h;
      const f32x4 gg = *(const f32x4*)(p.rec_norm_g + v);
      const u32x2 z = *(const u32x2*)(p.Zr + (size_t)tok * 512 + hd * 128 + v);
      u32x2 ov;
      ov[0] = pack2(o[vi][4 * g + 0] * rs * gg[0] * bflo(z[0]), o[vi][4 * g + 1] * rs * gg[1] * bfhi(z[0]));
      ov[1] = pack2(o[vi][4 * g + 2] * rs * gg[2] * bflo(z[1]), o[vi][4 * g + 3] * rs * gg[3] * bfhi(z[1]));
      *(u32x2*)(p.Mix + (size_t)tok * 1024 + 512 + hd * 128 + v) = ov;
    }
  __syncthreads();
}

template <bool DIAG>
DI void attn_tile_a(const char* ks, const bf16x8 (&qf)[4], f32x16 (&O)[4], bf16x8 (&pf)[4], float& mrun, float& lsum, float sl2, float qrel,
                    int m, int r, int h2) {
  f32x16 S[2];
#pragma unroll
  for (int st = 0; st < 2; ++st) {
    S[st] = zero16();
#pragma unroll
    for (int s = 0; s < 4; ++s) {
      bf16x8 a = *(const bf16x8*)(ks + (32 * st + r) * 272 + m * 128 + s * 32 + h2 * 16);
      S[st] = MFMA(a, qf[s], S[st]);
    }
  }
  float mx = -1e30f;
#pragma unroll
  for (int st = 0; st < 2; ++st)
#pragma unroll
    for (int e = 0; e < 16; ++e) {
      const float cst = (float)(32 * st + (e & 3) + 8 * (e >> 2));
      float sv;
      if (DIAG) sv = fmaf(-sl2, fabsf(qrel - cst), S[st][e]);
      else sv = fmaf(sl2, cst, S[st][e]);
      S[st][e] = sv; mx = fmaxf(mx, sv);
    }
  const float L = DIAG ? 0.f : -sl2 * qrel;
  mx += L;
  mx = fmaxf(mx, __shfl_xor(mx, 32));
  if (__builtin_amdgcn_ballot_w64(mx > mrun + 6.f) != 0) {
    const float mnew = fmaxf(mrun, mx);
    const float alpha = __builtin_amdgcn_exp2f(mrun - mnew);
    mrun = mnew; lsum *= alpha;
#pragma unroll
    for (int vt = 0; vt < 4; ++vt)
#pragma unroll
      for (int e = 0; e < 16; ++e) O[vt][e] *= alpha;
  }
  const float off = L - mrun;
  float rs = 0.f;
#pragma unroll
  for (int st = 0; st < 2; ++st)
#pragma unroll
    for (int e = 0; e < 16; ++e) { const float pv = __builtin_amdgcn_exp2f(S[st][e] + off); S[st][e] = pv; rs += pv; }
  lsum += rs;
  pf[0] = pack8(S[0], 0); pf[1] = pack8(S[0], 1); pf[2] = pack8(S[1], 0); pf[3] = pack8(S[1], 1);
}
template <bool DIAG>
DI void attn_tile_f(const char* ks, const bf16x8 (&qf)[4], bf16x8 (&pf)[4], float& lsum, float sl2, float qrel, float mref, int m, int r, int h2) {
  f32x16 S[2];
  const float offL = -sl2 * qrel - mref;
#pragma unroll
  for (int st = 0; st < 2; ++st) {
#pragma unroll
    for (int e = 0; e < 16; ++e) {
      const float cst = (float)(32 * st + (e & 3) + 8 * (e >> 2));
      S[st][e] = DIAG ? (-sl2 * fabsf(qrel - cst) - mref) : fmaf(sl2, cst, offL);
    }
#pragma unroll
    for (int s = 0; s < 4; ++s) {
      bf16x8 a = *(const bf16x8*)(ks + (32 * st + r) * 272 + m * 128 + s * 32 + h2 * 16);
      S[st] = MFMA(a, qf[s], S[st]);
    }
  }
  float rs = 0.f;
#pragma unroll
  for (int st = 0; st < 2; ++st)
#pragma unroll
    for (int e = 0; e < 16; ++e) { const float pv = __builtin_amdgcn_exp2f(S[st][e]); S[st][e] = pv; rs += pv; }
  lsum += rs;
  pf[0] = pack8(S[0], 0); pf[1] = pack8(S[0], 1); pf[2] = pack8(S[1], 0); pf[3] = pack8(S[1], 1);
}
DI void attn_tile_b(const char* vs, const bf16x8 (&pf)[4], f32x16 (&O)[4], int h2, int q, int pp, int blk) {
  const char* vb = vs + (4 * h2 + q) * 320 + 32 * blk + 8 * pp;
  bf16x8 a0[4], a1[4];
#pragma unroll
  for (int vt = 0; vt < 4; ++vt) a0[vt] = tr_frag(vb + 64 * vt, 8 * 320);
  __builtin_amdgcn_sched_barrier(0);
#pragma unroll
  for (int vt = 0; vt < 4; ++vt) a1[vt] = tr_frag(vb + 16 * 320 + 64 * vt, 8 * 320);
#pragma unroll
  for (int vt = 0; vt < 4; ++vt) O[vt] = MFMA(a0[vt], pf[0], O[vt]);
  __builtin_amdgcn_sched_barrier(0);
#pragma unroll
  for (int vt = 0; vt < 4; ++vt) a0[vt] = tr_frag(vb + 32 * 320 + 64 * vt, 8 * 320);
#pragma unroll
  for (int vt = 0; vt < 4; ++vt) O[vt] = MFMA(a1[vt], pf[1], O[vt]);
  __builtin_amdgcn_sched_barrier(0);
#pragma unroll
  for (int vt = 0; vt < 4; ++vt) a1[vt] = tr_frag(vb + 48 * 320 + 64 * vt, 8 * 320);
#pragma unroll
  for (int vt = 0; vt < 4; ++vt) O[vt] = MFMA(a0[vt], pf[2], O[vt]);
  __builtin_amdgcn_sched_barrier(0);
#pragma unroll
  for (int vt = 0; vt < 4; ++vt) O[vt] = MFMA(a1[vt], pf[3], O[vt]);
}

DI void attn_item(const Params& p, char* smem, int tid, int tq0, int qpos0, int kvbase, int ntb, int hd, float lam, bool can_skip, int nq) {
  const int lane = tid & 63, w = tid >> 6, r = lane & 31, h2 = lane >> 5;
  const int q = (lane & 15) >> 2, pp = lane & 3, blk = (lane >> 4) & 1;
  const int qg = w & 3, m = w >> 2, ch = qg >> 1;
  const bool wact = qg < nq;
  const float sl2 = exp2f(-2.f * (float)(hd + 1)) * 1.44269504089f;
  const int qtok = tq0 + 32 * qg + r;
  const float qposf = (float)(qpos0 + 32 * qg + r);
  const int ntw = can_skip ? ntb - 1 + ch : ntb;
  int kt0w = 0, kt0b = 0;
  bool fast = false; float kn_w = 0.f;
  if (can_skip) {
    const int I0 = (tq0 >> 6) * 4 + hd;
    const int crk = kvbase >> 6;
    fast = true; kt0b = ntb;
#pragma unroll
    for (int mm = 0; mm < 2; ++mm) {
      float KN = 0.f;
      for (int c = lane; c < ntb; c += 64) KN = fmaxf(KN, p.NQ[((crk + c) * 4 + hd) * 4 + 2 + mm]);
#pragma unroll
      for (int o = 32; o >= 1; o >>= 1) KN = fmaxf(KN, __shfl_xor(KN, o));
#pragma unroll
      for (int cc = 0; cc < 2; ++cc) {
        const float QN = p.NQ[(I0 + 4 * cc) * 4 + mm];
        const float D = (2.02f * QN * KN + 66.f) / sl2;
        const float f = ((float)(qpos0 + 64 * cc - 63) - D) * (1.f / 64.f);
        const int k0 = f < 0.f ? 0 : (int)f + 1;
        kt0b = k0 < kt0b ? k0 : kt0b;
        fast = fast && (2.02f * QN * KN < 60.f);
        if (mm == m && cc == ch) { kt0w = k0; kn_w = KN; }
      }
    }
  }
  bf16x8 qf[4];
  if (wact) {
#pragma unroll
    for (int s = 0; s < 4; ++s) qf[s] = *(const bf16x8*)(p.Qb + (size_t)qtok * 512 + hd * 128 + m * 64 + 16 * s + 8 * h2);
  } else {
#pragma unroll
    for (int s = 0; s < 4; ++s) qf[s] = (bf16x8){0, 0, 0, 0, 0, 0, 0, 0};
  }
  float mref = 0.f;
  if (fast) {
    float qq = 0.f;
#pragma unroll
    for (int s = 0; s < 4; ++s) {
      const u32x4 u = __builtin_bit_cast(u32x4, qf[s]);
#pragma unroll
      for (int i = 0; i < 4; ++i) { const float lo = bflo(u[i]), hi = bfhi(u[i]); qq += lo * lo + hi * hi; }
    }
    qq += __shfl_xor(qq, 32);
    mref = sqrtf(qq) * kn_w * 1.01f + 0.5f;
  }
  f32x16 O[4];
#pragma unroll
  for (int vt = 0; vt < 4; ++vt) O[vt] = zero16();
  float mrun = -1e30f, lsum = 0.f;
  u32x4 rk[2], rv[2];
  const int lrow = tid >> 4, lcc = tid & 15;
  const size_t gofs = (size_t)(kvbase + lrow) * 512 + hd * 128 + lcc * 8;
  const u16* kp = p.Kall + gofs;
  const u16* vp = p.Vall + gofs;
  char* kw = smem + lrow * 272 + lcc * 16;
  char* vw = smem + 17408 + lrow * 320 + lcc * 16;
  const int nit = ntb - kt0b;
  {
    const size_t go = (size_t)(fast ? kt0b : ntb - 1) * 64 * 512;
#pragma unroll
    for (int i = 0; i < 2; ++i) { rk[i] = *(const u32x4*)(kp + go + (size_t)i * 32 * 512); rv[i] = *(const u32x4*)(vp + go + (size_t)i * 32 * 512); }
#pragma unroll
    for (int i = 0; i < 2; ++i) { *(u32x4*)(kw + i * 32 * 272) = rk[i]; *(u32x4*)(vw + i * 32 * 320) = rv[i]; }
    const int k1 = fast ? (kt0b + 1 < ntb ? kt0b + 1 : ntb - 1) : (ntb - 2 > kt0b ? ntb - 2 : kt0b);
    const size_t g1 = (size_t)k1 * 64 * 512;
#pragma unroll
    for (int i = 0; i < 2; ++i) { rk[i] = *(const u32x4*)(kp + g1 + (size_t)i * 32 * 512); rv[i] = *(const u32x4*)(vp + g1 + (size_t)i * 32 * 512); }
  }
  __syncthreads();
  if (fast) {
    for (int it = 0; it < nit; ++it) {
      const int kt = kt0b + it;
      const bool active = wact && kt >= kt0w && kt < ntw;
      const char* ks = smem + (it & 1) * 37888;
      char* wb = kw + ((it + 1) & 1) * 37888;
      char* wbv = vw + ((it + 1) & 1) * 37888;
#pragma unroll
      for (int i = 0; i < 2; ++i) { *(u32x4*)(wb + i * 32 * 272) = rk[i]; *(u32x4*)(wbv + i * 32 * 320) = rv[i]; }
      {
        const int k2 = kt + 2 < ntb ? kt + 2 : ntb - 1;
        const size_t g2 = (size_t)k2 * 64 * 512;
#pragma unroll
        for (int i = 0; i < 2; ++i) { rk[i] = *(const u32x4*)(kp + g2 + (size_t)i * 32 * 512); rv[i] = *(const u32x4*)(vp + g2 + (size_t)i * 32 * 512); }
      }
      __builtin_amdgcn_sched_barrier(0);
      if (active) {
        bf16x8 pf[4];
        const float qrel = qposf - (float)(kt * 64 + 4 * h2);
        if (kt == ntw - 1) attn_tile_f<true>(ks, qf, pf, lsum, sl2, qrel, mref, m, r, h2);
        else attn_tile_f<false>(ks, qf, pf, lsum, sl2, qrel, mref, m, r, h2);
        attn_tile_b(ks + 17408, pf, O, h2, q, pp, blk);
      }
      __syncthreads();
    }
  } else {
    for (int it = 0; it < nit; ++it) {
      const int kt = ntb - 1 - it;
      const bool active = wact && kt >= kt0w && kt < ntw;
      const char* ks = smem + (it & 1) * 37888;
      char* wb = kw + ((it + 1) & 1) * 37888;
      char* wbv = vw + ((it + 1) & 1) * 37888;
#pragma unroll
      for (int i = 0; i < 2; ++i) { *(u32x4*)(wb + i * 32 * 272) = rk[i]; *(u32x4*)(wbv + i * 32 * 320) = rv[i]; }
      {
        const int k2 = kt - 2 > kt0b ? kt - 2 : kt0b;
        const size_t g2 = (size_t)k2 * 64 * 512;
#pragma unroll
        for (int i = 0; i < 2; ++i) { rk[i] = *(const u32x4*)(kp + g2 + (size_t)i * 32 * 512); rv[i] = *(const u32x4*)(vp + g2 + (size_t)i * 32 * 512); }
      }
      __builtin_amdgcn_sched_barrier(0);
      if (active) {
        bf16x8 pf[4];
        const float qrel = qposf - (float)(kt * 64 + 4 * h2);
        if (kt == ntw - 1) attn_tile_a<true>(ks, qf, O, pf, mrun, lsum, sl2, qrel, m, r, h2);
        else attn_tile_a<false>(ks, qf, O, pf, mrun, lsum, sl2, qrel, m, r, h2);
        attn_tile_b(ks + 17408, pf, O, h2, q, pp, blk);
      }
      __syncthreads();
    }
  }
  const float lt = lsum + __shfl_xor(lsum, 32);
  const float inv = wact ? 1.f / lt : 0.f;
  float* exch = (float*)smem + qg * 4096 + lane;
  if (m == 1) {
#pragma unroll
    for (int vt = 0; vt < 4; ++vt)
#pragma unroll
      for (int e = 0; e < 16; ++e) exch[(vt * 16 + e) * 64] = O[vt][e] * inv;
  }
  __syncthreads();
  if (m == 0 && wact) {
    float ss = 0.f;
#pragma unroll
    for (int vt = 0; vt < 4; ++vt)
#pragma unroll
      for (int e = 0; e < 16; ++e) { const float ov = O[vt][e] * inv - lam * exch[(vt * 16 + e) * 64]; O[vt][e] = ov; ss += ov * ov; }
    ss += __shfl_xor(ss, 32);
    const float rsn = rsqrtf(ss * (1.f / 128.f) + 1e-6f) * 0.8f;
#pragma unroll
    for (int vt = 0; vt < 4; ++vt)
#pragma unroll
      for (int g = 0; g < 4; ++g) {
        const int v = 32 * vt + 8 * g + 4 * h2;
        const f32x4 gg = *(const f32x4*)(p.subln_g + v);
        const u32x2 z = *(const u32x2*)(p.Za + (size_t)qtok * 512 + hd * 128 + v);
        u32x2 ov;
        ov[0] = pack2(O[vt][4 * g + 0] * rsn * gg[0] * bflo(z[0]), O[vt][4 * g + 1] * rsn * gg[1] * bfhi(z[0]));
        ov[1] = pack2(O[vt][4 * g + 2] * rsn * gg[2] * bflo(z[1]), O[vt][4 * g + 3] * rsn * gg[3] * bfhi(z[1]));
        *(u32x2*)(p.Mix + (size_t)qtok * 1024 + hd * 128 + v) = ov;
      }
  }
  __syncthreads();
}

DI void phase4(const Params& p, char* smem) {
  const int tid = threadIdx.x, lane = tid & 63;
  float lam;
  {
    const float a = p.lambda_qk[lane] * p.lambda_qk[64 + lane];
    const float b = p.lambda_qk[128 + lane] * p.lambda_qk[192 + lane];
    lam = __expf(wave_sum(a)) - __expf(wave_sum(b)) + 0.2f;
  }
  int* sitem = (int*)(smem + 153584);
  constexpr int NPA = 1024, NSA = 32, TOTAL = NPA + NSA + NITEM / 2;
  for (;;) {
    if (tid == 0) *sitem = atomicAdd(p.counter, 1);
    __syncthreads();
    const int item = *sitem;
    __syncthreads();
    if (item >= TOTAL) break;
    int tid_o = tid;
    asm volatile("" : "+v"(tid_o));
    if (item < NPA + NSA) {
      int tq0, qpos0, kvbase, ntb, hd, nq; bool can_skip;
      if (item < NPA) {
        const int qb = 127 - ((item & 255) >> 1), b = item & 1;
        hd = 3 - (item >> 8); tq0 = b * 16384 + qb * 128; qpos0 = qb * 128; kvbase = b * 16384; ntb = 2 * qb + 2; can_skip = true; nq = 4;
      } else {
        const int it = item - NPA, bs = it >> 2;
        hd = it & 3; tq0 = NPTOK + bs * 64; qpos0 = 1024; kvbase = NPTOK + bs * 1088; ntb = 17; can_skip = false; nq = 2;
      }
      attn_item(p, smem, tid_o, tq0, qpos0, kvbase, ntb, hd, lam, can_skip, nq);
    } else {
      const int hf = tid_o >> 8;
      r3_item(p, smem + hf * 65536, tid_o & 255, (item - NPA - NSA) * 2 + hf);
    }
  }
}

DI void phase5(const Params& p, char* smem) {
  float* wsum = (float*)(smem + 132096);
  for (int strip = blockIdx.x; strip < NTOK / 64; strip += gridDim.x) {
    int tid = threadIdx.x;
    asm volatile("" : "+v"(tid));
    const int lane = tid & 63, w = tid >> 6, r = lane & 31, h = lane >> 5;
    const int m0 = strip * 64;
    {
      const u16* gb = p.Mix + (size_t)m0 * 1024;
      const int loff = (tid >> 7) * 1024 + (tid & 127) * 8;
      char* lw = smem + (tid >> 7) * 2064 + (tid & 127) * 16;
#pragma unroll
      for (int i = 0; i < 16; ++i)
        *(u32x4*)(lw + i * 4 * 2064) = __builtin_nontemporal_load((const u32x4*)((gb + i * 4096) + loff));
    }
    f32x16 acc[2][4];
#pragma unroll
    for (int i = 0; i < 2; ++i)
#pragma unroll
      for (int j = 0; j < 4; ++j) acc[i][j] = zero16();
    const u16* bp = p.WoutT + (size_t)(w * 4) * 64 * 512 + lane * 8;
    bf16x8 b[2][4];
#pragma unroll
    for (int u = 0; u < 2; ++u)
#pragma unroll
      for (int j = 0; j < 4; ++j) b[u][j] = *(const bf16x8*)(bp + (size_t)(j * 64 + u) * 512);
    __syncthreads();
    const char* ap = smem + r * 2064 + h * 16;
    for (int ks0 = 0; ks0 < 64; ks0 += 2) {
#pragma unroll
      for (int u = 0; u < 2; ++u) {
        const int ks = ks0 + u;
        const bf16x8 a0 = *(const bf16x8*)(ap + ks * 32), a1 = *(const bf16x8*)(ap + 32 * 2064 + ks * 32);
#pragma unroll
        for (int j = 0; j < 4; ++j) { acc[0][j] = MFMA(a0, b[u][j], acc[0][j]); acc[1][j] = MFMA(a1, b[u][j], acc[1][j]); }
        const int kn = ks + 2 < 64 ? ks + 2 : 63;
#pragma unroll
        for (int j = 0; j < 4; ++j) b[u][j] = *(const bf16x8*)(bp + (size_t)(j * 64 + kn) * 512);
        __builtin_amdgcn_sched_barrier(0);
      }
    }
    const float* xs_u = (m0 < NPTOK ? p.x_prompt : p.x_sample - (size_t)NPTOK * 1024) + (size_t)m0 * 1024;
    const int lane_off = h * 4096 + w * 128 + r;
#pragma unroll
    for (int i = 0; i < 2; ++i) {
      float ps[16];
#pragma unroll
      for (int e = 0; e < 16; ++e) ps[e] = 0.f;
#pragma unroll
      for (int j = 0; j < 4; ++j) {
#pragma unroll
        for (int e = 0; e < 16; ++e) {
          const float hv = acc[i][j][e] + __builtin_nontemporal_load((xs_u + (i * 32 + (e & 3) + 8 * (e >> 2)) * 1024 + j * 32) + lane_off);
          acc[i][j][e] = hv; ps[e] += hv * hv;
        }
        __builtin_amdgcn_sched_barrier(0);
      }
#pragma unroll
      for (int e = 0; e < 16; ++e) {
#pragma unroll
        for (int o = 16; o >= 1; o >>= 1) ps[e] += __shfl_xor(ps[e], o);
      }
      if (r == 0) {
#pragma unroll
        for (int e = 0; e < 16; ++e) wsum[w * 64 + i * 32 + crow(e, h)] = ps[e];
      }
      __builtin_amdgcn_sched_barrier(0);
    }
    __syncthreads();
    float* yo_u = p.out + OFF_Y + (size_t)m0 * 1024;
#pragma unroll
    for (int i = 0; i < 2; ++i) {
      float sc[16];
#pragma unroll
      for (int e = 0; e < 16; ++e) {
        const int rw = i * 32 + crow(e, h);
        float t = 0.f;
#pragma unroll
        for (int k = 0; k < 8; ++k) t += wsum[k * 64 + rw];
        sc[e] = rsqrtf(t * (1.f / 1024.f) + 1e-6f);
      }
#pragma unroll
      for (int j = 0; j < 4; ++j) {
        const float g = (p.final_g + j * 32)[w * 128 + r];
#pragma unroll
        for (int e = 0; e < 16; ++e)
          __builtin_nontemporal_store(acc[i][j][e] * sc[e] * g, (yo_u + (i * 32 + (e & 3) + 8 * (e >> 2)) * 1024 + j * 32) + lane_off);
        __builtin_amdgcn_sched_barrier(0);
      }
    }
    __syncthreads();
  }
}

__global__ void __launch_bounds__(512, 2) fwd_megakernel(Params p) {
  __shared__ __attribute__((aligned(16))) char smem[153600];
  cg::grid_group grid = cg::this_grid();
  float* scratch_out = p.out + OFF_Y;
  const int lo = p.phase_lo, hi = p.phase_hi, rm = p.rep_mask;
  if (lo <= 0 && hi >= 0) phase0(p, smem);
  if (lo <= 0 && hi >= 1) grid.sync();
  if (lo <= 1 && hi >= 1) phase1(p, smem);
  if (rm & 2) { grid.sync(); phase1(p, smem); }
  if (lo <= 1 && hi >= 2) grid.sync();
  if (lo <= 2 && hi >= 2) phase2(p, smem, (u16*)scratch_out);
  if (lo <= 2 && hi >= 3) grid.sync();
  if (lo <= 3 && hi >= 3) phase3(p, (const u16*)scratch_out);
  if (lo <= 3 && hi >= 4) grid.sync();
  if (lo <= 4 && hi >= 4) phase4(p, smem);
  if (lo <= 4 && hi >= 5) grid.sync();
  if (lo <= 5 && hi >= 5) phase5(p, smem);
  if (rm & 32) { grid.sync(); phase5(p, smem); }
}

extern "C" void kernel_launch(void* const* d_in, const int* in_sizes, int n_in, void* d_out, int out_size, void* d_ws, size_t ws_size,
                              hipStream_t stream) {
  static int grid_blocks = 0;
  if (!grid_blocks) {
    int dev = 0, cus = 0, per_cu = 0;
    hipGetDevice(&dev);
    hipDeviceGetAttribute(&cus, hipDeviceAttributeMultiprocessorCount, dev);
    hipOccupancyMaxActiveBlocksPerMultiprocessor(&per_cu, fwd_megakernel, 512, 0);
    if (per_cu > 1) per_cu = 1;
    if (per_cu < 1) per_cu = 1;
    grid_blocks = cus * per_cu;
  }
  Params p{};
  p.x_prompt = (const float*)d_in[0]; p.x_sample = (const float*)d_in[1]; p.cache_k = (const float*)d_in[2]; p.cache_v = (const float*)d_in[3];
  p.state_h = (const float*)d_in[4]; p.norm_g = (const float*)d_in[5]; p.w_in = (const float*)d_in[6]; p.lambda_qk = (const float*)d_in[7];
  p.subln_g = (const float*)d_in[8]; p.rec_lb = (const float*)d_in[9]; p.rec_norm_g = (const float*)d_in[10]; p.w_out = (const float*)d_in[11];
  p.final_g = (const float*)d_in[12];
  p.out = (float*)d_out;
  char* ws = (char*)d_ws; size_t off = 0;
  auto take = [&](size_t bytes) { char* r = ws + off; off += (bytes + 255) & ~(size_t)255; return r; };
  p.WinT = (u16*)take((size_t)4096 * 1024 * 2);
  p.WoutT = (u16*)take((size_t)1024 * 1024 * 2);
  p.Xn = (u16*)take((size_t)NTOK * 1024 * 2);
  p.SbufT = p.Xn;
  p.Qb = (u16*)take((size_t)NTOK * 512 * 2);
  p.Kall = (u16*)take((size_t)KVROWS * 512 * 2);
  p.Vall = (u16*)take((size_t)KVROWS * 512 * 2);
  p.Za = (u16*)take((size_t)NTOK * 512 * 2);
  p.Qr = (u16*)take((size_t)NTOK * 512 * 2);
  p.Ir = (u16*)take((size_t)NTOK * 512 * 2);
  p.Zr = (u16*)take((size_t)NTOK * 512 * 2);
  p.Mix = (u16*)take((size_t)NTOK * 1024 * 2);
  p.Fr = (float*)take((size_t)NTOK * 512 * 4);
  p.Abuf = (float*)take((size_t)NITEM * 128 * 4);
  p.NQ = (float*)take((size_t)NITEM * 4 * 4);
  p.counter = (int*)take(256);
  p.phase_lo = 0; p.phase_hi = 6; p.rep_mask = 0; p.pad_ = 0;
  if (off > ws_size) { fprintf(stderr, "workspace too small: need %zu have %zu\n", off, ws_size); return; }
  void* args[] = {&p};
  hipError_t e = hipLaunchCooperativeKernel((void*)fwd_megakernel, dim3(grid_blocks), dim3(512), args, 0, stream);
  if (e != hipSuccess) fprintf(stderr, "cooperative launch failed: %s (grid %d)\n", hipGetErrorString(e), grid_blocks);
}
```

```cpp
#include <hip/hip_runtime.h>
#include <hip/hip_cooperative_groups.h>
#include <cstdio>
namespace cg = cooperative_groups;

#define DI __device__ __forceinline__
typedef unsigned short u16;
using bf16x8 = __attribute__((ext_vector_type(8))) short;
using s16x4  = __attribute__((ext_vector_type(4))) short;
using f32x16 = __attribute__((ext_vector_type(16))) float;
using f32x4  = __attribute__((ext_vector_type(4))) float;
using f32x2  = __attribute__((ext_vector_type(2))) float;
using u32x4  = __attribute__((ext_vector_type(4))) unsigned;
using u32x2  = __attribute__((ext_vector_type(2))) unsigned;
typedef __bf16 bf2_t __attribute__((ext_vector_type(2)));

#define MFMA(a, b, c) __builtin_amdgcn_mfma_f32_32x32x16_bf16((a), (b), (c), 0, 0, 0)

static constexpr int NTOK = 33280;
static constexpr int NPTOK = 32768;
static constexpr int KVROWS = 32768 + 8 * 1088;
static constexpr int NITEM = 2080;
static constexpr size_t OFF_Y = 0;
static constexpr size_t OFF_NKP = 34078720;
static constexpr size_t OFF_NVP = 50855936;
static constexpr size_t OFF_NHP = 67633152;
static constexpr size_t OFF_NKS = 67764224;
static constexpr size_t OFF_NVS = 68026368;
static constexpr size_t OFF_NHS = 68288512;

struct Params {
  const float *x_prompt, *x_sample, *cache_k, *cache_v, *state_h, *norm_g, *w_in, *lambda_qk, *subln_g, *rec_lb, *rec_norm_g, *w_out, *final_g;
  float* out;
  u16 *WinT, *WoutT, *Xn, *Qb, *Kall, *Vall, *Za, *Qr, *Ir, *Zr, *Mix, *SbufT;
  float *Fr, *Abuf, *NQ;
  int* counter;
  int phase_lo, phase_hi, rep_mask, pad_;
};

DI unsigned pack2(float a, float b) { f32x2 v = {a, b}; bf2_t r = __builtin_convertvector(v, bf2_t); return __builtin_bit_cast(unsigned, r); }
DI u16 f2bf(float a) { return (u16)(pack2(a, 0.f) & 0xffffu); }
DI float bflo(unsigned u) { return __uint_as_float(u << 16); }
DI float bfhi(unsigned u) { return __uint_as_float(u & 0xffff0000u); }
DI int crow(int e, int h) { return (e & 3) + 8 * (e >> 2) + 4 * h; }
DI float wave_sum(float v) {
#pragma unroll
  for (int o = 32; o >= 1; o >>= 1) v += __shfl_xor(v, o);
  return v;
}
DI float silu_f(float v) { return v / (1.f + __expf(-v)); }
DI s16x4 tr_read(const char* p) {
  return __builtin_amdgcn_ds_read_tr16_b64_v4i16((__attribute__((address_space(3))) s16x4*)(p));
}
DI bf16x8 tr_frag(const char* p0, int stride4) {
  s16x4 lo = tr_read(p0), hi = tr_read(p0 + stride4);
  return __builtin_shufflevector(lo, hi, 0, 1, 2, 3, 4, 5, 6, 7);
}
DI bf16x8 pack8(const f32x16& x, int s) {
  u32x4 p;
  p[0] = pack2(x[8 * s + 0], x[8 * s + 1]);
  p[1] = pack2(x[8 * s + 2], x[8 * s + 3]);
  p[2] = pack2(x[8 * s + 4], x[8 * s + 5]);
  p[3] = pack2(x[8 * s + 6], x[8 * s + 7]);
  return __builtin_bit_cast(bf16x8, p);
}
DI f32x16 zero16() { f32x16 z; for (int i = 0; i < 16; ++i) z[i] = 0.f; return z; }

DI void phase0(const Params& p, char* smem) {
  const int tid = threadIdx.x, lane = tid & 63, w = tid >> 6;
  constexpr int NT_W1 = 16 * 64, NT_W2 = 16 * 16, NT_ROW = NTOK / 16, NT_CACHE = 1024;
  constexpr int total = NT_W1 + NT_W2 + NT_ROW + NT_CACHE;
  float (*tile)[65] = (float (*)[65])smem;
  if (blockIdx.x == 0 && tid == 0) *p.counter = 0;
  for (int it = blockIdx.x; it < total; it += gridDim.x) {
    if (it < NT_W1 + NT_W2) {
      const float* src; u16* dst; int N, kt, nt;
      if (it < NT_W1) { src = p.w_in; dst = p.WinT; N = 4096; kt = it >> 6; nt = it & 63; }
      else { int j = it - NT_W1; src = p.w_out; dst = p.WoutT; N = 1024; kt = j >> 4; nt = j & 15; }
      const int c = tid & 63, r0 = tid >> 6;
      for (int i = 0; i < 8; ++i) { int r = r0 + 8 * i; tile[r][c] = src[(size_t)(kt * 64 + r) * N + nt * 64 + c]; }
      __syncthreads();
      if (it < NT_W1) {
        for (int i = 0; i < 8; ++i) { int r = r0 + 8 * i; dst[(size_t)(nt * 64 + r) * 1024 + kt * 64 + c] = f2bf(tile[c][r]); }
      } else {
        for (int i = 0; i < 8; ++i) {
          const int r = r0 + 8 * i, n = nt * 64 + r, k = kt * 64 + c;
          dst[((size_t)((n >> 5) * 64 + (k >> 4)) * 64 + ((k >> 3) & 1) * 32 + (n & 31)) * 8 + (k & 7)] = f2bf(tile[c][r]);
        }
      }
      __syncthreads();
    } else if (it < NT_W1 + NT_W2 + NT_ROW) {
      const int row0 = (it - NT_W1 - NT_W2) * 16 + w * 2;
      f32x4 v[2][4]; float ss[2] = {0.f, 0.f};
#pragma unroll
      for (int rr = 0; rr < 2; ++rr) {
        const int row = row0 + rr;
        const float* src = row < NPTOK ? p.x_prompt + (size_t)row * 1024 : p.x_sample + (size_t)(row - NPTOK) * 1024;
#pragma unroll
        for (int i = 0; i < 4; ++i) v[rr][i] = *(const f32x4*)(src + i * 256 + lane * 4);
      }
#pragma unroll
      for (int rr = 0; rr < 2; ++rr) {
#pragma unroll
        for (int i = 0; i < 4; ++i) ss[rr] += v[rr][i][0] * v[rr][i][0] + v[rr][i][1] * v[rr][i][1] + v[rr][i][2] * v[rr][i][2] + v[rr][i][3] * v[rr][i][3];
        ss[rr] = wave_sum(ss[rr]);
      }
#pragma unroll
      for (int rr = 0; rr < 2; ++rr) {
        const float sc = rsqrtf(ss[rr] * (1.f / 1024.f) + 1e-6f);
#pragma unroll
        for (int i = 0; i < 4; ++i) {
          f32x4 g = *(const f32x4*)(p.norm_g + i * 256 + lane * 4);
          u32x2 o; o[0] = pack2(v[rr][i][0] * sc * g[0], v[rr][i][1] * sc * g[1]); o[1] = pack2(v[rr][i][2] * sc * g[2], v[rr][i][3] * sc * g[3]);
          *(u32x2*)(p.Xn + (size_t)(row0 + rr) * 1024 + i * 256 + lane * 4) = o;
        }
      }
    } else {
      const int task0 = (it - NT_W1 - NT_W2 - NT_ROW) * 16 + w * 2;
      f32x4 a[2], b[2];
#pragma unroll
      for (int rr = 0; rr < 2; ++rr) {
        const int task = task0 + rr, which = task >> 13, r8 = task & 8191;
        const float* src = (which ? p.cache_v : p.cache_k) + (size_t)r8 * 512 + lane * 8;
        a[rr] = *(const f32x4*)src; b[rr] = *(const f32x4*)(src + 4);
      }
#pragma unroll
      for (int rr = 0; rr < 2; ++rr) {
        const int task = task0 + rr, which = task >> 13, r8 = task & 8191;
        u16* dst = (which ? p.Vall : p.Kall) + (size_t)(NPTOK + (r8 >> 10) * 1088 + (r8 & 1023)) * 512 + lane * 8;
        u32x4 o; o[0] = pack2(a[rr][0], a[rr][1]); o[1] = pack2(a[rr][2], a[rr][3]); o[2] = pack2(b[rr][0], b[rr][1]); o[3] = pack2(b[rr][2], b[rr][3]);
        *(u32x4*)dst = o;
      }
    }
  }
}

#define G_LOAD(RA, RB, KT_)                                                                                        \
  {                                                                                                                 \
    _Pragma("unroll") for (int i_ = 0; i_ < 4; ++i_) RA[i_] = *(const u32x4*)((ap + (size_t)i_ * 64 * K + (KT_) * 64) + loff); \
    _Pragma("unroll") for (int i_ = 0; i_ < 4; ++i_) RB[i_] = *(const u32x4*)((bp + (size_t)i_ * 64 * K + (KT_) * 64) + loff); \
  }
#define G_WRITE(RA, RB, BUF_)                                                                                      \
  {                                                                                                                 \
    _Pragma("unroll") for (int i_ = 0; i_ < 4; ++i_) *(u32x4*)(wbase + (BUF_) * 73728 + i_ * 64 * 144) = RA[i_];         \
    _Pragma("unroll") for (int i_ = 0; i_ < 4; ++i_) *(u32x4*)(wbase + (BUF_) * 73728 + 36864 + i_ * 64 * 144) = RB[i_]; \
  }
#define G_FRAGS(FA, FB, S_)                                                                                        \
  {                                                                                                                 \
    _Pragma("unroll") for (int i_ = 0; i_ < 4; ++i_) FA[i_] = *(const bf16x8*)(as_ + i_ * 32 * 144 + (S_) * 32);      \
    FB[0] = *(const bf16x8*)(bs_ + (S_) * 32); FB[1] = *(const bf16x8*)(bs_ + 32 * 144 + (S_) * 32);                \
  }
#define G_MFMA8(FA, FB)                                                                                            \
  {                                                                                                                 \
    _Pragma("unroll") for (int i_ = 0; i_ < 4; ++i_) {                                                              \
      acc[i_][0] = MFMA(FA[i_], FB[0], acc[i_][0]);                                                                 \
      acc[i_][1] = MFMA(FA[i_], FB[1], acc[i_][1]);                                                                 \
    }                                                                                                               \
  }
#define G_COMPUTE(BUF_)                                                                                            \
  {                                                                                                                 \
    const char* as_ = smem + (BUF_) * 73728 + (wm * 128 + r) * 144 + h * 16;                                        \
    const char* bs_ = smem + (BUF_) * 73728 + 36864 + (wn * 64 + r) * 144 + h * 16;                                 \
    bf16x8 fa0[4], fb0[2], fa1[4], fb1[2];                                                                          \
    G_FRAGS(fa0, fb0, 0);                                                                                           \
    G_FRAGS(fa1, fb1, 1); __builtin_amdgcn_sched_barrier(0); G_MFMA8(fa0, fb0); __builtin_amdgcn_sched_barrier(0);  \
    G_FRAGS(fa0, fb0, 2); __builtin_amdgcn_sched_barrier(0); G_MFMA8(fa1, fb1); __builtin_amdgcn_sched_barrier(0);  \
    G_FRAGS(fa1, fb1, 3); __builtin_amdgcn_sched_barrier(0); G_MFMA8(fa0, fb0); __builtin_amdgcn_sched_barrier(0);  \
    G_MFMA8(fa1, fb1);                                                                                              \
  }
DI void gemm256(const u16* __restrict__ A, const u16* __restrict__ BT, int K, int m0, int n0, char* smem, int tid, f32x16 (&acc)[4][2]) {
  const int lane = tid & 63, w = tid >> 6, r = lane & 31, h = lane >> 5;
  const int wm = w >> 2, wn = w & 3;
#pragma unroll
  for (int i = 0; i < 4; ++i) { acc[i][0] = zero16(); acc[i][1] = zero16(); }
  u32x4 ra0[4], rb0[4];
  const int KT = K >> 6;
  const u16* ap = A + (size_t)m0 * K;
  const u16* bp = BT + (size_t)n0 * K;
  const int loff = (tid >> 3) * K + (tid & 7) * 8;
  char* wbase = smem + (tid >> 3) * 144 + (tid & 7) * 16;
  G_LOAD(ra0, rb0, 0);
  G_WRITE(ra0, rb0, 0);
  __syncthreads();
  for (int kt = 0; kt < KT; kt += 2) {
    { const int k1 = kt + 1 < KT ? kt + 1 : KT - 1; G_LOAD(ra0, rb0, k1); }
    __builtin_amdgcn_sched_barrier(0);
    G_COMPUTE(0);
    __builtin_amdgcn_sched_barrier(0);
    G_WRITE(ra0, rb0, 1);
    __syncthreads();
    { const int k2 = kt + 2 < KT ? kt + 2 : KT - 1; G_LOAD(ra0, rb0, k2); }
    __builtin_amdgcn_sched_barrier(0);
    G_COMPUTE(1);
    __builtin_amdgcn_sched_barrier(0);
    G_WRITE(ra0, rb0, 0);
    __syncthreads();
  }
}
struct TileMap {
  int MT, NT, C, NG, NST, st, lb, lin;
  bool xcd;
  DI TileMap(int mt_, int nt_) : MT(mt_), NT(nt_) {
    const int nb = gridDim.x >> 3;
    C = nb >> 3;
    xcd = (gridDim.x & 63) == 0 && C > 0 && (NT % C) == 0;
    NG = xcd ? NT / C : 1;
    NST = ((MT + 7) >> 3) * NG;
    st = blockIdx.x & 7; lb = blockIdx.x >> 3; lin = blockIdx.x;
  }
  DI bool next(int& mt, int& nt) {
    if (!xcd) {
      if (lin >= MT * NT) return false;
      mt = lin / NT; nt = lin - mt * NT; lin += gridDim.x; return true;
    }
    while (st < NST) {
      const int mg = st / NG, ng = st - mg * NG;
      mt = mg * 8 + lb / C; nt = ng * C + lb % C;
      st += 8;
      if (mt < MT) return true;
    }
    return false;
  }
};
DI void stage_half(const f32x16 (&acc)[4][2], float* cs, int half, int wm, int wn, int r, int h) {
  if (wm == half) {
#pragma unroll
    for (int i = 0; i < 4; ++i)
#pragma unroll
      for (int j = 0; j < 2; ++j)
#pragma unroll
        for (int e = 0; e < 16; ++e) cs[(i * 32 + crow(e, h)) * 260 + wn * 64 + j * 32 + r] = acc[i][j][e];
  }
}

DI void phase1(const Params& p, char* smem) {
  constexpr int MT = NTOK / 256, NT = 16;
  TileMap tm(MT, NT);
  int mt, nt;
  while (tm.next(mt, nt)) {
    const int m0 = mt * 256, n0 = nt * 256;
    f32x16 acc[4][2];
    {
      int tg = threadIdx.x;
      asm volatile("" : "+v"(tg));
      gemm256(p.Xn, p.WinT, 1024, m0, n0, smem, tg, acc);
    }
    int tid = threadIdx.x;
    asm volatile("" : "+v"(tid));
    const int lane = tid & 63, w = tid >> 6, r = lane & 31, h = lane >> 5;
    const int wm = w >> 2, wn = w & 3;
    const int sec = n0 >> 9;
    const bool samp = m0 >= NPTOK;
    float* cs = (float*)smem;
    const int c0 = (tid & 31) * 8, rb = tid >> 5;
    const int csc = (n0 & 511) + c0;
#pragma unroll 1
    for (int half = 0; half < 2; ++half) {
      stage_half(acc, cs, half, wm, wn, r, h);
      __syncthreads();
#pragma unroll 2
      for (int ps = 0; ps < 8; ++ps) {
        const int row = rb + 16 * ps;
        const int t = m0 + half * 128 + row;
        f32x4 va = *(const f32x4*)(cs + row * 260 + c0), vb = *(const f32x4*)(cs + row * 260 + c0 + 4);
        const size_t o512 = (size_t)t * 512 + csc;
        if (sec == 5) { __builtin_nontemporal_store(va, (f32x4*)(p.Fr + o512)); __builtin_nontemporal_store(vb, (f32x4*)(p.Fr + o512 + 4)); }
        else {
          u16* dst;
          if (sec == 0) {
            const float qs = 0.125f * 1.44269504089f;
            va *= qs; vb *= qs; dst = p.Qb + o512;
          } else if (sec == 1 || sec == 2) {
            size_t kvr; float* od;
            if (!samp) { kvr = t; od = p.out + (sec == 1 ? OFF_NKP : OFF_NVP) + o512; }
            else { const int ts = t - NPTOK; kvr = NPTOK + (ts >> 6) * 1088 + 1024 + (ts & 63); od = p.out + (sec == 1 ? OFF_NKS : OFF_NVS) + (size_t)ts * 512 + csc; }
            __builtin_nontemporal_store(va, (f32x4*)od); __builtin_nontemporal_store(vb, (f32x4*)(od + 4));
            dst = (sec == 1 ? p.Kall : p.Vall) + kvr * 512 + csc;
          } else if (sec == 6) { dst = p.Ir + o512; }
          else {
#pragma unroll
            for (int i = 0; i < 4; ++i) { va[i] = silu_f(va[i]); vb[i] = silu_f(vb[i]); }
            dst = (sec == 3 ? p.Za : (sec == 4 ? p.Qr : p.Zr)) + o512;
          }
          u32x4 o; o[0] = pack2(va[0], va[1]); o[1] = pack2(va[2], va[3]); o[2] = pack2(vb[0], vb[1]); o[3] = pack2(vb[2], vb[3]);
          __builtin_nontemporal_store(o, (u32x4*)dst);
        }
      }
      __syncthreads();
    }
  }
}

DI void rec_pre(const Params& p, int tid, int I, float* totS, float (&cum)[32], float (&key)[32], float& lastv) {
  const int d = tid & 127, half = tid >> 7;
  const int hd = I & 3, t0 = (I >> 2) * 64;
  const float r0 = p.rec_lb[hd * 128 + d], r1 = p.rec_lb[512 + hd * 128 + d];
  const float lb = 1.f / (1.f + __expf(r1 - r0));
  const float* fp = p.Fr + (size_t)(t0 + half * 32) * 512 + hd * 128 + d;
  float run = 0.f;
#pragma unroll
  for (int i = 0; i < 32; ++i) {
    float x = fp[(size_t)i * 512];
    x = fminf(fmaxf(x, -30.f), 30.f);
    const float e = __expf(-x), sg = 1.f / (1.f + e);
    run += __logf(lb + (1.f - lb) * sg);
    cum[i] = run; key[i] = (1.f - lb) * e * sg;
  }
  totS[tid] = run;
  __syncthreads();
  const float tot0 = totS[d], tot1 = totS[128 + d];
  if (half) {
#pragma unroll
    for (int i = 0; i < 32; ++i) cum[i] += tot0;
  }
  lastv = tot0 + tot1;
}

DI void phase2(const Params& p, char* smem0, u16* BbufT) {
  const int hf = threadIdx.x >> 8;
  const int tid = threadIdx.x & 255, lane = tid & 63, w = tid >> 6, r = lane & 31, h = lane >> 5;
  const int q = (lane & 15) >> 2, pp = lane & 3, blk = (lane >> 4) & 1;
  const int d = tid & 127, half = tid >> 7;
  char* smem = smem0 + hf * 65536;
  char* KdI = smem; char* VrI = smem + 17408; float* totS = (float*)(smem + 60000);
  for (int I = blockIdx.x * 2 + hf; I < NITEM; I += gridDim.x * 2) {
    const int hd = I & 3, t0 = (I >> 2) * 64;
    if (I < 2048) {
      const int token = tid & 63, which = tid >> 6;
      const u16* src = (which < 2 ? p.Qb : p.Kall) + (size_t)(t0 + token) * 512 + hd * 128 + (which & 1) * 64;
      float ss = 0.f;
#pragma unroll
      for (int c = 0; c < 8; ++c) {
        const u32x4 v = *(const u32x4*)(src + c * 8);
#pragma unroll
        for (int i = 0; i < 4; ++i) { const float lo = bflo(v[i]), hi = bfhi(v[i]); ss += lo * lo + hi * hi; }
      }
#pragma unroll
      for (int o = 32; o >= 1; o >>= 1) ss = fmaxf(ss, __shfl_xor(ss, o));
      if (lane == 0) p.NQ[I * 4 + which] = sqrtf(ss);
    }
    float cum[32], key[32], lastv;
    rec_pre(p, tid, I, totS, cum, key, lastv);
#pragma unroll
    for (int i = 0; i < 32; ++i) {
      const int t = half * 32 + i;
      *(u16*)(KdI + t * 272 + d * 2) = f2bf(key[i] * __expf(lastv - cum[i]));
    }
#pragma unroll
    for (int i = 0; i < 4; ++i) {
      const int ch = tid + 256 * i, row = ch >> 4, cc = ch & 15;
      *(u32x4*)(VrI + row * 272 + cc * 16) = *(const u32x4*)(p.Ir + (size_t)(t0 + row) * 512 + hd * 128 + cc * 8);
    }
    if (half) p.Abuf[I * 128 + d] = __expf(lastv);
    __syncthreads();
    f32x16 acc[4];
#pragma unroll
    for (int ct = 0; ct < 4; ++ct) acc[ct] = zero16();
#pragma unroll
    for (int ks = 0; ks < 4; ++ks) {
      const int rowoff = (16 * ks + 8 * h + q) * 272 + 32 * blk + 8 * pp;
      bf16x8 a = tr_frag(VrI + rowoff + 64 * w, 4 * 272);
#pragma unroll
      for (int ct = 0; ct < 4; ++ct) {
        bf16x8 b = tr_frag(KdI + rowoff + 64 * ct, 4 * 272);
        acc[ct] = MFMA(a, b, acc[ct]);
      }
    }
    u16* ob = BbufT + (size_t)I * 16384;
#pragma unroll
    for (int ct = 0; ct < 4; ++ct)
#pragma unroll
      for (int e = 0; e < 16; ++e) ob[(32 * w + crow(e, h)) * 128 + 32 * ct + r] = f2bf(acc[ct][e]);
    __syncthreads();
  }
}

DI void phase3(const Params& p, const u16* BbufT) {
  const int tid = threadIdx.x & 255;
  for (int it = blockIdx.x * 2 + (threadIdx.x >> 8); it < 512 + 1024; it += gridDim.x * 2) {
    if (it < 512) {
      const int bh = it >> 6, b = bh >> 2, hd = bh & 3;
      const int e1 = (it & 63) * 256 + tid, v = e1 >> 7, d = e1 & 127;
      float sx = 0.f;
      const size_t eo = (size_t)v * 128 + d;
      const int I0 = (b * 256) * 4 + hd;
      const float* ap = p.Abuf + (size_t)I0 * 128 + d;
      const u16* bp = BbufT + (size_t)I0 * 16384 + eo;
      u16* sp = p.SbufT + (size_t)I0 * 16384 + eo;
      for (int c0 = 0; c0 < 256; c0 += 16) {
        float av[16]; u16 bw[16];
#pragma unroll
        for (int i = 0; i < 16; ++i) { av[i] = ap[(size_t)(c0 + i) * 4 * 128]; bw[i] = bp[(size_t)(c0 + i) * 4 * 16384]; }
#pragma unroll
        for (int i = 0; i < 16; ++i) {
          sp[(size_t)(c0 + i) * 4 * 16384] = f2bf(sx);
          sx = av[i] * sx + bflo(bw[i]);
        }
      }
      p.out[OFF_NHP + (size_t)(b * 4 + hd) * 16384 + d * 128 + v] = sx;
    } else {
      const int j = it - 512;
      const int sh = j >> 5, bs = sh >> 2, hd = sh & 3;
      const int e2 = (j & 31) * 256 + tid, v = e2 >> 6, d2 = (e2 & 63) * 2;
      const int I = (512 + bs) * 4 + hd;
      const float* sh0 = p.state_h + (size_t)(bs * 4 + hd) * 16384;
      float sx = sh0[d2 * 128 + v], sy = sh0[(d2 + 1) * 128 + v];
      const size_t eo = (size_t)v * 128 + d2;
      const f32x2 a = *(const f32x2*)(p.Abuf + I * 128 + d2);
      const unsigned bw = *(const unsigned*)(BbufT + (size_t)I * 16384 + eo);
      *(unsigned*)(p.SbufT + (size_t)I * 16384 + eo) = pack2(sx, sy);
      sx = a[0] * sx + bflo(bw); sy = a[1] * sy + bfhi(bw);
      float* oh = p.out + OFF_NHS + (size_t)(bs * 4 + hd) * 16384;
      oh[d2 * 128 + v] = sx; oh[(d2 + 1) * 128 + v] = sy;
    }
  }
}

DI void r3_item(const Params& p, char* smem, int tid, int I) {
  const int lane = tid & 63, w = tid >> 6, r = lane & 31, h = lane >> 5;
  const int q = (lane & 15) >> 2, pp = lane & 3, blk = (lane >> 4) & 1;
  const int d = tid & 127, half = tid >> 7;
  char* QdI = smem; char* KdI = smem + 17408; char* VrI = smem + 34816;
  float* totS = (float*)(smem + 60000); float* ssS = (float*)(smem + 62048);
  const int hd = I & 3, t0 = (I >> 2) * 64;
  {
    float cum[32], key[32], lastv;
    rec_pre(p, tid, I, totS, cum, key, lastv);
    const u16* qp = p.Qr + (size_t)(t0 + half * 32) * 512 + hd * 128 + d;
#pragma unroll
    for (int i = 0; i < 32; ++i) {
      const int t = half * 32 + i;
      const float qv = bflo(qp[(size_t)i * 512]);
      *(u16*)(QdI + t * 272 + d * 2) = f2bf(qv * __expf(cum[i]));
      *(u16*)(KdI + t * 272 + d * 2) = f2bf(key[i] * __expf(-cum[i]));
    }
  }
#pragma unroll
  for (int i = 0; i < 4; ++i) {
    const int ch = tid + 256 * i, row = ch >> 4, cc = ch & 15;
    *(u32x4*)(VrI + row * 272 + cc * 16) = *(const u32x4*)(p.Ir + (size_t)(t0 + row) * 512 + hd * 128 + cc * 8);
  }
  __syncthreads();
  const int tt = w & 1, vh = w >> 1;
  bf16x8 qf[8];
#pragma unroll
  for (int ks = 0; ks < 8; ++ks) qf[ks] = *(const bf16x8*)(QdI + (32 * tt + r) * 272 + ks * 32 + h * 16);
  f32x16 sc[2]; sc[0] = zero16(); sc[1] = zero16();
#pragma unroll
  for (int ks = 0; ks < 8; ++ks) {
    bf16x8 a0 = *(const bf16x8*)(KdI + r * 272 + ks * 32 + h * 16);
    sc[0] = MFMA(a0, qf[ks], sc[0]);
  }
  if (tt == 1) {
#pragma unroll
    for (int ks = 0; ks < 8; ++ks) {
      bf16x8 a1 = *(const bf16x8*)(KdI + (32 + r) * 272 + ks * 32 + h * 16);
      sc[1] = MFMA(a1, qf[ks], sc[1]);
    }
  }
#pragma unroll
  for (int e = 0; e < 16; ++e) {
    const bool keep = crow(e, h) <= r;
    if (tt == 0) { if (!keep) sc[0][e] = 0.f; }
    else { if (!keep) sc[1][e] = 0.f; }
  }
  bf16x8 pf[4];
  pf[0] = pack8(sc[0], 0); pf[1] = pack8(sc[0], 1); pf[2] = pack8(sc[1], 0); pf[3] = pack8(sc[1], 1);
  f32x16 o[2]; o[0] = zero16(); o[1] = zero16();
  const u16* sp = p.SbufT + (size_t)I * 16384;
#pragma unroll
  for (int vi = 0; vi < 2; ++vi) {
    const int vt = 2 * vh + vi;
#pragma unroll
    for (int k4 = 0; k4 < 4; ++k4) {
      if (k4 < 2 || tt == 1) {
        bf16x8 a = tr_frag(VrI + (16 * k4 + 4 * h + q) * 272 + (32 * vt + 16 * blk) * 2 + 8 * pp, 8 * 272);
        o[vi] = MFMA(a, pf[k4], o[vi]);
      }
    }
#pragma unroll
    for (int ks = 0; ks < 8; ++ks) {
      bf16x8 a = *(const bf16x8*)(sp + (size_t)(32 * vt + r) * 128 + ks * 16 + h * 8);
      o[vi] = MFMA(a, qf[ks], o[vi]);
    }
  }
  float ss = 0.f;
#pragma unroll
  for (int vi = 0; vi < 2; ++vi)
#pragma unroll
    for (int e = 0; e < 16; ++e) ss += o[vi][e] * o[vi][e];
  ss += __shfl_xor(ss, 32);
  if (h == 0) ssS[w * 32 + r] = ss;
  __syncthreads();
  const float tot = ssS[tt * 32 + r] + ssS[(tt + 2) * 32 + r];
  const float rs = rsqrtf(tot * (1.f / 128.f) + 1e-6f);
  const int tok = t0 + 32 * tt + r;
#pragma unroll
  for (int vi = 0; vi < 2; ++vi)
#pragma unroll
    for (int g = 0; g < 4; ++g) {
      const int v = 32 * (2 * vh + vi) + 8 * g + 4 * h;
      const f32x4 gg = *(const f32x4*)(p.rec_norm_g + v);
      const u32x2 z = *(const u32x2*)(p.Zr + (size_t)tok * 512 + hd * 128 + v);
      u32x2 ov;
      ov[0] = pack2(o[vi][4 * g + 0] * rs * gg[0] * bflo(z[0]), o[vi][4 * g + 1] * rs * gg[1] * bfhi(z[0]));
      ov[1] = pack2(o[vi][4 * g + 2] * rs * gg[2] * bflo(z[1]), o[vi][4 * g + 3] * rs * gg[3] * bfhi(z[1]));
      *(u32x2*)(p.Mix + (size_t)tok * 1024 + 512 + hd * 128 + v) = ov;
    }
  __syncthreads();
}

template <bool DIAG>
DI void attn_tile_a(const char* ks, const bf16x8 (&qf)[4], f32x16 (&O)[4], bf16x8 (&pf)[4], float& mrun, float& lsum, float sl2, float qrel,
                    int m, int r, int h2) {
  f32x16 S[2];
#pragma unroll
  for (int st = 0; st < 2; ++st) {
    S[st] = zero16();
#pragma unroll
    for (int s = 0; s < 4; ++s) {
      bf16x8 a = *(const bf16x8*)(ks + (32 * st + r) * 272 + m * 128 + s * 32 + h2 * 16);
      S[st] = MFMA(a, qf[s], S[st]);
    }
  }
  float mx = -1e30f;
#pragma unroll
  for (int st = 0; st < 2; ++st)
#pragma unroll
    for (int e = 0; e < 16; ++e) {
      const float cst = (float)(32 * st + (e & 3) + 8 * (e >> 2));
      float sv;
      if (DIAG) sv = fmaf(-sl2, fabsf(qrel - cst), S[st][e]);
      else sv = fmaf(sl2, cst, S[st][e]);
      S[st][e] = sv; mx = fmaxf(mx, sv);
    }
  const float L = DIAG ? 0.f : -sl2 * qrel;
  mx += L;
  mx = fmaxf(mx, __shfl_xor(mx, 32));
  if (__builtin_amdgcn_ballot_w64(mx > mrun + 6.f) != 0) {
    const float mnew = fmaxf(mrun, mx);
    const float alpha = __builtin_amdgcn_exp2f(mrun - mnew);
    mrun = mnew; lsum *= alpha;
#pragma unroll
    for (int vt = 0; vt < 4; ++vt)
#pragma unroll
      for (int e = 0; e < 16; ++e) O[vt][e] *= alpha;
  }
  const float off = L - mrun;
  float rs = 0.f;
#pragma unroll
  for (int st = 0; st < 2; ++st)
#pragma unroll
    for (int e = 0; e < 16; ++e) { const float pv = __builtin_amdgcn_exp2f(S[st][e] + off); S[st][e] = pv; rs += pv; }
  lsum += rs;
  pf[0] = pack8(S[0], 0); pf[1] = pack8(S[0], 1); pf[2] = pack8(S[1], 0); pf[3] = pack8(S[1], 1);
}
template <bool DIAG>
DI void attn_tile_f(const char* ks, const bf16x8 (&qf)[4], bf16x8 (&pf)[4], float& lsum, float sl2, float qrel, float mref, int m, int r, int h2) {
  f32x16 S[2];
  const float offL = -sl2 * qrel - mref;
#pragma unroll
  for (int st = 0; st < 2; ++st) {
#pragma unroll
    for (int e = 0; e < 16; ++e) {
      const float cst = (float)(32 * st + (e & 3) + 8 * (e >> 2));
      S[st][e] = DIAG ? (-sl2 * fabsf(qrel - cst) - mref) : fmaf(sl2, cst, offL);
    }
#pragma unroll
    for (int s = 0; s < 4; ++s) {
      bf16x8 a = *(const bf16x8*)(ks + (32 * st + r) * 272 + m * 128 + s * 32 + h2 * 16);
      S[st] = MFMA(a, qf[s], S[st]);
    }
  }
  float rs = 0.f;
#pragma unroll
  for (int st = 0; st < 2; ++st)
#pragma unroll
    for (int e = 0; e < 16; ++e) { const float pv = __builtin_amdgcn_exp2f(S[st][e]); S[st][e] = pv; rs += pv; }
  lsum += rs;
  pf[0] = pack8(S[0], 0); pf[1] = pack8(S[0], 1); pf[2] = pack8(S[1], 0); pf[3] = pack8(S[1], 1);
}
DI void attn_tile_b(const char* vs, const bf16x8 (&pf)[4], f32x16 (&O)[4], int h2, int q, int pp, int blk) {
  const char* vb = vs + (4 * h2 + q) * 320 + 32 * blk + 8 * pp;
  bf16x8 a0[4], a1[4];
#pragma unroll
  for (int vt = 0; vt < 4; ++vt) a0[vt] = tr_frag(vb + 64 * vt, 8 * 320);
  __builtin_amdgcn_sched_barrier(0);
#pragma unroll
  for (int vt = 0; vt < 4; ++vt) a1[vt] = tr_frag(vb + 16 * 320 + 64 * vt, 8 * 320);
#pragma unroll
  for (int vt = 0; vt < 4; ++vt) O[vt] = MFMA(a0[vt], pf[0], O[vt]);
  __builtin_amdgcn_sched_barrier(0);
#pragma unroll
  for (int vt = 0; vt < 4; ++vt) a0[vt] = tr_frag(vb + 32 * 320 + 64 * vt, 8 * 320);
#pragma unroll
  for (int vt = 0; vt < 4; ++vt) O[vt] = MFMA(a1[vt], pf[1], O[vt]);
  __builtin_amdgcn_sched_barrier(0);
#pragma unroll
  for (int vt = 0; vt < 4; ++vt) a1[vt] = tr_frag(vb + 48 * 320 + 64 * vt, 8 * 320);
#pragma unroll
  for (int vt = 0; vt < 4; ++vt) O[vt] = MFMA(a0[vt], pf[2], O[vt]);
  __builtin_amdgcn_sched_barrier(0);
#pragma unroll
  for (int vt = 0; vt < 4; ++vt) O[vt] = MFMA(a1[vt], pf[3], O[vt]);
}

DI void attn_item(const Params& p, char* smem, int tid, int tq0, int qpos0, int kvbase, int ntb, int hd, float lam, bool can_skip, int nq) {
  const int lane = tid & 63, w = tid >> 6, r = lane & 31, h2 = lane >> 5;
  const int q = (lane & 15) >> 2, pp = lane & 3, blk = (lane >> 4) & 1;
  const int qg = w & 3, m = w >> 2, ch = qg >> 1;
  const bool wact = qg < nq;
  const float sl2 = exp2f(-2.f * (float)(hd + 1)) * 1.44269504089f;
  const int qtok = tq0 + 32 * qg + r;
  const float qposf = (float)(qpos0 + 32 * qg + r);
  const int ntw = can_skip ? ntb - 1 + ch : ntb;
  int kt0w = 0, kt0b = 0;
  bool fast = false; float kn_w = 0.f;
  if (can_skip) {
    const int I0 = (tq0 >> 6) * 4 + hd;
    const int crk = kvbase >> 6;
    fast = true; kt0b = ntb;
#pragma unroll
    for (int mm = 0; mm < 2; ++mm) {
      float KN = 0.f;
      for (int c = lane; c < ntb; c += 64) KN = fmaxf(KN, p.NQ[((crk + c) * 4 + hd) * 4 + 2 + mm]);
#pragma unroll
      for (int o = 32; o >= 1; o >>= 1) KN = fmaxf(KN, __shfl_xor(KN, o));
#pragma unroll
      for (int cc = 0; cc < 2; ++cc) {
        const float QN = p.NQ[(I0 + 4 * cc) * 4 + mm];
        const float D = (2.02f * QN * KN + 66.f) / sl2;
        const float f = ((float)(qpos0 + 64 * cc - 63) - D) * (1.f / 64.f);
        const int k0 = f < 0.f ? 0 : (int)f + 1;
        kt0b = k0 < kt0b ? k0 : kt0b;
        fast = fast && (2.02f * QN * KN < 60.f);
        if (mm == m && cc == ch) { kt0w = k0; kn_w = KN; }
      }
    }
  }
  bf16x8 qf[4];
  if (wact) {
#pragma unroll
    for (int s = 0; s < 4; ++s) qf[s] = *(const bf16x8*)(p.Qb + (size_t)qtok * 512 + hd * 128 + m * 64 + 16 * s + 8 * h2);
  } else {
#pragma unroll
    for (int s = 0; s < 4; ++s) qf[s] = (bf16x8){0, 0, 0, 0, 0, 0, 0, 0};
  }
  float mref = 0.f;
  if (fast) {
    float qq = 0.f;
#pragma unroll
    for (int s = 0; s < 4; ++s) {
      const u32x4 u = __builtin_bit_cast(u32x4, qf[s]);
#pragma unroll
      for (int i = 0; i < 4; ++i) { const float lo = bflo(u[i]), hi = bfhi(u[i]); qq += lo * lo + hi * hi; }
    }
    qq += __shfl_xor(qq, 32);
    mref = sqrtf(qq) * kn_w * 1.01f + 0.5f;
  }
  f32x16 O[4];
#pragma unroll
  for (int vt = 0; vt < 4; ++vt) O[vt] = zero16();
  float mrun = -1e30f, lsum = 0.f;
  u32x4 rk[2], rv[2];
  const int lrow = tid >> 4, lcc = tid & 15;
  const size_t gofs = (size_t)(kvbase + lrow) * 512 + hd * 128 + lcc * 8;
  const u16* kp = p.Kall + gofs;
  const u16* vp = p.Vall + gofs;
  char* kw = smem + lrow * 272 + lcc * 16;
  char* vw = smem + 17408 + lrow * 320 + lcc * 16;
  const int nit = ntb - kt0b;
  {
    const size_t go = (size_t)(fast ? kt0b : ntb - 1) * 64 * 512;
#pragma unroll
    for (int i = 0; i < 2; ++i) { rk[i] = *(const u32x4*)(kp + go + (size_t)i * 32 * 512); rv[i] = *(const u32x4*)(vp + go + (size_t)i * 32 * 512); }
#pragma unroll
    for (int i = 0; i < 2; ++i) { *(u32x4*)(kw + i * 32 * 272) = rk[i]; *(u32x4*)(vw + i * 32 * 320) = rv[i]; }
    const int k1 = fast ? (kt0b + 1 < ntb ? kt0b + 1 : ntb - 1) : (ntb - 2 > kt0b ? ntb - 2 : kt0b);
    const size_t g1 = (size_t)k1 * 64 * 512;
#pragma unroll
    for (int i = 0; i < 2; ++i) { rk[i] = *(const u32x4*)(kp + g1 + (size_t)i * 32 * 512); rv[i] = *(const u32x4*)(vp + g1 + (size_t)i * 32 * 512); }
  }
  __syncthreads();
  if (fast) {
    for (int it = 0; it < nit; ++it) {
      const int kt = kt0b + it;
      const bool active = wact && kt >= kt0w && kt < ntw;
      const char* ks = smem + (it & 1) * 37888;
      char* wb = kw + ((it + 1) & 1) * 37888;
      char* wbv = vw + ((it + 1) & 1) * 37888;
#pragma unroll
      for (int i = 0; i < 2; ++i) { *(u32x4*)(wb + i * 32 * 272) = rk[i]; *(u32x4*)(wbv + i * 32 * 320) = rv[i]; }
      {
        const int k2 = kt + 2 < ntb ? kt + 2 : ntb - 1;
        const size_t g2 = (size_t)k2 * 64 * 512;
#pragma unroll
        for (int i = 0; i < 2; ++i) { rk[i] = *(const u32x4*)(kp + g2 + (size_t)i * 32 * 512); rv[i] = *(const u32x4*)(vp + g2 + (size_t)i * 32 * 512); }
      }
      __builtin_amdgcn_sched_barrier(0);
      if (active) {
        bf16x8 pf[4];
        const float qrel = qposf - (float)(kt * 64 + 4 * h2);
        if (kt == ntw - 1) attn_tile_f<true>(ks, qf, pf, lsum, sl2, qrel, mref, m, r, h2);
        else attn_tile_f<false>(ks, qf, pf, lsum, sl2, qrel, mref, m, r, h2);
        attn_tile_b(ks + 17408, pf, O, h2, q, pp, blk);
      }
      __syncthreads();
    }
  } else {
    for (int it = 0; it < nit; ++it) {
      const int kt = ntb - 1 - it;
      const bool active = wact && kt >= kt0w && kt < ntw;
      const char* ks = smem + (it & 1) * 37888;
      char* wb = kw + ((it + 1) & 1) * 37888;
      char* wbv = vw + ((it + 1) & 1) * 37888;
#pragma unroll
      for (int i = 0; i < 2; ++i) { *(u32x4*)(wb + i * 32 * 272) = rk[i]; *(u32x4*)(wbv + i * 32 * 320) = rv[i]; }
      {
        const int k2 = kt - 2 > kt0b ? kt - 2 : kt0b;
        const size_t g2 = (size_t)k2 * 64 * 512;
#pragma unroll
        for (int i = 0; i < 2; ++i) { rk[i] = *(const u32x4*)(kp + g2 + (size_t)i * 32 * 512); rv[i] = *(const u32x4*)(vp + g2 + (size_t)i * 32 * 512); }
      }
      __builtin_amdgcn_sched_barrier(0);
      if (active) {
        bf16x8 pf[4];
        const float qrel = qposf - (float)(kt * 64 + 4 * h2);
        if (kt == ntw - 1) attn_tile_a<true>(ks, qf, O, pf, mrun, lsum, sl2, qrel, m, r, h2);
        else attn_tile_a<false>(ks, qf, O, pf, mrun, lsum, sl2, qrel, m, r, h2);
        attn_tile_b(ks + 17408, pf, O, h2, q, pp, blk);
      }
      __syncthreads();
    }
  }
  const float lt = lsum + __shfl_xor(lsum, 32);
  const float inv = wact ? 1.f / lt : 0.f;
  float* exch = (float*)smem + qg * 4096 + lane;
  if (m == 1) {
#pragma unroll
    for (int vt = 0; vt < 4; ++vt)
#pragma unroll
      for (int e = 0; e < 16; ++e) exch[(vt * 16 + e) * 64] = O[vt][e] * inv;
  }
  __syncthreads();
  if (m == 0 && wact) {
    float ss = 0.f;
#pragma unroll
    for (int vt = 0; vt < 4; ++vt)
#pragma unroll
      for (int e = 0; e < 16; ++e) { const float ov = O[vt][e] * inv - lam * exch[(vt * 16 + e) * 64]; O[vt][e] = ov; ss += ov * ov; }
    ss += __shfl_xor(ss, 32);
    const float rsn = rsqrtf(ss * (1.f / 128.f) + 1e-6f) * 0.8f;
#pragma unroll
    for (int vt = 0; vt < 4; ++vt)
#pragma unroll
      for (int g = 0; g < 4; ++g) {
        const int v = 32 * vt + 8 * g + 4 * h2;
        const f32x4 gg = *(const f32x4*)(p.subln_g + v);
        const u32x2 z = *(const u32x2*)(p.Za + (size_t)qtok * 512 + hd * 128 + v);
        u32x2 ov;
        ov[0] = pack2(O[vt][4 * g + 0] * rsn * gg[0] * bflo(z[0]), O[vt][4 * g + 1] * rsn * gg[1] * bfhi(z[0]));
        ov[1] = pack2(O[vt][4 * g + 2] * rsn * gg[2] * bflo(z[1]), O[vt][4 * g + 3] * rsn * gg[3] * bfhi(z[1]));
        *(u32x2*)(p.Mix + (size_t)qtok * 1024 + hd * 128 + v) = ov;
      }
  }
  __syncthreads();
}

DI void phase4(const Params& p, char* smem) {
  const int tid = threadIdx.x, lane = tid & 63;
  float lam;
  {
    const float a = p.lambda_qk[lane] * p.lambda_qk[64 + lane];
    const float b = p.lambda_qk[128 + lane] * p.lambda_qk[192 + lane];
    lam = __expf(wave_sum(a)) - __expf(wave_sum(b)) + 0.2f;
  }
  int* sitem = (int*)(smem + 153584);
  constexpr int NPA = 1024, NSA = 32, TOTAL = NPA + NSA + NITEM / 2;
  for (;;) {
    if (tid == 0) *sitem = atomicAdd(p.counter, 1);
    __syncthreads();
    const int item = *sitem;
    __syncthreads();
    if (item >= TOTAL) break;
    int tid_o = tid;
    asm volatile("" : "+v"(tid_o));
    if (item < NPA + NSA) {
      int tq0, qpos0, kvbase, ntb, hd, nq; bool can_skip;
      if (item < NPA) {
        const int qb = 127 - ((item & 255) >> 1), b = item & 1;
        hd = 3 - (item >> 8); tq0 = b * 16384 + qb * 128; qpos0 = qb * 128; kvbase = b * 16384; ntb = 2 * qb + 2; can_skip = true; nq = 4;
      } else {
        const int it = item - NPA, bs = it >> 2;
        hd = it & 3; tq0 = NPTOK + bs * 64; qpos0 = 1024; kvbase = NPTOK + bs * 1088; ntb = 17; can_skip = false; nq = 2;
      }
      attn_item(p, smem, tid_o, tq0, qpos0, kvbase, ntb, hd, lam, can_skip, nq);
    } else {
      const int hf = tid_o >> 8;
      r3_item(p, smem + hf * 65536, tid_o & 255, (item - NPA - NSA) * 2 + hf);
    }
  }
}

DI void phase5(const Params& p, char* smem) {
  float* wsum = (float*)(smem + 132096);
  for (int strip = blockIdx.x; strip < NTOK / 64; strip += gridDim.x) {
    int tid = threadIdx.x;
    asm volatile("" : "+v"(tid));
    const int lane = tid & 63, w = tid >> 6, r = lane & 31, h = lane >> 5;
    const int m0 = strip * 64;
    {
      const u16* gb = p.Mix + (size_t)m0 * 1024;
      const int loff = (tid >> 7) * 1024 + (tid & 127) * 8;
      char* lw = smem + (tid >> 7) * 2064 + (tid & 127) * 16;
#pragma unroll
      for (int i = 0; i < 16; ++i)
        *(u32x4*)(lw + i * 4 * 2064) = __builtin_nontemporal_load((const u32x4*)((gb + i * 4096) + loff));
    }
    f32x16 acc[2][4];
#pragma unroll
    for (int i = 0; i < 2; ++i)
#pragma unroll
      for (int j = 0; j < 4; ++j) acc[i][j] = zero16();
    const u16* bp = p.WoutT + (size_t)(w * 4) * 64 * 512 + lane * 8;
    bf16x8 b[2][4];
#pragma unroll
    for (int u = 0; u < 2; ++u)
#pragma unroll
      for (int j = 0; j < 4; ++j) b[u][j] = *(const bf16x8*)(bp + (size_t)(j * 64 + u) * 512);
    __syncthreads();
    const char* ap = smem + r * 2064 + h * 16;
    for (int ks0 = 0; ks0 < 64; ks0 += 2) {
#pragma unroll
      for (int u = 0; u < 2; ++u) {
        const int ks = ks0 + u;
        const bf16x8 a0 = *(const bf16x8*)(ap + ks * 32), a1 = *(const bf16x8*)(ap + 32 * 2064 + ks * 32);
#pragma unroll
        for (int j = 0; j < 4; ++j) { acc[0][j] = MFMA(a0, b[u][j], acc[0][j]); acc[1][j] = MFMA(a1, b[u][j], acc[1][j]); }
        const int kn = ks + 2 < 64 ? ks + 2 : 63;
#pragma unroll
        for (int j = 0; j < 4; ++j) b[u][j] = *(const bf16x8*)(bp + (size_t)(j * 64 + kn) * 512);
        __builtin_amdgcn_sched_barrier(0);
      }
    }
    const float* xs_u = (m0 < NPTOK ? p.x_prompt : p.x_sample - (size_t)NPTOK * 1024) + (size_t)m0 * 1024;
    const int lane_off = h * 4096 + w * 128 + r;
#pragma unroll
    for (int i = 0; i < 2; ++i) {
      float ps[16];
#pragma unroll
      for (int e = 0; e < 16; ++e) ps[e] = 0.f;
#pragma unroll
      for (int j = 0; j < 4; ++j) {
#pragma unroll
        for (int e = 0; e < 16; ++e) {
          const float hv = acc[i][j][e] + __builtin_nontemporal_load((xs_u + (i * 32 + (e & 3) + 8 * (e >> 2)) * 1024 + j * 32) + lane_off);
          acc[i][j][e] = hv; ps[e] += hv * hv;
        }
        __builtin_amdgcn_sched_barrier(0);
      }
#pragma unroll
      for (int e = 0; e < 16; ++e) {
#pragma unroll
        for (int o = 16; o >= 1; o >>= 1) ps[e] += __shfl_xor(ps[e], o);
      }
      if (r == 0) {
#pragma unroll
        for (int e = 0; e < 16; ++e) wsum[w * 64 + i * 32 + crow(e, h)] = ps[e];
      }
      __builtin_amdgcn_sched_barrier(0);
    }
    __syncthreads();
    float* yo_u = p.out + OFF_Y + (size_t)m0 * 1024;
#pragma unroll
    for (int i = 0; i < 2; ++i) {
      float sc[16];
#pragma unroll
      for (int e = 0; e < 16; ++e) {
        const int rw = i * 32 + crow(e, h);
        float t = 0.f;
#pragma unroll
        for (int k = 0; k < 8; ++k) t += wsum[k * 64 + rw];
        sc[e] = rsqrtf(t * (1.f / 1024.f) + 1e-6f);
      }
#pragma unroll
      for (int j = 0; j < 4; ++j) {
        const float g = (p.final_g + j * 32)[w * 128 + r];
#pragma unroll
        for (int e = 0; e < 16; ++e)
          __builtin_nontemporal_store(acc[i][j][e] * sc[e] * g, (yo_u + (i * 32 + (e & 3) + 8 * (e >> 2)) * 1024 + j * 32) + lane_off);
        __builtin_amdgcn_sched_barrier(0);
      }
    }
    __syncthreads();
  }
}

__global__ void __launch_bounds__(512, 2) fwd_megakernel(Params p) {
  __shared__ __attribute__((aligned(16))) char smem[153600];
  cg::grid_group grid = cg::this_grid();
  float* scratch_out = p.out + OFF_Y;
  const int lo = p.phase_lo, hi = p.phase_hi;
  if (lo <= 0 && hi >= 0) phase0(p, smem);
  if (lo <= 0 && hi >= 1) grid.sync();
  if (lo <= 1 && hi >= 1) phase1(p, smem);
  if (lo <= 1 && hi >= 2) grid.sync();
  if (lo <= 2 && hi >= 2) phase2(p, smem, (u16*)scratch_out);
  if (lo <= 2 && hi >= 3) grid.sync();
  if (lo <= 3 && hi >= 3) phase3(p, (const u16*)scratch_out);
  if (lo <= 3 && hi >= 4) grid.sync();
  if (lo <= 4 && hi >= 4) phase4(p, smem);
  if (lo <= 4 && hi >= 5) grid.sync();
  if (lo <= 5 && hi >= 5) phase5(p, smem);
}

extern "C" void kernel_launch(void* const* d_in, const int* in_sizes, int n_in, void* d_out, int out_size, void* d_ws, size_t ws_size,
                              hipStream_t stream) {
  static int grid_blocks = 0;
  if (!grid_blocks) {
    int dev = 0, cus = 0, per_cu = 0;
    hipGetDevice(&dev);
    hipDeviceGetAttribute(&cus, hipDeviceAttributeMultiprocessorCount, dev);
    hipOccupancyMaxActiveBlocksPerMultiprocessor(&per_cu, fwd_megakernel, 512, 0);
    if (per_cu > 1) per_cu = 1;
    if (per_cu < 1) per_cu = 1;
    grid_blocks = cus * per_cu;
  }
  Params p{};
  p.x_prompt = (const float*)d_in[0]; p.x_sample = (const float*)d_in[1]; p.cache_k = (const float*)d_in[2]; p.cache_v = (const float*)d_in[3];
  p.state_h = (const float*)d_in[4]; p.norm_g = (const float*)d_in[5]; p.w_in = (const float*)d_in[6]; p.lambda_qk = (const float*)d_in[7];
  p.subln_g = (const float*)d_in[8]; p.rec_lb = (const float*)d_in[9]; p.rec_norm_g = (const float*)d_in[10]; p.w_out = (const float*)d_in[11];
  p.final_g = (const float*)d_in[12];
  p.out = (float*)d_out;
  char* ws = (char*)d_ws; size_t off = 0;
  auto take = [&](size_t bytes) { char* r = ws + off; off += (bytes + 255) & ~(size_t)255; return r; };
  p.WinT = (u16*)take((size_t)4096 * 1024 * 2);
  p.WoutT = (u16*)take((size_t)1024 * 1024 * 2);
  p.Xn = (u16*)take((size_t)NTOK * 1024 * 2);
  p.SbufT = p.Xn;
  p.Qb = (u16*)take((size_t)NTOK * 512 * 2);
  p.Kall = (u16*)take((size_t)KVROWS * 512 * 2);
  p.Vall = (u16*)take((size_t)KVROWS * 512 * 2);
  p.Za = (u16*)take((size_t)NTOK * 512 * 2);
  p.Qr = (u16*)take((size_t)NTOK * 512 * 2);
  p.Ir = (u16*)take((size_t)NTOK * 512 * 2);
  p.Zr = (u16*)take((size_t)NTOK * 512 * 2);
  p.Mix = (u16*)take((size_t)NTOK * 1024 * 2);
  p.Fr = (float*)take((size_t)NTOK * 512 * 4);
  p.Abuf = (float*)take((size_t)NITEM * 128 * 4);
  p.NQ = (float*)take((size_t)NITEM * 4 * 4);
  p.counter = (int*)take(256);
  p.phase_lo = 0; p.phase_hi = 6; p.rep_mask = 0; p.pad_ = 0;
  if (off > ws_size) { fprintf(stderr, "workspace too small: need %zu have %zu\n", off, ws_size); return; }
  void* args[] = {&p};
  hipError_t e = hipLaunchCooperativeKernel((void*)fwd_megakernel, dim3(grid_blocks), dim3(512), args, 0, stream);
  if (e != hipSuccess) fprintf(stderr, "cooperative launch failed: %s (grid %d)\n", hipGetErrorString(e), grid_blocks);
}
```

```cpp
#include <hip/hip_runtime.h>
#include <hip/hip_cooperative_groups.h>
#include <cstdio>
namespace cg = cooperative_groups;

#define DI __device__ __forceinline__
typedef unsigned short u16;
using bf16x8 = __attribute__((ext_vector_type(8))) short;
using s16x4  = __attribute__((ext_vector_type(4))) short;
using f32x16 = __attribute__((ext_vector_type(16))) float;
using f32x4  = __attribute__((ext_vector_type(4))) float;
using f32x2  = __attribute__((ext_vector_type(2))) float;
using u32x4  = __attribute__((ext_vector_type(4))) unsigned;
using u32x2  = __attribute__((ext_vector_type(2))) unsigned;
typedef __bf16 bf2_t __attribute__((ext_vector_type(2)));

#define MFMA(a, b, c) __builtin_amdgcn_mfma_f32_32x32x16_bf16((a), (b), (c), 0, 0, 0)

static constexpr int NTOK = 33280;
static constexpr int NPTOK = 32768;
static constexpr int KVROWS = 32768 + 8 * 1088;
static constexpr int NITEM = 2080;
static constexpr size_t OFF_Y = 0;
static constexpr size_t OFF_NKP = 34078720;
static constexpr size_t OFF_NVP = 50855936;
static constexpr size_t OFF_NHP = 67633152;
static constexpr size_t OFF_NKS = 67764224;
static constexpr size_t OFF_NVS = 68026368;
static constexpr size_t OFF_NHS = 68288512;

struct Params {
  const float *x_prompt, *x_sample, *cache_k, *cache_v, *state_h, *norm_g, *w_in, *lambda_qk, *subln_g, *rec_lb, *rec_norm_g, *w_out, *final_g;
  float* out;
  u16 *WinT, *WoutT, *Xn, *Qb, *Kall, *Vall, *Za, *Qr, *Ir, *Zr, *Mix, *SbufT;
  float *Fr, *Abuf, *NQ;
  int* counter;
  int phase_lo, phase_hi, rep_mask, pad_;
};

DI unsigned pack2(float a, float b) { f32x2 v = {a, b}; bf2_t r = __builtin_convertvector(v, bf2_t); return __builtin_bit_cast(unsigned, r); }
DI u16 f2bf(float a) { return (u16)(pack2(a, 0.f) & 0xffffu); }
DI float bflo(unsigned u) { return __uint_as_float(u << 16); }
DI float bfhi(unsigned u) { return __uint_as_float(u & 0xffff0000u); }
DI int crow(int e, int h) { return (e & 3) + 8 * (e >> 2) + 4 * h; }
DI float wave_sum(float v) {
#pragma unroll
  for (int o = 32; o >= 1; o >>= 1) v += __shfl_xor(v, o);
  return v;
}
DI float silu_f(float v) { return v / (1.f + __expf(-v)); }
DI s16x4 tr_read(const char* p) {
  return __builtin_amdgcn_ds_read_tr16_b64_v4i16((__attribute__((address_space(3))) s16x4*)(p));
}
DI bf16x8 tr_frag(const char* p0, int stride4) {
  s16x4 lo = tr_read(p0), hi = tr_read(p0 + stride4);
  return __builtin_shufflevector(lo, hi, 0, 1, 2, 3, 4, 5, 6, 7);
}
DI bf16x8 pack8(const f32x16& x, int s) {
  u32x4 p;
  p[0] = pack2(x[8 * s + 0], x[8 * s + 1]);
  p[1] = pack2(x[8 * s + 2], x[8 * s + 3]);
  p[2] = pack2(x[8 * s + 4], x[8 * s + 5]);
  p[3] = pack2(x[8 * s + 6], x[8 * s + 7]);
  return __builtin_bit_cast(bf16x8, p);
}
DI f32x16 zero16() { f32x16 z; for (int i = 0; i < 16; ++i) z[i] = 0.f; return z; }

DI void phase0(const Params& p, char* smem) {
  const int tid = threadIdx.x, lane = tid & 63, w = tid >> 6;
  constexpr int NT_W1 = 16 * 64, NT_W2 = 16 * 16, NT_ROW = NTOK / 16, NT_CACHE = 1024;
  constexpr int total = NT_W1 + NT_W2 + NT_ROW + NT_CACHE;
  float (*tile)[65] = (float (*)[65])smem;
  if (blockIdx.x == 0 && tid == 0) *p.counter = 0;
  for (int it = blockIdx.x; it < total; it += gridDim.x) {
    if (it < NT_W1 + NT_W2) {
      const float* src; u16* dst; int N, kt, nt;
      if (it < NT_W1) { src = p.w_in; dst = p.WinT; N = 4096; kt = it >> 6; nt = it & 63; }
      else { int j = it - NT_W1; src = p.w_out; dst = p.WoutT; N = 1024; kt = j >> 4; nt = j & 15; }
      const int c = tid & 63, r0 = tid >> 6;
      for (int i = 0; i < 8; ++i) { int r = r0 + 8 * i; tile[r][c] = src[(size_t)(kt * 64 + r) * N + nt * 64 + c]; }
      __syncthreads();
      if (it < NT_W1) {
        for (int i = 0; i < 8; ++i) { int r = r0 + 8 * i; dst[(size_t)(nt * 64 + r) * 1024 + kt * 64 + c] = f2bf(tile[c][r]); }
      } else {
        for (int i = 0; i < 8; ++i) {
          const int r = r0 + 8 * i, n = nt * 64 + r, k = kt * 64 + c;
          dst[((size_t)((n >> 5) * 64 + (k >> 4)) * 64 + ((k >> 3) & 1) * 32 + (n & 31)) * 8 + (k & 7)] = f2bf(tile[c][r]);
        }
      }
      __syncthreads();
    } else if (it < NT_W1 + NT_W2 + NT_ROW) {
      const int row0 = (it - NT_W1 - NT_W2) * 16 + w * 2;
      f32x4 v[2][4]; float ss[2] = {0.f, 0.f};
#pragma unroll
      for (int rr = 0; rr < 2; ++rr) {
        const int row = row0 + rr;
        const float* src = row < NPTOK ? p.x_prompt + (size_t)row * 1024 : p.x_sample + (size_t)(row - NPTOK) * 1024;
#pragma unroll
        for (int i = 0; i < 4; ++i) v[rr][i] = *(const f32x4*)(src + i * 256 + lane * 4);
      }
#pragma unroll
      for (int rr = 0; rr < 2; ++rr) {
#pragma unroll
        for (int i = 0; i < 4; ++i) ss[rr] += v[rr][i][0] * v[rr][i][0] + v[rr][i][1] * v[rr][i][1] + v[rr][i][2] * v[rr][i][2] + v[rr][i][3] * v[rr][i][3];
        ss[rr] = wave_sum(ss[rr]);
      }
#pragma unroll
      for (int rr = 0; rr < 2; ++rr) {
        const float sc = rsqrtf(ss[rr] * (1.f / 1024.f) + 1e-6f);
#pragma unroll
        for (int i = 0; i < 4; ++i) {
          f32x4 g = *(const f32x4*)(p.norm_g + i * 256 + lane * 4);
          u32x2 o; o[0] = pack2(v[rr][i][0] * sc * g[0], v[rr][i][1] * sc * g[1]); o[1] = pack2(v[rr][i][2] * sc * g[2], v[rr][i][3] * sc * g[3]);
          *(u32x2*)(p.Xn + (size_t)(row0 + rr) * 1024 + i * 256 + lane * 4) = o;
        }
      }
    } else {
      const int task0 = (it - NT_W1 - NT_W2 - NT_ROW) * 16 + w * 2;
      f32x4 a[2], b[2];
#pragma unroll
      for (int rr = 0; rr < 2; ++rr) {
        const int task = task0 + rr, which = task >> 13, r8 = task & 8191;
        const float* src = (which ? p.cache_v : p.cache_k) + (size_t)r8 * 512 + lane * 8;
        a[rr] = *(const f32x4*)src; b[rr] = *(const f32x4*)(src + 4);
      }
#pragma unroll
      for (int rr = 0; rr < 2; ++rr) {
        const int task = task0 + rr, which = task >> 13, r8 = task & 8191;
        u16* dst = (which ? p.Vall : p.Kall) + (size_t)(NPTOK + (r8 >> 10) * 1088 + (r8 & 1023)) * 512 + lane * 8;
        u32x4 o; o[0] = pack2(a[rr][0], a[rr][1]); o[1] = pack2(a[rr][2], a[rr][3]); o[2] = pack2(b[rr][0], b[rr][1]); o[3] = pack2(b[rr][2], b[rr][3]);
        *(u32x4*)dst = o;
      }
    }
  }
}

#define G_LOAD(RA, RB, KT_)                                                                                        \
  {                                                                                                                 \
    _Pragma("unroll") for (int i_ = 0; i_ < 4; ++i_) RA[i_] = *(const u32x4*)((ap + (size_t)i_ * 64 * K + (KT_) * 64) + loff); \
    _Pragma("unroll") for (int i_ = 0; i_ < 4; ++i_) RB[i_] = *(const u32x4*)((bp + (size_t)i_ * 64 * K + (KT_) * 64) + loff); \
  }
#define G_WRITE(RA, RB, BUF_)                                                                                      \
  {                                                                                                                 \
    _Pragma("unroll") for (int i_ = 0; i_ < 4; ++i_) *(u32x4*)(wbase + (BUF_) * 73728 + i_ * 64 * 144) = RA[i_];         \
    _Pragma("unroll") for (int i_ = 0; i_ < 4; ++i_) *(u32x4*)(wbase + (BUF_) * 73728 + 36864 + i_ * 64 * 144) = RB[i_]; \
  }
#define G_FRAGS(FA, FB, S_)                                                                                        \
  {                                                                                                                 \
    _Pragma("unroll") for (int i_ = 0; i_ < 4; ++i_) FA[i_] = *(const bf16x8*)(as_ + i_ * 32 * 144 + (S_) * 32);      \
    FB[0] = *(const bf16x8*)(bs_ + (S_) * 32); FB[1] = *(const bf16x8*)(bs_ + 32 * 144 + (S_) * 32);                \
  }
#define G_MFMA8(FA, FB)                                                                                            \
  {                                                                                                                 \
    _Pragma("unroll") for (int i_ = 0; i_ < 4; ++i_) {                                                              \
      acc[i_][0] = MFMA(FA[i_], FB[0], acc[i_][0]);                                                                 \
      acc[i_][1] = MFMA(FA[i_], FB[1], acc[i_][1]);                                                                 \
    }                                                                                                               \
  }
#define G_COMPUTE(BUF_)                                                                                            \
  {                                                                                                                 \
    const char* as_ = smem + (BUF_) * 73728 + (wm * 128 + r) * 144 + h * 16;                                        \
    const char* bs_ = smem + (BUF_) * 73728 + 36864 + (wn * 64 + r) * 144 + h * 16;                                 \
    bf16x8 fa0[4], fb0[2], fa1[4], fb1[2];                                                                          \
    G_FRAGS(fa0, fb0, 0);                                                                                           \
    G_FRAGS(fa1, fb1, 1); __builtin_amdgcn_sched_barrier(0); G_MFMA8(fa0, fb0); __builtin_amdgcn_sched_barrier(0);  \
    G_FRAGS(fa0, fb0, 2); __builtin_amdgcn_sched_barrier(0); G_MFMA8(fa1, fb1); __builtin_amdgcn_sched_barrier(0);  \
    G_FRAGS(fa1, fb1, 3); __builtin_amdgcn_sched_barrier(0); G_MFMA8(fa0, fb0); __builtin_amdgcn_sched_barrier(0);  \
    G_MFMA8(fa1, fb1);                                                                                              \
  }
DI void gemm256(const u16* __restrict__ A, const u16* __restrict__ BT, int K, int m0, int n0, char* smem, int tid, f32x16 (&acc)[4][2]) {
  const int lane = tid & 63, w = tid >> 6, r = lane & 31, h = lane >> 5;
  const int wm = w >> 2, wn = w & 3;
#pragma unroll
  for (int i = 0; i < 4; ++i) { acc[i][0] = zero16(); acc[i][1] = zero16(); }
  u32x4 ra0[4], rb0[4];
  const int KT = K >> 6;
  const u16* ap = A + (size_t)m0 * K;
  const u16* bp = BT + (size_t)n0 * K;
  const int loff = (tid >> 3) * K + (tid & 7) * 8;
  char* wbase = smem + (tid >> 3) * 144 + (tid & 7) * 16;
  G_LOAD(ra0, rb0, 0);
  G_WRITE(ra0, rb0, 0);
  __syncthreads();
  for (int kt = 0; kt < KT; kt += 2) {
    { const int k1 = kt + 1 < KT ? kt + 1 : KT - 1; G_LOAD(ra0, rb0, k1); }
    __builtin_amdgcn_sched_barrier(0);
    G_COMPUTE(0);
    __builtin_amdgcn_sched_barrier(0);
    G_WRITE(ra0, rb0, 1);
    __syncthreads();
    { const int k2 = kt + 2 < KT ? kt + 2 : KT - 1; G_LOAD(ra0, rb0, k2); }
    __builtin_amdgcn_sched_barrier(0);
    G_COMPUTE(1);
    __builtin_amdgcn_sched_barrier(0);
    G_WRITE(ra0, rb0, 0);
    __syncthreads();
  }
}
struct TileMap {
  int MT, NT, C, NG, NST, st, lb, lin;
  bool xcd;
  DI TileMap(int mt_, int nt_) : MT(mt_), NT(nt_) {
    const int nb = gridDim.x >> 3;
    C = nb >> 3;
    xcd = (gridDim.x & 63) == 0 && C > 0 && (NT % C) == 0;
    NG = xcd ? NT / C : 1;
    NST = ((MT + 7) >> 3) * NG;
    st = blockIdx.x & 7; lb = blockIdx.x >> 3; lin = blockIdx.x;
  }
  DI bool next(int& mt, int& nt) {
    if (!xcd) {
      if (lin >= MT * NT) return false;
      mt = lin / NT; nt = lin - mt * NT; lin += gridDim.x; return true;
    }
    while (st < NST) {
      const int mg = st / NG, ng = st - mg * NG;
      mt = mg * 8 + lb / C; nt = ng * C + lb % C;
      st += 8;
      if (mt < MT) return true;
    }
    return false;
  }
};
DI void stage_half(const f32x16 (&acc)[4][2], float* cs, int half, int wm, int wn, int r, int h) {
  if (wm == half) {
#pragma unroll
    for (int i = 0; i < 4; ++i)
#pragma unroll
      for (int j = 0; j < 2; ++j)
#pragma unroll
        for (int e = 0; e < 16; ++e) cs[(i * 32 + crow(e, h)) * 260 + wn * 64 + j * 32 + r] = acc[i][j][e];
  }
}

DI void phase1(const Params& p, char* smem) {
  constexpr int MT = NTOK / 256, NT = 16;
  TileMap tm(MT, NT);
  int mt, nt;
  while (tm.next(mt, nt)) {
    const int m0 = mt * 256, n0 = nt * 256;
    f32x16 acc[4][2];
    {
      int tg = threadIdx.x;
      asm volatile("" : "+v"(tg));
      gemm256(p.Xn, p.WinT, 1024, m0, n0, smem, tg, acc);
    }
    int tid = threadIdx.x;
    asm volatile("" : "+v"(tid));
    const int lane = tid & 63, w = tid >> 6, r = lane & 31, h = lane >> 5;
    const int wm = w >> 2, wn = w & 3;
    const int sec = n0 >> 9;
    const bool samp = m0 >= NPTOK;
    float* cs = (float*)smem;
    const int c0 = (tid & 31) * 8, rb = tid >> 5;
    const int csc = (n0 & 511) + c0;
#pragma unroll 1
    for (int half = 0; half < 2; ++half) {
      stage_half(acc, cs, half, wm, wn, r, h);
      __syncthreads();
#pragma unroll 2
      for (int ps = 0; ps < 8; ++ps) {
        const int row = rb + 16 * ps;
        const int t = m0 + half * 128 + row;
        f32x4 va = *(const f32x4*)(cs + row * 260 + c0), vb = *(const f32x4*)(cs + row * 260 + c0 + 4);
        const size_t o512 = (size_t)t * 512 + csc;
        if (sec == 5) { __builtin_nontemporal_store(va, (f32x4*)(p.Fr + o512)); __builtin_nontemporal_store(vb, (f32x4*)(p.Fr + o512 + 4)); }
        else {
          u16* dst;
          if (sec == 0) {
            const float qs = 0.125f * 1.44269504089f;
            va *= qs; vb *= qs; dst = p.Qb + o512;
          } else if (sec == 1 || sec == 2) {
            size_t kvr; float* od;
            if (!samp) { kvr = t; od = p.out + (sec == 1 ? OFF_NKP : OFF_NVP) + o512; }
            else { const int ts = t - NPTOK; kvr = NPTOK + (ts >> 6) * 1088 + 1024 + (ts & 63); od = p.out + (sec == 1 ? OFF_NKS : OFF_NVS) + (size_t)ts * 512 + csc; }
            __builtin_nontemporal_store(va, (f32x4*)od); __builtin_nontemporal_store(vb, (f32x4*)(od + 4));
            dst = (sec == 1 ? p.Kall : p.Vall) + kvr * 512 + csc;
          } else if (sec == 6) { dst = p.Ir + o512; }
          else {
#pragma unroll
            for (int i = 0; i < 4; ++i) { va[i] = silu_f(va[i]); vb[i] = silu_f(vb[i]); }
            dst = (sec == 3 ? p.Za : (sec == 4 ? p.Qr : p.Zr)) + o512;
          }
          u32x4 o; o[0] = pack2(va[0], va[1]); o[1] = pack2(va[2], va[3]); o[2] = pack2(vb[0], vb[1]); o[3] = pack2(vb[2], vb[3]);
          __builtin_nontemporal_store(o, (u32x4*)dst);
        }
      }
      __syncthreads();
    }
  }
}

DI void rec_load(const Params& p, int tid, int I, float (&xv)[32]) {
  const int d = tid & 127, half = tid >> 7;
  const int hd = I & 3, t0 = (I >> 2) * 64;
  const float* fp = p.Fr + (size_t)(t0 + half * 32) * 512 + hd * 128 + d;
#pragma unroll
  for (int i = 0; i < 32; ++i) xv[i] = fp[(size_t)i * 512];
}
DI void rec_pre_x(const Params& p, int tid, int I, float* totS, const float (&xv)[32], float (&cum)[32], float (&key)[32], float& lastv) {
  const int d = tid & 127, half = tid >> 7;
  const int hd = I & 3;
  const float r0 = p.rec_lb[hd * 128 + d], r1 = p.rec_lb[512 + hd * 128 + d];
  const float lb = 1.f / (1.f + __expf(r1 - r0));
  float run = 0.f;
#pragma unroll
  for (int i = 0; i < 32; ++i) {
    float x = xv[i];
    x = fminf(fmaxf(x, -30.f), 30.f);
    const float e = __expf(-x), sg = 1.f / (1.f + e);
    run += __logf(lb + (1.f - lb) * sg);
    cum[i] = run; key[i] = (1.f - lb) * e * sg;
  }
  totS[tid] = run;
  __syncthreads();
  const float tot0 = totS[d], tot1 = totS[128 + d];
  if (half) {
#pragma unroll
    for (int i = 0; i < 32; ++i) cum[i] += tot0;
  }
  lastv = tot0 + tot1;
}
DI void rec_pre(const Params& p, int tid, int I, float* totS, float (&cum)[32], float (&key)[32], float& lastv) {
  float xv[32];
  rec_load(p, tid, I, xv);
  rec_pre_x(p, tid, I, totS, xv, cum, key, lastv);
}

DI void phase2(const Params& p, char* smem0, u16* BbufT) {
  const int hf = threadIdx.x >> 8;
  const int tid = threadIdx.x & 255, lane = tid & 63, w = tid >> 6, r = lane & 31, h = lane >> 5;
  const int q = (lane & 15) >> 2, pp = lane & 3, blk = (lane >> 4) & 1;
  const int d = tid & 127, half = tid >> 7;
  char* smem = smem0 + hf * 65536;
  char* KdI = smem; char* VrI = smem + 17408; float* totS = (float*)(smem + 60000);
  float xv[32];
  rec_load(p, tid, blockIdx.x * 2 + hf < NITEM ? blockIdx.x * 2 + hf : NITEM - 1, xv);
  for (int I = blockIdx.x * 2 + hf; I < NITEM; I += gridDim.x * 2) {
    const int hd = I & 3, t0 = (I >> 2) * 64;
    if (I < 2048) {
      const int token = tid & 63, which = tid >> 6;
      const u16* src = (which < 2 ? p.Qb : p.Kall) + (size_t)(t0 + token) * 512 + hd * 128 + (which & 1) * 64;
      float ss = 0.f;
#pragma unroll
      for (int c = 0; c < 8; ++c) {
        const u32x4 v = *(const u32x4*)(src + c * 8);
#pragma unroll
        for (int i = 0; i < 4; ++i) { const float lo = bflo(v[i]), hi = bfhi(v[i]); ss += lo * lo + hi * hi; }
      }
#pragma unroll
      for (int o = 32; o >= 1; o >>= 1) ss = fmaxf(ss, __shfl_xor(ss, o));
      if (lane == 0) p.NQ[I * 4 + which] = sqrtf(ss);
    }
    float cum[32], key[32], lastv;
    rec_pre_x(p, tid, I, totS, xv, cum, key, lastv);
    {
      const int In = I + gridDim.x * 2;
      rec_load(p, tid, In < NITEM ? In : I, xv);
    }
#pragma unroll
    for (int i = 0; i < 32; ++i) {
      const int t = half * 32 + i;
      *(u16*)(KdI + t * 272 + d * 2) = f2bf(key[i] * __expf(lastv - cum[i]));
    }
#pragma unroll
    for (int i = 0; i < 4; ++i) {
      const int ch = tid + 256 * i, row = ch >> 4, cc = ch & 15;
      *(u32x4*)(VrI + row * 272 + cc * 16) = *(const u32x4*)(p.Ir + (size_t)(t0 + row) * 512 + hd * 128 + cc * 8);
    }
    if (half) p.Abuf[I * 128 + d] = __expf(lastv);
    __syncthreads();
    f32x16 acc[4];
#pragma unroll
    for (int ct = 0; ct < 4; ++ct) acc[ct] = zero16();
#pragma unroll
    for (int ks = 0; ks < 4; ++ks) {
      const int rowoff = (16 * ks + 8 * h + q) * 272 + 32 * blk + 8 * pp;
      bf16x8 a = tr_frag(VrI + rowoff + 64 * w, 4 * 272);
#pragma unroll
      for (int ct = 0; ct < 4; ++ct) {
        bf16x8 b = tr_frag(KdI + rowoff + 64 * ct, 4 * 272);
        acc[ct] = MFMA(a, b, acc[ct]);
      }
    }
    u16* ob = BbufT + (size_t)I * 16384;
#pragma unroll
    for (int ct = 0; ct < 4; ++ct)
#pragma unroll
      for (int e = 0; e < 16; ++e) ob[(32 * w + crow(e, h)) * 128 + 32 * ct + r] = f2bf(acc[ct][e]);
    __syncthreads();
  }
}

DI void phase3(const Params& p, const u16* BbufT) {
  const int tid = threadIdx.x & 255;
  for (int it = blockIdx.x * 2 + (threadIdx.x >> 8); it < 512 + 1024; it += gridDim.x * 2) {
    if (it < 512) {
      const int bh = it >> 6, b = bh >> 2, hd = bh & 3;
      const int e1 = (it & 63) * 256 + tid, v = e1 >> 7, d = e1 & 127;
      float sx = 0.f;
      const size_t eo = (size_t)v * 128 + d;
      const int I0 = (b * 256) * 4 + hd;
      const float* ap = p.Abuf + (size_t)I0 * 128 + d;
      const u16* bp = BbufT + (size_t)I0 * 16384 + eo;
      u16* sp = p.SbufT + (size_t)I0 * 16384 + eo;
      for (int c0 = 0; c0 < 256; c0 += 16) {
        float av[16]; u16 bw[16];
#pragma unroll
        for (int i = 0; i < 16; ++i) { av[i] = ap[(size_t)(c0 + i) * 4 * 128]; bw[i] = bp[(size_t)(c0 + i) * 4 * 16384]; }
#pragma unroll
        for (int i = 0; i < 16; ++i) {
          sp[(size_t)(c0 + i) * 4 * 16384] = f2bf(sx);
          sx = av[i] * sx + bflo(bw[i]);
        }
      }
      p.out[OFF_NHP + (size_t)(b * 4 + hd) * 16384 + d * 128 + v] = sx;
    } else {
      const int j = it - 512;
      const int sh = j >> 5, bs = sh >> 2, hd = sh & 3;
      const int e2 = (j & 31) * 256 + tid, v = e2 >> 6, d2 = (e2 & 63) * 2;
      const int I = (512 + bs) * 4 + hd;
      const float* sh0 = p.state_h + (size_t)(bs * 4 + hd) * 16384;
      float sx = sh0[d2 * 128 + v], sy = sh0[(d2 + 1) * 128 + v];
      const size_t eo = (size_t)v * 128 + d2;
      const f32x2 a = *(const f32x2*)(p.Abuf + I * 128 + d2);
      const unsigned bw = *(const unsigned*)(BbufT + (size_t)I * 16384 + eo);
      *(unsigned*)(p.SbufT + (size_t)I * 16384 + eo) = pack2(sx, sy);
      sx = a[0] * sx + bflo(bw); sy = a[1] * sy + bfhi(bw);
      float* oh = p.out + OFF_NHS + (size_t)(bs * 4 + hd) * 16384;
      oh[d2 * 128 + v] = sx; oh[(d2 + 1) * 128 + v] = sy;
    }
  }
}

DI void r3_item(const Params& p, char* smem, int tid, int I) {
  const int lane = tid & 63, w = tid >> 6, r = lane & 31, h = lane >> 5;
  const int q = (lane & 15) >> 2, pp = lane & 3, blk = (lane >> 4) & 1;
  const int d = tid & 127, half = tid >> 7;
  char* QdI = smem; char* KdI = smem + 17408; char* VrI = smem + 34816;
  float* totS = (float*)(smem + 60000); float* ssS = (float*)(smem + 62048);
  const int hd = I & 3, t0 = (I >> 2) * 64;
  {
    float cum[32], key[32], lastv;
    rec_pre(p, tid, I, totS, cum, key, lastv);
    const u16* qp = p.Qr + (size_t)(t0 + half * 32) * 512 + hd * 128 + d;
#pragma unroll
    for (int i = 0; i < 32; ++i) {
      const int t = half * 32 + i;
      const float qv = bflo(qp[(size_t)i * 512]);
      *(u16*)(QdI + t * 272 + d * 2) = f2bf(qv * __expf(cum[i]));
      *(u16*)(KdI + t * 272 + d * 2) = f2bf(key[i] * __expf(-cum[i]));
    }
  }
#pragma unroll
  for (int i = 0; i < 4; ++i) {
    const int ch = tid + 256 * i, row = ch >> 4, cc = ch & 15;
    *(u32x4*)(VrI + row * 272 + cc * 16) = *(const u32x4*)(p.Ir + (size_t)(t0 + row) * 512 + hd * 128 + cc * 8);
  }
  __syncthreads();
  const int tt = w & 1, vh = w >> 1;
  bf16x8 qf[8];
#pragma unroll
  for (int ks = 0; ks < 8; ++ks) qf[ks] = *(const bf16x8*)(QdI + (32 * tt + r) * 272 + ks * 32 + h * 16);
  f32x16 sc[2]; sc[0] = zero16(); sc[1] = zero16();
#pragma unroll
  for (int ks = 0; ks < 8; ++ks) {
    bf16x8 a0 = *(const bf16x8*)(KdI + r * 272 + ks * 32 + h * 16);
    sc[0] = MFMA(a0, qf[ks], sc[0]);
  }
  if (tt == 1) {
#pragma unroll
    for (int ks = 0; ks < 8; ++ks) {
      bf16x8 a1 = *(const bf16x8*)(KdI + (32 + r) * 272 + ks * 32 + h * 16);
      sc[1] = MFMA(a1, qf[ks], sc[1]);
    }
  }
#pragma unroll
  for (int e = 0; e < 16; ++e) {
    const bool keep = crow(e, h) <= r;
    if (tt == 0) { if (!keep) sc[0][e] = 0.f; }
    else { if (!keep) sc[1][e] = 0.f; }
  }
  bf16x8 pf[4];
  pf[0] = pack8(sc[0], 0); pf[1] = pack8(sc[0], 1); pf[2] = pack8(sc[1], 0); pf[3] = pack8(sc[1], 1);
  f32x16 o[2]; o[0] = zero16(); o[1] = zero16();
  const u16* sp = p.SbufT + (size_t)I * 16384;
#pragma unroll
  for (int vi = 0; vi < 2; ++vi) {
    const int vt = 2 * vh + vi;
#pragma unroll
    for (int k4 = 0; k4 < 4; ++k4) {
      if (k4 < 2 || tt == 1) {
        bf16x8 a = tr_frag(VrI + (16 * k4 + 4 * h + q) * 272 + (32 * vt + 16 * blk) * 2 + 8 * pp, 8 * 272);
        o[vi] = MFMA(a, pf[k4], o[vi]);
      }
    }
#pragma unroll
    for (int ks = 0; ks < 8; ++ks) {
      bf16x8 a = *(const bf16x8*)(sp + (size_t)(32 * vt + r) * 128 + ks * 16 + h * 8);
      o[vi] = MFMA(a, qf[ks], o[vi]);
    }
  }
  float ss = 0.f;
#pragma unroll
  for (int vi = 0; vi < 2; ++vi)
#pragma unroll
    for (int e = 0; e < 16; ++e) ss += o[vi][e] * o[vi][e];
  ss += __shfl_xor(ss, 32);
  if (h == 0) ssS[w * 32 + r] = ss;
  __syncthreads();
  const float tot = ssS[tt * 32 + r] + ssS[(tt + 2) * 32 + r];
  const float rs = rsqrtf(tot * (1.f / 128.f) + 1e-6f);
  const int tok = t0 + 32 * tt + r;
#pragma unroll
  for (int vi = 0; vi < 2; ++vi)
#pragma unroll
    for (int g = 0; g < 4; ++g) {
      const int v = 32 * (2 * vh + vi) + 8 * g + 4 * h;
      const f32x4 gg = *(const f32x4*)(p.rec_norm_g + v);
      const u32x2 z = *(const u32x2*)(p.Zr + (size_t)tok * 512 + hd * 128 + v);
      u32x2 ov;
      ov[0] = pack2(o[vi][4 * g + 0] * rs * gg[0] * bflo(z[0]), o[vi][4 * g + 1] * rs * gg[1] * bfhi(z[0]));
      ov[1] = pack2(o[vi][4 * g + 2] * rs * gg[2] * bflo(z[1]), o[vi][4 * g + 3] * rs * gg[3] * bfhi(z[1]));
      *(u32x2*)(p.Mix + (size_t)tok * 1024 + 512 + hd * 128 + v) = ov;
    }
  __syncthreads();
}

template <bool DIAG>
DI void attn_tile_a(const char* ks, const bf16x8 (&qf)[4], f32x16 (&O)[4], bf16x8 (&pf)[4], float& mrun, float& lsum, float sl2, float qrel,
                    int m, int r, int h2) {
  f32x16 S[2];
#pragma unroll
  for (int st = 0; st < 2; ++st) {
    S[st] = zero16();
#pragma unroll
    for (int s = 0; s < 4; ++s) {
      bf16x8 a = *(const bf16x8*)(ks + (32 * st + r) * 272 + m * 128 + s * 32 + h2 * 16);
      S[st] = MFMA(a, qf[s], S[st]);
    }
  }
  float mx = -1e30f;
#pragma unroll
  for (int st = 0; st < 2; ++st)
#pragma unroll
    for (int e = 0; e < 16; ++e) {
      const float cst = (float)(32 * st + (e & 3) + 8 * (e >> 2));
      float sv;
      if (DIAG) sv = fmaf(-sl2, fabsf(qrel - cst), S[st][e]);
      else sv = fmaf(sl2, cst, S[st][e]);
      S[st][e] = sv; mx = fmaxf(mx, sv);
    }
  const float L = DIAG ? 0.f : -sl2 * qrel;
  mx += L;
  mx = fmaxf(mx, __shfl_xor(mx, 32));
  if (__builtin_amdgcn_ballot_w64(mx > mrun + 6.f) != 0) {
    const float mnew = fmaxf(mrun, mx);
    const float alpha = __builtin_amdgcn_exp2f(mrun - mnew);
    mrun = mnew; lsum *= alpha;
#pragma unroll
    for (int vt = 0; vt < 4; ++vt)
#pragma unroll
      for (int e = 0; e < 16; ++e) O[vt][e] *= alpha;
  }
  const float off = L - mrun;
  float rs = 0.f;
#pragma unroll
  for (int st = 0; st < 2; ++st)
#pragma unroll
    for (int e = 0; e < 16; ++e) { const float pv = __builtin_amdgcn_exp2f(S[st][e] + off); S[st][e] = pv; rs += pv; }
  lsum += rs;
  pf[0] = pack8(S[0], 0); pf[1] = pack8(S[0], 1); pf[2] = pack8(S[1], 0); pf[3] = pack8(S[1], 1);
}
template <bool DIAG>
DI void attn_tile_f(const char* ks, const bf16x8 (&qf)[4], bf16x8 (&pf)[4], float& lsum, float sl2, float qrel, float mref, int m, int r, int h2) {
  f32x16 S[2];
  const float offL = -sl2 * qrel - mref;
#pragma unroll
  for (int st = 0; st < 2; ++st) {
#pragma unroll
    for (int e = 0; e < 16; ++e) {
      const float cst = (float)(32 * st + (e & 3) + 8 * (e >> 2));
      S[st][e] = DIAG ? (-sl2 * fabsf(qrel - cst) - mref) : fmaf(sl2, cst, offL);
    }
#pragma unroll
    for (int s = 0; s < 4; ++s) {
      bf16x8 a = *(const bf16x8*)(ks + (32 * st + r) * 272 + m * 128 + s * 32 + h2 * 16);
      S[st] = MFMA(a, qf[s], S[st]);
    }
  }
  float rs = 0.f;
#pragma unroll
  for (int st = 0; st < 2; ++st)
#pragma unroll
    for (int e = 0; e < 16; ++e) { const float pv = __builtin_amdgcn_exp2f(S[st][e]); S[st][e] = pv; rs += pv; }
  lsum += rs;
  pf[0] = pack8(S[0], 0); pf[1] = pack8(S[0], 1); pf[2] = pack8(S[1], 0); pf[3] = pack8(S[1], 1);
}
DI void attn_tile_b(const char* vs, const bf16x8 (&pf)[4], f32x16 (&O)[4], int h2, int q, int pp, int blk) {
  const char* vb = vs + (4 * h2 + q) * 320 + 32 * blk + 8 * pp;
  bf16x8 a0[4], a1[4];
#pragma unroll
  for (int vt = 0; vt < 4; ++vt) a0[vt] = tr_frag(vb + 64 * vt, 8 * 320);
  __builtin_amdgcn_sched_barrier(0);
#pragma unroll
  for (int vt = 0; vt < 4; ++vt) a1[vt] = tr_frag(vb + 16 * 320 + 64 * vt, 8 * 320);
#pragma unroll
  for (int vt = 0; vt < 4; ++vt) O[vt] = MFMA(a0[vt], pf[0], O[vt]);
  __builtin_amdgcn_sched_barrier(0);
#pragma unroll
  for (int vt = 0; vt < 4; ++vt) a0[vt] = tr_frag(vb + 32 * 320 + 64 * vt, 8 * 320);
#pragma unroll
  for (int vt = 0; vt < 4; ++vt) O[vt] = MFMA(a1[vt], pf[1], O[vt]);
  __builtin_amdgcn_sched_barrier(0);
#pragma unroll
  for (int vt = 0; vt < 4; ++vt) a1[vt] = tr_frag(vb + 48 * 320 + 64 * vt, 8 * 320);
#pragma unroll
  for (int vt = 0; vt < 4; ++vt) O[vt] = MFMA(a0[vt], pf[2], O[vt]);
  __builtin_amdgcn_sched_barrier(0);
#pragma unroll
  for (int vt = 0; vt < 4; ++vt) O[vt] = MFMA(a1[vt], pf[3], O[vt]);
}

DI void attn_item(const Params& p, char* smem, int tid, int tq0, int qpos0, int kvbase, int ntb, int hd, float lam, bool can_skip, int nq) {
  const int lane = tid & 63, w = tid >> 6, r = lane & 31, h2 = lane >> 5;
  const int q = (lane & 15) >> 2, pp = lane & 3, blk = (lane >> 4) & 1;
  const int qg = w & 3, m = w >> 2, ch = qg >> 1;
  const bool wact = qg < nq;
  const float sl2 = exp2f(-2.f * (float)(hd + 1)) * 1.44269504089f;
  const int qtok = tq0 + 32 * qg + r;
  const float qposf = (float)(qpos0 + 32 * qg + r);
  const int ntw = can_skip ? ntb - 1 + ch : ntb;
  int kt0w = 0, kt0b = 0;
  bool fast = false; float kn_w = 0.f;
  if (can_skip) {
    const int I0 = (tq0 >> 6) * 4 + hd;
    const int crk = kvbase >> 6;
    fast = true; kt0b = ntb;
#pragma unroll
    for (int mm = 0; mm < 2; ++mm) {
      float KN = 0.f;
      for (int c = lane; c < ntb; c += 64) KN = fmaxf(KN, p.NQ[((crk + c) * 4 + hd) * 4 + 2 + mm]);
#pragma unroll
      for (int o = 32; o >= 1; o >>= 1) KN = fmaxf(KN, __shfl_xor(KN, o));
#pragma unroll
      for (int cc = 0; cc < 2; ++cc) {
        const float QN = p.NQ[(I0 + 4 * cc) * 4 + mm];
        const float D = (2.02f * QN * KN + 66.f) / sl2;
        const float f = ((float)(qpos0 + 64 * cc - 63) - D) * (1.f / 64.f);
        const int k0 = f < 0.f ? 0 : (int)f + 1;
        kt0b = k0 < kt0b ? k0 : kt0b;
        fast = fast && (2.02f * QN * KN < 60.f);
        if (mm == m && cc == ch) { kt0w = k0; kn_w = KN; }
      }
    }
  }
  bf16x8 qf[4];
  if (wact) {
#pragma unroll
    for (int s = 0; s < 4; ++s) qf[s] = *(const bf16x8*)(p.Qb + (size_t)qtok * 512 + hd * 128 + m * 64 + 16 * s + 8 * h2);
  } else {
#pragma unroll
    for (int s = 0; s < 4; ++s) qf[s] = (bf16x8){0, 0, 0, 0, 0, 0, 0, 0};
  }
  float mref = 0.f;
  if (fast) {
    float qq = 0.f;
#pragma unroll
    for (int s = 0; s < 4; ++s) {
      const u32x4 u = __builtin_bit_cast(u32x4, qf[s]);
#pragma unroll
      for (int i = 0; i < 4; ++i) { const float lo = bflo(u[i]), hi = bfhi(u[i]); qq += lo * lo + hi * hi; }
    }
    qq += __shfl_xor(qq, 32);
    mref = sqrtf(qq) * kn_w * 1.01f + 0.5f;
  }
  f32x16 O[4];
#pragma unroll
  for (int vt = 0; vt < 4; ++vt) O[vt] = zero16();
  float mrun = -1e30f, lsum = 0.f;
  u32x4 rk[2], rv[2];
  const int lrow = tid >> 4, lcc = tid & 15;
  const size_t gofs = (size_t)(kvbase + lrow) * 512 + hd * 128 + lcc * 8;
  const u16* kp = p.Kall + gofs;
  const u16* vp = p.Vall + gofs;
  char* kw = smem + lrow * 272 + lcc * 16;
  char* vw = smem + 17408 + lrow * 320 + lcc * 16;
  const int nit = ntb - kt0b;
  {
    const size_t go = (size_t)(fast ? kt0b : ntb - 1) * 64 * 512;
#pragma unroll
    for (int i = 0; i < 2; ++i) { rk[i] = *(const u32x4*)(kp + go + (size_t)i * 32 * 512); rv[i] = *(const u32x4*)(vp + go + (size_t)i * 32 * 512); }
#pragma unroll
    for (int i = 0; i < 2; ++i) { *(u32x4*)(kw + i * 32 * 272) = rk[i]; *(u32x4*)(vw + i * 32 * 320) = rv[i]; }
    const int k1 = fast ? (kt0b + 1 < ntb ? kt0b + 1 : ntb - 1) : (ntb - 2 > kt0b ? ntb - 2 : kt0b);
    const size_t g1 = (size_t)k1 * 64 * 512;
#pragma unroll
    for (int i = 0; i < 2; ++i) { rk[i] = *(const u32x4*)(kp + g1 + (size_t)i * 32 * 512); rv[i] = *(const u32x4*)(vp + g1 + (size_t)i * 32 * 512); }
  }
  __syncthreads();
  if (fast) {
    for (int it = 0; it < nit; ++it) {
      const int kt = kt0b + it;
      const bool active = wact && kt >= kt0w && kt < ntw;
      const char* ks = smem + (it & 1) * 37888;
      char* wb = kw + ((it + 1) & 1) * 37888;
      char* wbv = vw + ((it + 1) & 1) * 37888;
#pragma unroll
      for (int i = 0; i < 2; ++i) { *(u32x4*)(wb + i * 32 * 272) = rk[i]; *(u32x4*)(wbv + i * 32 * 320) = rv[i]; }
      {
        const int k2 = kt + 2 < ntb ? kt + 2 : ntb - 1;
        const size_t g2 = (size_t)k2 * 64 * 512;
#pragma unroll
        for (int i = 0; i < 2; ++i) { rk[i] = *(const u32x4*)(kp + g2 + (size_t)i * 32 * 512); rv[i] = *(const u32x4*)(vp + g2 + (size_t)i * 32 * 512); }
      }
      __builtin_amdgcn_sched_barrier(0);
      if (active) {
        bf16x8 pf[4];
        const float qrel = qposf - (float)(kt * 64 + 4 * h2);
        if (kt == ntw - 1) attn_tile_f<true>(ks, qf, pf, lsum, sl2, qrel, mref, m, r, h2);
        else attn_tile_f<false>(ks, qf, pf, lsum, sl2, qrel, mref, m, r, h2);
        attn_tile_b(ks + 17408, pf, O, h2, q, pp, blk);
      }
      __syncthreads();
    }
  } else {
    for (int it = 0; it < nit; ++it) {
      const int kt = ntb - 1 - it;
      const bool active = wact && kt >= kt0w && kt < ntw;
      const char* ks = smem + (it & 1) * 37888;
      char* wb = kw + ((it + 1) & 1) * 37888;
      char* wbv = vw + ((it + 1) & 1) * 37888;
#pragma unroll
      for (int i = 0; i < 2; ++i) { *(u32x4*)(wb + i * 32 * 272) = rk[i]; *(u32x4*)(wbv + i * 32 * 320) = rv[i]; }
      {
        const int k2 = kt - 2 > kt0b ? kt - 2 : kt0b;
        const size_t g2 = (size_t)k2 * 64 * 512;
#pragma unroll
        for (int i = 0; i < 2; ++i) { rk[i] = *(const u32x4*)(kp + g2 + (size_t)i * 32 * 512); rv[i] = *(const u32x4*)(vp + g2 + (size_t)i * 32 * 512); }
      }
      __builtin_amdgcn_sched_barrier(0);
      if (active) {
        bf16x8 pf[4];
        const float qrel = qposf - (float)(kt * 64 + 4 * h2);
        if (kt == ntw - 1) attn_tile_a<true>(ks, qf, O, pf, mrun, lsum, sl2, qrel, m, r, h2);
        else attn_tile_a<false>(ks, qf, O, pf, mrun, lsum, sl2, qrel, m, r, h2);
        attn_tile_b(ks + 17408, pf, O, h2, q, pp, blk);
      }
      __syncthreads();
    }
  }
  const float lt = lsum + __shfl_xor(lsum, 32);
  const float inv = wact ? 1.f / lt : 0.f;
  float* exch = (float*)smem + qg * 4096 + lane;
  if (m == 1) {
#pragma unroll
    for (int vt = 0; vt < 4; ++vt)
#pragma unroll
      for (int e = 0; e < 16; ++e) exch[(vt * 16 + e) * 64] = O[vt][e] * inv;
  }
  __syncthreads();
  if (m == 0 && wact) {
    float ss = 0.f;
#pragma unroll
    for (int vt = 0; vt < 4; ++vt)
#pragma unroll
      for (int e = 0; e < 16; ++e) { const float ov = O[vt][e] * inv - lam * exch[(vt * 16 + e) * 64]; O[vt][e] = ov; ss += ov * ov; }
    ss += __shfl_xor(ss, 32);
    const float rsn = rsqrtf(ss * (1.f / 128.f) + 1e-6f) * 0.8f;
#pragma unroll
    for (int vt = 0; vt < 4; ++vt)
#pragma unroll
      for (int g = 0; g < 4; ++g) {
        const int v = 32 * vt + 8 * g + 4 * h2;
        const f32x4 gg = *(const f32x4*)(p.subln_g + v);
        const u32x2 z = *(const u32x2*)(p.Za + (size_t)qtok * 512 + hd * 128 + v);
        u32x2 ov;
        ov[0] = pack2(O[vt][4 * g + 0] * rsn * gg[0] * bflo(z[0]), O[vt][4 * g + 1] * rsn * gg[1] * bfhi(z[0]));
        ov[1] = pack2(O[vt][4 * g + 2] * rsn * gg[2] * bflo(z[1]), O[vt][4 * g + 3] * rsn * gg[3] * bfhi(z[1]));
        *(u32x2*)(p.Mix + (size_t)qtok * 1024 + hd * 128 + v) = ov;
      }
  }
  __syncthreads();
}

DI void phase4(const Params& p, char* smem) {
  const int tid = threadIdx.x, lane = tid & 63;
  float lam;
  {
    const float a = p.lambda_qk[lane] * p.lambda_qk[64 + lane];
    const float b = p.lambda_qk[128 + lane] * p.lambda_qk[192 + lane];
    lam = __expf(wave_sum(a)) - __expf(wave_sum(b)) + 0.2f;
  }
  int* sitem = (int*)(smem + 153584);
  constexpr int NPA = 1024, NSA = 32, TOTAL = NPA + NSA + NITEM / 2;
  for (;;) {
    if (tid == 0) *sitem = atomicAdd(p.counter, 1);
    __syncthreads();
    const int item = *sitem;
    __syncthreads();
    if (item >= TOTAL) break;
    int tid_o = tid;
    asm volatile("" : "+v"(tid_o));
    if (item < NPA + NSA) {
      int tq0, qpos0, kvbase, ntb, hd, nq; bool can_skip;
      if (item < NPA) {
        const int qb = 127 - ((item & 255) >> 1), b = item & 1;
        hd = 3 - (item >> 8); tq0 = b * 16384 + qb * 128; qpos0 = qb * 128; kvbase = b * 16384; ntb = 2 * qb + 2; can_skip = true; nq = 4;
      } else {
        const int it = item - NPA, bs = it >> 2;
        hd = it & 3; tq0 = NPTOK + bs * 64; qpos0 = 1024; kvbase = NPTOK + bs * 1088; ntb = 17; can_skip = false; nq = 2;
      }
      attn_item(p, smem, tid_o, tq0, qpos0, kvbase, ntb, hd, lam, can_skip, nq);
    } else {
      const int hf = tid_o >> 8;
      r3_item(p, smem + hf * 65536, tid_o & 255, (item - NPA - NSA) * 2 + hf);
    }
  }
}

DI void phase5(const Params& p, char* smem) {
  float* wsum = (float*)(smem + 132096);
  for (int strip = blockIdx.x; strip < NTOK / 64; strip += gridDim.x) {
    int tid = threadIdx.x;
    asm volatile("" : "+v"(tid));
    const int lane = tid & 63, w = tid >> 6, r = lane & 31, h = lane >> 5;
    const int m0 = strip * 64;
    {
      const u16* gb = p.Mix + (size_t)m0 * 1024;
      const int loff = (tid >> 7) * 1024 + (tid & 127) * 8;
      char* lw = smem + (tid >> 7) * 2064 + (tid & 127) * 16;
#pragma unroll
      for (int i = 0; i < 16; ++i)
        *(u32x4*)(lw + i * 4 * 2064) = __builtin_nontemporal_load((const u32x4*)((gb + i * 4096) + loff));
    }
    f32x16 acc[2][4];
#pragma unroll
    for (int i = 0; i < 2; ++i)
#pragma unroll
      for (int j = 0; j < 4; ++j) acc[i][j] = zero16();
    const u16* bp = p.WoutT + (size_t)(w * 4) * 64 * 512 + lane * 8;
    bf16x8 b[2][4];
#pragma unroll
    for (int u = 0; u < 2; ++u)
#pragma unroll
      for (int j = 0; j < 4; ++j) b[u][j] = *(const bf16x8*)(bp + (size_t)(j * 64 + u) * 512);
    __syncthreads();
    const char* ap = smem + r * 2064 + h * 16;
    for (int ks0 = 0; ks0 < 64; ks0 += 2) {
#pragma unroll
      for (int u = 0; u < 2; ++u) {
        const int ks = ks0 + u;
        const bf16x8 a0 = *(const bf16x8*)(ap + ks * 32), a1 = *(const bf16x8*)(ap + 32 * 2064 + ks * 32);
#pragma unroll
        for (int j = 0; j < 4; ++j) { acc[0][j] = MFMA(a0, b[u][j], acc[0][j]); acc[1][j] = MFMA(a1, b[u][j], acc[1][j]); }
        const int kn = ks + 2 < 64 ? ks + 2 : 63;
#pragma unroll
        for (int j = 0; j < 4; ++j) b[u][j] = *(const bf16x8*)(bp + (size_t)(j * 64 + kn) * 512);
        __builtin_amdgcn_sched_barrier(0);
      }
    }
    const float* xs_u = (m0 < NPTOK ? p.x_prompt : p.x_sample - (size_t)NPTOK * 1024) + (size_t)m0 * 1024;
    const int lane_off = h * 4096 + w * 128 + r;
#pragma unroll
    for (int i = 0; i < 2; ++i) {
      float ps[16];
#pragma unroll
      for (int e = 0; e < 16; ++e) ps[e] = 0.f;
#pragma unroll
      for (int j = 0; j < 4; ++j) {
#pragma unroll
        for (int e = 0; e < 16; ++e) {
          const float hv = acc[i][j][e] + __builtin_nontemporal_load((xs_u + (i * 32 + (e & 3) + 8 * (e >> 2)) * 1024 + j * 32) + lane_off);
          acc[i][j][e] = hv; ps[e] += hv * hv;
        }
        __builtin_amdgcn_sched_barrier(0);
      }
#pragma unroll
      for (int e = 0; e < 16; ++e) {
#pragma unroll
        for (int o = 16; o >= 1; o >>= 1) ps[e] += __shfl_xor(ps[e], o);
      }
      if (r == 0) {
#pragma unroll
        for (int e = 0; e < 16; ++e) wsum[w * 64 + i * 32 + crow(e, h)] = ps[e];
      }
      __builtin_amdgcn_sched_barrier(0);
    }
    __syncthreads();
    float* yo_u = p.out + OFF_Y + (size_t)m0 * 1024;
#pragma unroll
    for (int i = 0; i < 2; ++i) {
      float sc[16];
#pragma unroll
      for (int e = 0; e < 16; ++e) {
        const int rw = i * 32 + crow(e, h);
        float t = 0.f;
#pragma unroll
        for (int k = 0; k < 8; ++k) t += wsum[k * 64 + rw];
        sc[e] = rsqrtf(t * (1.f / 1024.f) + 1e-6f);
      }
#pragma unroll
      for (int j = 0; j < 4; ++j) {
        const float g = (p.final_g + j * 32)[w * 128 + r];
#pragma unroll
        for (int e = 0; e < 16; ++e)
          __builtin_nontemporal_store(acc[i][j][e] * sc[e] * g, (yo_u + (i * 32 + (e & 3) + 8 * (e >> 2)) * 1024 + j * 32) + lane_off);
        __builtin_amdgcn_sched_barrier(0);
      }
    }
    __syncthreads();
  }
}

__global__ void __launch_bounds__(512, 2) fwd_megakernel(Params p) {
  __shared__ __attribute__((aligned(16))) char smem[153600];
  cg::grid_group grid = cg::this_grid();
  float* scratch_out = p.out + OFF_Y;
  const int lo = p.phase_lo, hi = p.phase_hi;
  if (lo <= 0 && hi >= 0) phase0(p, smem);
  if (lo <= 0 && hi >= 1) grid.sync();
  if (lo <= 1 && hi >= 1) phase1(p, smem);
  if (lo <= 1 && hi >= 2) grid.sync();
  if (lo <= 2 && hi >= 2) phase2(p, smem, (u16*)scratch_out);
  if (lo <= 2 && hi >= 3) grid.sync();
  if (lo <= 3 && hi >= 3) phase3(p, (const u16*)scratch_out);
  if (lo <= 3 && hi >= 4) grid.sync();
  if (lo <= 4 && hi >= 4) phase4(p, smem);
  if (lo <= 4 && hi >= 5) grid.sync();
  if (lo <= 5 && hi >= 5) phase5(p, smem);
}

extern "C" void kernel_launch(void* const* d_in, const int* in_sizes, int n_in, void* d_out, int out_size, void* d_ws, size_t ws_size,
                              hipStream_t stream) {
  static int grid_blocks = 0;
  if (!grid_blocks) {
    int dev = 0, cus = 0, per_cu = 0;
    hipGetDevice(&dev);
    hipDeviceGetAttribute(&cus, hipDeviceAttributeMultiprocessorCount, dev);
    hipOccupancyMaxActiveBlocksPerMultiprocessor(&per_cu, fwd_megakernel, 512, 0);
    if (per_cu > 1) per_cu = 1;
    if (per_cu < 1) per_cu = 1;
    grid_blocks = cus * per_cu;
  }
  Params p{};
  p.x_prompt = (const float*)d_in[0]; p.x_sample = (const float*)d_in[1]; p.cache_k = (const float*)d_in[2]; p.cache_v = (const float*)d_in[3];
  p.state_h = (const float*)d_in[4]; p.norm_g = (const float*)d_in[5]; p.w_in = (const float*)d_in[6]; p.lambda_qk = (const float*)d_in[7];
  p.subln_g = (const float*)d_in[8]; p.rec_lb = (const float*)d_in[9]; p.rec_norm_g = (const float*)d_in[10]; p.w_out = (const float*)d_in[11];
  p.final_g = (const float*)d_in[12];
  p.out = (float*)d_out;
  char* ws = (char*)d_ws; size_t off = 0;
  auto take = [&](size_t bytes) { char* r = ws + off; off += (bytes + 255) & ~(size_t)255; return r; };
  p.WinT = (u16*)take((size_t)4096 * 1024 * 2);
  p.WoutT = (u16*)take((size_t)1024 * 1024 * 2);
  p.Xn = (u16*)take((size_t)NTOK * 1024 * 2);
  p.SbufT = p.Xn;
  p.Qb = (u16*)take((size_t)NTOK * 512 * 2);
  p.Kall = (u16*)take((size_t)KVROWS * 512 * 2);
  p.Vall = (u16*)take((size_t)KVROWS * 512 * 2);
  p.Za = (u16*)take((size_t)NTOK * 512 * 2);
  p.Qr = (u16*)take((size_t)NTOK * 512 * 2);
  p.Ir = (u16*)take((size_t)NTOK * 512 * 2);
  p.Zr = (u16*)take((size_t)NTOK * 512 * 2);
  p.Mix = (u16*)take((size_t)NTOK * 1024 * 2);
  p.Fr = (float*)take((size_t)NTOK * 512 * 4);
  p.Abuf = (float*)take((size_t)NITEM * 128 * 4);
  p.NQ = (float*)take((size_t)NITEM * 4 * 4);
  p.counter = (int*)take(256);
  p.phase_lo = 0; p.phase_hi = 6; p.rep_mask = 0; p.pad_ = 0;
  if (off > ws_size) { fprintf(stderr, "workspace too small: need %zu have %zu\n", off, ws_size); return; }
  void* args[] = {&p};
  hipError_t e = hipLaunchCooperativeKernel((void*)fwd_megakernel, dim3(grid_blocks), dim3(512), args, 0, stream);
  if (e != hipSuccess) fprintf(stderr, "cooperative launch failed: %s (grid %d)\n", hipGetErrorString(e), grid_blocks);
}
```

```cpp
#include <hip/hip_runtime.h>
#include <hip/hip_cooperative_groups.h>
#include <cstdio>
namespace cg = cooperative_groups;

#define DI __device__ __forceinline__
typedef unsigned short u16;
using bf16x8 = __attribute__((ext_vector_type(8))) short;
using s16x4  = __attribute__((ext_vector_type(4))) short;
using f32x16 = __attribute__((ext_vector_type(16))) float;
using f32x4  = __attribute__((ext_vector_type(4))) float;
using f32x2  = __attribute__((ext_vector_type(2))) float;
using u32x4  = __attribute__((ext_vector_type(4))) unsigned;
using u32x2  = __attribute__((ext_vector_type(2))) unsigned;
typedef __bf16 bf2_t __attribute__((ext_vector_type(2)));

#define MFMA(a, b, c) __builtin_amdgcn_mfma_f32_32x32x16_bf16((a), (b), (c), 0, 0, 0)

static constexpr int NTOK = 33280;
static constexpr int NPTOK = 32768;
static constexpr int KVROWS = 32768 + 8 * 1088;
static constexpr int NITEM = 2080;
static constexpr size_t OFF_Y = 0;
static constexpr size_t OFF_NKP = 34078720;
static constexpr size_t OFF_NVP = 50855936;
static constexpr size_t OFF_NHP = 67633152;
static constexpr size_t OFF_NKS = 67764224;
static constexpr size_t OFF_NVS = 68026368;
static constexpr size_t OFF_NHS = 68288512;

struct Params {
  const float *x_prompt, *x_sample, *cache_k, *cache_v, *state_h, *norm_g, *w_in, *lambda_qk, *subln_g, *rec_lb, *rec_norm_g, *w_out, *final_g;
  float* out;
  u16 *WinT, *WoutT, *Xn, *Qb, *Kall, *Vall, *Za, *Qr, *Ir, *Zr, *Mix, *SbufT;
  float *Fr, *Abuf, *NQ;
  int* counter;
  int phase_lo, phase_hi, rep_mask, pad_;
};

DI unsigned pack2(float a, float b) { f32x2 v = {a, b}; bf2_t r = __builtin_convertvector(v, bf2_t); return __builtin_bit_cast(unsigned, r); }
DI u16 f2bf(float a) { return (u16)(pack2(a, 0.f) & 0xffffu); }
DI float bflo(unsigned u) { return __uint_as_float(u << 16); }
DI float bfhi(unsigned u) { return __uint_as_float(u & 0xffff0000u); }
DI int crow(int e, int h) { return (e & 3) + 8 * (e >> 2) + 4 * h; }
DI float wave_sum(float v) {
#pragma unroll
  for (int o = 32; o >= 1; o >>= 1) v += __shfl_xor(v, o);
  return v;
}
DI float silu_f(float v) { return v / (1.f + __expf(-v)); }
DI s16x4 tr_read(const char* p) {
  return __builtin_amdgcn_ds_read_tr16_b64_v4i16((__attribute__((address_space(3))) s16x4*)(p));
}
DI bf16x8 tr_frag(const char* p0, int stride4) {
  s16x4 lo = tr_read(p0), hi = tr_read(p0 + stride4);
  return __builtin_shufflevector(lo, hi, 0, 1, 2, 3, 4, 5, 6, 7);
}
DI bf16x8 pack8(const f32x16& x, int s) {
  u32x4 p;
  p[0] = pack2(x[8 * s + 0], x[8 * s + 1]);
  p[1] = pack2(x[8 * s + 2], x[8 * s + 3]);
  p[2] = pack2(x[8 * s + 4], x[8 * s + 5]);
  p[3] = pack2(x[8 * s + 6], x[8 * s + 7]);
  return __builtin_bit_cast(bf16x8, p);
}
DI f32x16 zero16() { f32x16 z; for (int i = 0; i < 16; ++i) z[i] = 0.f; return z; }

DI void phase0(const Params& p, char* smem) {
  const int tid = threadIdx.x, lane = tid & 63, w = tid >> 6;
  constexpr int NT_W1 = 16 * 64, NT_W2 = 16 * 16, NT_ROW = NTOK / 16, NT_CACHE = 1024;
  constexpr int total = NT_W1 + NT_W2 + NT_ROW + NT_CACHE;
  float (*tile)[65] = (float (*)[65])smem;
  if (blockIdx.x == 0 && tid == 0) *p.counter = 0;
  for (int it = blockIdx.x; it < total; it += gridDim.x) {
    if (it < NT_W1 + NT_W2) {
      const float* src; u16* dst; int N, kt, nt;
      if (it < NT_W1) { src = p.w_in; dst = p.WinT; N = 4096; kt = it >> 6; nt = it & 63; }
      else { int j = it - NT_W1; src = p.w_out; dst = p.WoutT; N = 1024; kt = j >> 4; nt = j & 15; }
      const int c = tid & 63, r0 = tid >> 6;
      for (int i = 0; i < 8; ++i) { int r = r0 + 8 * i; tile[r][c] = src[(size_t)(kt * 64 + r) * N + nt * 64 + c]; }
      __syncthreads();
      if (it < NT_W1) {
        for (int i = 0; i < 8; ++i) { int r = r0 + 8 * i; dst[(size_t)(nt * 64 + r) * 1024 + kt * 64 + c] = f2bf(tile[c][r]); }
      } else {
        for (int i = 0; i < 8; ++i) {
          const int r = r0 + 8 * i, n = nt * 64 + r, k = kt * 64 + c;
          dst[((size_t)((n >> 5) * 64 + (k >> 4)) * 64 + ((k >> 3) & 1) * 32 + (n & 31)) * 8 + (k & 7)] = f2bf(tile[c][r]);
        }
      }
      __syncthreads();
    } else if (it < NT_W1 + NT_W2 + NT_ROW) {
      const int row0 = (it - NT_W1 - NT_W2) * 16 + w * 2;
      f32x4 v[2][4]; float ss[2] = {0.f, 0.f};
#pragma unroll
      for (int rr = 0; rr < 2; ++rr) {
        const int row = row0 + rr;
        const float* src = row < NPTOK ? p.x_prompt + (size_t)row * 1024 : p.x_sample + (size_t)(row - NPTOK) * 1024;
#pragma unroll
        for (int i = 0; i < 4; ++i) v[rr][i] = *(const f32x4*)(src + i * 256 + lane * 4);
      }
#pragma unroll
      for (int rr = 0; rr < 2; ++rr) {
#pragma unroll
        for (int i = 0; i < 4; ++i) ss[rr] += v[rr][i][0] * v[rr][i][0] + v[rr][i][1] * v[rr][i][1] + v[rr][i][2] * v[rr][i][2] + v[rr][i][3] * v[rr][i][3];
        ss[rr] = wave_sum(ss[rr]);
      }
#pragma unroll
      for (int rr = 0; rr < 2; ++rr) {
        const float sc = rsqrtf(ss[rr] * (1.f / 1024.f) + 1e-6f);
#pragma unroll
        for (int i = 0; i < 4; ++i) {
          f32x4 g = *(const f32x4*)(p.norm_g + i * 256 + lane * 4);
          u32x2 o; o[0] = pack2(v[rr][i][0] * sc * g[0], v[rr][i][1] * sc * g[1]); o[1] = pack2(v[rr][i][2] * sc * g[2], v[rr][i][3] * sc * g[3]);
          *(u32x2*)(p.Xn + (size_t)(row0 + rr) * 1024 + i * 256 + lane * 4) = o;
        }
      }
    } else {
      const int task0 = (it - NT_W1 - NT_W2 - NT_ROW) * 16 + w * 2;
      f32x4 a[2], b[2];
#pragma unroll
      for (int rr = 0; rr < 2; ++rr) {
        const int task = task0 + rr, which = task >> 13, r8 = task & 8191;
        const float* src = (which ? p.cache_v : p.cache_k) + (size_t)r8 * 512 + lane * 8;
        a[rr] = *(const f32x4*)src; b[rr] = *(const f32x4*)(src + 4);
      }
#pragma unroll
      for (int rr = 0; rr < 2; ++rr) {
        const int task = task0 + rr, which = task >> 13, r8 = task & 8191;
        u16* dst = (which ? p.Vall : p.Kall) + (size_t)(NPTOK + (r8 >> 10) * 1088 + (r8 & 1023)) * 512 + lane * 8;
        u32x4 o; o[0] = pack2(a[rr][0], a[rr][1]); o[1] = pack2(a[rr][2], a[rr][3]); o[2] = pack2(b[rr][0], b[rr][1]); o[3] = pack2(b[rr][2], b[rr][3]);
        *(u32x4*)dst = o;
      }
    }
  }
}

#define G_LOAD(RA, RB, KT_)                                                                                        \
  {                                                                                                                 \
    _Pragma("unroll") for (int i_ = 0; i_ < 4; ++i_) RA[i_] = *(const u32x4*)((ap + (size_t)i_ * 64 * K + (KT_) * 64) + loff); \
    _Pragma("unroll") for (int i_ = 0; i_ < 4; ++i_) RB[i_] = *(const u32x4*)((bp + (size_t)i_ * 64 * K + (KT_) * 64) + loff); \
  }
#define G_WRITE(RA, RB, BUF_)                                                                                      \
  {                                                                                                                 \
    _Pragma("unroll") for (int i_ = 0; i_ < 4; ++i_) *(u32x4*)(wbase + (BUF_) * 73728 + i_ * 64 * 144) = RA[i_];         \
    _Pragma("unroll") for (int i_ = 0; i_ < 4; ++i_) *(u32x4*)(wbase + (BUF_) * 73728 + 36864 + i_ * 64 * 144) = RB[i_]; \
  }
#define G_FRAGS(FA, FB, S_)                                                                                        \
  {                                                                                                                 \
    _Pragma("unroll") for (int i_ = 0; i_ < 4; ++i_) FA[i_] = *(const bf16x8*)(as_ + i_ * 32 * 144 + (S_) * 32);      \
    FB[0] = *(const bf16x8*)(bs_ + (S_) * 32); FB[1] = *(const bf16x8*)(bs_ + 32 * 144 + (S_) * 32);                \
  }
#define G_MFMA8(FA, FB)                                                                                            \
  {                                                                                                                 \
    _Pragma("unroll") for (int i_ = 0; i_ < 4; ++i_) {                                                              \
      acc[i_][0] = MFMA(FA[i_], FB[0], acc[i_][0]);                                                                 \
      acc[i_][1] = MFMA(FA[i_], FB[1], acc[i_][1]);                                                                 \
    }                                                                                                               \
  }
#define G_COMPUTE(BUF_)                                                                                            \
  {                                                                                                                 \
    const char* as_ = smem + (BUF_) * 73728 + (wm * 128 + r) * 144 + h * 16;                                        \
    const char* bs_ = smem + (BUF_) * 73728 + 36864 + (wn * 64 + r) * 144 + h * 16;                                 \
    bf16x8 fa0[4], fb0[2], fa1[4], fb1[2];                                                                          \
    G_FRAGS(fa0, fb0, 0);                                                                                           \
    G_FRAGS(fa1, fb1, 1); __builtin_amdgcn_sched_barrier(0); G_MFMA8(fa0, fb0); __builtin_amdgcn_sched_barrier(0);  \
    G_FRAGS(fa0, fb0, 2); __builtin_amdgcn_sched_barrier(0); G_MFMA8(fa1, fb1); __builtin_amdgcn_sched_barrier(0);  \
    G_FRAGS(fa1, fb1, 3); __builtin_amdgcn_sched_barrier(0); G_MFMA8(fa0, fb0); __builtin_amdgcn_sched_barrier(0);  \
    G_MFMA8(fa1, fb1);                                                                                              \
  }
DI void gemm_preload(const u16* __restrict__ A, const u16* __restrict__ BT, int K, int m0, int n0, int tid, u32x4 (&ra0)[4], u32x4 (&rb0)[4]) {
  const u16* ap = A + (size_t)m0 * K;
  const u16* bp = BT + (size_t)n0 * K;
  const int loff = (tid >> 3) * K + (tid & 7) * 8;
  G_LOAD(ra0, rb0, 0);
}
DI void gemm256(const u16* __restrict__ A, const u16* __restrict__ BT, int K, int m0, int n0, char* smem, int tid, f32x16 (&acc)[4][2],
                u32x4 (&ra0)[4], u32x4 (&rb0)[4]) {
  const int lane = tid & 63, w = tid >> 6, r = lane & 31, h = lane >> 5;
  const int wm = w >> 2, wn = w & 3;
#pragma unroll
  for (int i = 0; i < 4; ++i) { acc[i][0] = zero16(); acc[i][1] = zero16(); }
  const int KT = K >> 6;
  const u16* ap = A + (size_t)m0 * K;
  const u16* bp = BT + (size_t)n0 * K;
  const int loff = (tid >> 3) * K + (tid & 7) * 8;
  char* wbase = smem + (tid >> 3) * 144 + (tid & 7) * 16;
  G_WRITE(ra0, rb0, 0);
  __syncthreads();
  for (int kt = 0; kt < KT; kt += 2) {
    { const int k1 = kt + 1 < KT ? kt + 1 : KT - 1; G_LOAD(ra0, rb0, k1); }
    __builtin_amdgcn_sched_barrier(0);
    G_COMPUTE(0);
    __builtin_amdgcn_sched_barrier(0);
    G_WRITE(ra0, rb0, 1);
    __syncthreads();
    { const int k2 = kt + 2 < KT ? kt + 2 : KT - 1; G_LOAD(ra0, rb0, k2); }
    __builtin_amdgcn_sched_barrier(0);
    G_COMPUTE(1);
    __builtin_amdgcn_sched_barrier(0);
    G_WRITE(ra0, rb0, 0);
    __syncthreads();
  }
}
struct TileMap {
  int MT, NT, C, NG, NST, st, lb, lin;
  bool xcd;
  DI TileMap(int mt_, int nt_) : MT(mt_), NT(nt_) {
    const int nb = gridDim.x >> 3;
    C = nb >> 3;
    xcd = (gridDim.x & 63) == 0 && C > 0 && (NT % C) == 0;
    NG = xcd ? NT / C : 1;
    NST = ((MT + 7) >> 3) * NG;
    st = blockIdx.x & 7; lb = blockIdx.x >> 3; lin = blockIdx.x;
  }
  DI bool next(int& mt, int& nt) {
    if (!xcd) {
      if (lin >= MT * NT) return false;
      mt = lin / NT; nt = lin - mt * NT; lin += gridDim.x; return true;
    }
    while (st < NST) {
      const int mg = st / NG, ng = st - mg * NG;
      mt = mg * 8 + lb / C; nt = ng * C + lb % C;
      st += 8;
      if (mt < MT) return true;
    }
    return false;
  }
};
DI void stage_half(const f32x16 (&acc)[4][2], float* cs, int half, int wm, int wn, int r, int h) {
  if (wm == half) {
#pragma unroll
    for (int i = 0; i < 4; ++i)
#pragma unroll
      for (int j = 0; j < 2; ++j)
#pragma unroll
        for (int e = 0; e < 16; ++e) cs[(i * 32 + crow(e, h)) * 260 + wn * 64 + j * 32 + r] = acc[i][j][e];
  }
}

DI void phase1(const Params& p, char* smem) {
  constexpr int MT = NTOK / 256, NT = 16;
  TileMap tm(MT, NT);
  int mt, nt;
  bool have = tm.next(mt, nt);
  u32x4 pa[4], pb[4];
  if (have) gemm_preload(p.Xn, p.WinT, 1024, mt * 256, nt * 256, threadIdx.x, pa, pb);
  while (have) {
    const int m0 = mt * 256, n0 = nt * 256;
    f32x16 acc[4][2];
    {
      int tg = threadIdx.x;
      asm volatile("" : "+v"(tg));
      gemm256(p.Xn, p.WinT, 1024, m0, n0, smem, tg, acc, pa, pb);
    }
    have = tm.next(mt, nt);
    if (have) {
      int tg = threadIdx.x;
      asm volatile("" : "+v"(tg));
      gemm_preload(p.Xn, p.WinT, 1024, mt * 256, nt * 256, tg, pa, pb);
    }
    int tid = threadIdx.x;
    asm volatile("" : "+v"(tid));
    const int lane = tid & 63, w = tid >> 6, r = lane & 31, h = lane >> 5;
    const int wm = w >> 2, wn = w & 3;
    const int sec = n0 >> 9;
    const bool samp = m0 >= NPTOK;
    float* cs = (float*)smem;
    const int c0 = (tid & 31) * 8, rb = tid >> 5;
    const int csc = (n0 & 511) + c0;
#pragma unroll 1
    for (int half = 0; half < 2; ++half) {
      stage_half(acc, cs, half, wm, wn, r, h);
      __syncthreads();
#pragma unroll 2
      for (int ps = 0; ps < 8; ++ps) {
        const int row = rb + 16 * ps;
        const int t = m0 + half * 128 + row;
        f32x4 va = *(const f32x4*)(cs + row * 260 + c0), vb = *(const f32x4*)(cs + row * 260 + c0 + 4);
        const size_t o512 = (size_t)t * 512 + csc;
        if (sec == 5) { __builtin_nontemporal_store(va, (f32x4*)(p.Fr + o512)); __builtin_nontemporal_store(vb, (f32x4*)(p.Fr + o512 + 4)); }
        else {
          u16* dst;
          if (sec == 0) {
            const float qs = 0.125f * 1.44269504089f;
            va *= qs; vb *= qs; dst = p.Qb + o512;
          } else if (sec == 1 || sec == 2) {
            size_t kvr; float* od;
            if (!samp) { kvr = t; od = p.out + (sec == 1 ? OFF_NKP : OFF_NVP) + o512; }
            else { const int ts = t - NPTOK; kvr = NPTOK + (ts >> 6) * 1088 + 1024 + (ts & 63); od = p.out + (sec == 1 ? OFF_NKS : OFF_NVS) + (size_t)ts * 512 + csc; }
            __builtin_nontemporal_store(va, (f32x4*)od); __builtin_nontemporal_store(vb, (f32x4*)(od + 4));
            dst = (sec == 1 ? p.Kall : p.Vall) + kvr * 512 + csc;
          } else if (sec == 6) { dst = p.Ir + o512; }
          else {
#pragma unroll
            for (int i = 0; i < 4; ++i) { va[i] = silu_f(va[i]); vb[i] = silu_f(vb[i]); }
            dst = (sec == 3 ? p.Za : (sec == 4 ? p.Qr : p.Zr)) + o512;
          }
          u32x4 o; o[0] = pack2(va[0], va[1]); o[1] = pack2(va[2], va[3]); o[2] = pack2(vb[0], vb[1]); o[3] = pack2(vb[2], vb[3]);
          __builtin_nontemporal_store(o, (u32x4*)dst);
        }
      }
      __syncthreads();
    }
  }
}

DI void rec_load(const Params& p, int tid, int I, float (&xv)[32]) {
  const int d = tid & 127, half = tid >> 7;
  const int hd = I & 3, t0 = (I >> 2) * 64;
  const float* fp = p.Fr + (size_t)(t0 + half * 32) * 512 + hd * 128 + d;
#pragma unroll
  for (int i = 0; i < 32; ++i) xv[i] = fp[(size_t)i * 512];
}
DI void rec_pre_x(const Params& p, int tid, int I, float* totS, const float (&xv)[32], float (&cum)[32], float (&key)[32], float& lastv) {
  const int d = tid & 127, half = tid >> 7;
  const int hd = I & 3;
  const float r0 = p.rec_lb[hd * 128 + d], r1 = p.rec_lb[512 + hd * 128 + d];
  const float lb = 1.f / (1.f + __expf(r1 - r0));
  float run = 0.f;
#pragma unroll
  for (int i = 0; i < 32; ++i) {
    float x = xv[i];
    x = fminf(fmaxf(x, -30.f), 30.f);
    const float e = __expf(-x), sg = 1.f / (1.f + e);
    run += __logf(lb + (1.f - lb) * sg);
    cum[i] = run; key[i] = (1.f - lb) * e * sg;
  }
  totS[tid] = run;
  __syncthreads();
  const float tot0 = totS[d], tot1 = totS[128 + d];
  if (half) {
#pragma unroll
    for (int i = 0; i < 32; ++i) cum[i] += tot0;
  }
  lastv = tot0 + tot1;
}
DI void rec_pre(const Params& p, int tid, int I, float* totS, float (&cum)[32], float (&key)[32], float& lastv) {
  float xv[32];
  rec_load(p, tid, I, xv);
  rec_pre_x(p, tid, I, totS, xv, cum, key, lastv);
}

DI void phase2(const Params& p, char* smem0, u16* BbufT) {
  const int hf = threadIdx.x >> 8;
  const int tid = threadIdx.x & 255, lane = tid & 63, w = tid >> 6, r = lane & 31, h = lane >> 5;
  const int q = (lane & 15) >> 2, pp = lane & 3, blk = (lane >> 4) & 1;
  const int d = tid & 127, half = tid >> 7;
  char* smem = smem0 + hf * 65536;
  char* KdI = smem; char* VrI = smem + 17408; float* totS = (float*)(smem + 60000);
  float xv[32];
  rec_load(p, tid, blockIdx.x * 2 + hf < NITEM ? blockIdx.x * 2 + hf : NITEM - 1, xv);
  for (int I = blockIdx.x * 2 + hf; I < NITEM; I += gridDim.x * 2) {
    const int hd = I & 3, t0 = (I >> 2) * 64;
    if (I < 2048) {
      const int token = tid & 63, which = tid >> 6;
      const u16* src = (which < 2 ? p.Qb : p.Kall) + (size_t)(t0 + token) * 512 + hd * 128 + (which & 1) * 64;
      float ss = 0.f;
#pragma unroll
      for (int c = 0; c < 8; ++c) {
        const u32x4 v = *(const u32x4*)(src + c * 8);
#pragma unroll
        for (int i = 0; i < 4; ++i) { const float lo = bflo(v[i]), hi = bfhi(v[i]); ss += lo * lo + hi * hi; }
      }
#pragma unroll
      for (int o = 32; o >= 1; o >>= 1) ss = fmaxf(ss, __shfl_xor(ss, o));
      if (lane == 0) p.NQ[I * 4 + which] = sqrtf(ss);
    }
    float cum[32], key[32], lastv;
    rec_pre_x(p, tid, I, totS, xv, cum, key, lastv);
    {
      const int In = I + gridDim.x * 2;
      rec_load(p, tid, In < NITEM ? In : I, xv);
    }
#pragma unroll
    for (int i = 0; i < 32; ++i) {
      const int t = half * 32 + i;
      *(u16*)(KdI + t * 272 + d * 2) = f2bf(key[i] * __expf(lastv - cum[i]));
    }
#pragma unroll
    for (int i = 0; i < 4; ++i) {
      const int ch = tid + 256 * i, row = ch >> 4, cc = ch & 15;
      *(u32x4*)(VrI + row * 272 + cc * 16) = *(const u32x4*)(p.Ir + (size_t)(t0 + row) * 512 + hd * 128 + cc * 8);
    }
    if (half) p.Abuf[I * 128 + d] = __expf(lastv);
    __syncthreads();
    f32x16 acc[4];
#pragma unroll
    for (int ct = 0; ct < 4; ++ct) acc[ct] = zero16();
#pragma unroll
    for (int ks = 0; ks < 4; ++ks) {
      const int rowoff = (16 * ks + 8 * h + q) * 272 + 32 * blk + 8 * pp;
      bf16x8 a = tr_frag(VrI + rowoff + 64 * w, 4 * 272);
#pragma unroll
      for (int ct = 0; ct < 4; ++ct) {
        bf16x8 b = tr_frag(KdI + rowoff + 64 * ct, 4 * 272);
        acc[ct] = MFMA(a, b, acc[ct]);
      }
    }
    u16* ob = BbufT + (size_t)I * 16384;
#pragma unroll
    for (int ct = 0; ct < 4; ++ct)
#pragma unroll
      for (int e = 0; e < 16; ++e) ob[(32 * w + crow(e, h)) * 128 + 32 * ct + r] = f2bf(acc[ct][e]);
    __syncthreads();
  }
}

DI void phase3(const Params& p, const u16* BbufT) {
  const int tid = threadIdx.x & 255;
  for (int it = blockIdx.x * 2 + (threadIdx.x >> 8); it < 512 + 1024; it += gridDim.x * 2) {
    if (it < 512) {
      const int bh = it >> 6, b = bh >> 2, hd = bh & 3;
      const int e1 = (it & 63) * 256 + tid, v = e1 >> 7, d = e1 & 127;
      float sx = 0.f;
      const size_t eo = (size_t)v * 128 + d;
      const int I0 = (b * 256) * 4 + hd;
      const float* ap = p.Abuf + (size_t)I0 * 128 + d;
      const u16* bp = BbufT + (size_t)I0 * 16384 + eo;
      u16* sp = p.SbufT + (size_t)I0 * 16384 + eo;
      for (int c0 = 0; c0 < 256; c0 += 16) {
        float av[16]; u16 bw[16];
#pragma unroll
        for (int i = 0; i < 16; ++i) { av[i] = ap[(size_t)(c0 + i) * 4 * 128]; bw[i] = bp[(size_t)(c0 + i) * 4 * 16384]; }
#pragma unroll
        for (int i = 0; i < 16; ++i) {
          sp[(size_t)(c0 + i) * 4 * 16384] = f2bf(sx);
          sx = av[i] * sx + bflo(bw[i]);
        }
      }
      p.out[OFF_NHP + (size_t)(b * 4 + hd) * 16384 + d * 128 + v] = sx;
    } else {
      const int j = it - 512;
      const int sh = j >> 5, bs = sh >> 2, hd = sh & 3;
      const int e2 = (j & 31) * 256 + tid, v = e2 >> 6, d2 = (e2 & 63) * 2;
      const int I = (512 + bs) * 4 + hd;
      const float* sh0 = p.state_h + (size_t)(bs * 4 + hd) * 16384;
      float sx = sh0[d2 * 128 + v], sy = sh0[(d2 + 1) * 128 + v];
      const size_t eo = (size_t)v * 128 + d2;
      const f32x2 a = *(const f32x2*)(p.Abuf + I * 128 + d2);
      const unsigned bw = *(const unsigned*)(BbufT + (size_t)I * 16384 + eo);
      *(unsigned*)(p.SbufT + (size_t)I * 16384 + eo) = pack2(sx, sy);
      sx = a[0] * sx + bflo(bw); sy = a[1] * sy + bfhi(bw);
      float* oh = p.out + OFF_NHS + (size_t)(bs * 4 + hd) * 16384;
      oh[d2 * 128 + v] = sx; oh[(d2 + 1) * 128 + v] = sy;
    }
  }
}

DI void r3_item(const Params& p, char* smem, int tid, int I) {
  const int lane = tid & 63, w = tid >> 6, r = lane & 31, h = lane >> 5;
  const int q = (lane & 15) >> 2, pp = lane & 3, blk = (lane >> 4) & 1;
  const int d = tid & 127, half = tid >> 7;
  char* QdI = smem; char* KdI = smem + 17408; char* VrI = smem + 34816;
  float* totS = (float*)(smem + 60000); float* ssS = (float*)(smem + 62048);
  const int hd = I & 3, t0 = (I >> 2) * 64;
  {
    float cum[32], key[32], lastv;
    rec_pre(p, tid, I, totS, cum, key, lastv);
    const u16* qp = p.Qr + (size_t)(t0 + half * 32) * 512 + hd * 128 + d;
#pragma unroll
    for (int i = 0; i < 32; ++i) {
      const int t = half * 32 + i;
      const float qv = bflo(qp[(size_t)i * 512]);
      *(u16*)(QdI + t * 272 + d * 2) = f2bf(qv * __expf(cum[i]));
      *(u16*)(KdI + t * 272 + d * 2) = f2bf(key[i] * __expf(-cum[i]));
    }
  }
#pragma unroll
  for (int i = 0; i < 4; ++i) {
    const int ch = tid + 256 * i, row = ch >> 4, cc = ch & 15;
    *(u32x4*)(VrI + row * 272 + cc * 16) = *(const u32x4*)(p.Ir + (size_t)(t0 + row) * 512 + hd * 128 + cc * 8);
  }
  __syncthreads();
  const int tt = w & 1, vh = w >> 1;
  bf16x8 qf[8];
#pragma unroll
  for (int ks = 0; ks < 8; ++ks) qf[ks] = *(const bf16x8*)(QdI + (32 * tt + r) * 272 + ks * 32 + h * 16);
  f32x16 sc[2]; sc[0] = zero16(); sc[1] = zero16();
#pragma unroll
  for (int ks = 0; ks < 8; ++ks) {
    bf16x8 a0 = *(const bf16x8*)(KdI + r * 272 + ks * 32 + h * 16);
    sc[0] = MFMA(a0, qf[ks], sc[0]);
  }
  if (tt == 1) {
#pragma unroll
    for (int ks = 0; ks < 8; ++ks) {
      bf16x8 a1 = *(const bf16x8*)(KdI + (32 + r) * 272 + ks * 32 + h * 16);
      sc[1] = MFMA(a1, qf[ks], sc[1]);
    }
  }
#pragma unroll
  for (int e = 0; e < 16; ++e) {
    const bool keep = crow(e, h) <= r;
    if (tt == 0) { if (!keep) sc[0][e] = 0.f; }
    else { if (!keep) sc[1][e] = 0.f; }
  }
  bf16x8 pf[4];
  pf[0] = pack8(sc[0], 0); pf[1] = pack8(sc[0], 1); pf[2] = pack8(sc[1], 0); pf[3] = pack8(sc[1], 1);
  f32x16 o[2]; o[0] = zero16(); o[1] = zero16();
  const u16* sp = p.SbufT + (size_t)I * 16384;
#pragma unroll
  for (int vi = 0; vi < 2; ++vi) {
    const int vt = 2 * vh + vi;
#pragma unroll
    for (int k4 = 0; k4 < 4; ++k4) {
      if (k4 < 2 || tt == 1) {
        bf16x8 a = tr_frag(VrI + (16 * k4 + 4 * h + q) * 272 + (32 * vt + 16 * blk) * 2 + 8 * pp, 8 * 272);
        o[vi] = MFMA(a, pf[k4], o[vi]);
      }
    }
#pragma unroll
    for (int ks = 0; ks < 8; ++ks) {
      bf16x8 a = *(const bf16x8*)(sp + (size_t)(32 * vt + r) * 128 + ks * 16 + h * 8);
      o[vi] = MFMA(a, qf[ks], o[vi]);
    }
  }
  float ss = 0.f;
#pragma unroll
  for (int vi = 0; vi < 2; ++vi)
#pragma unroll
    for (int e = 0; e < 16; ++e) ss += o[vi][e] * o[vi][e];
  ss += __shfl_xor(ss, 32);
  if (h == 0) ssS[w * 32 + r] = ss;
  __syncthreads();
  const float tot = ssS[tt * 32 + r] + ssS[(tt + 2) * 32 + r];
  const float rs = rsqrtf(tot * (1.f / 128.f) + 1e-6f);
  const int tok = t0 + 32 * tt + r;
#pragma unroll
  for (int vi = 0; vi < 2; ++vi)
#pragma unroll
    for (int g = 0; g < 4; ++g) {
      const int v = 32 * (2 * vh + vi) + 8 * g + 4 * h;
      const f32x4 gg = *(const f32x4*)(p.rec_norm_g + v);
      const u32x2 z = *(const u32x2*)(p.Zr + (size_t)tok * 512 + hd * 128 + v);
      u32x2 ov;
      ov[0] = pack2(o[vi][4 * g + 0] * rs * gg[0] * bflo(z[0]), o[vi][4 * g + 1] * rs * gg[1] * bfhi(z[0]));
      ov[1] = pack2(o[vi][4 * g + 2] * rs * gg[2] * bflo(z[1]), o[vi][4 * g + 3] * rs * gg[3] * bfhi(z[1]));
      *(u32x2*)(p.Mix + (size_t)tok * 1024 + 512 + hd * 128 + v) = ov;
    }
  __syncthreads();
}

template <bool DIAG>
DI void attn_tile_a(const char* ks, const bf16x8 (&qf)[4], f32x16 (&O)[4], bf16x8 (&pf)[4], float& mrun, float& lsum, float sl2, float qrel,
                    int m, int r, int h2) {
  f32x16 S[2];
#pragma unroll
  for (int st = 0; st < 2; ++st) {
    S[st] = zero16();
#pragma unroll
    for (int s = 0; s < 4; ++s) {
      bf16x8 a = *(const bf16x8*)(ks + (32 * st + r) * 272 + m * 128 + s * 32 + h2 * 16);
      S[st] = MFMA(a, qf[s], S[st]);
    }
  }
  float mx = -1e30f;
#pragma unroll
  for (int st = 0; st < 2; ++st)
#pragma unroll
    for (int e = 0; e < 16; ++e) {
      const float cst = (float)(32 * st + (e & 3) + 8 * (e >> 2));
      float sv;
      if (DIAG) sv = fmaf(-sl2, fabsf(qrel - cst), S[st][e]);
      else sv = fmaf(sl2, cst, S[st][e]);
      S[st][e] = sv; mx = fmaxf(mx, sv);
    }
  const float L = DIAG ? 0.f : -sl2 * qrel;
  mx += L;
  mx = fmaxf(mx, __shfl_xor(mx, 32));
  if (__builtin_amdgcn_ballot_w64(mx > mrun + 6.f) != 0) {
    const float mnew = fmaxf(mrun, mx);
    const float alpha = __builtin_amdgcn_exp2f(mrun - mnew);
    mrun = mnew; lsum *= alpha;
#pragma unroll
    for (int vt = 0; vt < 4; ++vt)
#pragma unroll
      for (int e = 0; e < 16; ++e) O[vt][e] *= alpha;
  }
  const float off = L - mrun;
  float rs = 0.f;
#pragma unroll
  for (int st = 0; st < 2; ++st)
#pragma unroll
    for (int e = 0; e < 16; ++e) { const float pv = __builtin_amdgcn_exp2f(S[st][e] + off); S[st][e] = pv; rs += pv; }
  lsum += rs;
  pf[0] = pack8(S[0], 0); pf[1] = pack8(S[0], 1); pf[2] = pack8(S[1], 0); pf[3] = pack8(S[1], 1);
}
template <bool DIAG>
DI void attn_tile_f(const char* ks, const bf16x8 (&qf)[4], bf16x8 (&pf)[4], float& lsum, float sl2, float qrel, float mref, int m, int r, int h2) {
  f32x16 S[2];
  const float offL = -sl2 * qrel - mref;
#pragma unroll
  for (int st = 0; st < 2; ++st) {
#pragma unroll
    for (int e = 0; e < 16; ++e) {
      const float cst = (float)(32 * st + (e & 3) + 8 * (e >> 2));
      S[st][e] = DIAG ? (-sl2 * fabsf(qrel - cst) - mref) : fmaf(sl2, cst, offL);
    }
#pragma unroll
    for (int s = 0; s < 4; ++s) {
      bf16x8 a = *(const bf16x8*)(ks + (32 * st + r) * 272 + m * 128 + s * 32 + h2 * 16);
      S[st] = MFMA(a, qf[s], S[st]);
    }
  }
  float rs = 0.f;
#pragma unroll
  for (int st = 0; st < 2; ++st)
#pragma unroll
    for (int e = 0; e < 16; ++e) { const float pv = __builtin_amdgcn_exp2f(S[st][e]); S[st][e] = pv; rs += pv; }
  lsum += rs;
  pf[0] = pack8(S[0], 0); pf[1] = pack8(S[0], 1); pf[2] = pack8(S[1], 0); pf[3] = pack8(S[1], 1);
}
DI void attn_tile_b(const char* vs, const bf16x8 (&pf)[4], f32x16 (&O)[4], int h2, int q, int pp, int blk) {
  const char* vb = vs + (4 * h2 + q) * 320 + 32 * blk + 8 * pp;
  bf16x8 a0[4], a1[4];
#pragma unroll
  for (int vt = 0; vt < 4; ++vt) a0[vt] = tr_frag(vb + 64 * vt, 8 * 320);
  __builtin_amdgcn_sched_barrier(0);
#pragma unroll
  for (int vt = 0; vt < 4; ++vt) a1[vt] = tr_frag(vb + 16 * 320 + 64 * vt, 8 * 320);
#pragma unroll
  for (int vt = 0; vt < 4; ++vt) O[vt] = MFMA(a0[vt], pf[0], O[vt]);
  __builtin_amdgcn_sched_barrier(0);
#pragma unroll
  for (int vt = 0; vt < 4; ++vt) a0[vt] = tr_frag(vb + 32 * 320 + 64 * vt, 8 * 320);
#pragma unroll
  for (int vt = 0; vt < 4; ++vt) O[vt] = MFMA(a1[vt], pf[1], O[vt]);
  __builtin_amdgcn_sched_barrier(0);
#pragma unroll
  for (int vt = 0; vt < 4; ++vt) a1[vt] = tr_frag(vb + 48 * 320 + 64 * vt, 8 * 320);
#pragma unroll
  for (int vt = 0; vt < 4; ++vt) O[vt] = MFMA(a0[vt], pf[2], O[vt]);
  __builtin_amdgcn_sched_barrier(0);
#pragma unroll
  for (int vt = 0; vt < 4; ++vt) O[vt] = MFMA(a1[vt], pf[3], O[vt]);
}

DI void attn_item(const Params& p, char* smem, int tid, int tq0, int qpos0, int kvbase, int ntb, int hd, float lam, bool can_skip, int nq) {
  const int lane = tid & 63, w = tid >> 6, r = lane & 31, h2 = lane >> 5;
  const int q = (lane & 15) >> 2, pp = lane & 3, blk = (lane >> 4) & 1;
  const int qg = w & 3, m = w >> 2, ch = qg >> 1;
  const bool wact = qg < nq;
  const float sl2 = exp2f(-2.f * (float)(hd + 1)) * 1.44269504089f;
  const int qtok = tq0 + 32 * qg + r;
  const float qposf = (float)(qpos0 + 32 * qg + r);
  const int ntw = can_skip ? ntb - 1 + ch : ntb;
  int kt0w = 0, kt0b = 0;
  bool fast = false; float kn_w = 0.f;
  if (can_skip) {
    const int I0 = (tq0 >> 6) * 4 + hd;
    const int crk = kvbase >> 6;
    fast = true; kt0b = ntb;
#pragma unroll
    for (int mm = 0; mm < 2; ++mm) {
      float KN = 0.f;
      for (int c = lane; c < ntb; c += 64) KN = fmaxf(KN, p.NQ[((crk + c) * 4 + hd) * 4 + 2 + mm]);
#pragma unroll
      for (int o = 32; o >= 1; o >>= 1) KN = fmaxf(KN, __shfl_xor(KN, o));
#pragma unroll
      for (int cc = 0; cc < 2; ++cc) {
        const float QN = p.NQ[(I0 + 4 * cc) * 4 + mm];
        const float D = (2.02f * QN * KN + 66.f) / sl2;
        const float f = ((float)(qpos0 + 64 * cc - 63) - D) * (1.f / 64.f);
        const int k0 = f < 0.f ? 0 : (int)f + 1;
        kt0b = k0 < kt0b ? k0 : kt0b;
        fast = fast && (2.02f * QN * KN < 60.f);
        if (mm == m && cc == ch) { kt0w = k0; kn_w = KN; }
      }
    }
  }
  bf16x8 qf[4];
  if (wact) {
#pragma unroll
    for (int s = 0; s < 4; ++s) qf[s] = *(const bf16x8*)(p.Qb + (size_t)qtok * 512 + hd * 128 + m * 64 + 16 * s + 8 * h2);
  } else {
#pragma unroll
    for (int s = 0; s < 4; ++s) qf[s] = (bf16x8){0, 0, 0, 0, 0, 0, 0, 0};
  }
  float mref = 0.f;
  if (fast) {
    float qq = 0.f;
#pragma unroll
    for (int s = 0; s < 4; ++s) {
      const u32x4 u = __builtin_bit_cast(u32x4, qf[s]);
#pragma unroll
      for (int i = 0; i < 4; ++i) { const float lo = bflo(u[i]), hi = bfhi(u[i]); qq += lo * lo + hi * hi; }
    }
    qq += __shfl_xor(qq, 32);
    mref = sqrtf(qq) * kn_w * 1.01f + 0.5f;
  }
  f32x16 O[4];
#pragma unroll
  for (int vt = 0; vt < 4; ++vt) O[vt] = zero16();
  float mrun = -1e30f, lsum = 0.f;
  u32x4 rk[2], rv[2];
  const int lrow = tid >> 4, lcc = tid & 15;
  const size_t gofs = (size_t)(kvbase + lrow) * 512 + hd * 128 + lcc * 8;
  const u16* kp = p.Kall + gofs;
  const u16* vp = p.Vall + gofs;
  char* kw = smem + lrow * 272 + lcc * 16;
  char* vw = smem + 17408 + lrow * 320 + lcc * 16;
  const int nit = ntb - kt0b;
  {
    const size_t go = (size_t)(fast ? kt0b : ntb - 1) * 64 * 512;
#pragma unroll
    for (int i = 0; i < 2; ++i) { rk[i] = *(const u32x4*)(kp + go + (size_t)i * 32 * 512); rv[i] = *(const u32x4*)(vp + go + (size_t)i * 32 * 512); }
#pragma unroll
    for (int i = 0; i < 2; ++i) { *(u32x4*)(kw + i * 32 * 272) = rk[i]; *(u32x4*)(vw + i * 32 * 320) = rv[i]; }
    const int k1 = fast ? (kt0b + 1 < ntb ? kt0b + 1 : ntb - 1) : (ntb - 2 > kt0b ? ntb - 2 : kt0b);
    const size_t g1 = (size_t)k1 * 64 * 512;
#pragma unroll
    for (int i = 0; i < 2; ++i) { rk[i] = *(const u32x4*)(kp + g1 + (size_t)i * 32 * 512); rv[i] = *(const u32x4*)(vp + g1 + (size_t)i * 32 * 512); }
  }
  __syncthreads();
  if (fast) {
    for (int it = 0; it < nit; ++it) {
      const int kt = kt0b + it;
      const bool active = wact && kt >= kt0w && kt < ntw;
      const char* ks = smem + (it & 1) * 37888;
      char* wb = kw + ((it + 1) & 1) * 37888;
      char* wbv = vw + ((it + 1) & 1) * 37888;
#pragma unroll
      for (int i = 0; i < 2; ++i) { *(u32x4*)(wb + i * 32 * 272) = rk[i]; *(u32x4*)(wbv + i * 32 * 320) = rv[i]; }
      {
        const int k2 = kt + 2 < ntb ? kt + 2 : ntb - 1;
        const size_t g2 = (size_t)k2 * 64 * 512;
#pragma unroll
        for (int i = 0; i < 2; ++i) { rk[i] = *(const u32x4*)(kp + g2 + (size_t)i * 32 * 512); rv[i] = *(const u32x4*)(vp + g2 + (size_t)i * 32 * 512); }
      }
      __builtin_amdgcn_sched_barrier(0);
      if (active) {
        bf16x8 pf[4];
        const float qrel = qposf - (float)(kt * 64 + 4 * h2);
        if (kt == ntw - 1) attn_tile_f<true>(ks, qf, pf, lsum, sl2, qrel, mref, m, r, h2);
        else attn_tile_f<false>(ks, qf, pf, lsum, sl2, qrel, mref, m, r, h2);
        attn_tile_b(ks + 17408, pf, O, h2, q, pp, blk);
      }
      __syncthreads();
    }
  } else {
    for (int it = 0; it < nit; ++it) {
      const int kt = ntb - 1 - it;
      const bool active = wact && kt >= kt0w && kt < ntw;
      const char* ks = smem + (it & 1) * 37888;
      char* wb = kw + ((it + 1) & 1) * 37888;
      char* wbv = vw + ((it + 1) & 1) * 37888;
#pragma unroll
      for (int i = 0; i < 2; ++i) { *(u32x4*)(wb + i * 32 * 272) = rk[i]; *(u32x4*)(wbv + i * 32 * 320) = rv[i]; }
      {
        const int k2 = kt - 2 > kt0b ? kt - 2 : kt0b;
        const size_t g2 = (size_t)k2 * 64 * 512;
#pragma unroll
        for (int i = 0; i < 2; ++i) { rk[i] = *(const u32x4*)(kp + g2 + (size_t)i * 32 * 512); rv[i] = *(const u32x4*)(vp + g2 + (size_t)i * 32 * 512); }
      }
      __builtin_amdgcn_sched_barrier(0);
      if (active) {
        bf16x8 pf[4];
        const float qrel = qposf - (float)(kt * 64 + 4 * h2);
        if (kt == ntw - 1) attn_tile_a<true>(ks, qf, O, pf, mrun, lsum, sl2, qrel, m, r, h2);
        else attn_tile_a<false>(ks, qf, O, pf, mrun, lsum, sl2, qrel, m, r, h2);
        attn_tile_b(ks + 17408, pf, O, h2, q, pp, blk);
      }
      __syncthreads();
    }
  }
  const float lt = lsum + __shfl_xor(lsum, 32);
  const float inv = wact ? 1.f / lt : 0.f;
  float* exch = (float*)smem + qg * 4096 + lane;
  if (m == 1) {
#pragma unroll
    for (int vt = 0; vt < 4; ++vt)
#pragma unroll
      for (int e = 0; e < 16; ++e) exch[(vt * 16 + e) * 64] = O[vt][e] * inv;
  }
  __syncthreads();
  if (m == 0 && wact) {
    float ss = 0.f;
#pragma unroll
    for (int vt = 0; vt < 4; ++vt)
#pragma unroll
      for (int e = 0; e < 16; ++e) { const float ov = O[vt][e] * inv - lam * exch[(vt * 16 + e) * 64]; O[vt][e] = ov; ss += ov * ov; }
    ss += __shfl_xor(ss, 32);
    const float rsn = rsqrtf(ss * (1.f / 128.f) + 1e-6f) * 0.8f;
#pragma unroll
    for (int vt = 0; vt < 4; ++vt)
#pragma unroll
      for (int g = 0; g < 4; ++g) {
        const int v = 32 * vt + 8 * g + 4 * h2;
        const f32x4 gg = *(const f32x4*)(p.subln_g + v);
        const u32x2 z = *(const u32x2*)(p.Za + (size_t)qtok * 512 + hd * 128 + v);
        u32x2 ov;
        ov[0] = pack2(O[vt][4 * g + 0] * rsn * gg[0] * bflo(z[0]), O[vt][4 * g + 1] * rsn * gg[1] * bfhi(z[0]));
        ov[1] = pack2(O[vt][4 * g + 2] * rsn * gg[2] * bflo(z[1]), O[vt][4 * g + 3] * rsn * gg[3] * bfhi(z[1]));
        *(u32x2*)(p.Mix + (size_t)qtok * 1024 + hd * 128 + v) = ov;
      }
  }
  __syncthreads();
}

DI void phase4(const Params& p, char* smem) {
  const int tid = threadIdx.x, lane = tid & 63;
  float lam;
  {
    const float a = p.lambda_qk[lane] * p.lambda_qk[64 + lane];
    const float b = p.lambda_qk[128 + lane] * p.lambda_qk[192 + lane];
    lam = __expf(wave_sum(a)) - __expf(wave_sum(b)) + 0.2f;
  }
  int* sitem = (int*)(smem + 153584);
  constexpr int NPA = 1024, NSA = 32, TOTAL = NPA + NSA + NITEM / 2;
  for (;;) {
    if (tid == 0) *sitem = atomicAdd(p.counter, 1);
    __syncthreads();
    const int item = *sitem;
    __syncthreads();
    if (item >= TOTAL) break;
    int tid_o = tid;
    asm volatile("" : "+v"(tid_o));
    if (item < NPA + NSA) {
      int tq0, qpos0, kvbase, ntb, hd, nq; bool can_skip;
      if (item < NPA) {
        const int qb = 127 - ((item & 255) >> 1), b = item & 1;
        hd = 3 - (item >> 8); tq0 = b * 16384 + qb * 128; qpos0 = qb * 128; kvbase = b * 16384; ntb = 2 * qb + 2; can_skip = true; nq = 4;
      } else {
        const int it = item - NPA, bs = it >> 2;
        hd = it & 3; tq0 = NPTOK + bs * 64; qpos0 = 1024; kvbase = NPTOK + bs * 1088; ntb = 17; can_skip = false; nq = 2;
      }
      attn_item(p, smem, tid_o, tq0, qpos0, kvbase, ntb, hd, lam, can_skip, nq);
    } else {
      const int hf = tid_o >> 8;
      r3_item(p, smem + hf * 65536, tid_o & 255, (item - NPA - NSA) * 2 + hf);
    }
  }
}

DI void phase5(const Params& p, char* smem) {
  float* wsum = (float*)(smem + 132096);
  for (int strip = blockIdx.x; strip < NTOK / 64; strip += gridDim.x) {
    int tid = threadIdx.x;
    asm volatile("" : "+v"(tid));
    const int lane = tid & 63, w = tid >> 6, r = lane & 31, h = lane >> 5;
    const int m0 = strip * 64;
    {
      const u16* gb = p.Mix + (size_t)m0 * 1024;
      const int loff = (tid >> 7) * 1024 + (tid & 127) * 8;
      char* lw = smem + (tid >> 7) * 2064 + (tid & 127) * 16;
#pragma unroll
      for (int i = 0; i < 16; ++i)
        *(u32x4*)(lw + i * 4 * 2064) = __builtin_nontemporal_load((const u32x4*)((gb + i * 4096) + loff));
    }
    f32x16 acc[2][4];
#pragma unroll
    for (int i = 0; i < 2; ++i)
#pragma unroll
      for (int j = 0; j < 4; ++j) acc[i][j] = zero16();
    const u16* bp = p.WoutT + (size_t)(w * 4) * 64 * 512 + lane * 8;
    bf16x8 b[2][4];
#pragma unroll
    for (int u = 0; u < 2; ++u)
#pragma unroll
      for (int j = 0; j < 4; ++j) b[u][j] = *(const bf16x8*)(bp + (size_t)(j * 64 + u) * 512);
    __syncthreads();
    const char* ap = smem + r * 2064 + h * 16;
    for (int ks0 = 0; ks0 < 64; ks0 += 2) {
#pragma unroll
      for (int u = 0; u < 2; ++u) {
        const int ks = ks0 + u;
        const bf16x8 a0 = *(const bf16x8*)(ap + ks * 32), a1 = *(const bf16x8*)(ap + 32 * 2064 + ks * 32);
#pragma unroll
        for (int j = 0; j < 4; ++j) { acc[0][j] = MFMA(a0, b[u][j], acc[0][j]); acc[1][j] = MFMA(a1, b[u][j], acc[1][j]); }
        const int kn = ks + 2 < 64 ? ks + 2 : 63;
#pragma unroll
        for (int j = 0; j < 4; ++j) b[u][j] = *(const bf16x8*)(bp + (size_t)(j * 64 + kn) * 512);
        __builtin_amdgcn_sched_barrier(0);
      }
    }
    const float* xs_u = (m0 < NPTOK ? p.x_prompt : p.x_sample - (size_t)NPTOK * 1024) + (size_t)m0 * 1024;
    const int lane_off = h * 4096 + w * 128 + r;
#pragma unroll
    for (int i = 0; i < 2; ++i) {
      float ps[16];
#pragma unroll
      for (int e = 0; e < 16; ++e) ps[e] = 0.f;
#pragma unroll
      for (int j = 0; j < 4; ++j) {
#pragma unroll
        for (int e = 0; e < 16; ++e) {
          const float hv = acc[i][j][e] + __builtin_nontemporal_load((xs_u + (i * 32 + (e & 3) + 8 * (e >> 2)) * 1024 + j * 32) + lane_off);
          acc[i][j][e] = hv; ps[e] += hv * hv;
        }
        __builtin_amdgcn_sched_barrier(0);
      }
#pragma unroll
      for (int e = 0; e < 16; ++e) {
#pragma unroll
        for (int o = 16; o >= 1; o >>= 1) ps[e] += __shfl_xor(ps[e], o);
      }
      if (r == 0) {
#pragma unroll
        for (int e = 0; e < 16; ++e) wsum[w * 64 + i * 32 + crow(e, h)] = ps[e];
      }
      __builtin_amdgcn_sched_barrier(0);
    }
    __syncthreads();
    float* yo_u = p.out + OFF_Y + (size_t)m0 * 1024;
#pragma unroll
    for (int i = 0; i < 2; ++i) {
      float sc[16];
#pragma unroll
      for (int e = 0; e < 16; ++e) {
        const int rw = i * 32 + crow(e, h);
        float t = 0.f;
#pragma unroll
        for (int k = 0; k < 8; ++k) t += wsum[k * 64 + rw];
        sc[e] = rsqrtf(t * (1.f / 1024.f) + 1e-6f);
      }
#pragma unroll
      for (int j = 0; j < 4; ++j) {
        const float g = (p.final_g + j * 32)[w * 128 + r];
#pragma unroll
        for (int e = 0; e < 16; ++e)
          __builtin_nontemporal_store(acc[i][j][e] * sc[e] * g, (yo_u + (i * 32 + (e & 3) + 8 * (e >> 2)) * 1024 + j * 32) + lane_off);
        __builtin_amdgcn_sched_barrier(0);
      }
    }
    __syncthreads();
  }
}

__global__ void __launch_bounds__(512, 2) fwd_megakernel(Params p) {
  __shared__ __attribute__((aligned(16))) char smem[153600];
  cg::grid_group grid = cg::this_grid();
  float* scratch_out = p.out + OFF_Y;
  const int lo = p.phase_lo, hi = p.phase_hi;
  if (lo <= 0 && hi >= 0) phase0(p, smem);
  if (lo <= 0 && hi >= 1) grid.sync();
  if (lo <= 1 && hi >= 1) phase1(p, smem);
  if (lo <= 1 && hi >= 2) grid.sync();
  if (lo <= 2 && hi >= 2) phase2(p, smem, (u16*)scratch_out);
  if (lo <= 2 && hi >= 3) grid.sync();
  if (lo <= 3 && hi >= 3) phase3(p, (const u16*)scratch_out);
  if (lo <= 3 && hi >= 4) grid.sync();
  if (lo <= 4 && hi >= 4) phase4(p, smem);
  if (lo <= 4 && hi >= 5) grid.sync();
  if (lo <= 5 && hi >= 5) phase5(p, smem);
}

extern "C" void kernel_launch(void* const* d_in, const int* in_sizes, int n_in, void* d_out, int out_size, void* d_ws, size_t ws_size,
                              hipStream_t stream) {
  static int grid_blocks = 0;
  if (!grid_blocks) {
    int dev = 0, cus = 0, per_cu = 0;
    hipGetDevice(&dev);
    hipDeviceGetAttribute(&cus, hipDeviceAttributeMultiprocessorCount, dev);
    hipOccupancyMaxActiveBlocksPerMultiprocessor(&per_cu, fwd_megakernel, 512, 0);
    if (per_cu > 1) per_cu = 1;
    if (per_cu < 1) per_cu = 1;
    grid_blocks = cus * per_cu;
  }
  Params p{};
  p.x_prompt = (const float*)d_in[0]; p.x_sample = (const float*)d_in[1]; p.cache_k = (const float*)d_in[2]; p.cache_v = (const float*)d_in[3];
  p.state_h = (const float*)d_in[4]; p.norm_g = (const float*)d_in[5]; p.w_in = (const float*)d_in[6]; p.lambda_qk = (const float*)d_in[7];
  p.subln_g = (const float*)d_in[8]; p.rec_lb = (const float*)d_in[9]; p.rec_norm_g = (const float*)d_in[10]; p.w_out = (const float*)d_in[11];
  p.final_g = (const float*)d_in[12];
  p.out = (float*)d_out;
  char* ws = (char*)d_ws; size_t off = 0;
  auto take = [&](size_t bytes) { char* r = ws + off; off += (bytes + 255) & ~(size_t)255; return r; };
  p.WinT = (u16*)take((size_t)4096 * 1024 * 2);
  p.WoutT = (u16*)take((size_t)1024 * 1024 * 2);
  p.Xn = (u16*)take((size_t)NTOK * 1024 * 2);
  p.SbufT = p.Xn;
  p.Qb = (u16*)take((size_t)NTOK * 512 * 2);
  p.Kall = (u16*)take((size_t)KVROWS * 512 * 2);
  p.Vall = (u16*)take((size_t)KVROWS * 512 * 2);
  p.Za = (u16*)take((size_t)NTOK * 512 * 2);
  p.Qr = (u16*)take((size_t)NTOK * 512 * 2);
  p.Ir = (u16*)take((size_t)NTOK * 512 * 2);
  p.Zr = (u16*)take((size_t)NTOK * 512 * 2);
  p.Mix = (u16*)take((size_t)NTOK * 1024 * 2);
  p.Fr = (float*)take((size_t)NTOK * 512 * 4);
  p.Abuf = (float*)take((size_t)NITEM * 128 * 4);
  p.NQ = (float*)take((size_t)NITEM * 4 * 4);
  p.counter = (int*)take(256);
  p.phase_lo = 0; p.phase_hi = 6; p.rep_mask = 0; p.pad_ = 0;
  if (off > ws_size) { fprintf(stderr, "workspace too small: need %zu have %zu\n", off, ws_size); return; }
  void* args[] = {&p};
  hipError_t e = hipLaunchCooperativeKernel((void*)fwd_megakernel, dim3(grid_blocks), dim3(512), args, 0, stream);
  if (e != hipSuccess) fprintf(stderr, "cooperative launch failed: %s (grid %d)\n", hipGetErrorString(e), grid_blocks);
}
```

```cpp
#include <hip/hip_runtime.h>
#include <hip/hip_cooperative_groups.h>
#include <cstdio>
namespace cg = cooperative_groups;

#define DI __device__ __forceinline__
typedef unsigned short u16;
using bf16x8 = __attribute__((ext_vector_type(8))) short;
using s16x4  = __attribute__((ext_vector_type(4))) short;
using f32x16 = __attribute__((ext_vector_type(16))) float;
using f32x4  = __attribute__((ext_vector_type(4))) float;
using f32x2  = __attribute__((ext_vector_type(2))) float;
using u32x4  = __attribute__((ext_vector_type(4))) unsigned;
using u32x2  = __attribute__((ext_vector_type(2))) unsigned;
typedef __bf16 bf2_t __attribute__((ext_vector_type(2)));

#define MFMA(a, b, c) __builtin_amdgcn_mfma_f32_32x32x16_bf16((a), (b), (c), 0, 0, 0)

static constexpr int NTOK = 33280;
static constexpr int NPTOK = 32768;
static constexpr int KVROWS = 32768 + 8 * 1088;
static constexpr int NITEM = 2080;
static constexpr size_t OFF_Y = 0;
static constexpr size_t OFF_NKP = 34078720;
static constexpr size_t OFF_NVP = 50855936;
static constexpr size_t OFF_NHP = 67633152;
static constexpr size_t OFF_NKS = 67764224;
static constexpr size_t OFF_NVS = 68026368;
static constexpr size_t OFF_NHS = 68288512;

struct Params {
  const float *x_prompt, *x_sample, *cache_k, *cache_v, *state_h, *norm_g, *w_in, *lambda_qk, *subln_g, *rec_lb, *rec_norm_g, *w_out, *final_g;
  float* out;
  u16 *WinT, *WoutT, *Xn, *Qb, *Kall, *Vall, *Za, *Qr, *Ir, *Zr, *Mix, *SbufT;
  float *Fr, *Abuf, *NQ;
  int* counter;
  int phase_lo, phase_hi, rep_mask, pad_;
};

DI unsigned pack2(float a, float b) { f32x2 v = {a, b}; bf2_t r = __builtin_convertvector(v, bf2_t); return __builtin_bit_cast(unsigned, r); }
DI u16 f2bf(float a) { return (u16)(pack2(a, 0.f) & 0xffffu); }
DI float bflo(unsigned u) { return __uint_as_float(u << 16); }
DI float bfhi(unsigned u) { return __uint_as_float(u & 0xffff0000u); }
DI int crow(int e, int h) { return (e & 3) + 8 * (e >> 2) + 4 * h; }
DI float wave_sum(float v) {
#pragma unroll
  for (int o = 32; o >= 1; o >>= 1) v += __shfl_xor(v, o);
  return v;
}
DI float silu_f(float v) { return v / (1.f + __expf(-v)); }
DI s16x4 tr_read(const char* p) {
  return __builtin_amdgcn_ds_read_tr16_b64_v4i16((__attribute__((address_space(3))) s16x4*)(p));
}
DI bf16x8 tr_frag(const char* p0, int stride4) {
  s16x4 lo = tr_read(p0), hi = tr_read(p0 + stride4);
  return __builtin_shufflevector(lo, hi, 0, 1, 2, 3, 4, 5, 6, 7);
}
DI bf16x8 pack8(const f32x16& x, int s) {
  u32x4 p;
  p[0] = pack2(x[8 * s + 0], x[8 * s + 1]);
  p[1] = pack2(x[8 * s + 2], x[8 * s + 3]);
  p[2] = pack2(x[8 * s + 4], x[8 * s + 5]);
  p[3] = pack2(x[8 * s + 6], x[8 * s + 7]);
  return __builtin_bit_cast(bf16x8, p);
}
DI f32x16 zero16() { f32x16 z; for (int i = 0; i < 16; ++i) z[i] = 0.f; return z; }

DI void phase0(const Params& p, char* smem) {
  const int tid = threadIdx.x, lane = tid & 63, w = tid >> 6;
  constexpr int NT_W1 = 16 * 64, NT_W2 = 16 * 16, NT_ROW = NTOK / 16, NT_CACHE = 1024;
  constexpr int total = NT_W1 + NT_W2 + NT_ROW + NT_CACHE;
  float (*tile)[65] = (float (*)[65])smem;
  if (blockIdx.x == 0 && tid == 0) *p.counter = 0;
  for (int it = blockIdx.x; it < total; it += gridDim.x) {
    if (it < NT_W1 + NT_W2) {
      const float* src; u16* dst; int N, kt, nt;
      if (it < NT_W1) { src = p.w_in; dst = p.WinT; N = 4096; kt = it >> 6; nt = it & 63; }
      else { int j = it - NT_W1; src = p.w_out; dst = p.WoutT; N = 1024; kt = j >> 4; nt = j & 15; }
      const int c = tid & 63, r0 = tid >> 6;
      for (int i = 0; i < 8; ++i) { int r = r0 + 8 * i; tile[r][c] = src[(size_t)(kt * 64 + r) * N + nt * 64 + c]; }
      __syncthreads();
      if (it < NT_W1) {
        for (int i = 0; i < 8; ++i) { int r = r0 + 8 * i; dst[(size_t)(nt * 64 + r) * 1024 + kt * 64 + c] = f2bf(tile[c][r]); }
      } else {
        for (int i = 0; i < 8; ++i) {
          const int r = r0 + 8 * i, n = nt * 64 + r, k = kt * 64 + c;
          dst[((size_t)((n >> 5) * 64 + (k >> 4)) * 64 + ((k >> 3) & 1) * 32 + (n & 31)) * 8 + (k & 7)] = f2bf(tile[c][r]);
        }
      }
      __syncthreads();
    } else if (it < NT_W1 + NT_W2 + NT_ROW) {
      const int row0 = (it - NT_W1 - NT_W2) * 16 + w * 2;
      f32x4 v[2][4]; float ss[2] = {0.f, 0.f};
#pragma unroll
      for (int rr = 0; rr < 2; ++rr) {
        const int row = row0 + rr;
        const float* src = row < NPTOK ? p.x_prompt + (size_t)row * 1024 : p.x_sample + (size_t)(row - NPTOK) * 1024;
#pragma unroll
        for (int i = 0; i < 4; ++i) v[rr][i] = *(const f32x4*)(src + i * 256 + lane * 4);
      }
#pragma unroll
      for (int rr = 0; rr < 2; ++rr) {
#pragma unroll
        for (int i = 0; i < 4; ++i) ss[rr] += v[rr][i][0] * v[rr][i][0] + v[rr][i][1] * v[rr][i][1] + v[rr][i][2] * v[rr][i][2] + v[rr][i][3] * v[rr][i][3];
        ss[rr] = wave_sum(ss[rr]);
      }
#pragma unroll
      for (int rr = 0; rr < 2; ++rr) {
        const float sc = rsqrtf(ss[rr] * (1.f / 1024.f) + 1e-6f);
#pragma unroll
        for (int i = 0; i < 4; ++i) {
          f32x4 g = *(const f32x4*)(p.norm_g + i * 256 + lane * 4);
          u32x2 o; o[0] = pack2(v[rr][i][0] * sc * g[0], v[rr][i][1] * sc * g[1]); o[1] = pack2(v[rr][i][2] * sc * g[2], v[rr][i][3] * sc * g[3]);
          *(u32x2*)(p.Xn + (size_t)(row0 + rr) * 1024 + i * 256 + lane * 4) = o;
        }
      }
    } else {
      const int task0 = (it - NT_W1 - NT_W2 - NT_ROW) * 16 + w * 2;
      f32x4 a[2], b[2];
#pragma unroll
      for (int rr = 0; rr < 2; ++rr) {
        const int task = task0 + rr, which = task >> 13, r8 = task & 8191;
        const float* src = (which ? p.cache_v : p.cache_k) + (size_t)r8 * 512 + lane * 8;
        a[rr] = *(const f32x4*)src; b[rr] = *(const f32x4*)(src + 4);
      }
#pragma unroll
      for (int rr = 0; rr < 2; ++rr) {
        const int task = task0 + rr, which = task >> 13, r8 = task & 8191;
        u16* dst = (which ? p.Vall : p.Kall) + (size_t)(NPTOK + (r8 >> 10) * 1088 + (r8 & 1023)) * 512 + lane * 8;
        u32x4 o; o[0] = pack2(a[rr][0], a[rr][1]); o[1] = pack2(a[rr][2], a[rr][3]); o[2] = pack2(b[rr][0], b[rr][1]); o[3] = pack2(b[rr][2], b[rr][3]);
        *(u32x4*)dst = o;
      }
    }
  }
}

#define G_LOAD(RA, RB, KT_)                                                                                        \
  {                                                                                                                 \
    _Pragma("unroll") for (int i_ = 0; i_ < 4; ++i_) RA[i_] = *(const u32x4*)((ap + (size_t)i_ * 64 * K + (KT_) * 64) + loff); \
    _Pragma("unroll") for (int i_ = 0; i_ < 4; ++i_) RB[i_] = *(const u32x4*)((bp + (size_t)i_ * 64 * K + (KT_) * 64) + loff); \
  }
#define G_WRITE(RA, RB, BUF_)                                                                                      \
  {                                                                                                                 \
    _Pragma("unroll") for (int i_ = 0; i_ < 4; ++i_) *(u32x4*)(wbase + (BUF_) * 73728 + i_ * 64 * 144) = RA[i_];         \
    _Pragma("unroll") for (int i_ = 0; i_ < 4; ++i_) *(u32x4*)(wbase + (BUF_) * 73728 + 36864 + i_ * 64 * 144) = RB[i_]; \
  }
#define G_FRAGS(FA, FB, S_)                                                                                        \
  {                                                                                                                 \
    _Pragma("unroll") for (int i_ = 0; i_ < 4; ++i_) FA[i_] = *(const bf16x8*)(as_ + i_ * 32 * 144 + (S_) * 32);      \
    FB[0] = *(const bf16x8*)(bs_ + (S_) * 32); FB[1] = *(const bf16x8*)(bs_ + 32 * 144 + (S_) * 32);                \
  }
#define G_MFMA8(FA, FB)                                                                                            \
  {                                                                                                                 \
    _Pragma("unroll") for (int i_ = 0; i_ < 4; ++i_) {                                                              \
      acc[i_][0] = MFMA(FA[i_], FB[0], acc[i_][0]);                                                                 \
      acc[i_][1] = MFMA(FA[i_], FB[1], acc[i_][1]);                                                                 \
    }                                                                                                               \
  }
#define G_COMPUTE(BUF_)                                                                                            \
  {                                                                                                                 \
    const char* as_ = smem + (BUF_) * 73728 + (wm * 128 + r) * 144 + h * 16;                                        \
    const char* bs_ = smem + (BUF_) * 73728 + 36864 + (wn * 64 + r) * 144 + h * 16;                                 \
    bf16x8 fa0[4], fb0[2], fa1[4], fb1[2];                                                                          \
    G_FRAGS(fa0, fb0, 0);                                                                                           \
    G_FRAGS(fa1, fb1, 1); __builtin_amdgcn_sched_barrier(0); G_MFMA8(fa0, fb0); __builtin_amdgcn_sched_barrier(0);  \
    G_FRAGS(fa0, fb0, 2); __builtin_amdgcn_sched_barrier(0); G_MFMA8(fa1, fb1); __builtin_amdgcn_sched_barrier(0);  \
    G_FRAGS(fa1, fb1, 3); __builtin_amdgcn_sched_barrier(0); G_MFMA8(fa0, fb0); __builtin_amdgcn_sched_barrier(0);  \
    G_MFMA8(fa1, fb1);                                                                                              \
  }
DI void gemm_preload(const u16* __restrict__ A, const u16* __restrict__ BT, int K, int m0, int n0, int tid, u32x4 (&ra0)[4], u32x4 (&rb0)[4]) {
  const u16* ap = A + (size_t)m0 * K;
  const u16* bp = BT + (size_t)n0 * K;
  const int loff = (tid >> 3) * K + (tid & 7) * 8;
  G_LOAD(ra0, rb0, 0);
}
DI void gemm256(const u16* __restrict__ A, const u16* __restrict__ BT, int K, int m0, int n0, char* smem, int tid, f32x16 (&acc)[4][2],
                u32x4 (&ra0)[4], u32x4 (&rb0)[4]) {
  const int lane = tid & 63, w = tid >> 6, r = lane & 31, h = lane >> 5;
  const int wm = w >> 2, wn = w & 3;
#pragma unroll
  for (int i = 0; i < 4; ++i) { acc[i][0] = zero16(); acc[i][1] = zero16(); }
  const int KT = K >> 6;
  const u16* ap = A + (size_t)m0 * K;
  const u16* bp = BT + (size_t)n0 * K;
  const int loff = (tid >> 3) * K + (tid & 7) * 8;
  char* wbase = smem + (tid >> 3) * 144 + (tid & 7) * 16;
  G_WRITE(ra0, rb0, 0);
  __syncthreads();
  for (int kt = 0; kt < KT; kt += 2) {
    { const int k1 = kt + 1 < KT ? kt + 1 : KT - 1; G_LOAD(ra0, rb0, k1); }
    __builtin_amdgcn_sched_barrier(0);
    G_COMPUTE(0);
    __builtin_amdgcn_sched_barrier(0);
    G_WRITE(ra0, rb0, 1);
    __syncthreads();
    { const int k2 = kt + 2 < KT ? kt + 2 : KT - 1; G_LOAD(ra0, rb0, k2); }
    __builtin_amdgcn_sched_barrier(0);
    G_COMPUTE(1);
    __builtin_amdgcn_sched_barrier(0);
    G_WRITE(ra0, rb0, 0);
    __syncthreads();
  }
}
struct TileMap {
  int MT, NT, C, NG, NST, st, lb, lin;
  bool xcd;
  DI TileMap(int mt_, int nt_) : MT(mt_), NT(nt_) {
    const int nb = gridDim.x >> 3;
    C = nb >> 3;
    xcd = (gridDim.x & 63) == 0 && C > 0 && (NT % C) == 0;
    NG = xcd ? NT / C : 1;
    NST = ((MT + 7) >> 3) * NG;
    st = blockIdx.x & 7; lb = blockIdx.x >> 3; lin = blockIdx.x;
  }
  DI bool next(int& mt, int& nt) {
    if (!xcd) {
      if (lin >= MT * NT) return false;
      mt = lin / NT; nt = lin - mt * NT; lin += gridDim.x; return true;
    }
    while (st < NST) {
      const int mg = st / NG, ng = st - mg * NG;
      mt = mg * 8 + lb / C; nt = ng * C + lb % C;
      st += 8;
      if (mt < MT) return true;
    }
    return false;
  }
};
DI void stage_half(const f32x16 (&acc)[4][2], float* cs, int half, int wm, int wn, int r, int h) {
  if (wm == half) {
#pragma unroll
    for (int i = 0; i < 4; ++i)
#pragma unroll
      for (int j = 0; j < 2; ++j)
#pragma unroll
        for (int e = 0; e < 16; ++e) cs[(i * 32 + crow(e, h)) * 260 + wn * 64 + j * 32 + r] = acc[i][j][e];
  }
}

DI void phase1(const Params& p, char* smem) {
  constexpr int MT = NTOK / 256, NT = 16;
  TileMap tm(MT, NT);
  int mt, nt;
  bool have = tm.next(mt, nt);
  u32x4 pa[4], pb[4];
  if (have) gemm_preload(p.Xn, p.WinT, 1024, mt * 256, nt * 256, threadIdx.x, pa, pb);
  while (have) {
    const int m0 = mt * 256, n0 = nt * 256;
    f32x16 acc[4][2];
    {
      int tg = threadIdx.x;
      asm volatile("" : "+v"(tg));
      gemm256(p.Xn, p.WinT, 1024, m0, n0, smem, tg, acc, pa, pb);
    }
    have = tm.next(mt, nt);
    if (have) {
      int tg = threadIdx.x;
      asm volatile("" : "+v"(tg));
      gemm_preload(p.Xn, p.WinT, 1024, mt * 256, nt * 256, tg, pa, pb);
    }
    int tid = threadIdx.x;
    asm volatile("" : "+v"(tid));
    const int lane = tid & 63, w = tid >> 6, r = lane & 31, h = lane >> 5;
    const int wm = w >> 2, wn = w & 3;
    const int sec = n0 >> 9;
    const bool samp = m0 >= NPTOK;
    float* cs = (float*)smem;
    const int c0 = (tid & 31) * 8, rb = tid >> 5;
    const int csc = (n0 & 511) + c0;
#pragma unroll 1
    for (int half = 0; half < 2; ++half) {
      stage_half(acc, cs, half, wm, wn, r, h);
      __syncthreads();
#pragma unroll 2
      for (int ps = 0; ps < 8; ++ps) {
        const int row = rb + 16 * ps;
        const int t = m0 + half * 128 + row;
        f32x4 va = *(const f32x4*)(cs + row * 260 + c0), vb = *(const f32x4*)(cs + row * 260 + c0 + 4);
        const size_t o512 = (size_t)t * 512 + csc;
        if (sec == 5) { __builtin_nontemporal_store(va, (f32x4*)(p.Fr + o512)); __builtin_nontemporal_store(vb, (f32x4*)(p.Fr + o512 + 4)); }
        else {
          u16* dst;
          if (sec == 0) {
            const float qs = 0.125f * 1.44269504089f;
            va *= qs; vb *= qs; dst = p.Qb + o512;
          } else if (sec == 1 || sec == 2) {
            size_t kvr; float* od;
            if (!samp) { kvr = t; od = p.out + (sec == 1 ? OFF_NKP : OFF_NVP) + o512; }
            else { const int ts = t - NPTOK; kvr = NPTOK + (ts >> 6) * 1088 + 1024 + (ts & 63); od = p.out + (sec == 1 ? OFF_NKS : OFF_NVS) + (size_t)ts * 512 + csc; }
            __builtin_nontemporal_store(va, (f32x4*)od); __builtin_nontemporal_store(vb, (f32x4*)(od + 4));
            dst = (sec == 1 ? p.Kall : p.Vall) + kvr * 512 + csc;
          } else if (sec == 6) { dst = p.Ir + o512; }
          else {
#pragma unroll
            for (int i = 0; i < 4; ++i) { va[i] = silu_f(va[i]); vb[i] = silu_f(vb[i]); }
            dst = (sec == 3 ? p.Za : (sec == 4 ? p.Qr : p.Zr)) + o512;
          }
          u32x4 o; o[0] = pack2(va[0], va[1]); o[1] = pack2(va[2], va[3]); o[2] = pack2(vb[0], vb[1]); o[3] = pack2(vb[2], vb[3]);
          __builtin_nontemporal_store(o, (u32x4*)dst);
        }
      }
      __syncthreads();
    }
  }
}

DI void rec_load(const Params& p, int tid, int I, float (&xv)[32]) {
  const int d = tid & 127, half = tid >> 7;
  const int hd = I & 3, t0 = (I >> 2) * 64;
  const float* fp = p.Fr + (size_t)(t0 + half * 32) * 512 + hd * 128 + d;
#pragma unroll
  for (int i = 0; i < 32; ++i) xv[i] = fp[(size_t)i * 512];
}
DI void rec_pre_x(const Params& p, int tid, int I, float* totS, const float (&xv)[32], float (&cum)[32], float (&key)[32], float& lastv) {
  const int d = tid & 127, half = tid >> 7;
  const int hd = I & 3;
  const float r0 = p.rec_lb[hd * 128 + d], r1 = p.rec_lb[512 + hd * 128 + d];
  const float lb = 1.f / (1.f + __expf(r1 - r0));
  float run = 0.f;
#pragma unroll
  for (int i = 0; i < 32; ++i) {
    float x = xv[i];
    x = fminf(fmaxf(x, -30.f), 30.f);
    const float e = __expf(-x), sg = 1.f / (1.f + e);
    run += __logf(lb + (1.f - lb) * sg);
    cum[i] = run; key[i] = (1.f - lb) * e * sg;
  }
  totS[tid] = run;
  __syncthreads();
  const float tot0 = totS[d], tot1 = totS[128 + d];
  if (half) {
#pragma unroll
    for (int i = 0; i < 32; ++i) cum[i] += tot0;
  }
  lastv = tot0 + tot1;
}
DI void rec_pre(const Params& p, int tid, int I, float* totS, float (&cum)[32], float (&key)[32], float& lastv) {
  float xv[32];
  rec_load(p, tid, I, xv);
  rec_pre_x(p, tid, I, totS, xv, cum, key, lastv);
}

DI void phase2(const Params& p, char* smem0, u16* BbufT) {
  const int hf = threadIdx.x >> 8;
  const int tid = threadIdx.x & 255, lane = tid & 63, w = tid >> 6, r = lane & 31, h = lane >> 5;
  const int q = (lane & 15) >> 2, pp = lane & 3, blk = (lane >> 4) & 1;
  const int d = tid & 127, half = tid >> 7;
  char* smem = smem0 + hf * 65536;
  char* KdI = smem; char* VrI = smem + 17408; float* totS = (float*)(smem + 60000);
  float xv[32];
  rec_load(p, tid, blockIdx.x * 2 + hf < NITEM ? blockIdx.x * 2 + hf : NITEM - 1, xv);
  for (int I = blockIdx.x * 2 + hf; I < NITEM; I += gridDim.x * 2) {
    const int hd = I & 3, t0 = (I >> 2) * 64;
    if (I < 2048) {
      const int token = tid & 63, which = tid >> 6;
      const u16* src = (which < 2 ? p.Qb : p.Kall) + (size_t)(t0 + token) * 512 + hd * 128 + (which & 1) * 64;
      float ss = 0.f;
#pragma unroll
      for (int c = 0; c < 8; ++c) {
        const u32x4 v = *(const u32x4*)(src + c * 8);
#pragma unroll
        for (int i = 0; i < 4; ++i) { const float lo = bflo(v[i]), hi = bfhi(v[i]); ss += lo * lo + hi * hi; }
      }
#pragma unroll
      for (int o = 32; o >= 1; o >>= 1) ss = fmaxf(ss, __shfl_xor(ss, o));
      if (lane == 0) p.NQ[I * 4 + which] = sqrtf(ss);
    }
    float cum[32], key[32], lastv;
    rec_pre_x(p, tid, I, totS, xv, cum, key, lastv);
    {
      const int In = I + gridDim.x * 2;
      rec_load(p, tid, In < NITEM ? In : I, xv);
    }
#pragma unroll
    for (int i = 0; i < 32; ++i) {
      const int t = half * 32 + i;
      *(u16*)(KdI + t * 272 + d * 2) = f2bf(key[i] * __expf(lastv - cum[i]));
    }
#pragma unroll
    for (int i = 0; i < 4; ++i) {
      const int ch = tid + 256 * i, row = ch >> 4, cc = ch & 15;
      *(u32x4*)(VrI + row * 272 + cc * 16) = *(const u32x4*)(p.Ir + (size_t)(t0 + row) * 512 + hd * 128 + cc * 8);
    }
    if (half) p.Abuf[I * 128 + d] = __expf(lastv);
    __syncthreads();
    f32x16 acc[4];
#pragma unroll
    for (int ct = 0; ct < 4; ++ct) acc[ct] = zero16();
#pragma unroll
    for (int ks = 0; ks < 4; ++ks) {
      const int rowoff = (16 * ks + 8 * h + q) * 272 + 32 * blk + 8 * pp;
      bf16x8 a = tr_frag(VrI + rowoff + 64 * w, 4 * 272);
#pragma unroll
      for (int ct = 0; ct < 4; ++ct) {
        bf16x8 b = tr_frag(KdI + rowoff + 64 * ct, 4 * 272);
        acc[ct] = MFMA(a, b, acc[ct]);
      }
    }
    u16* ob = BbufT + (size_t)I * 16384;
#pragma unroll
    for (int ct = 0; ct < 4; ++ct)
#pragma unroll
      for (int e = 0; e < 16; ++e) ob[(32 * w + crow(e, h)) * 128 + 32 * ct + r] = f2bf(acc[ct][e]);
    __syncthreads();
  }
}

DI void phase3(const Params& p, const u16* BbufT) {
  const int tid = threadIdx.x & 255;
  for (int it = blockIdx.x * 2 + (threadIdx.x >> 8); it < 512 + 1024; it += gridDim.x * 2) {
    if (it < 512) {
      const int bh = it >> 6, b = bh >> 2, hd = bh & 3;
      const int e1 = (it & 63) * 256 + tid, v = e1 >> 7, d = e1 & 127;
      float sx = 0.f;
      const size_t eo = (size_t)v * 128 + d;
      const int I0 = (b * 256) * 4 + hd;
      const float* ap = p.Abuf + (size_t)I0 * 128 + d;
      const u16* bp = BbufT + (size_t)I0 * 16384 + eo;
      u16* sp = p.SbufT + (size_t)I0 * 16384 + eo;
      for (int c0 = 0; c0 < 256; c0 += 16) {
        float av[16]; u16 bw[16];
#pragma unroll
        for (int i = 0; i < 16; ++i) { av[i] = ap[(size_t)(c0 + i) * 4 * 128]; bw[i] = bp[(size_t)(c0 + i) * 4 * 16384]; }
#pragma unroll
        for (int i = 0; i < 16; ++i) {
          sp[(size_t)(c0 + i) * 4 * 16384] = f2bf(sx);
          sx = av[i] * sx + bflo(bw[i]);
        }
      }
      p.out[OFF_NHP + (size_t)(b * 4 + hd) * 16384 + d * 128 + v] = sx;
    } else {
      const int j = it - 512;
      const int sh = j >> 5, bs = sh >> 2, hd = sh & 3;
      const int e2 = (j & 31) * 256 + tid, v = e2 >> 6, d2 = (e2 & 63) * 2;
      const int I = (512 + bs) * 4 + hd;
      const float* sh0 = p.state_h + (size_t)(bs * 4 + hd) * 16384;
      float sx = sh0[d2 * 128 + v], sy = sh0[(d2 + 1) * 128 + v];
      const size_t eo = (size_t)v * 128 + d2;
      const f32x2 a = *(const f32x2*)(p.Abuf + I * 128 + d2);
      const unsigned bw = *(const unsigned*)(BbufT + (size_t)I * 16384 + eo);
      *(unsigned*)(p.SbufT + (size_t)I * 16384 + eo) = pack2(sx, sy);
      sx = a[0] * sx + bflo(bw); sy = a[1] * sy + bfhi(bw);
      float* oh = p.out + OFF_NHS + (size_t)(bs * 4 + hd) * 16384;
      oh[d2 * 128 + v] = sx; oh[(d2 + 1) * 128 + v] = sy;
    }
  }
}

DI void r3_item(const Params& p, char* smem, int tid, int I) {
  const int lane = tid & 63, w = tid >> 6, r = lane & 31, h = lane >> 5;
  const int q = (lane & 15) >> 2, pp = lane & 3, blk = (lane >> 4) & 1;
  const int d = tid & 127, half = tid >> 7;
  char* QdI = smem; char* KdI = smem + 17408; char* VrI = smem + 34816;
  float* totS = (float*)(smem + 60000); float* ssS = (float*)(smem + 62048);
  const int hd = I & 3, t0 = (I >> 2) * 64;
  {
    float cum[32], key[32], lastv;
    rec_pre(p, tid, I, totS, cum, key, lastv);
    const u16* qp = p.Qr + (size_t)(t0 + half * 32) * 512 + hd * 128 + d;
#pragma unroll
    for (int i = 0; i < 32; ++i) {
      const int t = half * 32 + i;
      const float qv = bflo(qp[(size_t)i * 512]);
      *(u16*)(QdI + t * 272 + d * 2) = f2bf(qv * __expf(cum[i]));
      *(u16*)(KdI + t * 272 + d * 2) = f2bf(key[i] * __expf(-cum[i]));
    }
  }
#pragma unroll
  for (int i = 0; i < 4; ++i) {
    const int ch = tid + 256 * i, row = ch >> 4, cc = ch & 15;
    *(u32x4*)(VrI + row * 272 + cc * 16) = *(const u32x4*)(p.Ir + (size_t)(t0 + row) * 512 + hd * 128 + cc * 8);
  }
  __syncthreads();
  const int tt = w & 1, vh = w >> 1;
  bf16x8 qf[8];
#pragma unroll
  for (int ks = 0; ks < 8; ++ks) qf[ks] = *(const bf16x8*)(QdI + (32 * tt + r) * 272 + ks * 32 + h * 16);
  f32x16 sc[2]; sc[0] = zero16(); sc[1] = zero16();
#pragma unroll
  for (int ks = 0; ks < 8; ++ks) {
    bf16x8 a0 = *(const bf16x8*)(KdI + r * 272 + ks * 32 + h * 16);
    sc[0] = MFMA(a0, qf[ks], sc[0]);
  }
  if (tt == 1) {
#pragma unroll
    for (int ks = 0; ks < 8; ++ks) {
      bf16x8 a1 = *(const bf16x8*)(KdI + (32 + r) * 272 + ks * 32 + h * 16);
      sc[1] = MFMA(a1, qf[ks], sc[1]);
    }
  }
#pragma unroll
  for (int e = 0; e < 16; ++e) {
    const bool keep = crow(e, h) <= r;
    if (tt == 0) { if (!keep) sc[0][e] = 0.f; }
    else { if (!keep) sc[1][e] = 0.f; }
  }
  bf16x8 pf[4];
  pf[0] = pack8(sc[0], 0); pf[1] = pack8(sc[0], 1); pf[2] = pack8(sc[1], 0); pf[3] = pack8(sc[1], 1);
  f32x16 o[2]; o[0] = zero16(); o[1] = zero16();
  const u16* sp = p.SbufT + (size_t)I * 16384;
#pragma unroll
  for (int vi = 0; vi < 2; ++vi) {
    const int vt = 2 * vh + vi;
#pragma unroll
    for (int k4 = 0; k4 < 4; ++k4) {
      if (k4 < 2 || tt == 1) {
        bf16x8 a = tr_frag(VrI + (16 * k4 + 4 * h + q) * 272 + (32 * vt + 16 * blk) * 2 + 8 * pp, 8 * 272);
        o[vi] = MFMA(a, pf[k4], o[vi]);
      }
    }
#pragma unroll
    for (int ks = 0; ks < 8; ++ks) {
      bf16x8 a = *(const bf16x8*)(sp + (size_t)(32 * vt + r) * 128 + ks * 16 + h * 8);
      o[vi] = MFMA(a, qf[ks], o[vi]);
    }
  }
  float ss = 0.f;
#pragma unroll
  for (int vi = 0; vi < 2; ++vi)
#pragma unroll
    for (int e = 0; e < 16; ++e) ss += o[vi][e] * o[vi][e];
  ss += __shfl_xor(ss, 32);
  if (h == 0) ssS[w * 32 + r] = ss;
  __syncthreads();
  const float tot = ssS[tt * 32 + r] + ssS[(tt + 2) * 32 + r];
  const float rs = rsqrtf(tot * (1.f / 128.f) + 1e-6f);
  const int tok = t0 + 32 * tt + r;
#pragma unroll
  for (int vi = 0; vi < 2; ++vi)
#pragma unroll
    for (int g = 0; g < 4; ++g) {
      const int v = 32 * (2 * vh + vi) + 8 * g + 4 * h;
      const f32x4 gg = *(const f32x4*)(p.rec_norm_g + v);
      const u32x2 z = *(const u32x2*)(p.Zr + (size_t)tok * 512 + hd * 128 + v);
      u32x2 ov;
      ov[0] = pack2(o[vi][4 * g + 0] * rs * gg[0] * bflo(z[0]), o[vi][4 * g + 1] * rs * gg[1] * bfhi(z[0]));
      ov[1] = pack2(o[vi][4 * g + 2] * rs * gg[2] * bflo(z[1]), o[vi][4 * g + 3] * rs * gg[3] * bfhi(z[1]));
      *(u32x2*)(p.Mix + (size_t)tok * 1024 + 512 + hd * 128 + v) = ov;
    }
  __syncthreads();
}

template <bool DIAG>
DI void attn_tile_a(const char* ks, const bf16x8 (&qf)[4], f32x16 (&O)[4], bf16x8 (&pf)[4], float& mrun, float& lsum, float sl2, float qrel,
                    int m, int r, int h2) {
  f32x16 S[2];
#pragma unroll
  for (int st = 0; st < 2; ++st) {
    S[st] = zero16();
#pragma unroll
    for (int s = 0; s < 4; ++s) {
      bf16x8 a = *(const bf16x8*)(ks + (32 * st + r) * 272 + m * 128 + s * 32 + h2 * 16);
      S[st] = MFMA(a, qf[s], S[st]);
    }
  }
  float mx = -1e30f;
#pragma unroll
  for (int st = 0; st < 2; ++st)
#pragma unroll
    for (int e = 0; e < 16; ++e) {
      const float cst = (float)(32 * st + (e & 3) + 8 * (e >> 2));
      float sv;
      if (DIAG) sv = fmaf(-sl2, fabsf(qrel - cst), S[st][e]);
      else sv = fmaf(sl2, cst, S[st][e]);
      S[st][e] = sv; mx = fmaxf(mx, sv);
    }
  const float L = DIAG ? 0.f : -sl2 * qrel;
  mx += L;
  mx = fmaxf(mx, __shfl_xor(mx, 32));
  if (__builtin_amdgcn_ballot_w64(mx > mrun + 6.f) != 0) {
    const float mnew = fmaxf(mrun, mx);
    const float alpha = __builtin_amdgcn_exp2f(mrun - mnew);
    mrun = mnew; lsum *= alpha;
#pragma unroll
    for (int vt = 0; vt < 4; ++vt)
#pragma unroll
      for (int e = 0; e < 16; ++e) O[vt][e] *= alpha;
  }
  const float off = L - mrun;
  float rs = 0.f;
#pragma unroll
  for (int st = 0; st < 2; ++st)
#pragma unroll
    for (int e = 0; e < 16; ++e) { const float pv = __builtin_amdgcn_exp2f(S[st][e] + off); S[st][e] = pv; rs += pv; }
  lsum += rs;
  pf[0] = pack8(S[0], 0); pf[1] = pack8(S[0], 1); pf[2] = pack8(S[1], 0); pf[3] = pack8(S[1], 1);
}
template <bool DIAG>
DI void attn_tile_f(const char* ks, const bf16x8 (&qf)[4], bf16x8 (&pf)[4], float& lsum, float sl2, float qrel, float mref, int m, int r, int h2) {
  f32x16 S[2];
  const float offL = -sl2 * qrel - mref;
#pragma unroll
  for (int st = 0; st < 2; ++st) {
#pragma unroll
    for (int e = 0; e < 16; ++e) {
      const float cst = (float)(32 * st + (e & 3) + 8 * (e >> 2));
      S[st][e] = DIAG ? (-sl2 * fabsf(qrel - cst) - mref) : fmaf(sl2, cst, offL);
    }
#pragma unroll
    for (int s = 0; s < 4; ++s) {
      bf16x8 a = *(const bf16x8*)(ks + (32 * st + r) * 272 + m * 128 + s * 32 + h2 * 16);
      S[st] = MFMA(a, qf[s], S[st]);
    }
  }
  float rs = 0.f;
#pragma unroll
  for (int st = 0; st < 2; ++st)
#pragma unroll
    for (int e = 0; e < 16; ++e) { const float pv = __builtin_amdgcn_exp2f(S[st][e]); S[st][e] = pv; rs += pv; }
  lsum += rs;
  pf[0] = pack8(S[0], 0); pf[1] = pack8(S[0], 1); pf[2] = pack8(S[1], 0); pf[3] = pack8(S[1], 1);
}
DI void attn_tile_b(const char* vs, const bf16x8 (&pf)[4], f32x16 (&O)[4], int h2, int q, int pp, int blk) {
  const char* vb = vs + (4 * h2 + q) * 320 + 32 * blk + 8 * pp;
  bf16x8 a0[4], a1[4];
#pragma unroll
  for (int vt = 0; vt < 4; ++vt) a0[vt] = tr_frag(vb + 64 * vt, 8 * 320);
  __builtin_amdgcn_sched_barrier(0);
#pragma unroll
  for (int vt = 0; vt < 4; ++vt) a1[vt] = tr_frag(vb + 16 * 320 + 64 * vt, 8 * 320);
#pragma unroll
  for (int vt = 0; vt < 4; ++vt) O[vt] = MFMA(a0[vt], pf[0], O[vt]);
  __builtin_amdgcn_sched_barrier(0);
#pragma unroll
  for (int vt = 0; vt < 4; ++vt) a0[vt] = tr_frag(vb + 32 * 320 + 64 * vt, 8 * 320);
#pragma unroll
  for (int vt = 0; vt < 4; ++vt) O[vt] = MFMA(a1[vt], pf[1], O[vt]);
  __builtin_amdgcn_sched_barrier(0);
#pragma unroll
  for (int vt = 0; vt < 4; ++vt) a1[vt] = tr_frag(vb + 48 * 320 + 64 * vt, 8 * 320);
#pragma unroll
  for (int vt = 0; vt < 4; ++vt) O[vt] = MFMA(a0[vt], pf[2], O[vt]);
  __builtin_amdgcn_sched_barrier(0);
#pragma unroll
  for (int vt = 0; vt < 4; ++vt) O[vt] = MFMA(a1[vt], pf[3], O[vt]);
}

DI void attn_item(const Params& p, char* smem, int tid, int tq0, int qpos0, int kvbase, int ntb, int hd, float lam, bool can_skip, int nq) {
  const int lane = tid & 63, w = tid >> 6, r = lane & 31, h2 = lane >> 5;
  const int q = (lane & 15) >> 2, pp = lane & 3, blk = (lane >> 4) & 1;
  const int qg = w & 3, m = w >> 2, ch = qg >> 1;
  const bool wact = qg < nq;
  const float sl2 = exp2f(-2.f * (float)(hd + 1)) * 1.44269504089f;
  const int qtok = tq0 + 32 * qg + r;
  const float qposf = (float)(qpos0 + 32 * qg + r);
  const int ntw = can_skip ? ntb - 1 + ch : ntb;
  int kt0w = 0, kt0b = 0;
  bool fast = false; float kn_w = 0.f;
  if (can_skip) {
    const int I0 = (tq0 >> 6) * 4 + hd;
    const int crk = kvbase >> 6;
    fast = true; kt0b = ntb;
#pragma unroll
    for (int mm = 0; mm < 2; ++mm) {
      float KN = 0.f;
      for (int c = lane; c < ntb; c += 64) KN = fmaxf(KN, p.NQ[((crk + c) * 4 + hd) * 4 + 2 + mm]);
#pragma unroll
      for (int o = 32; o >= 1; o >>= 1) KN = fmaxf(KN, __shfl_xor(KN, o));
#pragma unroll
      for (int cc = 0; cc < 2; ++cc) {
        const float QN = p.NQ[(I0 + 4 * cc) * 4 + mm];
        const float D = (2.02f * QN * KN + 66.f) / sl2;
        const float f = ((float)(qpos0 + 64 * cc - 63) - D) * (1.f / 64.f);
        const int k0 = f < 0.f ? 0 : (int)f + 1;
        kt0b = k0 < kt0b ? k0 : kt0b;
        fast = fast && (2.02f * QN * KN < 60.f);
        if (mm == m && cc == ch) { kt0w = k0; kn_w = KN; }
      }
    }
  }
  bf16x8 qf[4];
  if (wact) {
#pragma unroll
    for (int s = 0; s < 4; ++s) qf[s] = *(const bf16x8*)(p.Qb + (size_t)qtok * 512 + hd * 128 + m * 64 + 16 * s + 8 * h2);
  } else {
#pragma unroll
    for (int s = 0; s < 4; ++s) qf[s] = (bf16x8){0, 0, 0, 0, 0, 0, 0, 0};
  }
  float mref = 0.f;
  if (fast) {
    float qq = 0.f;
#pragma unroll
    for (int s = 0; s < 4; ++s) {
      const u32x4 u = __builtin_bit_cast(u32x4, qf[s]);
#pragma unroll
      for (int i = 0; i < 4; ++i) { const float lo = bflo(u[i]), hi = bfhi(u[i]); qq += lo * lo + hi * hi; }
    }
    qq += __shfl_xor(qq, 32);
    mref = sqrtf(qq) * kn_w * 1.01f + 0.5f;
  }
  f32x16 O[4];
#pragma unroll
  for (int vt = 0; vt < 4; ++vt) O[vt] = zero16();
  float mrun = -1e30f, lsum = 0.f;
  u32x4 rk[2], rv[2];
  const int lrow = tid >> 4, lcc = tid & 15;
  const size_t gofs = (size_t)(kvbase + lrow) * 512 + hd * 128 + lcc * 8;
  const u16* kp = p.Kall + gofs;
  const u16* vp = p.Vall + gofs;
  char* kw = smem + lrow * 272 + lcc * 16;
  char* vw = smem + 17408 + lrow * 320 + lcc * 16;
  const int nit = ntb - kt0b;
  {
    const size_t go = (size_t)(fast ? kt0b : ntb - 1) * 64 * 512;
#pragma unroll
    for (int i = 0; i < 2; ++i) { rk[i] = *(const u32x4*)(kp + go + (size_t)i * 32 * 512); rv[i] = *(const u32x4*)(vp + go + (size_t)i * 32 * 512); }
#pragma unroll
    for (int i = 0; i < 2; ++i) { *(u32x4*)(kw + i * 32 * 272) = rk[i]; *(u32x4*)(vw + i * 32 * 320) = rv[i]; }
    const int k1 = fast ? (kt0b + 1 < ntb ? kt0b + 1 : ntb - 1) : (ntb - 2 > kt0b ? ntb - 2 : kt0b);
    const size_t g1 = (size_t)k1 * 64 * 512;
#pragma unroll
    for (int i = 0; i < 2; ++i) { rk[i] = *(const u32x4*)(kp + g1 + (size_t)i * 32 * 512); rv[i] = *(const u32x4*)(vp + g1 + (size_t)i * 32 * 512); }
  }
  __syncthreads();
  if (fast) {
    for (int it = 0; it < nit; ++it) {
      const int kt = kt0b + it;
      const bool active = wact && kt >= kt0w && kt < ntw;
      const char* ks = smem + (it & 1) * 37888;
      char* wb = kw + ((it + 1) & 1) * 37888;
      char* wbv = vw + ((it + 1) & 1) * 37888;
#pragma unroll
      for (int i = 0; i < 2; ++i) { *(u32x4*)(wb + i * 32 * 272) = rk[i]; *(u32x4*)(wbv + i * 32 * 320) = rv[i]; }
      {
        const int k2 = kt + 2 < ntb ? kt + 2 : ntb - 1;
        const size_t g2 = (size_t)k2 * 64 * 512;
#pragma unroll
        for (int i = 0; i < 2; ++i) { rk[i] = *(const u32x4*)(kp + g2 + (size_t)i * 32 * 512); rv[i] = *(const u32x4*)(vp + g2 + (size_t)i * 32 * 512); }
      }
      __builtin_amdgcn_sched_barrier(0);
      if (active) {
        bf16x8 pf[4];
        const float qrel = qposf - (float)(kt * 64 + 4 * h2);
        if (kt == ntw - 1) attn_tile_f<true>(ks, qf, pf, lsum, sl2, qrel, mref, m, r, h2);
        else attn_tile_f<false>(ks, qf, pf, lsum, sl2, qrel, mref, m, r, h2);
        attn_tile_b(ks + 17408, pf, O, h2, q, pp, blk);
      }
      __syncthreads();
    }
  } else {
    for (int it = 0; it < nit; ++it) {
      const int kt = ntb - 1 - it;
      const bool active = wact && kt >= kt0w && kt < ntw;
      const char* ks = smem + (it & 1) * 37888;
      char* wb = kw + ((it + 1) & 1) * 37888;
      char* wbv = vw + ((it + 1) & 1) * 37888;
#pragma unroll
      for (int i = 0; i < 2; ++i) { *(u32x4*)(wb + i * 32 * 272) = rk[i]; *(u32x4*)(wbv + i * 32 * 320) = rv[i]; }
      {
        const int k2 = kt - 2 > kt0b ? kt - 2 : kt0b;
        const size_t g2 = (size_t)k2 * 64 * 512;
#pragma unroll
        for (int i = 0; i < 2; ++i) { rk[i] = *(const u32x4*)(kp + g2 + (size_t)i * 32 * 512); rv[i] = *(const u32x4*)(vp + g2 + (size_t)i * 32 * 512); }
      }
      __builtin_amdgcn_sched_barrier(0);
      if (active) {
        bf16x8 pf[4];
        const float qrel = qposf - (float)(kt * 64 + 4 * h2);
        if (kt == ntw - 1) attn_tile_a<true>(ks, qf, O, pf, mrun, lsum, sl2, qrel, m, r, h2);
        else attn_tile_a<false>(ks, qf, O, pf, mrun, lsum, sl2, qrel, m, r, h2);
        attn_tile_b(ks + 17408, pf, O, h2, q, pp, blk);
      }
      __syncthreads();
    }
  }
  const float lt = lsum + __shfl_xor(lsum, 32);
  const float inv = wact ? 1.f / lt : 0.f;
  float* exch = (float*)smem + qg * 4096 + lane;
  if (m == 1) {
#pragma unroll
    for (int vt = 0; vt < 4; ++vt)
#pragma unroll
      for (int e = 0; e < 16; ++e) exch[(vt * 16 + e) * 64] = O[vt][e] * inv;
  }
  __syncthreads();
  if (m == 0 && wact) {
    float ss = 0.f;
#pragma unroll
    for (int vt = 0; vt < 4; ++vt)
#pragma unroll
      for (int e = 0; e < 16; ++e) { const float ov = O[vt][e] * inv - lam * exch[(vt * 16 + e) * 64]; O[vt][e] = ov; ss += ov * ov; }
    ss += __shfl_xor(ss, 32);
    const float rsn = rsqrtf(ss * (1.f / 128.f) + 1e-6f) * 0.8f;
#pragma unroll
    for (int vt = 0; vt < 4; ++vt)
#pragma unroll
      for (int g = 0; g < 4; ++g) {
        const int v = 32 * vt + 8 * g + 4 * h2;
        const f32x4 gg = *(const f32x4*)(p.subln_g + v);
        const u32x2 z = *(const u32x2*)(p.Za + (size_t)qtok * 512 + hd * 128 + v);
        u32x2 ov;
        ov[0] = pack2(O[vt][4 * g + 0] * rsn * gg[0] * bflo(z[0]), O[vt][4 * g + 1] * rsn * gg[1] * bfhi(z[0]));
        ov[1] = pack2(O[vt][4 * g + 2] * rsn * gg[2] * bflo(z[1]), O[vt][4 * g + 3] * rsn * gg[3] * bfhi(z[1]));
        *(u32x2*)(p.Mix + (size_t)qtok * 1024 + hd * 128 + v) = ov;
      }
  }
  __syncthreads();
}

DI void phase4(const Params& p, char* smem) {
  const int tid = threadIdx.x, lane = tid & 63;
  float lam;
  {
    const float a = p.lambda_qk[lane] * p.lambda_qk[64 + lane];
    const float b = p.lambda_qk[128 + lane] * p.lambda_qk[192 + lane];
    lam = __expf(wave_sum(a)) - __expf(wave_sum(b)) + 0.2f;
  }
  int* sitem = (int*)(smem + 153584);
  constexpr int NPA = 1024, NSA = 32, TOTAL = NPA + NSA + NITEM / 2;
  for (;;) {
    if (tid == 0) *sitem = atomicAdd(p.counter, 1);
    __syncthreads();
    const int item = *sitem;
    __syncthreads();
    if (item >= TOTAL) break;
    int tid_o = tid;
    asm volatile("" : "+v"(tid_o));
    if (item < NPA + NSA) {
      int tq0, qpos0, kvbase, ntb, hd, nq; bool can_skip;
      if (item < NPA) {
        const int qb = 127 - ((item & 255) >> 1), b = item & 1;
        hd = 3 - (item >> 8); tq0 = b * 16384 + qb * 128; qpos0 = qb * 128; kvbase = b * 16384; ntb = 2 * qb + 2; can_skip = true; nq = 4;
      } else {
        const int it = item - NPA, bs = it >> 2;
        hd = it & 3; tq0 = NPTOK + bs * 64; qpos0 = 1024; kvbase = NPTOK + bs * 1088; ntb = 17; can_skip = false; nq = 2;
      }
      attn_item(p, smem, tid_o, tq0, qpos0, kvbase, ntb, hd, lam, can_skip, nq);
    } else {
      const int hf = tid_o >> 8;
      r3_item(p, smem + hf * 65536, tid_o & 255, (item - NPA - NSA) * 2 + hf);
    }
  }
}

DI void phase5(const Params& p, char* smem) {
  float* wsum = (float*)(smem + 132096);
  for (int strip = blockIdx.x; strip < NTOK / 64; strip += gridDim.x) {
    int tid = threadIdx.x;
    asm volatile("" : "+v"(tid));
    const int lane = tid & 63, w = tid >> 6, r = lane & 31, h = lane >> 5;
    const int m0 = strip * 64;
    {
      const u16* gb = p.Mix + (size_t)m0 * 1024;
      const int loff = (tid >> 7) * 1024 + (tid & 127) * 8;
      char* lw = smem + (tid >> 7) * 2064 + (tid & 127) * 16;
#pragma unroll
      for (int i = 0; i < 16; ++i)
        *(u32x4*)(lw + i * 4 * 2064) = __builtin_nontemporal_load((const u32x4*)((gb + i * 4096) + loff));
    }
    f32x16 acc[2][4];
#pragma unroll
    for (int i = 0; i < 2; ++i)
#pragma unroll
      for (int j = 0; j < 4; ++j) acc[i][j] = zero16();
    const u16* bp = p.WoutT + (size_t)(w * 4) * 64 * 512 + lane * 8;
    bf16x8 b[4][4];
#pragma unroll
    for (int u = 0; u < 3; ++u)
#pragma unroll
      for (int j = 0; j < 4; ++j) b[u][j] = *(const bf16x8*)(bp + (size_t)(j * 64 + u) * 512);
    __syncthreads();
    const char* ap = smem + r * 2064 + h * 16;
    for (int ks0 = 0; ks0 < 64; ks0 += 4) {
#pragma unroll
      for (int u = 0; u < 4; ++u) {
        const int ks = ks0 + u;
        {
          const int kn = ks + 3 < 64 ? ks + 3 : 63;
#pragma unroll
          for (int j = 0; j < 4; ++j) b[(u + 3) & 3][j] = *(const bf16x8*)(bp + (size_t)(j * 64 + kn) * 512);
        }
        const bf16x8 a0 = *(const bf16x8*)(ap + ks * 32), a1 = *(const bf16x8*)(ap + 32 * 2064 + ks * 32);
#pragma unroll
        for (int j = 0; j < 4; ++j) { acc[0][j] = MFMA(a0, b[u][j], acc[0][j]); acc[1][j] = MFMA(a1, b[u][j], acc[1][j]); }
        __builtin_amdgcn_sched_barrier(0);
      }
    }
    const float* xs_u = (m0 < NPTOK ? p.x_prompt : p.x_sample - (size_t)NPTOK * 1024) + (size_t)m0 * 1024;
    const int lane_off = h * 4096 + w * 128 + r;
#pragma unroll
    for (int i = 0; i < 2; ++i) {
      float ps[16];
#pragma unroll
      for (int e = 0; e < 16; ++e) ps[e] = 0.f;
#pragma unroll
      for (int j = 0; j < 4; ++j) {
#pragma unroll
        for (int e = 0; e < 16; ++e) {
          const float hv = acc[i][j][e] + __builtin_nontemporal_load((xs_u + (i * 32 + (e & 3) + 8 * (e >> 2)) * 1024 + j * 32) + lane_off);
          acc[i][j][e] = hv; ps[e] += hv * hv;
        }
        __builtin_amdgcn_sched_barrier(0);
      }
#pragma unroll
      for (int e = 0; e < 16; ++e) {
#pragma unroll
        for (int o = 16; o >= 1; o >>= 1) ps[e] += __shfl_xor(ps[e], o);
      }
      if (r == 0) {
#pragma unroll
        for (int e = 0; e < 16; ++e) wsum[w * 64 + i * 32 + crow(e, h)] = ps[e];
      }
      __builtin_amdgcn_sched_barrier(0);
    }
    __syncthreads();
    float* yo_u = p.out + OFF_Y + (size_t)m0 * 1024;
#pragma unroll
    for (int i = 0; i < 2; ++i) {
      float sc[16];
#pragma unroll
      for (int e = 0; e < 16; ++e) {
        const int rw = i * 32 + crow(e, h);
        float t = 0.f;
#pragma unroll
        for (int k = 0; k < 8; ++k) t += wsum[k * 64 + rw];
        sc[e] = rsqrtf(t * (1.f / 1024.f) + 1e-6f);
      }
#pragma unroll
      for (int j = 0; j < 4; ++j) {
        const float g = (p.final_g + j * 32)[w * 128 + r];
#pragma unroll
        for (int e = 0; e < 16; ++e)
          __builtin_nontemporal_store(acc[i][j][e] * sc[e] * g, (yo_u + (i * 32 + (e & 3) + 8 * (e >> 2)) * 1024 + j * 32) + lane_off);
        __builtin_amdgcn_sched_barrier(0);
      }
    }
    __syncthreads();
  }
}

__global__ void __launch_bounds__(512, 2) fwd_megakernel(Params p) {
  __shared__ __attribute__((aligned(16))) char smem[153600];
  cg::grid_group grid = cg::this_grid();
  float* scratch_out = p.out + OFF_Y;
  const int lo = p.phase_lo, hi = p.phase_hi;
  if (lo <= 0 && hi >= 0) phase0(p, smem);
  if (lo <= 0 && hi >= 1) grid.sync();
  if (lo <= 1 && hi >= 1) phase1(p, smem);
  if (lo <= 1 && hi >= 2) grid.sync();
  if (lo <= 2 && hi >= 2) phase2(p, smem, (u16*)scratch_out);
  if (lo <= 2 && hi >= 3) grid.sync();
  if (lo <= 3 && hi >= 3) phase3(p, (const u16*)scratch_out);
  if (lo <= 3 && hi >= 4) grid.sync();
  if (lo <= 4 && hi >= 4) phase4(p, smem);
  if (lo <= 4 && hi >= 5) grid.sync();
  if (lo <= 5 && hi >= 5) phase5(p, smem);
}

extern "C" void kernel_launch(void* const* d_in, const int* in_sizes, int n_in, void* d_out, int out_size, void* d_ws, size_t ws_size,
                              hipStream_t stream) {
  static int grid_blocks = 0;
  if (!grid_blocks) {
    int dev = 0, cus = 0, per_cu = 0;
    hipGetDevice(&dev);
    hipDeviceGetAttribute(&cus, hipDeviceAttributeMultiprocessorCount, dev);
    hipOccupancyMaxActiveBlocksPerMultiprocessor(&per_cu, fwd_megakernel, 512, 0);
    if (per_cu > 1) per_cu = 1;
    if (per_cu < 1) per_cu = 1;
    grid_blocks = cus * per_cu;
  }
  Params p{};
  p.x_prompt = (const float*)d_in[0]; p.x_sample = (const float*)d_in[1]; p.cache_k = (const float*)d_in[2]; p.cache_v = (const float*)d_in[3];
  p.state_h = (const float*)d_in[4]; p.norm_g = (const float*)d_in[5]; p.w_in = (const float*)d_in[6]; p.lambda_qk = (const float*)d_in[7];
  p.subln_g = (const float*)d_in[8]; p.rec_lb = (const float*)d_in[9]; p.rec_norm_g = (const float*)d_in[10]; p.w_out = (const float*)d_in[11];
  p.final_g = (const float*)d_in[12];
  p.out = (float*)d_out;
  char* ws = (char*)d_ws; size_t off = 0;
  auto take = [&](size_t bytes) { char* r = ws + off; off += (bytes + 255) & ~(size_t)255; return r; };
  p.WinT = (u16*)take((size_t)4096 * 1024 * 2);
  p.WoutT = (u16*)take((size_t)1024 * 1024 * 2);
  p.Xn = (u16*)take((size_t)NTOK * 1024 * 2);
  p.SbufT = p.Xn;
  p.Qb = (u16*)take((size_t)NTOK * 512 * 2);
  p.Kall = (u16*)take((size_t)KVROWS * 512 * 2);
  p.Vall = (u16*)take((size_t)KVROWS * 512 * 2);
  p.Za = (u16*)take((size_t)NTOK * 512 * 2);
  p.Qr = (u16*)take((size_t)NTOK * 512 * 2);
  p.Ir = (u16*)take((size_t)NTOK * 512 * 2);
  p.Zr = (u16*)take((size_t)NTOK * 512 * 2);
  p.Mix = (u16*)take((size_t)NTOK * 1024 * 2);
  p.Fr = (float*)take((size_t)NTOK * 512 * 4);
  p.Abuf = (float*)take((size_t)NITEM * 128 * 4);
  p.NQ = (float*)take((size_t)NITEM * 4 * 4);
  p.counter = (int*)take(256);
  p.phase_lo = 0; p.phase_hi = 6; p.rep_mask = 0; p.pad_ = 0;
  if (off > ws_size) { fprintf(stderr, "workspace too small: need %zu have %zu\n", off, ws_size); return; }
  void* args[] = {&p};
  hipError_t e = hipLaunchCooperativeKernel((void*)fwd_megakernel, dim3(grid_blocks), dim3(512), args, 0, stream);
  if (e != hipSuccess) fprintf(stderr, "cooperative launch failed: %s (grid %d)\n", hipGetErrorString(e), grid_blocks);
}
```

```cpp
#include <hip/hip_runtime.h>
#include <hip/hip_cooperative_groups.h>
#include <cstdio>
namespace cg = cooperative_groups;

#define DI __device__ __forceinline__
typedef unsigned short u16;
using bf16x8 = __attribute__((ext_vector_type(8))) short;
using s16x4  = __attribute__((ext_vector_type(4))) short;
using f32x16 = __attribute__((ext_vector_type(16))) float;
using f32x4  = __attribute__((ext_vector_type(4))) float;
using f32x2  = __attribute__((ext_vector_type(2))) float;
using u32x4  = __attribute__((ext_vector_type(4))) unsigned;
using u32x2  = __attribute__((ext_vector_type(2))) unsigned;
typedef __bf16 bf2_t __attribute__((ext_vector_type(2)));

#define MFMA(a, b, c) __builtin_amdgcn_mfma_f32_32x32x16_bf16((a), (b), (c), 0, 0, 0)

static constexpr int NTOK = 33280;
static constexpr int NPTOK = 32768;
static constexpr int KVROWS = 32768 + 8 * 1088;
static constexpr int NITEM = 2080;
static constexpr size_t OFF_Y = 0;
static constexpr size_t OFF_NKP = 34078720;
static constexpr size_t OFF_NVP = 50855936;
static constexpr size_t OFF_NHP = 67633152;
static constexpr size_t OFF_NKS = 67764224;
static constexpr size_t OFF_NVS = 68026368;
static constexpr size_t OFF_NHS = 68288512;

struct Params {
  const float *x_prompt, *x_sample, *cache_k, *cache_v, *state_h, *norm_g, *w_in, *lambda_qk, *subln_g, *rec_lb, *rec_norm_g, *w_out, *final_g;
  float* out;
  u16 *WinT, *WoutT, *Xn, *Qb, *Kall, *Vall, *Za, *Qr, *Ir, *Zr, *Mix, *SbufT;
  float *Fr, *Abuf, *NQ;
  int* counter;
  int phase_lo, phase_hi, rep_mask, pad_;
};

DI unsigned pack2(float a, float b) { f32x2 v = {a, b}; bf2_t r = __builtin_convertvector(v, bf2_t); return __builtin_bit_cast(unsigned, r); }
DI u16 f2bf(float a) { return (u16)(pack2(a, 0.f) & 0xffffu); }
DI float bflo(unsigned u) { return __uint_as_float(u << 16); }
DI float bfhi(unsigned u) { return __uint_as_float(u & 0xffff0000u); }
DI int crow(int e, int h) { return (e & 3) + 8 * (e >> 2) + 4 * h; }
DI float wave_sum(float v) {
#pragma unroll
  for (int o = 32; o >= 1; o >>= 1) v += __shfl_xor(v, o);
  return v;
}
DI float silu_f(float v) { return v / (1.f + __expf(-v)); }
DI s16x4 tr_read(const char* p) {
  return __builtin_amdgcn_ds_read_tr16_b64_v4i16((__attribute__((address_space(3))) s16x4*)(p));
}
DI bf16x8 tr_frag(const char* p0, int stride4) {
  s16x4 lo = tr_read(p0), hi = tr_read(p0 + stride4);
  return __builtin_shufflevector(lo, hi, 0, 1, 2, 3, 4, 5, 6, 7);
}
DI bf16x8 pack8(const f32x16& x, int s) {
  u32x4 p;
  p[0] = pack2(x[8 * s + 0], x[8 * s + 1]);
  p[1] = pack2(x[8 * s + 2], x[8 * s + 3]);
  p[2] = pack2(x[8 * s + 4], x[8 * s + 5]);
  p[3] = pack2(x[8 * s + 6], x[8 * s + 7]);
  return __builtin_bit_cast(bf16x8, p);
}
DI f32x16 zero16() { f32x16 z; for (int i = 0; i < 16; ++i) z[i] = 0.f; return z; }

DI void phase0(const Params& p, char* smem) {
  const int tid = threadIdx.x, lane = tid & 63, w = tid >> 6;
  constexpr int NT_W1 = 16 * 64, NT_W2 = 16 * 16, NT_ROW = NTOK / 16, NT_CACHE = 1024;
  constexpr int total = NT_W1 + NT_W2 + NT_ROW + NT_CACHE;
  float (*tile)[65] = (float (*)[65])smem;
  if (blockIdx.x == 0 && tid < 16) p.counter[tid] = 0;
  for (int it = blockIdx.x; it < total; it += gridDim.x) {
    if (it < NT_W1 + NT_W2) {
      const float* src; u16* dst; int N, kt, nt;
      if (it < NT_W1) { src = p.w_in; dst = p.WinT; N = 4096; kt = it >> 6; nt = it & 63; }
      else { int j = it - NT_W1; src = p.w_out; dst = p.WoutT; N = 1024; kt = j >> 4; nt = j & 15; }
      const int c = tid & 63, r0 = tid >> 6;
      for (int i = 0; i < 8; ++i) { int r = r0 + 8 * i; tile[r][c] = src[(size_t)(kt * 64 + r) * N + nt * 64 + c]; }
      __syncthreads();
      if (it < NT_W1) {
        for (int i = 0; i < 8; ++i) { int r = r0 + 8 * i; dst[(size_t)(nt * 64 + r) * 1024 + kt * 64 + c] = f2bf(tile[c][r]); }
      } else {
        for (int i = 0; i < 8; ++i) {
          const int r = r0 + 8 * i, n = nt * 64 + r, k = kt * 64 + c;
          dst[((size_t)((n >> 5) * 64 + (k >> 4)) * 64 + ((k >> 3) & 1) * 32 + (n & 31)) * 8 + (k & 7)] = f2bf(tile[c][r]);
        }
      }
      __syncthreads();
    } else if (it < NT_W1 + NT_W2 + NT_ROW) {
      const int row0 = (it - NT_W1 - NT_W2) * 16 + w * 2;
      f32x4 v[2][4]; float ss[2] = {0.f, 0.f};
#pragma unroll
      for (int rr = 0; rr < 2; ++rr) {
        const int row = row0 + rr;
        const float* src = row < NPTOK ? p.x_prompt + (size_t)row * 1024 : p.x_sample + (size_t)(row - NPTOK) * 1024;
#pragma unroll
        for (int i = 0; i < 4; ++i) v[rr][i] = *(const f32x4*)(src + i * 256 + lane * 4);
      }
#pragma unroll
      for (int rr = 0; rr < 2; ++rr) {
#pragma unroll
        for (int i = 0; i < 4; ++i) ss[rr] += v[rr][i][0] * v[rr][i][0] + v[rr][i][1] * v[rr][i][1] + v[rr][i][2] * v[rr][i][2] + v[rr][i][3] * v[rr][i][3];
        ss[rr] = wave_sum(ss[rr]);
      }
#pragma unroll
      for (int rr = 0; rr < 2; ++rr) {
        const float sc = rsqrtf(ss[rr] * (1.f / 1024.f) + 1e-6f);
#pragma unroll
        for (int i = 0; i < 4; ++i) {
          f32x4 g = *(const f32x4*)(p.norm_g + i * 256 + lane * 4);
          u32x2 o; o[0] = pack2(v[rr][i][0] * sc * g[0], v[rr][i][1] * sc * g[1]); o[1] = pack2(v[rr][i][2] * sc * g[2], v[rr][i][3] * sc * g[3]);
          *(u32x2*)(p.Xn + (size_t)(row0 + rr) * 1024 + i * 256 + lane * 4) = o;
        }
      }
    } else {
      const int task0 = (it - NT_W1 - NT_W2 - NT_ROW) * 16 + w * 2;
      f32x4 a[2], b[2];
#pragma unroll
      for (int rr = 0; rr < 2; ++rr) {
        const int task = task0 + rr, which = task >> 13, r8 = task & 8191;
        const float* src = (which ? p.cache_v : p.cache_k) + (size_t)r8 * 512 + lane * 8;
        a[rr] = *(const f32x4*)src; b[rr] = *(const f32x4*)(src + 4);
      }
#pragma unroll
      for (int rr = 0; rr < 2; ++rr) {
        const int task = task0 + rr, which = task >> 13, r8 = task & 8191;
        u16* dst = (which ? p.Vall : p.Kall) + (size_t)(NPTOK + (r8 >> 10) * 1088 + (r8 & 1023)) * 512 + lane * 8;
        u32x4 o; o[0] = pack2(a[rr][0], a[rr][1]); o[1] = pack2(a[rr][2], a[rr][3]); o[2] = pack2(b[rr][0], b[rr][1]); o[3] = pack2(b[rr][2], b[rr][3]);
        *(u32x4*)dst = o;
      }
    }
  }
}

#define G_LOAD(RA, RB, KT_)                                                                                        \
  {                                                                                                                 \
    _Pragma("unroll") for (int i_ = 0; i_ < 4; ++i_) RA[i_] = *(const u32x4*)((ap + (size_t)i_ * 64 * K + (KT_) * 64) + loff); \
    _Pragma("unroll") for (int i_ = 0; i_ < 4; ++i_) RB[i_] = *(const u32x4*)((bp + (size_t)i_ * 64 * K + (KT_) * 64) + loff); \
  }
#define G_WRITE(RA, RB, BUF_)                                                                                      \
  {                                                                                                                 \
    _Pragma("unroll") for (int i_ = 0; i_ < 4; ++i_) *(u32x4*)(wbase + (BUF_) * 73728 + i_ * 64 * 144) = RA[i_];         \
    _Pragma("unroll") for (int i_ = 0; i_ < 4; ++i_) *(u32x4*)(wbase + (BUF_) * 73728 + 36864 + i_ * 64 * 144) = RB[i_]; \
  }
#define G_FRAGS(FA, FB, S_)                                                                                        \
  {                                                                                                                 \
    _Pragma("unroll") for (int i_ = 0; i_ < 4; ++i_) FA[i_] = *(const bf16x8*)(as_ + i_ * 32 * 144 + (S_) * 32);      \
    FB[0] = *(const bf16x8*)(bs_ + (S_) * 32); FB[1] = *(const bf16x8*)(bs_ + 32 * 144 + (S_) * 32);                \
  }
#define G_MFMA8(FA, FB)                                                                                            \
  {                                                                                                                 \
    _Pragma("unroll") for (int i_ = 0; i_ < 4; ++i_) {                                                              \
      acc[i_][0] = MFMA(FA[i_], FB[0], acc[i_][0]);                                                                 \
      acc[i_][1] = MFMA(FA[i_], FB[1], acc[i_][1]);                                                                 \
    }                                                                                                               \
  }
#define G_COMPUTE(BUF_)                                                                                            \
  {                                                                                                                 \
    const char* as_ = smem + (BUF_) * 73728 + (wm * 128 + r) * 144 + h * 16;                                        \
    const char* bs_ = smem + (BUF_) * 73728 + 36864 + (wn * 64 + r) * 144 + h * 16;                                 \
    bf16x8 fa0[4], fb0[2], fa1[4], fb1[2];                                                                          \
    G_FRAGS(fa0, fb0, 0);                                                                                           \
    G_FRAGS(fa1, fb1, 1); __builtin_amdgcn_sched_barrier(0); G_MFMA8(fa0, fb0); __builtin_amdgcn_sched_barrier(0);  \
    G_FRAGS(fa0, fb0, 2); __builtin_amdgcn_sched_barrier(0); G_MFMA8(fa1, fb1); __builtin_amdgcn_sched_barrier(0);  \
    G_FRAGS(fa1, fb1, 3); __builtin_amdgcn_sched_barrier(0); G_MFMA8(fa0, fb0); __builtin_amdgcn_sched_barrier(0);  \
    G_MFMA8(fa1, fb1);                                                                                              \
  }
DI void gemm_preload(const u16* __restrict__ A, const u16* __restrict__ BT, int K, int m0, int n0, int tid, u32x4 (&ra0)[4], u32x4 (&rb0)[4]) {
  const u16* ap = A + (size_t)m0 * K;
  const u16* bp = BT + (size_t)n0 * K;
  const int loff = (tid >> 3) * K + (tid & 7) * 8;
  G_LOAD(ra0, rb0, 0);
}
DI void gemm256(const u16* __restrict__ A, const u16* __restrict__ BT, int K, int m0, int n0, char* smem, int tid, f32x16 (&acc)[4][2],
                u32x4 (&ra0)[4], u32x4 (&rb0)[4]) {
  const int lane = tid & 63, w = tid >> 6, r = lane & 31, h = lane >> 5;
  const int wm = w >> 2, wn = w & 3;
#pragma unroll
  for (int i = 0; i < 4; ++i) { acc[i][0] = zero16(); acc[i][1] = zero16(); }
  const int KT = K >> 6;
  const u16* ap = A + (size_t)m0 * K;
  const u16* bp = BT + (size_t)n0 * K;
  const int loff = (tid >> 3) * K + (tid & 7) * 8;
  char* wbase = smem + (tid >> 3) * 144 + (tid & 7) * 16;
  G_WRITE(ra0, rb0, 0);
  __syncthreads();
  for (int kt = 0; kt < KT; kt += 2) {
    { const int k1 = kt + 1 < KT ? kt + 1 : KT - 1; G_LOAD(ra0, rb0, k1); }
    __builtin_amdgcn_sched_barrier(0);
    G_COMPUTE(0);
    __builtin_amdgcn_sched_barrier(0);
    G_WRITE(ra0, rb0, 1);
    __syncthreads();
    { const int k2 = kt + 2 < KT ? kt + 2 : KT - 1; G_LOAD(ra0, rb0, k2); }
    __builtin_amdgcn_sched_barrier(0);
    G_COMPUTE(1);
    __builtin_amdgcn_sched_barrier(0);
    G_WRITE(ra0, rb0, 0);
    __syncthreads();
  }
}
struct TileMap {
  int MT, NT, C, NG, NST, st, lb, lin;
  bool xcd;
  DI TileMap(int mt_, int nt_) : MT(mt_), NT(nt_) {
    const int nb = gridDim.x >> 3;
    C = nb >> 3;
    xcd = (gridDim.x & 63) == 0 && C > 0 && (NT % C) == 0;
    NG = xcd ? NT / C : 1;
    NST = ((MT + 7) >> 3) * NG;
    st = blockIdx.x & 7; lb = blockIdx.x >> 3; lin = blockIdx.x;
  }
  DI bool next(int& mt, int& nt) {
    if (!xcd) {
      if (lin >= MT * NT) return false;
      mt = lin / NT; nt = lin - mt * NT; lin += gridDim.x; return true;
    }
    while (st < NST) {
      const int mg = st / NG, ng = st - mg * NG;
      mt = mg * 8 + lb / C; nt = ng * C + lb % C;
      st += 8;
      if (mt < MT) return true;
    }
    return false;
  }
};
DI void stage_half(const f32x16 (&acc)[4][2], float* cs, int half, int wm, int wn, int r, int h) {
  if (wm == half) {
#pragma unroll
    for (int i = 0; i < 4; ++i)
#pragma unroll
      for (int j = 0; j < 2; ++j)
#pragma unroll
        for (int e = 0; e < 16; ++e) cs[(i * 32 + crow(e, h)) * 260 + wn * 64 + j * 32 + r] = acc[i][j][e];
  }
}

struct XcdTiles {
  int q, tried;
  DI XcdTiles() { q = (int)(__builtin_amdgcn_s_getreg((3 << 11) | 20) & 7u); tried = 0; }
  DI bool next(const Params& p, int* sl, int& mt, int& nt) {
    for (;;) {
      if (threadIdx.x == 0) *sl = atomicAdd(p.counter + 8 + q, 1);
      __syncthreads();
      const int t = *sl;
      __syncthreads();
      const int npatch = (68 - q + 7) >> 3;
      if (t < npatch * 32) {
        const int patch = q + 8 * (t >> 5), inner = t & 31;
        mt = (patch >> 2) * 8 + (inner >> 2); nt = (patch & 3) * 4 + (inner & 3);
        if (mt < NTOK / 256) return true;
      } else {
        q = (q + 1) & 7;
        if (++tried == 8) return false;
      }
    }
  }
};
DI void phase1(const Params& p, char* smem) {
  constexpr int MT = NTOK / 256, NT = 16;
  XcdTiles tm;
  int* sl = (int*)(smem + 153584);
  int mt, nt;
  bool have = tm.next(p, sl, mt, nt);
  u32x4 pa[4], pb[4];
  if (have) gemm_preload(p.Xn, p.WinT, 1024, mt * 256, nt * 256, threadIdx.x, pa, pb);
  while (have) {
    const int m0 = mt * 256, n0 = nt * 256;
    f32x16 acc[4][2];
    {
      int tg = threadIdx.x;
      asm volatile("" : "+v"(tg));
      gemm256(p.Xn, p.WinT, 1024, m0, n0, smem, tg, acc, pa, pb);
    }
    have = tm.next(p, sl, mt, nt);
    if (have) {
      int tg = threadIdx.x;
      asm volatile("" : "+v"(tg));
      gemm_preload(p.Xn, p.WinT, 1024, mt * 256, nt * 256, tg, pa, pb);
    }
    int tid = threadIdx.x;
    asm volatile("" : "+v"(tid));
    const int lane = tid & 63, w = tid >> 6, r = lane & 31, h = lane >> 5;
    const int wm = w >> 2, wn = w & 3;
    const int sec = n0 >> 9;
    const bool samp = m0 >= NPTOK;
    float* cs = (float*)smem;
    const int c0 = (tid & 31) * 8, rb = tid >> 5;
    const int csc = (n0 & 511) + c0;
#pragma unroll 1
    for (int half = 0; half < 2; ++half) {
      stage_half(acc, cs, half, wm, wn, r, h);
      __syncthreads();
#pragma unroll 2
      for (int ps = 0; ps < 8; ++ps) {
        const int row = rb + 16 * ps;
        const int t = m0 + half * 128 + row;
        f32x4 va = *(const f32x4*)(cs + row * 260 + c0), vb = *(const f32x4*)(cs + row * 260 + c0 + 4);
        const size_t o512 = (size_t)t * 512 + csc;
        if (sec == 5) { __builtin_nontemporal_store(va, (f32x4*)(p.Fr + o512)); __builtin_nontemporal_store(vb, (f32x4*)(p.Fr + o512 + 4)); }
        else {
          u16* dst;
          if (sec == 0) {
            const float qs = 0.125f * 1.44269504089f;
            va *= qs; vb *= qs; dst = p.Qb + o512;
          } else if (sec == 1 || sec == 2) {
            size_t kvr; float* od;
            if (!samp) { kvr = t; od = p.out + (sec == 1 ? OFF_NKP : OFF_NVP) + o512; }
            else { const int ts = t - NPTOK; kvr = NPTOK + (ts >> 6) * 1088 + 1024 + (ts & 63); od = p.out + (sec == 1 ? OFF_NKS : OFF_NVS) + (size_t)ts * 512 + csc; }
            __builtin_nontemporal_store(va, (f32x4*)od); __builtin_nontemporal_store(vb, (f32x4*)(od + 4));
            dst = (sec == 1 ? p.Kall : p.Vall) + kvr * 512 + csc;
          } else if (sec == 6) { dst = p.Ir + o512; }
          else {
#pragma unroll
            for (int i = 0; i < 4; ++i) { va[i] = silu_f(va[i]); vb[i] = silu_f(vb[i]); }
            dst = (sec == 3 ? p.Za : (sec == 4 ? p.Qr : p.Zr)) + o512;
          }
          u32x4 o; o[0] = pack2(va[0], va[1]); o[1] = pack2(va[2], va[3]); o[2] = pack2(vb[0], vb[1]); o[3] = pack2(vb[2], vb[3]);
          __builtin_nontemporal_store(o, (u32x4*)dst);
        }
      }
      __syncthreads();
    }
  }
}

DI void rec_load(const Params& p, int tid, int I, float (&xv)[32]) {
  const int d = tid & 127, half = tid >> 7;
  const int hd = I & 3, t0 = (I >> 2) * 64;
  const float* fp = p.Fr + (size_t)(t0 + half * 32) * 512 + hd * 128 + d;
#pragma unroll
  for (int i = 0; i < 32; ++i) xv[i] = fp[(size_t)i * 512];
}
DI void rec_pre_x(const Params& p, int tid, int I, float* totS, const float (&xv)[32], float (&cum)[32], float (&key)[32], float& lastv) {
  const int d = tid & 127, half = tid >> 7;
  const int hd = I & 3;
  const float r0 = p.rec_lb[hd * 128 + d], r1 = p.rec_lb[512 + hd * 128 + d];
  const float lb = 1.f / (1.f + __expf(r1 - r0));
  float run = 0.f;
#pragma unroll
  for (int i = 0; i < 32; ++i) {
    float x = xv[i];
    x = fminf(fmaxf(x, -30.f), 30.f);
    const float e = __expf(-x), sg = 1.f / (1.f + e);
    run += __logf(lb + (1.f - lb) * sg);
    cum[i] = run; key[i] = (1.f - lb) * e * sg;
  }
  totS[tid] = run;
  __syncthreads();
  const float tot0 = totS[d], tot1 = totS[128 + d];
  if (half) {
#pragma unroll
    for (int i = 0; i < 32; ++i) cum[i] += tot0;
  }
  lastv = tot0 + tot1;
}
DI void rec_pre(const Params& p, int tid, int I, float* totS, float (&cum)[32], float (&key)[32], float& lastv) {
  float xv[32];
  rec_load(p, tid, I, xv);
  rec_pre_x(p, tid, I, totS, xv, cum, key, lastv);
}

DI void phase2(const Params& p, char* smem0, u16* BbufT) {
  const int hf = threadIdx.x >> 8;
  const int tid = threadIdx.x & 255, lane = tid & 63, w = tid >> 6, r = lane & 31, h = lane >> 5;
  const int q = (lane & 15) >> 2, pp = lane & 3, blk = (lane >> 4) & 1;
  const int d = tid & 127, half = tid >> 7;
  char* smem = smem0 + hf * 65536;
  char* KdI = smem; char* VrI = smem + 17408; float* totS = (float*)(smem + 60000);
  float xv[32];
  rec_load(p, tid, blockIdx.x * 2 + hf < NITEM ? blockIdx.x * 2 + hf : NITEM - 1, xv);
  for (int I = blockIdx.x * 2 + hf; I < NITEM; I += gridDim.x * 2) {
    const int hd = I & 3, t0 = (I >> 2) * 64;
    if (I < 2048) {
      const int token = tid & 63, which = tid >> 6;
      const u16* src = (which < 2 ? p.Qb : p.Kall) + (size_t)(t0 + token) * 512 + hd * 128 + (which & 1) * 64;
      float ss = 0.f;
#pragma unroll
      for (int c = 0; c < 8; ++c) {
        const u32x4 v = *(const u32x4*)(src + c * 8);
#pragma unroll
        for (int i = 0; i < 4; ++i) { const float lo = bflo(v[i]), hi = bfhi(v[i]); ss += lo * lo + hi * hi; }
      }
#pragma unroll
      for (int o = 32; o >= 1; o >>= 1) ss = fmaxf(ss, __shfl_xor(ss, o));
      if (lane == 0) p.NQ[I * 4 + which] = sqrtf(ss);
    }
    float cum[32], key[32], lastv;
    rec_pre_x(p, tid, I, totS, xv, cum, key, lastv);
    {
      const int In = I + gridDim.x * 2;
      rec_load(p, tid, In < NITEM ? In : I, xv);
    }
#pragma unroll
    for (int i = 0; i < 32; ++i) {
      const int t = half * 32 + i;
      *(u16*)(KdI + t * 272 + d * 2) = f2bf(key[i] * __expf(lastv - cum[i]));
    }
#pragma unroll
    for (int i = 0; i < 4; ++i) {
      const int ch = tid + 256 * i, row = ch >> 4, cc = ch & 15;
      *(u32x4*)(VrI + row * 272 + cc * 16) = *(const u32x4*)(p.Ir + (size_t)(t0 + row) * 512 + hd * 128 + cc * 8);
    }
    if (half) p.Abuf[I * 128 + d] = __expf(lastv);
    __syncthreads();
    f32x16 acc[4];
#pragma unroll
    for (int ct = 0; ct < 4; ++ct) acc[ct] = zero16();
#pragma unroll
    for (int ks = 0; ks < 4; ++ks) {
      const int rowoff = (16 * ks + 8 * h + q) * 272 + 32 * blk + 8 * pp;
      bf16x8 a = tr_frag(VrI + rowoff + 64 * w, 4 * 272);
#pragma unroll
      for (int ct = 0; ct < 4; ++ct) {
        bf16x8 b = tr_frag(KdI + rowoff + 64 * ct, 4 * 272);
        acc[ct] = MFMA(a, b, acc[ct]);
      }
    }
    u16* ob = BbufT + (size_t)I * 16384;
#pragma unroll
    for (int ct = 0; ct < 4; ++ct)
#pragma unroll
      for (int e = 0; e < 16; ++e) ob[(32 * w + crow(e, h)) * 128 + 32 * ct + r] = f2bf(acc[ct][e]);
    __syncthreads();
  }
}

DI void phase3(const Params& p, const u16* BbufT) {
  const int tid = threadIdx.x & 255;
  for (int it = blockIdx.x * 2 + (threadIdx.x >> 8); it < 512 + 1024; it += gridDim.x * 2) {
    if (it < 512) {
      const int bh = it >> 6, b = bh >> 2, hd = bh & 3;
      const int e1 = (it & 63) * 256 + tid, v = e1 >> 7, d = e1 & 127;
      float sx = 0.f;
      const size_t eo = (size_t)v * 128 + d;
      const int I0 = (b * 256) * 4 + hd;
      const float* ap = p.Abuf + (size_t)I0 * 128 + d;
      const u16* bp = BbufT + (size_t)I0 * 16384 + eo;
      u16* sp = p.SbufT + (size_t)I0 * 16384 + eo;
      for (int c0 = 0; c0 < 256; c0 += 16) {
        float av[16]; u16 bw[16];
#pragma unroll
        for (int i = 0; i < 16; ++i) { av[i] = ap[(size_t)(c0 + i) * 4 * 128]; bw[i] = bp[(size_t)(c0 + i) * 4 * 16384]; }
#pragma unroll
        for (int i = 0; i < 16; ++i) {
          sp[(size_t)(c0 + i) * 4 * 16384] = f2bf(sx);
          sx = av[i] * sx + bflo(bw[i]);
        }
      }
      p.out[OFF_NHP + (size_t)(b * 4 + hd) * 16384 + d * 128 + v] = sx;
    } else {
      const int j = it - 512;
      const int sh = j >> 5, bs = sh >> 2, hd = sh & 3;
      const int e2 = (j & 31) * 256 + tid, v = e2 >> 6, d2 = (e2 & 63) * 2;
      const int I = (512 + bs) * 4 + hd;
      const float* sh0 = p.state_h + (size_t)(bs * 4 + hd) * 16384;
      float sx = sh0[d2 * 128 + v], sy = sh0[(d2 + 1) * 128 + v];
      const size_t eo = (size_t)v * 128 + d2;
      const f32x2 a = *(const f32x2*)(p.Abuf + I * 128 + d2);
      const unsigned bw = *(const unsigned*)(BbufT + (size_t)I * 16384 + eo);
      *(unsigned*)(p.SbufT + (size_t)I * 16384 + eo) = pack2(sx, sy);
      sx = a[0] * sx + bflo(bw); sy = a[1] * sy + bfhi(bw);
      float* oh = p.out + OFF_NHS + (size_t)(bs * 4 + hd) * 16384;
      oh[d2 * 128 + v] = sx; oh[(d2 + 1) * 128 + v] = sy;
    }
  }
}

DI void r3_item(const Params& p, char* smem, int tid, int I) {
  const int lane = tid & 63, w = tid >> 6, r = lane & 31, h = lane >> 5;
  const int q = (lane & 15) >> 2, pp = lane & 3, blk = (lane >> 4) & 1;
  const int d = tid & 127, half = tid >> 7;
  char* QdI = smem; char* KdI = smem + 17408; char* VrI = smem + 34816;
  float* totS = (float*)(smem + 60000); float* ssS = (float*)(smem + 62048);
  const int hd = I & 3, t0 = (I >> 2) * 64;
  {
    float cum[32], key[32], lastv;
    rec_pre(p, tid, I, totS, cum, key, lastv);
    const u16* qp = p.Qr + (size_t)(t0 + half * 32) * 512 + hd * 128 + d;
#pragma unroll
    for (int i = 0; i < 32; ++i) {
      const int t = half * 32 + i;
      const float qv = bflo(qp[(size_t)i * 512]);
      *(u16*)(QdI + t * 272 + d * 2) = f2bf(qv * __expf(cum[i]));
      *(u16*)(KdI + t * 272 + d * 2) = f2bf(key[i] * __expf(-cum[i]));
    }
  }
#pragma unroll
  for (int i = 0; i < 4; ++i) {
    const int ch = tid + 256 * i, row = ch >> 4, cc = ch & 15;
    *(u32x4*)(VrI + row * 272 + cc * 16) = *(const u32x4*)(p.Ir + (size_t)(t0 + row) * 512 + hd * 128 + cc * 8);
  }
  __syncthreads();
  const int tt = w & 1, vh = w >> 1;
  bf16x8 qf[8];
#pragma unroll
  for (int ks = 0; ks < 8; ++ks) qf[ks] = *(const bf16x8*)(QdI + (32 * tt + r) * 272 + ks * 32 + h * 16);
  f32x16 sc[2]; sc[0] = zero16(); sc[1] = zero16();
#pragma unroll
  for (int ks = 0; ks < 8; ++ks) {
    bf16x8 a0 = *(const bf16x8*)(KdI + r * 272 + ks * 32 + h * 16);
    sc[0] = MFMA(a0, qf[ks], sc[0]);
  }
  if (tt == 1) {
#pragma unroll
    for (int ks = 0; ks < 8; ++ks) {
      bf16x8 a1 = *(const bf16x8*)(KdI + (32 + r) * 272 + ks * 32 + h * 16);
      sc[1] = MFMA(a1, qf[ks], sc[1]);
    }
  }
#pragma unroll
  for (int e = 0; e < 16; ++e) {
    const bool keep = crow(e, h) <= r;
    if (tt == 0) { if (!keep) sc[0][e] = 0.f; }
    else { if (!keep) sc[1][e] = 0.f; }
  }
  bf16x8 pf[4];
  pf[0] = pack8(sc[0], 0); pf[1] = pack8(sc[0], 1); pf[2] = pack8(sc[1], 0); pf[3] = pack8(sc[1], 1);
  f32x16 o[2]; o[0] = zero16(); o[1] = zero16();
  const u16* sp = p.SbufT + (size_t)I * 16384;
#pragma unroll
  for (int vi = 0; vi < 2; ++vi) {
    const int vt = 2 * vh + vi;
#pragma unroll
    for (int k4 = 0; k4 < 4; ++k4) {
      if (k4 < 2 || tt == 1) {
        bf16x8 a = tr_frag(VrI + (16 * k4 + 4 * h + q) * 272 + (32 * vt + 16 * blk) * 2 + 8 * pp, 8 * 272);
        o[vi] = MFMA(a, pf[k4], o[vi]);
      }
    }
#pragma unroll
    for (int ks = 0; ks < 8; ++ks) {
      bf16x8 a = *(const bf16x8*)(sp + (size_t)(32 * vt + r) * 128 + ks * 16 + h * 8);
      o[vi] = MFMA(a, qf[ks], o[vi]);
    }
  }
  float ss = 0.f;
#pragma unroll
  for (int vi = 0; vi < 2; ++vi)
#pragma unroll
    for (int e = 0; e < 16; ++e) ss += o[vi][e] * o[vi][e];
  ss += __shfl_xor(ss, 32);
  if (h == 0) ssS[w * 32 + r] = ss;
  __syncthreads();
  const float tot = ssS[tt * 32 + r] + ssS[(tt + 2) * 32 + r];
  const float rs = rsqrtf(tot * (1.f / 128.f) + 1e-6f);
  const int tok = t0 + 32 * tt + r;
#pragma unroll
  for (int vi = 0; vi < 2; ++vi)
#pragma unroll
    for (int g = 0; g < 4; ++g) {
      const int v = 32 * (2 * vh + vi) + 8 * g + 4 * h;
      const f32x4 gg = *(const f32x4*)(p.rec_norm_g + v);
      const u32x2 z = *(const u32x2*)(p.Zr + (size_t)tok * 512 + hd * 128 + v);
      u32x2 ov;
      ov[0] = pack2(o[vi][4 * g + 0] * rs * gg[0] * bflo(z[0]), o[vi][4 * g + 1] * rs * gg[1] * bfhi(z[0]));
      ov[1] = pack2(o[vi][4 * g + 2] * rs * gg[2] * bflo(z[1]), o[vi][4 * g + 3] * rs * gg[3] * bfhi(z[1]));
      *(u32x2*)(p.Mix + (size_t)tok * 1024 + 512 + hd * 128 + v) = ov;
    }
  __syncthreads();
}

template <bool DIAG>
DI void attn_tile_a(const char* ks, const bf16x8 (&qf)[4], f32x16 (&O)[4], bf16x8 (&pf)[4], float& mrun, float& lsum, float sl2, float qrel,
                    int m, int r, int h2) {
  f32x16 S[2];
#pragma unroll
  for (int st = 0; st < 2; ++st) {
    S[st] = zero16();
#pragma unroll
    for (int s = 0; s < 4; ++s) {
      bf16x8 a = *(const bf16x8*)(ks + (32 * st + r) * 272 + m * 128 + s * 32 + h2 * 16);
      S[st] = MFMA(a, qf[s], S[st]);
    }
  }
  float mx = -1e30f;
#pragma unroll
  for (int st = 0; st < 2; ++st)
#pragma unroll
    for (int e = 0; e < 16; ++e) {
      const float cst = (float)(32 * st + (e & 3) + 8 * (e >> 2));
      float sv;
      if (DIAG) sv = fmaf(-sl2, fabsf(qrel - cst), S[st][e]);
      else sv = fmaf(sl2, cst, S[st][e]);
      S[st][e] = sv; mx = fmaxf(mx, sv);
    }
  const float L = DIAG ? 0.f : -sl2 * qrel;
  mx += L;
  mx = fmaxf(mx, __shfl_xor(mx, 32));
  if (__builtin_amdgcn_ballot_w64(mx > mrun + 6.f) != 0) {
    const float mnew = fmaxf(mrun, mx);
    const float alpha = __builtin_amdgcn_exp2f(mrun - mnew);
    mrun = mnew; lsum *= alpha;
#pragma unroll
    for (int vt = 0; vt < 4; ++vt)
#pragma unroll
      for (int e = 0; e < 16; ++e) O[vt][e] *= alpha;
  }
  const float off = L - mrun;
  float rs = 0.f;
#pragma unroll
  for (int st = 0; st < 2; ++st)
#pragma unroll
    for (int e = 0; e < 16; ++e) { const float pv = __builtin_amdgcn_exp2f(S[st][e] + off); S[st][e] = pv; rs += pv; }
  lsum += rs;
  pf[0] = pack8(S[0], 0); pf[1] = pack8(S[0], 1); pf[2] = pack8(S[1], 0); pf[3] = pack8(S[1], 1);
}
template <bool DIAG>
DI void attn_tile_f(const char* ks, const bf16x8 (&qf)[4], bf16x8 (&pf)[4], float& lsum, float sl2, float qrel, float mref, int m, int r, int h2) {
  f32x16 S[2];
  const float offL = -sl2 * qrel - mref;
#pragma unroll
  for (int st = 0; st < 2; ++st) {
#pragma unroll
    for (int e = 0; e < 16; ++e) {
      const float cst = (float)(32 * st + (e & 3) + 8 * (e >> 2));
      S[st][e] = DIAG ? (-sl2 * fabsf(qrel - cst) - mref) : fmaf(sl2, cst, offL);
    }
#pragma unroll
    for (int s = 0; s < 4; ++s) {
      bf16x8 a = *(const bf16x8*)(ks + (32 * st + r) * 272 + m * 128 + s * 32 + h2 * 16);
      S[st] = MFMA(a, qf[s], S[st]);
    }
  }
  float rs = 0.f;
#pragma unroll
  for (int st = 0; st < 2; ++st)
#pragma unroll
    for (int e = 0; e < 16; ++e) { const float pv = __builtin_amdgcn_exp2f(S[st][e]); S[st][e] = pv; rs += pv; }
  lsum += rs;
  pf[0] = pack8(S[0], 0); pf[1] = pack8(S[0], 1); pf[2] = pack8(S[1], 0); pf[3] = pack8(S[1], 1);
}
DI void attn_tile_b(const char* vs, const bf16x8 (&pf)[4], f32x16 (&O)[4], int h2, int q, int pp, int blk) {
  const char* vb = vs + (4 * h2 + q) * 320 + 32 * blk + 8 * pp;
  bf16x8 a0[4], a1[4];
#pragma unroll
  for (int vt = 0; vt < 4; ++vt) a0[vt] = tr_frag(vb + 64 * vt, 8 * 320);
  __builtin_amdgcn_sched_barrier(0);
#pragma unroll
  for (int vt = 0; vt < 4; ++vt) a1[vt] = tr_frag(vb + 16 * 320 + 64 * vt, 8 * 320);
#pragma unroll
  for (int vt = 0; vt < 4; ++vt) O[vt] = MFMA(a0[vt], pf[0], O[vt]);
  __builtin_amdgcn_sched_barrier(0);
#pragma unroll
  for (int vt = 0; vt < 4; ++vt) a0[vt] = tr_frag(vb + 32 * 320 + 64 * vt, 8 * 320);
#pragma unroll
  for (int vt = 0; vt < 4; ++vt) O[vt] = MFMA(a1[vt], pf[1], O[vt]);
  __builtin_amdgcn_sched_barrier(0);
#pragma unroll
  for (int vt = 0; vt < 4; ++vt) a1[vt] = tr_frag(vb + 48 * 320 + 64 * vt, 8 * 320);
#pragma unroll
  for (int vt = 0; vt < 4; ++vt) O[vt] = MFMA(a0[vt], pf[2], O[vt]);
  __builtin_amdgcn_sched_barrier(0);
#pragma unroll
  for (int vt = 0; vt < 4; ++vt) O[vt] = MFMA(a1[vt], pf[3], O[vt]);
}

DI void attn_item(const Params& p, char* smem, int tid, int tq0, int qpos0, int kvbase, int ntb, int hd, float lam, bool can_skip, int nq) {
  const int lane = tid & 63, w = tid >> 6, r = lane & 31, h2 = lane >> 5;
  const int q = (lane & 15) >> 2, pp = lane & 3, blk = (lane >> 4) & 1;
  const int qg = w & 3, m = w >> 2, ch = qg >> 1;
  const bool wact = qg < nq;
  const float sl2 = exp2f(-2.f * (float)(hd + 1)) * 1.44269504089f;
  const int qtok = tq0 + 32 * qg + r;
  const float qposf = (float)(qpos0 + 32 * qg + r);
  const int ntw = can_skip ? ntb - 1 + ch : ntb;
  int kt0w = 0, kt0b = 0;
  bool fast = false; float kn_w = 0.f;
  if (can_skip) {
    const int I0 = (tq0 >> 6) * 4 + hd;
    const int crk = kvbase >> 6;
    fast = true; kt0b = ntb;
#pragma unroll
    for (int mm = 0; mm < 2; ++mm) {
      float KN = 0.f;
      for (int c = lane; c < ntb; c += 64) KN = fmaxf(KN, p.NQ[((crk + c) * 4 + hd) * 4 + 2 + mm]);
#pragma unroll
      for (int o = 32; o >= 1; o >>= 1) KN = fmaxf(KN, __shfl_xor(KN, o));
#pragma unroll
      for (int cc = 0; cc < 2; ++cc) {
        const float QN = p.NQ[(I0 + 4 * cc) * 4 + mm];
        const float D = (2.02f * QN * KN + 66.f) / sl2;
        const float f = ((float)(qpos0 + 64 * cc - 63) - D) * (1.f / 64.f);
        const int k0 = f < 0.f ? 0 : (int)f + 1;
        kt0b = k0 < kt0b ? k0 : kt0b;
        fast = fast && (2.02f * QN * KN < 60.f);
        if (mm == m && cc == ch) { kt0w = k0; kn_w = KN; }
      }
    }
  }
  bf16x8 qf[4];
  if (wact) {
#pragma unroll
    for (int s = 0; s < 4; ++s) qf[s] = *(const bf16x8*)(p.Qb + (size_t)qtok * 512 + hd * 128 + m * 64 + 16 * s + 8 * h2);
  } else {
#pragma unroll
    for (int s = 0; s < 4; ++s) qf[s] = (bf16x8){0, 0, 0, 0, 0, 0, 0, 0};
  }
  float mref = 0.f;
  if (fast) {
    float qq = 0.f;
#pragma unroll
    for (int s = 0; s < 4; ++s) {
      const u32x4 u = __builtin_bit_cast(u32x4, qf[s]);
#pragma unroll
      for (int i = 0; i < 4; ++i) { const float lo = bflo(u[i]), hi = bfhi(u[i]); qq += lo * lo + hi * hi; }
    }
    qq += __shfl_xor(qq, 32);
    mref = sqrtf(qq) * kn_w * 1.01f + 0.5f;
  }
  f32x16 O[4];
#pragma unroll
  for (int vt = 0; vt < 4; ++vt) O[vt] = zero16();
  float mrun = -1e30f, lsum = 0.f;
  u32x4 rk[2], rv[2];
  const int lrow = tid >> 4, lcc = tid & 15;
  const size_t gofs = (size_t)(kvbase + lrow) * 512 + hd * 128 + lcc * 8;
  const u16* kp = p.Kall + gofs;
  const u16* vp = p.Vall + gofs;
  char* kw = smem + lrow * 272 + lcc * 16;
  char* vw = smem + 17408 + lrow * 320 + lcc * 16;
  const int nit = ntb - kt0b;
  {
    const size_t go = (size_t)(fast ? kt0b : ntb - 1) * 64 * 512;
#pragma unroll
    for (int i = 0; i < 2; ++i) { rk[i] = *(const u32x4*)(kp + go + (size_t)i * 32 * 512); rv[i] = *(const u32x4*)(vp + go + (size_t)i * 32 * 512); }
#pragma unroll
    for (int i = 0; i < 2; ++i) { *(u32x4*)(kw + i * 32 * 272) = rk[i]; *(u32x4*)(vw + i * 32 * 320) = rv[i]; }
    const int k1 = fast ? (kt0b + 1 < ntb ? kt0b + 1 : ntb - 1) : (ntb - 2 > kt0b ? ntb - 2 : kt0b);
    const size_t g1 = (size_t)k1 * 64 * 512;
#pragma unroll
    for (int i = 0; i < 2; ++i) { rk[i] = *(const u32x4*)(kp + g1 + (size_t)i * 32 * 512); rv[i] = *(const u32x4*)(vp + g1 + (size_t)i * 32 * 512); }
  }
  __syncthreads();
  if (fast) {
    for (int it = 0; it < nit; ++it) {
      const int kt = kt0b + it;
      const bool active = wact && kt >= kt0w && kt < ntw;
      const char* ks = smem + (it & 1) * 37888;
      char* wb = kw + ((it + 1) & 1) * 37888;
      char* wbv = vw + ((it + 1) & 1) * 37888;
#pragma unroll
      for (int i = 0; i < 2; ++i) { *(u32x4*)(wb + i * 32 * 272) = rk[i]; *(u32x4*)(wbv + i * 32 * 320) = rv[i]; }
      {
        const int k2 = kt + 2 < ntb ? kt + 2 : ntb - 1;
        const size_t g2 = (size_t)k2 * 64 * 512;
#pragma unroll
        for (int i = 0; i < 2; ++i) { rk[i] = *(const u32x4*)(kp + g2 + (size_t)i * 32 * 512); rv[i] = *(const u32x4*)(vp + g2 + (size_t)i * 32 * 512); }
      }
      __builtin_amdgcn_sched_barrier(0);
      if (active) {
        bf16x8 pf[4];
        const float qrel = qposf - (float)(kt * 64 + 4 * h2);
        if (kt == ntw - 1) attn_tile_f<true>(ks, qf, pf, lsum, sl2, qrel, mref, m, r, h2);
        else attn_tile_f<false>(ks, qf, pf, lsum, sl2, qrel, mref, m, r, h2);
        attn_tile_b(ks + 17408, pf, O, h2, q, pp, blk);
      }
      __syncthreads();
    }
  } else {
    for (int it = 0; it < nit; ++it) {
      const int kt = ntb - 1 - it;
      const bool active = wact && kt >= kt0w && kt < ntw;
      const char* ks = smem + (it & 1) * 37888;
      char* wb = kw + ((it + 1) & 1) * 37888;
      char* wbv = vw + ((it + 1) & 1) * 37888;
#pragma unroll
      for (int i = 0; i < 2; ++i) { *(u32x4*)(wb + i * 32 * 272) = rk[i]; *(u32x4*)(wbv + i * 32 * 320) = rv[i]; }
      {
        const int k2 = kt - 2 > kt0b ? kt - 2 : kt0b;
        const size_t g2 = (size_t)k2 * 64 * 512;
#pragma unroll
        for (int i = 0; i < 2; ++i) { rk[i] = *(const u32x4*)(kp + g2 + (size_t)i * 32 * 512); rv[i] = *(const u32x4*)(vp + g2 + (size_t)i * 32 * 512); }
      }
      __builtin_amdgcn_sched_barrier(0);
      if (active) {
        bf16x8 pf[4];
        const float qrel = qposf - (float)(kt * 64 + 4 * h2);
        if (kt == ntw - 1) attn_tile_a<true>(ks, qf, O, pf, mrun, lsum, sl2, qrel, m, r, h2);
        else attn_tile_a<false>(ks, qf, O, pf, mrun, lsum, sl2, qrel, m, r, h2);
        attn_tile_b(ks + 17408, pf, O, h2, q, pp, blk);
      }
      __syncthreads();
    }
  }
  const float lt = lsum + __shfl_xor(lsum, 32);
  const float inv = wact ? 1.f / lt : 0.f;
  float* exch = (float*)smem + qg * 4096 + lane;
  if (m == 1) {
#pragma unroll
    for (int vt = 0; vt < 4; ++vt)
#pragma unroll
      for (int e = 0; e < 16; ++e) exch[(vt * 16 + e) * 64] = O[vt][e] * inv;
  }
  __syncthreads();
  if (m == 0 && wact) {
    float ss = 0.f;
#pragma unroll
    for (int vt = 0; vt < 4; ++vt)
#pragma unroll
      for (int e = 0; e < 16; ++e) { const float ov = O[vt][e] * inv - lam * exch[(vt * 16 + e) * 64]; O[vt][e] = ov; ss += ov * ov; }
    ss += __shfl_xor(ss, 32);
    const float rsn = rsqrtf(ss * (1.f / 128.f) + 1e-6f) * 0.8f;
#pragma unroll
    for (int vt = 0; vt < 4; ++vt)
#pragma unroll
      for (int g = 0; g < 4; ++g) {
        const int v = 32 * vt + 8 * g + 4 * h2;
        const f32x4 gg = *(const f32x4*)(p.subln_g + v);
        const u32x2 z = *(const u32x2*)(p.Za + (size_t)qtok * 512 + hd * 128 + v);
        u32x2 ov;
        ov[0] = pack2(O[vt][4 * g + 0] * rsn * gg[0] * bflo(z[0]), O[vt][4 * g + 1] * rsn * gg[1] * bfhi(z[0]));
        ov[1] = pack2(O[vt][4 * g + 2] * rsn * gg[2] * bflo(z[1]), O[vt][4 * g + 3] * rsn * gg[3] * bfhi(z[1]));
        *(u32x2*)(p.Mix + (size_t)qtok * 1024 + hd * 128 + v) = ov;
      }
  }
  __syncthreads();
}

DI void phase4(const Params& p, char* smem) {
  const int tid = threadIdx.x, lane = tid & 63;
  float lam;
  {
    const float a = p.lambda_qk[lane] * p.lambda_qk[64 + lane];
    const float b = p.lambda_qk[128 + lane] * p.lambda_qk[192 + lane];
    lam = __expf(wave_sum(a)) - __expf(wave_sum(b)) + 0.2f;
  }
  int* sitem = (int*)(smem + 153584);
  constexpr int NPA = 1024, NSA = 32, TOTAL = NPA + NSA + NITEM / 2;
  for (;;) {
    if (tid == 0) *sitem = atomicAdd(p.counter, 1);
    __syncthreads();
    const int item = *sitem;
    __syncthreads();
    if (item >= TOTAL) break;
    int tid_o = tid;
    asm volatile("" : "+v"(tid_o));
    if (item < NPA + NSA) {
      int tq0, qpos0, kvbase, ntb, hd, nq; bool can_skip;
      if (item < NPA) {
        const int qb = 127 - ((item & 255) >> 1), b = item & 1;
        hd = 3 - (item >> 8); tq0 = b * 16384 + qb * 128; qpos0 = qb * 128; kvbase = b * 16384; ntb = 2 * qb + 2; can_skip = true; nq = 4;
      } else {
        const int it = item - NPA, bs = it >> 2;
        hd = it & 3; tq0 = NPTOK + bs * 64; qpos0 = 1024; kvbase = NPTOK + bs * 1088; ntb = 17; can_skip = false; nq = 2;
      }
      attn_item(p, smem, tid_o, tq0, qpos0, kvbase, ntb, hd, lam, can_skip, nq);
    } else {
      const int hf = tid_o >> 8;
      r3_item(p, smem + hf * 65536, tid_o & 255, (item - NPA - NSA) * 2 + hf);
    }
  }
}

DI void phase5(const Params& p, char* smem) {
  float* wsum = (float*)(smem + 132096);
  for (int strip = blockIdx.x; strip < NTOK / 64; strip += gridDim.x) {
    int tid = threadIdx.x;
    asm volatile("" : "+v"(tid));
    const int lane = tid & 63, w = tid >> 6, r = lane & 31, h = lane >> 5;
    const int m0 = strip * 64;
    {
      const u16* gb = p.Mix + (size_t)m0 * 1024;
      const int loff = (tid >> 7) * 1024 + (tid & 127) * 8;
      char* lw = smem + (tid >> 7) * 2064 + (tid & 127) * 16;
#pragma unroll
      for (int i = 0; i < 16; ++i)
        *(u32x4*)(lw + i * 4 * 2064) = __builtin_nontemporal_load((const u32x4*)((gb + i * 4096) + loff));
    }
    f32x16 acc[2][4];
#pragma unroll
    for (int i = 0; i < 2; ++i)
#pragma unroll
      for (int j = 0; j < 4; ++j) acc[i][j] = zero16();
    const u16* bp = p.WoutT + (size_t)(w * 4) * 64 * 512 + lane * 8;
    bf16x8 b[4][4];
#pragma unroll
    for (int u = 0; u < 3; ++u)
#pragma unroll
      for (int j = 0; j < 4; ++j) b[u][j] = *(const bf16x8*)(bp + (size_t)(j * 64 + u) * 512);
    __syncthreads();
    const char* ap = smem + r * 2064 + h * 16;
    for (int ks0 = 0; ks0 < 64; ks0 += 4) {
#pragma unroll
      for (int u = 0; u < 4; ++u) {
        const int ks = ks0 + u;
        {
          const int kn = ks + 3 < 64 ? ks + 3 : 63;
#pragma unroll
          for (int j = 0; j < 4; ++j) b[(u + 3) & 3][j] = *(const bf16x8*)(bp + (size_t)(j * 64 + kn) * 512);
        }
        const bf16x8 a0 = *(const bf16x8*)(ap + ks * 32), a1 = *(const bf16x8*)(ap + 32 * 2064 + ks * 32);
#pragma unroll
        for (int j = 0; j < 4; ++j) { acc[0][j] = MFMA(a0, b[u][j], acc[0][j]); acc[1][j] = MFMA(a1, b[u][j], acc[1][j]); }
        __builtin_amdgcn_sched_barrier(0);
      }
    }
    const float* xs_u = (m0 < NPTOK ? p.x_prompt : p.x_sample - (size_t)NPTOK * 1024) + (size_t)m0 * 1024;
    const int lane_off = h * 4096 + w * 128 + r;
#pragma unroll
    for (int i = 0; i < 2; ++i) {
      float ps[16];
#pragma unroll
      for (int e = 0; e < 16; ++e) ps[e] = 0.f;
#pragma unroll
      for (int j = 0; j < 4; ++j) {
#pragma unroll
        for (int e = 0; e < 16; ++e) {
          const float hv = acc[i][j][e] + __builtin_nontemporal_load((xs_u + (i * 32 + (e & 3) + 8 * (e >> 2)) * 1024 + j * 32) + lane_off);
          acc[i][j][e] = hv; ps[e] += hv * hv;
        }
        __builtin_amdgcn_sched_barrier(0);
      }
#pragma unroll
      for (int e = 0; e < 16; ++e) {
#pragma unroll
        for (int o = 16; o >= 1; o >>= 1) ps[e] += __shfl_xor(ps[e], o);
      }
      if (r == 0) {
#pragma unroll
        for (int e = 0; e < 16; ++e) wsum[w * 64 + i * 32 + crow(e, h)] = ps[e];
      }
      __builtin_amdgcn_sched_barrier(0);
    }
    __syncthreads();
    float* yo_u = p.out + OFF_Y + (size_t)m0 * 1024;
#pragma unroll
    for (int i = 0; i < 2; ++i) {
      float sc[16];
#pragma unroll
      for (int e = 0; e < 16; ++e) {
        const int rw = i * 32 + crow(e, h);
        float t = 0.f;
#pragma unroll
        for (int k = 0; k < 8; ++k) t += wsum[k * 64 + rw];
        sc[e] = rsqrtf(t * (1.f / 1024.f) + 1e-6f);
      }
#pragma unroll
      for (int j = 0; j < 4; ++j) {
        const float g = (p.final_g + j * 32)[w * 128 + r];
#pragma unroll
        for (int e = 0; e < 16; ++e)
          __builtin_nontemporal_store(acc[i][j][e] * sc[e] * g, (yo_u + (i * 32 + (e & 3) + 8 * (e >> 2)) * 1024 + j * 32) + lane_off);
        __builtin_amdgcn_sched_barrier(0);
      }
    }
    __syncthreads();
  }
}

__global__ void __launch_bounds__(512, 2) fwd_megakernel(Params p) {
  __shared__ __attribute__((aligned(16))) char smem[153600];
  cg::grid_group grid = cg::this_grid();
  float* scratch_out = p.out + OFF_Y;
  const int lo = p.phase_lo, hi = p.phase_hi;
  if (lo <= 0 && hi >= 0) phase0(p, smem);
  if (lo <= 0 && hi >= 1) grid.sync();
  if (lo <= 1 && hi >= 1) phase1(p, smem);
  if (lo <= 1 && hi >= 2) grid.sync();
  if (lo <= 2 && hi >= 2) phase2(p, smem, (u16*)scratch_out);
  if (lo <= 2 && hi >= 3) grid.sync();
  if (lo <= 3 && hi >= 3) phase3(p, (const u16*)scratch_out);
  if (lo <= 3 && hi >= 4) grid.sync();
  if (lo <= 4 && hi >= 4) phase4(p, smem);
  if (lo <= 4 && hi >= 5) grid.sync();
  if (lo <= 5 && hi >= 5) phase5(p, smem);
}

extern "C" void kernel_launch(void* const* d_in, const int* in_sizes, int n_in, void* d_out, int out_size, void* d_ws, size_t ws_size,
                              hipStream_t stream) {
  static int grid_blocks = 0;
  if (!grid_blocks) {
    int dev = 0, cus = 0, per_cu = 0;
    hipGetDevice(&dev);
    hipDeviceGetAttribute(&cus, hipDeviceAttributeMultiprocessorCount, dev);
    hipOccupancyMaxActiveBlocksPerMultiprocessor(&per_cu, fwd_megakernel, 512, 0);
    if (per_cu > 1) per_cu = 1;
    if (per_cu < 1) per_cu = 1;
    grid_blocks = cus * per_cu;
  }
  Params p{};
  p.x_prompt = (const float*)d_in[0]; p.x_sample = (const float*)d_in[1]; p.cache_k = (const float*)d_in[2]; p.cache_v = (const float*)d_in[3];
  p.state_h = (const float*)d_in[4]; p.norm_g = (const float*)d_in[5]; p.w_in = (const float*)d_in[6]; p.lambda_qk = (const float*)d_in[7];
  p.subln_g = (const float*)d_in[8]; p.rec_lb = (const float*)d_in[9]; p.rec_norm_g = (const float*)d_in[10]; p.w_out = (const float*)d_in[11];
  p.final_g = (const float*)d_in[12];
  p.out = (float*)d_out;
  char* ws = (char*)d_ws; size_t off = 0;
  auto take = [&](size_t bytes) { char* r = ws + off; off += (bytes + 255) & ~(size_t)255; return r; };
  p.WinT = (u16*)take((size_t)4096 * 1024 * 2);
  p.WoutT = (u16*)take((size_t)1024 * 1024 * 2);
  p.Xn = (u16*)take((size_t)NTOK * 1024 * 2);
  p.SbufT = p.Xn;
  p.Qb = (u16*)take((size_t)NTOK * 512 * 2);
  p.Kall = (u16*)take((size_t)KVROWS * 512 * 2);
  p.Vall = (u16*)take((size_t)KVROWS * 512 * 2);
  p.Za = (u16*)take((size_t)NTOK * 512 * 2);
  p.Qr = (u16*)take((size_t)NTOK * 512 * 2);
  p.Ir = (u16*)take((size_t)NTOK * 512 * 2);
  p.Zr = (u16*)take((size_t)NTOK * 512 * 2);
  p.Mix = (u16*)take((size_t)NTOK * 1024 * 2);
  p.Fr = (float*)take((size_t)NTOK * 512 * 4);
  p.Abuf = (float*)take((size_t)NITEM * 128 * 4);
  p.NQ = (float*)take((size_t)NITEM * 4 * 4);
  p.counter = (int*)take(256);
  p.phase_lo = 0; p.phase_hi = 6; p.rep_mask = 0; p.pad_ = 0;
  if (off > ws_size) { fprintf(stderr, "workspace too small: need %zu have %zu\n", off, ws_size); return; }
  void* args[] = {&p};
  hipError_t e = hipLaunchCooperativeKernel((void*)fwd_megakernel, dim3(grid_blocks), dim3(512), args, 0, stream);
  if (e != hipSuccess) fprintf(stderr, "cooperative launch failed: %s (grid %d)\n", hipGetErrorString(e), grid_blocks);
}
```

```cpp
#include <hip/hip_runtime.h>
#include <hip/hip_cooperative_groups.h>
#include <cstdio>
namespace cg = cooperative_groups;

#define DI __device__ __forceinline__
typedef unsigned short u16;
using bf16x8 = __attribute__((ext_vector_type(8))) short;
using s16x4  = __attribute__((ext_vector_type(4))) short;
using f32x16 = __attribute__((ext_vector_type(16))) float;
using f32x4  = __attribute__((ext_vector_type(4))) float;
using f32x2  = __attribute__((ext_vector_type(2))) float;
using u32x4  = __attribute__((ext_vector_type(4))) unsigned;
using u32x2  = __attribute__((ext_vector_type(2))) unsigned;
typedef __bf16 bf2_t __attribute__((ext_vector_type(2)));

#define MFMA(a, b, c) __builtin_amdgcn_mfma_f32_32x32x16_bf16((a), (b), (c), 0, 0, 0)

static constexpr int NTOK = 33280;
static constexpr int NPTOK = 32768;
static constexpr int KVROWS = 32768 + 8 * 1088;
static constexpr int NITEM = 2080;
static constexpr size_t OFF_Y = 0;
static constexpr size_t OFF_NKP = 34078720;
static constexpr size_t OFF_NVP = 50855936;
static constexpr size_t OFF_NHP = 67633152;
static constexpr size_t OFF_NKS = 67764224;
static constexpr size_t OFF_NVS = 68026368;
static constexpr size_t OFF_NHS = 68288512;

struct Params {
  const float *x_prompt, *x_sample, *cache_k, *cache_v, *state_h, *norm_g, *w_in, *lambda_qk, *subln_g, *rec_lb, *rec_norm_g, *w_out, *final_g;
  float* out;
  u16 *WinT, *WoutT, *Xn, *Qb, *Kall, *Vall, *Za, *Qr, *Ir, *Zr, *Mix, *SbufT;
  float *Fr, *Abuf, *NQ;
  int* counter;
  int phase_lo, phase_hi, rep_mask, pad_;
};

DI unsigned pack2(float a, float b) { f32x2 v = {a, b}; bf2_t r = __builtin_convertvector(v, bf2_t); return __builtin_bit_cast(unsigned, r); }
DI u16 f2bf(float a) { return (u16)(pack2(a, 0.f) & 0xffffu); }
DI float bflo(unsigned u) { return __uint_as_float(u << 16); }
DI float bfhi(unsigned u) { return __uint_as_float(u & 0xffff0000u); }
DI int crow(int e, int h) { return (e & 3) + 8 * (e >> 2) + 4 * h; }
DI float wave_sum(float v) {
#pragma unroll
  for (int o = 32; o >= 1; o >>= 1) v += __shfl_xor(v, o);
  return v;
}
DI float silu_f(float v) { return v / (1.f + __expf(-v)); }
DI s16x4 tr_read(const char* p) {
  return __builtin_amdgcn_ds_read_tr16_b64_v4i16((__attribute__((address_space(3))) s16x4*)(p));
}
DI bf16x8 tr_frag(const char* p0, int stride4) {
  s16x4 lo = tr_read(p0), hi = tr_read(p0 + stride4);
  return __builtin_shufflevector(lo, hi, 0, 1, 2, 3, 4, 5, 6, 7);
}
DI bf16x8 pack8(const f32x16& x, int s) {
  u32x4 p;
  p[0] = pack2(x[8 * s + 0], x[8 * s + 1]);
  p[1] = pack2(x[8 * s + 2], x[8 * s + 3]);
  p[2] = pack2(x[8 * s + 4], x[8 * s + 5]);
  p[3] = pack2(x[8 * s + 6], x[8 * s + 7]);
  return __builtin_bit_cast(bf16x8, p);
}
DI f32x16 zero16() { f32x16 z; for (int i = 0; i < 16; ++i) z[i] = 0.f; return z; }

DI void phase0(const Params& p, char* smem) {
  const int tid = threadIdx.x, lane = tid & 63, w = tid >> 6;
  constexpr int NT_W1 = 16 * 64, NT_W2 = 16 * 16, NT_ROW = NTOK / 16, NT_CACHE = 1024;
  constexpr int total = NT_W1 + NT_W2 + NT_ROW + NT_CACHE;
  float (*tile)[65] = (float (*)[65])smem;
  if (blockIdx.x == 0 && tid < 16) p.counter[tid] = 0;
  for (int it = blockIdx.x; it < total; it += gridDim.x) {
    if (it < NT_W1 + NT_W2) {
      const float* src; u16* dst; int N, kt, nt;
      if (it < NT_W1) { src = p.w_in; dst = p.WinT; N = 4096; kt = it >> 6; nt = it & 63; }
      else { int j = it - NT_W1; src = p.w_out; dst = p.WoutT; N = 1024; kt = j >> 4; nt = j & 15; }
      const int c = tid & 63, r0 = tid >> 6;
      for (int i = 0; i < 8; ++i) { int r = r0 + 8 * i; tile[r][c] = src[(size_t)(kt * 64 + r) * N + nt * 64 + c]; }
      __syncthreads();
      if (it < NT_W1) {
        for (int i = 0; i < 8; ++i) { int r = r0 + 8 * i; dst[(size_t)(nt * 64 + r) * 1024 + kt * 64 + c] = f2bf(tile[c][r]); }
      } else {
        for (int i = 0; i < 8; ++i) {
          const int r = r0 + 8 * i, n = nt * 64 + r, k = kt * 64 + c;
          dst[((size_t)((n >> 5) * 64 + (k >> 4)) * 64 + ((k >> 3) & 1) * 32 + (n & 31)) * 8 + (k & 7)] = f2bf(tile[c][r]);
        }
      }
      __syncthreads();
    } else if (it < NT_W1 + NT_W2 + NT_ROW) {
      const int row0 = (it - NT_W1 - NT_W2) * 16 + w * 2;
      f32x4 v[2][4]; float ss[2] = {0.f, 0.f};
#pragma unroll
      for (int rr = 0; rr < 2; ++rr) {
        const int row = row0 + rr;
        const float* src = row < NPTOK ? p.x_prompt + (size_t)row * 1024 : p.x_sample + (size_t)(row - NPTOK) * 1024;
#pragma unroll
        for (int i = 0; i < 4; ++i) v[rr][i] = *(const f32x4*)(src + i * 256 + lane * 4);
      }
#pragma unroll
      for (int rr = 0; rr < 2; ++rr) {
#pragma unroll
        for (int i = 0; i < 4; ++i) ss[rr] += v[rr][i][0] * v[rr][i][0] + v[rr][i][1] * v[rr][i][1] + v[rr][i][2] * v[rr][i][2] + v[rr][i][3] * v[rr][i][3];
        ss[rr] = wave_sum(ss[rr]);
      }
#pragma unroll
      for (int rr = 0; rr < 2; ++rr) {
        const float sc = rsqrtf(ss[rr] * (1.f / 1024.f) + 1e-6f);
#pragma unroll
        for (int i = 0; i < 4; ++i) {
          f32x4 g = *(const f32x4*)(p.norm_g + i * 256 + lane * 4);
          u32x2 o; o[0] = pack2(v[rr][i][0] * sc * g[0], v[rr][i][1] * sc * g[1]); o[1] = pack2(v[rr][i][2] * sc * g[2], v[rr][i][3] * sc * g[3]);
          *(u32x2*)(p.Xn + (size_t)(row0 + rr) * 1024 + i * 256 + lane * 4) = o;
        }
      }
    } else {
      const int task0 = (it - NT_W1 - NT_W2 - NT_ROW) * 16 + w * 2;
      f32x4 a[2], b[2];
#pragma unroll
      for (int rr = 0; rr < 2; ++rr) {
        const int task = task0 + rr, which = task >> 13, r8 = task & 8191;
        const float* src = (which ? p.cache_v : p.cache_k) + (size_t)r8 * 512 + lane * 8;
        a[rr] = *(const f32x4*)src; b[rr] = *(const f32x4*)(src + 4);
      }
#pragma unroll
      for (int rr = 0; rr < 2; ++rr) {
        const int task = task0 + rr, which = task >> 13, r8 = task & 8191;
        u16* dst = (which ? p.Vall : p.Kall) + (size_t)(NPTOK + (r8 >> 10) * 1088 + (r8 & 1023)) * 512 + lane * 8;
        u32x4 o; o[0] = pack2(a[rr][0], a[rr][1]); o[1] = pack2(a[rr][2], a[rr][3]); o[2] = pack2(b[rr][0], b[rr][1]); o[3] = pack2(b[rr][2], b[rr][3]);
        *(u32x4*)dst = o;
      }
    }
  }
}

#define G_LOAD(RA, RB, KT_)                                                                                        \
  {                                                                                                                 \
    _Pragma("unroll") for (int i_ = 0; i_ < 4; ++i_) RA[i_] = *(const u32x4*)((ap + (size_t)i_ * 64 * K + (KT_) * 64) + loff); \
    _Pragma("unroll") for (int i_ = 0; i_ < 4; ++i_) RB[i_] = *(const u32x4*)((bp + (size_t)i_ * 64 * K + (KT_) * 64) + loff); \
  }
#define G_WRITE(RA, RB, BUF_)                                                                                      \
  {                                                                                                                 \
    _Pragma("unroll") for (int i_ = 0; i_ < 4; ++i_) *(u32x4*)(wbase + (BUF_) * 73728 + i_ * 64 * 144) = RA[i_];         \
    _Pragma("unroll") for (int i_ = 0; i_ < 4; ++i_) *(u32x4*)(wbase + (BUF_) * 73728 + 36864 + i_ * 64 * 144) = RB[i_]; \
  }
#define G_FRAGS(FA, FB, S_)                                                                                        \
  {                                                                                                                 \
    _Pragma("unroll") for (int i_ = 0; i_ < 4; ++i_) FA[i_] = *(const bf16x8*)(as_ + i_ * 32 * 144 + (S_) * 32);      \
    FB[0] = *(const bf16x8*)(bs_ + (S_) * 32); FB[1] = *(const bf16x8*)(bs_ + 32 * 144 + (S_) * 32);                \
  }
#define G_MFMA8(FA, FB)                                                                                            \
  {                                                                                                                 \
    _Pragma("unroll") for (int i_ = 0; i_ < 4; ++i_) {                                                              \
      acc[i_][0] = MFMA(FA[i_], FB[0], acc[i_][0]);                                                                 \
      acc[i_][1] = MFMA(FA[i_], FB[1], acc[i_][1]);                                                                 \
    }                                                                                                               \
  }
#define G_COMPUTE(BUF_)                                                                                            \
  {                                                                                                                 \
    const char* as_ = smem + (BUF_) * 73728 + (wm * 128 + r) * 144 + h * 16;                                        \
    const char* bs_ = smem + (BUF_) * 73728 + 36864 + (wn * 64 + r) * 144 + h * 16;                                 \
    bf16x8 fa0[4], fb0[2], fa1[4], fb1[2];                                                                          \
    G_FRAGS(fa0, fb0, 0);                                                                                           \
    G_FRAGS(fa1, fb1, 1); __builtin_amdgcn_sched_barrier(0); G_MFMA8(fa0, fb0); __builtin_amdgcn_sched_barrier(0);  \
    G_FRAGS(fa0, fb0, 2); __builtin_amdgcn_sched_barrier(0); G_MFMA8(fa1, fb1); __builtin_amdgcn_sched_barrier(0);  \
    G_FRAGS(fa1, fb1, 3); __builtin_amdgcn_sched_barrier(0); G_MFMA8(fa0, fb0); __builtin_amdgcn_sched_barrier(0);  \
    G_MFMA8(fa1, fb1);                                                                                              \
  }
DI void gemm_preload(const u16* __restrict__ A, const u16* __restrict__ BT, int K, int m0, int n0, int tid, u32x4 (&ra0)[4], u32x4 (&rb0)[4]) {
  const u16* ap = A + (size_t)m0 * K;
  const u16* bp = BT + (size_t)n0 * K;
  const int loff = (tid >> 3) * K + (tid & 7) * 8;
  G_LOAD(ra0, rb0, 0);
}
DI void gemm256(const u16* __restrict__ A, const u16* __restrict__ BT, int K, int m0, int n0, char* smem, int tid, f32x16 (&acc)[4][2],
                u32x4 (&ra0)[4], u32x4 (&rb0)[4]) {
  const int lane = tid & 63, w = tid >> 6, r = lane & 31, h = lane >> 5;
  const int wm = w >> 2, wn = w & 3;
#pragma unroll
  for (int i = 0; i < 4; ++i) { acc[i][0] = zero16(); acc[i][1] = zero16(); }
  const int KT = K >> 6;
  const u16* ap = A + (size_t)m0 * K;
  const u16* bp = BT + (size_t)n0 * K;
  const int loff = (tid >> 3) * K + (tid & 7) * 8;
  char* wbase = smem + (tid >> 3) * 144 + (tid & 7) * 16;
  G_WRITE(ra0, rb0, 0);
  __syncthreads();
  for (int kt = 0; kt < KT; kt += 2) {
    { const int k1 = kt + 1 < KT ? kt + 1 : KT - 1; G_LOAD(ra0, rb0, k1); }
    __builtin_amdgcn_sched_barrier(0);
    G_COMPUTE(0);
    __builtin_amdgcn_sched_barrier(0);
    G_WRITE(ra0, rb0, 1);
    __syncthreads();
    { const int k2 = kt + 2 < KT ? kt + 2 : KT - 1; G_LOAD(ra0, rb0, k2); }
    __builtin_amdgcn_sched_barrier(0);
    G_COMPUTE(1);
    __builtin_amdgcn_sched_barrier(0);
    G_WRITE(ra0, rb0, 0);
    __syncthreads();
  }
}
struct TileMap {
  int MT, NT, C, NG, NST, st, lb, lin;
  bool xcd;
  DI TileMap(int mt_, int nt_) : MT(mt_), NT(nt_) {
    const int nb = gridDim.x >> 3;
    C = nb >> 3;
    xcd = (gridDim.x & 63) == 0 && C > 0 && (NT % C) == 0;
    NG = xcd ? NT / C : 1;
    NST = ((MT + 7) >> 3) * NG;
    st = blockIdx.x & 7; lb = blockIdx.x >> 3; lin = blockIdx.x;
  }
  DI bool next(int& mt, int& nt) {
    if (!xcd) {
      if (lin >= MT * NT) return false;
      mt = lin / NT; nt = lin - mt * NT; lin += gridDim.x; return true;
    }
    while (st < NST) {
      const int mg = st / NG, ng = st - mg * NG;
      mt = mg * 8 + lb / C; nt = ng * C + lb % C;
      st += 8;
      if (mt < MT) return true;
    }
    return false;
  }
};
DI void stage_half(const f32x16 (&acc)[4][2], float* cs, int half, int wm, int wn, int r, int h) {
  if (wm == half) {
#pragma unroll
    for (int i = 0; i < 4; ++i)
#pragma unroll
      for (int j = 0; j < 2; ++j)
#pragma unroll
        for (int e = 0; e < 16; ++e) cs[(i * 32 + crow(e, h)) * 260 + wn * 64 + j * 32 + r] = acc[i][j][e];
  }
}

struct XcdTiles {
  int q, tried;
  DI XcdTiles() { q = (int)(__builtin_amdgcn_s_getreg((3 << 11) | 20) & 7u); tried = 0; }
  DI bool next(const Params& p, int* sl, int& mt, int& nt) {
    for (;;) {
      if (threadIdx.x == 0) *sl = atomicAdd(p.counter + 8 + q, 1);
      __syncthreads();
      const int t = *sl;
      __syncthreads();
      const int npatch = (68 - q + 7) >> 3;
      if (t < npatch * 32) {
        const int patch = q + 8 * (t >> 5), inner = t & 31;
        mt = (patch >> 2) * 8 + (inner >> 2); nt = (patch & 3) * 4 + (inner & 3);
        if (mt < NTOK / 256) return true;
      } else {
        q = (q + 1) & 7;
        if (++tried == 8) return false;
      }
    }
  }
};
DI void phase1(const Params& p, char* smem) {
  constexpr int MT = NTOK / 256, NT = 16;
  XcdTiles tm;
  int* sl = (int*)(smem + 153584);
  int mt, nt;
  bool have = tm.next(p, sl, mt, nt);
  u32x4 pa[4], pb[4];
  if (have) gemm_preload(p.Xn, p.WinT, 1024, mt * 256, nt * 256, threadIdx.x, pa, pb);
  while (have) {
    const int m0 = mt * 256, n0 = nt * 256;
    f32x16 acc[4][2];
    {
      int tg = threadIdx.x;
      asm volatile("" : "+v"(tg));
      gemm256(p.Xn, p.WinT, 1024, m0, n0, smem, tg, acc, pa, pb);
    }
    have = tm.next(p, sl, mt, nt);
    if (have) {
      int tg = threadIdx.x;
      asm volatile("" : "+v"(tg));
      gemm_preload(p.Xn, p.WinT, 1024, mt * 256, nt * 256, tg, pa, pb);
    }
    int tid = threadIdx.x;
    asm volatile("" : "+v"(tid));
    const int lane = tid & 63, w = tid >> 6, r = lane & 31, h = lane >> 5;
    const int wm = w >> 2, wn = w & 3;
    const int sec = n0 >> 9;
    const bool samp = m0 >= NPTOK;
    float* cs = (float*)smem;
    const int c0 = (tid & 31) * 8, rb = tid >> 5;
    const int csc = (n0 & 511) + c0;
#pragma unroll 1
    for (int half = 0; half < 2; ++half) {
      stage_half(acc, cs, half, wm, wn, r, h);
      __syncthreads();
#pragma unroll 2
      for (int ps = 0; ps < 8; ++ps) {
        const int row = rb + 16 * ps;
        const int t = m0 + half * 128 + row;
        f32x4 va = *(const f32x4*)(cs + row * 260 + c0), vb = *(const f32x4*)(cs + row * 260 + c0 + 4);
        const size_t o512 = (size_t)t * 512 + csc;
        if (sec == 5) { __builtin_nontemporal_store(va, (f32x4*)(p.Fr + o512)); __builtin_nontemporal_store(vb, (f32x4*)(p.Fr + o512 + 4)); }
        else {
          u16* dst;
          if (sec == 0) {
            const float qs = 0.125f * 1.44269504089f;
            va *= qs; vb *= qs; dst = p.Qb + o512;
          } else if (sec == 1 || sec == 2) {
            size_t kvr; float* od;
            if (!samp) { kvr = t; od = p.out + (sec == 1 ? OFF_NKP : OFF_NVP) + o512; }
            else { const int ts = t - NPTOK; kvr = NPTOK + (ts >> 6) * 1088 + 1024 + (ts & 63); od = p.out + (sec == 1 ? OFF_NKS : OFF_NVS) + (size_t)ts * 512 + csc; }
            __builtin_nontemporal_store(va, (f32x4*)od); __builtin_nontemporal_store(vb, (f32x4*)(od + 4));
            dst = (sec == 1 ? p.Kall : p.Vall) + kvr * 512 + csc;
          } else if (sec == 6) { dst = p.Ir + o512; }
          else {
#pragma unroll
            for (int i = 0; i < 4; ++i) { va[i] = silu_f(va[i]); vb[i] = silu_f(vb[i]); }
            dst = (sec == 3 ? p.Za : (sec == 4 ? p.Qr : p.Zr)) + o512;
          }
          u32x4 o; o[0] = pack2(va[0], va[1]); o[1] = pack2(va[2], va[3]); o[2] = pack2(vb[0], vb[1]); o[3] = pack2(vb[2], vb[3]);
          __builtin_nontemporal_store(o, (u32x4*)dst);
        }
      }
      __syncthreads();
    }
  }
}

DI void rec_load(const Params& p, int tid, int I, float (&xv)[32]) {
  const int d = tid & 127, half = tid >> 7;
  const int hd = I & 3, t0 = (I >> 2) * 64;
  const float* fp = p.Fr + (size_t)(t0 + half * 32) * 512 + hd * 128 + d;
#pragma unroll
  for (int i = 0; i < 32; ++i) xv[i] = fp[(size_t)i * 512];
}
DI void rec_pre_x(const Params& p, int tid, int I, float* totS, const float (&xv)[32], float (&cum)[32], float (&key)[32], float& lastv) {
  const int d = tid & 127, half = tid >> 7;
  const int hd = I & 3;
  const float r0 = p.rec_lb[hd * 128 + d], r1 = p.rec_lb[512 + hd * 128 + d];
  const float lb = 1.f / (1.f + __expf(r1 - r0));
  float run = 0.f;
#pragma unroll
  for (int i = 0; i < 32; ++i) {
    float x = xv[i];
    x = fminf(fmaxf(x, -30.f), 30.f);
    const float e = __expf(-x), sg = 1.f / (1.f + e);
    run += __logf(lb + (1.f - lb) * sg);
    cum[i] = run; key[i] = (1.f - lb) * e * sg;
  }
  totS[tid] = run;
  __syncthreads();
  const float tot0 = totS[d], tot1 = totS[128 + d];
  if (half) {
#pragma unroll
    for (int i = 0; i < 32; ++i) cum[i] += tot0;
  }
  lastv = tot0 + tot1;
}
DI void rec_pre(const Params& p, int tid, int I, float* totS, float (&cum)[32], float (&key)[32], float& lastv) {
  float xv[32];
  rec_load(p, tid, I, xv);
  rec_pre_x(p, tid, I, totS, xv, cum, key, lastv);
}

DI void phase2(const Params& p, char* smem0, u16* BbufT) {
  const int hf = threadIdx.x >> 8;
  const int tid = threadIdx.x & 255, lane = tid & 63, w = tid >> 6, r = lane & 31, h = lane >> 5;
  const int q = (lane & 15) >> 2, pp = lane & 3, blk = (lane >> 4) & 1;
  const int d = tid & 127, half = tid >> 7;
  char* smem = smem0 + hf * 65536;
  char* KdI = smem; char* VrI = smem + 17408; float* totS = (float*)(smem + 60000);
  float xv[32];
  rec_load(p, tid, blockIdx.x * 2 + hf < NITEM ? blockIdx.x * 2 + hf : NITEM - 1, xv);
  for (int I = blockIdx.x * 2 + hf; I < NITEM; I += gridDim.x * 2) {
    const int hd = I & 3, t0 = (I >> 2) * 64;
    if (I < 2048) {
      const int token = tid & 63, which = tid >> 6;
      const u16* src = (which < 2 ? p.Qb : p.Kall) + (size_t)(t0 + token) * 512 + hd * 128 + (which & 1) * 64;
      float ss = 0.f;
#pragma unroll
      for (int c = 0; c < 8; ++c) {
        const u32x4 v = *(const u32x4*)(src + c * 8);
#pragma unroll
        for (int i = 0; i < 4; ++i) { const float lo = bflo(v[i]), hi = bfhi(v[i]); ss += lo * lo + hi * hi; }
      }
#pragma unroll
      for (int o = 32; o >= 1; o >>= 1) ss = fmaxf(ss, __shfl_xor(ss, o));
      if (lane == 0) p.NQ[I * 4 + which] = sqrtf(ss);
    }
    float cum[32], key[32], lastv;
    rec_pre_x(p, tid, I, totS, xv, cum, key, lastv);
    {
      const int In = I + gridDim.x * 2;
      rec_load(p, tid, In < NITEM ? In : I, xv);
    }
#pragma unroll
    for (int i = 0; i < 32; ++i) {
      const int t = half * 32 + i;
      *(u16*)(KdI + t * 272 + d * 2) = f2bf(key[i] * __expf(lastv - cum[i]));
    }
#pragma unroll
    for (int i = 0; i < 4; ++i) {
      const int ch = tid + 256 * i, row = ch >> 4, cc = ch & 15;
      *(u32x4*)(VrI + row * 272 + cc * 16) = *(const u32x4*)(p.Ir + (size_t)(t0 + row) * 512 + hd * 128 + cc * 8);
    }
    if (half) p.Abuf[I * 128 + d] = __expf(lastv);
    __syncthreads();
    f32x16 acc[4];
#pragma unroll
    for (int ct = 0; ct < 4; ++ct) acc[ct] = zero16();
#pragma unroll
    for (int ks = 0; ks < 4; ++ks) {
      const int rowoff = (16 * ks + 8 * h + q) * 272 + 32 * blk + 8 * pp;
      bf16x8 a = tr_frag(VrI + rowoff + 64 * w, 4 * 272);
#pragma unroll
      for (int ct = 0; ct < 4; ++ct) {
        bf16x8 b = tr_frag(KdI + rowoff + 64 * ct, 4 * 272);
        acc[ct] = MFMA(a, b, acc[ct]);
      }
    }
    u16* ob = BbufT + (size_t)I * 16384;
#pragma unroll
    for (int ct = 0; ct < 4; ++ct)
#pragma unroll
      for (int e = 0; e < 16; ++e) ob[(32 * w + crow(e, h)) * 128 + 32 * ct + r] = f2bf(acc[ct][e]);
    __syncthreads();
  }
}

DI void phase3(const Params& p, const u16* BbufT) {
  const int tid = threadIdx.x & 255;
  for (int it = blockIdx.x * 2 + (threadIdx.x >> 8); it < 512 + 1024; it += gridDim.x * 2) {
    if (it < 512) {
      const int bh = it >> 6, b = bh >> 2, hd = bh & 3;
      const int e1 = (it & 63) * 256 + tid, v = e1 >> 7, d = e1 & 127;
      float sx = 0.f;
      const size_t eo = (size_t)v * 128 + d;
      const int I0 = (b * 256) * 4 + hd;
      const float* ap = p.Abuf + (size_t)I0 * 128 + d;
      const u16* bp = BbufT + (size_t)I0 * 16384 + eo;
      u16* sp = p.SbufT + (size_t)I0 * 16384 + eo;
      for (int c0 = 0; c0 < 256; c0 += 16) {
        float av[16]; u16 bw[16];
#pragma unroll
        for (int i = 0; i < 16; ++i) { av[i] = ap[(size_t)(c0 + i) * 4 * 128]; bw[i] = bp[(size_t)(c0 + i) * 4 * 16384]; }
#pragma unroll
        for (int i = 0; i < 16; ++i) {
          sp[(size_t)(c0 + i) * 4 * 16384] = f2bf(sx);
          sx = av[i] * sx + bflo(bw[i]);
        }
      }
      p.out[OFF_NHP + (size_t)(b * 4 + hd) * 16384 + d * 128 + v] = sx;
    } else {
      const int j = it - 512;
      const int sh = j >> 5, bs = sh >> 2, hd = sh & 3;
      const int e2 = (j & 31) * 256 + tid, v = e2 >> 6, d2 = (e2 & 63) * 2;
      const int I = (512 + bs) * 4 + hd;
      const float* sh0 = p.state_h + (size_t)(bs * 4 + hd) * 16384;
      float sx = sh0[d2 * 128 + v], sy = sh0[(d2 + 1) * 128 + v];
      const size_t eo = (size_t)v * 128 + d2;
      const f32x2 a = *(const f32x2*)(p.Abuf + I * 128 + d2);
      const unsigned bw = *(const unsigned*)(BbufT + (size_t)I * 16384 + eo);
      *(unsigned*)(p.SbufT + (size_t)I * 16384 + eo) = pack2(sx, sy);
      sx = a[0] * sx + bflo(bw); sy = a[1] * sy + bfhi(bw);
      float* oh = p.out + OFF_NHS + (size_t)(bs * 4 + hd) * 16384;
      oh[d2 * 128 + v] = sx; oh[(d2 + 1) * 128 + v] = sy;
    }
  }
}

DI void r3_item(const Params& p, char* smem, int tid, int I) {
  const int lane = tid & 63, w = tid >> 6, r = lane & 31, h = lane >> 5;
  const int q = (lane & 15) >> 2, pp = lane & 3, blk = (lane >> 4) & 1;
  const int d = tid & 127, half = tid >> 7;
  char* QdI = smem; char* KdI = smem + 17408; char* VrI = smem + 34816;
  float* totS = (float*)(smem + 60000); float* ssS = (float*)(smem + 62048);
  const int hd = I & 3, t0 = (I >> 2) * 64;
  {
    float cum[32], key[32], lastv;
    rec_pre(p, tid, I, totS, cum, key, lastv);
    const u16* qp = p.Qr + (size_t)(t0 + half * 32) * 512 + hd * 128 + d;
#pragma unroll
    for (int i = 0; i < 32; ++i) {
      const int t = half * 32 + i;
      const float qv = bflo(qp[(size_t)i * 512]);
      *(u16*)(QdI + t * 272 + d * 2) = f2bf(qv * __expf(cum[i]));
      *(u16*)(KdI + t * 272 + d * 2) = f2bf(key[i] * __expf(-cum[i]));
    }
  }
#pragma unroll
  for (int i = 0; i < 4; ++i) {
    const int ch = tid + 256 * i, row = ch >> 4, cc = ch & 15;
    *(u32x4*)(VrI + row * 272 + cc * 16) = *(const u32x4*)(p.Ir + (size_t)(t0 + row) * 512 + hd * 128 + cc * 8);
  }
  __syncthreads();
  const int tt = w & 1, vh = w >> 1;
  bf16x8 qf[8];
#pragma unroll
  for (int ks = 0; ks < 8; ++ks) qf[ks] = *(const bf16x8*)(QdI + (32 * tt + r) * 272 + ks * 32 + h * 16);
  f32x16 sc[2]; sc[0] = zero16(); sc[1] = zero16();
#pragma unroll
  for (int ks = 0; ks < 8; ++ks) {
    bf16x8 a0 = *(const bf16x8*)(KdI + r * 272 + ks * 32 + h * 16);
    sc[0] = MFMA(a0, qf[ks], sc[0]);
  }
  if (tt == 1) {
#pragma unroll
    for (int ks = 0; ks < 8; ++ks) {
      bf16x8 a1 = *(const bf16x8*)(KdI + (32 + r) * 272 + ks * 32 + h * 16);
      sc[1] = MFMA(a1, qf[ks], sc[1]);
    }
  }
#pragma unroll
  for (int e = 0; e < 16; ++e) {
    const bool keep = crow(e, h) <= r;
    if (tt == 0) { if (!keep) sc[0][e] = 0.f; }
    else { if (!keep) sc[1][e] = 0.f; }
  }
  bf16x8 pf[4];
  pf[0] = pack8(sc[0], 0); pf[1] = pack8(sc[0], 1); pf[2] = pack8(sc[1], 0); pf[3] = pack8(sc[1], 1);
  f32x16 o[2]; o[0] = zero16(); o[1] = zero16();
  const u16* sp = p.SbufT + (size_t)I * 16384;
#pragma unroll
  for (int vi = 0; vi < 2; ++vi) {
    const int vt = 2 * vh + vi;
#pragma unroll
    for (int k4 = 0; k4 < 4; ++k4) {
      if (k4 < 2 || tt == 1) {
        bf16x8 a = tr_frag(VrI + (16 * k4 + 4 * h + q) * 272 + (32 * vt + 16 * blk) * 2 + 8 * pp, 8 * 272);
        o[vi] = MFMA(a, pf[k4], o[vi]);
      }
    }
#pragma unroll
    for (int ks = 0; ks < 8; ++ks) {
      bf16x8 a = *(const bf16x8*)(sp + (size_t)(32 * vt + r) * 128 + ks * 16 + h * 8);
      o[vi] = MFMA(a, qf[ks], o[vi]);
    }
  }
  float ss = 0.f;
#pragma unroll
  for (int vi = 0; vi < 2; ++vi)
#pragma unroll
    for (int e = 0; e < 16; ++e) ss += o[vi][e] * o[vi][e];
  ss += __shfl_xor(ss, 32);
  if (h == 0) ssS[w * 32 + r] = ss;
  __syncthreads();
  const float tot = ssS[tt * 32 + r] + ssS[(tt + 2) * 32 + r];
  const float rs = rsqrtf(tot * (1.f / 128.f) + 1e-6f);
  const int tok = t0 + 32 * tt + r;
#pragma unroll
  for (int vi = 0; vi < 2; ++vi)
#pragma unroll
    for (int g = 0; g < 4; ++g) {
      const int v = 32 * (2 * vh + vi) + 8 * g + 4 * h;
      const f32x4 gg = *(const f32x4*)(p.rec_norm_g + v);
      const u32x2 z = *(const u32x2*)(p.Zr + (size_t)tok * 512 + hd * 128 + v);
      u32x2 ov;
      ov[0] = pack2(o[vi][4 * g + 0] * rs * gg[0] * bflo(z[0]), o[vi][4 * g + 1] * rs * gg[1] * bfhi(z[0]));
      ov[1] = pack2(o[vi][4 * g + 2] * rs * gg[2] * bflo(z[1]), o[vi][4 * g + 3] * rs * gg[3] * bfhi(z[1]));
      *(u32x2*)(p.Mix + (size_t)tok * 1024 + 512 + hd * 128 + v) = ov;
    }
  __syncthreads();
}

template <bool DIAG>
DI void attn_tile_a(const char* ks, const bf16x8 (&qf)[4], f32x16 (&O)[4], bf16x8 (&pf)[4], float& mrun, float& lsum, float sl2, float qrel,
                    int m, int r, int h2) {
  f32x16 S[2];
#pragma unroll
  for (int st = 0; st < 2; ++st) {
    S[st] = zero16();
#pragma unroll
    for (int s = 0; s < 4; ++s) {
      bf16x8 a = *(const bf16x8*)(ks + (32 * st + r) * 272 + m * 128 + s * 32 + h2 * 16);
      S[st] = MFMA(a, qf[s], S[st]);
    }
  }
  float mx = -1e30f;
#pragma unroll
  for (int st = 0; st < 2; ++st)
#pragma unroll
    for (int e = 0; e < 16; ++e) {
      const float cst = (float)(32 * st + (e & 3) + 8 * (e >> 2));
      float sv;
      if (DIAG) sv = fmaf(-sl2, fabsf(qrel - cst), S[st][e]);
      else sv = fmaf(sl2, cst, S[st][e]);
      S[st][e] = sv; mx = fmaxf(mx, sv);
    }
  const float L = DIAG ? 0.f : -sl2 * qrel;
  mx += L;
  mx = fmaxf(mx, __shfl_xor(mx, 32));
  if (__builtin_amdgcn_ballot_w64(mx > mrun + 6.f) != 0) {
    const float mnew = fmaxf(mrun, mx);
    const float alpha = __builtin_amdgcn_exp2f(mrun - mnew);
    mrun = mnew; lsum *= alpha;
#pragma unroll
    for (int vt = 0; vt < 4; ++vt)
#pragma unroll
      for (int e = 0; e < 16; ++e) O[vt][e] *= alpha;
  }
  const float off = L - mrun;
  float rs = 0.f;
#pragma unroll
  for (int st = 0; st < 2; ++st)
#pragma unroll
    for (int e = 0; e < 16; ++e) { const float pv = __builtin_amdgcn_exp2f(S[st][e] + off); S[st][e] = pv; rs += pv; }
  lsum += rs;
  pf[0] = pack8(S[0], 0); pf[1] = pack8(S[0], 1); pf[2] = pack8(S[1], 0); pf[3] = pack8(S[1], 1);
}
template <bool DIAG>
DI void attn_tile_f(const char* ks, const bf16x8 (&qf)[4], bf16x8 (&pf)[4], float& lsum, float sl2, float qrel, float mref, int m, int r, int h2) {
  f32x16 S[2];
  const float offL = -sl2 * qrel - mref;
#pragma unroll
  for (int st = 0; st < 2; ++st) {
#pragma unroll
    for (int e = 0; e < 16; ++e) {
      const float cst = (float)(32 * st + (e & 3) + 8 * (e >> 2));
      S[st][e] = DIAG ? (-sl2 * fabsf(qrel - cst) - mref) : fmaf(sl2, cst, offL);
    }
#pragma unroll
    for (int s = 0; s < 4; ++s) {
      bf16x8 a = *(const bf16x8*)(ks + (32 * st + r) * 272 + m * 128 + s * 32 + h2 * 16);
      S[st] = MFMA(a, qf[s], S[st]);
    }
  }
  float rs = 0.f;
#pragma unroll
  for (int st = 0; st < 2; ++st)
#pragma unroll
    for (int e = 0; e < 16; ++e) { const float pv = __builtin_amdgcn_exp2f(S[st][e]); S[st][e] = pv; rs += pv; }
  lsum += rs;
  pf[0] = pack8(S[0], 0); pf[1] = pack8(S[0], 1); pf[2] = pack8(S[1], 0); pf[3] = pack8(S[1], 1);
}
DI void attn_tile_b(const char* vs, const bf16x8 (&pf)[4], f32x16 (&O)[4], int h2, int q, int pp, int blk) {
  const char* vb = vs + (4 * h2 + q) * 320 + 32 * blk + 8 * pp;
  bf16x8 a0[4], a1[4];
#pragma unroll
  for (int vt = 0; vt < 4; ++vt) a0[vt] = tr_frag(vb + 64 * vt, 8 * 320);
  __builtin_amdgcn_sched_barrier(0);
#pragma unroll
  for (int vt = 0; vt < 4; ++vt) a1[vt] = tr_frag(vb + 16 * 320 + 64 * vt, 8 * 320);
#pragma unroll
  for (int vt = 0; vt < 4; ++vt) O[vt] = MFMA(a0[vt], pf[0], O[vt]);
  __builtin_amdgcn_sched_barrier(0);
#pragma unroll
  for (int vt = 0; vt < 4; ++vt) a0[vt] = tr_frag(vb + 32 * 320 + 64 * vt, 8 * 320);
#pragma unroll
  for (int vt = 0; vt < 4; ++vt) O[vt] = MFMA(a1[vt], pf[1], O[vt]);
  __builtin_amdgcn_sched_barrier(0);
#pragma unroll
  for (int vt = 0; vt < 4; ++vt) a1[vt] = tr_frag(vb + 48 * 320 + 64 * vt, 8 * 320);
#pragma unroll
  for (int vt = 0; vt < 4; ++vt) O[vt] = MFMA(a0[vt], pf[2], O[vt]);
  __builtin_amdgcn_sched_barrier(0);
#pragma unroll
  for (int vt = 0; vt < 4; ++vt) O[vt] = MFMA(a1[vt], pf[3], O[vt]);
}

DI void attn_item(const Params& p, char* smem, int tid, int tq0, int qpos0, int kvbase, int ntb, int hd, float lam, bool can_skip, int nq) {
  const int lane = tid & 63, w = tid >> 6, r = lane & 31, h2 = lane >> 5;
  const int q = (lane & 15) >> 2, pp = lane & 3, blk = (lane >> 4) & 1;
  const int qg = w & 3, m = w >> 2, ch = qg >> 1;
  const bool wact = qg < nq;
  const float sl2 = exp2f(-2.f * (float)(hd + 1)) * 1.44269504089f;
  const int qtok = tq0 + 32 * qg + r;
  const float qposf = (float)(qpos0 + 32 * qg + r);
  const int ntw = can_skip ? ntb - 1 + ch : ntb;
  int kt0w = 0, kt0b = 0;
  bool fast = false; float kn_w = 0.f;
  if (can_skip) {
    const int I0 = (tq0 >> 6) * 4 + hd;
    const int crk = kvbase >> 6;
    fast = true; kt0b = ntb;
#pragma unroll
    for (int mm = 0; mm < 2; ++mm) {
      float KN = 0.f;
      for (int c = lane; c < ntb; c += 64) KN = fmaxf(KN, p.NQ[((crk + c) * 4 + hd) * 4 + 2 + mm]);
#pragma unroll
      for (int o = 32; o >= 1; o >>= 1) KN = fmaxf(KN, __shfl_xor(KN, o));
#pragma unroll
      for (int cc = 0; cc < 2; ++cc) {
        const float QN = p.NQ[(I0 + 4 * cc) * 4 + mm];
        const float D = (2.02f * QN * KN + 66.f) / sl2;
        const float f = ((float)(qpos0 + 64 * cc - 63) - D) * (1.f / 64.f);
        const int k0 = f < 0.f ? 0 : (int)f + 1;
        kt0b = k0 < kt0b ? k0 : kt0b;
        fast = fast && (2.02f * QN * KN < 60.f);
        if (mm == m && cc == ch) { kt0w = k0; kn_w = KN; }
      }
    }
  }
  bf16x8 qf[4];
  if (wact) {
#pragma unroll
    for (int s = 0; s < 4; ++s) qf[s] = *(const bf16x8*)(p.Qb + (size_t)qtok * 512 + hd * 128 + m * 64 + 16 * s + 8 * h2);
  } else {
#pragma unroll
    for (int s = 0; s < 4; ++s) qf[s] = (bf16x8){0, 0, 0, 0, 0, 0, 0, 0};
  }
  float mref = 0.f;
  if (fast) {
    float qq = 0.f;
#pragma unroll
    for (int s = 0; s < 4; ++s) {
      const u32x4 u = __builtin_bit_cast(u32x4, qf[s]);
#pragma unroll
      for (int i = 0; i < 4; ++i) { const float lo = bflo(u[i]), hi = bfhi(u[i]); qq += lo * lo + hi * hi; }
    }
    qq += __shfl_xor(qq, 32);
    mref = sqrtf(qq) * kn_w * 1.01f + 0.5f;
  }
  f32x16 O[4];
#pragma unroll
  for (int vt = 0; vt < 4; ++vt) O[vt] = zero16();
  float mrun = -1e30f, lsum = 0.f;
  u32x4 rk[2], rv[2];
  const int lrow = tid >> 4, lcc = tid & 15;
  const size_t gofs = (size_t)(kvbase + lrow) * 512 + hd * 128 + lcc * 8;
  const u16* kp = p.Kall + gofs;
  const u16* vp = p.Vall + gofs;
  char* kw = smem + lrow * 272 + lcc * 16;
  char* vw = smem + 17408 + lrow * 320 + lcc * 16;
  const int nit = ntb - kt0b;
  {
    const size_t go = (size_t)(fast ? kt0b : ntb - 1) * 64 * 512;
#pragma unroll
    for (int i = 0; i < 2; ++i) { rk[i] = *(const u32x4*)(kp + go + (size_t)i * 32 * 512); rv[i] = *(const u32x4*)(vp + go + (size_t)i * 32 * 512); }
#pragma unroll
    for (int i = 0; i < 2; ++i) { *(u32x4*)(kw + i * 32 * 272) = rk[i]; *(u32x4*)(vw + i * 32 * 320) = rv[i]; }
    const int k1 = fast ? (kt0b + 1 < ntb ? kt0b + 1 : ntb - 1) : (ntb - 2 > kt0b ? ntb - 2 : kt0b);
    const size_t g1 = (size_t)k1 * 64 * 512;
#pragma unroll
    for (int i = 0; i < 2; ++i) { rk[i] = *(const u32x4*)(kp + g1 + (size_t)i * 32 * 512); rv[i] = *(const u32x4*)(vp + g1 + (size_t)i * 32 * 512); }
  }
  __syncthreads();
  if (fast) {
    for (int it = 0; it < nit; ++it) {
      const int kt = kt0b + it;
      const bool active = wact && kt >= kt0w && kt < ntw;
      const char* ks = smem + (it & 1) * 37888;
      char* wb = kw + ((it + 1) & 1) * 37888;
      char* wbv = vw + ((it + 1) & 1) * 37888;
#pragma unroll
      for (int i = 0; i < 2; ++i) { *(u32x4*)(wb + i * 32 * 272) = rk[i]; *(u32x4*)(wbv + i * 32 * 320) = rv[i]; }
      {
        const int k2 = kt + 2 < ntb ? kt + 2 : ntb - 1;
        const size_t g2 = (size_t)k2 * 64 * 512;
#pragma unroll
        for (int i = 0; i < 2; ++i) { rk[i] = *(const u32x4*)(kp + g2 + (size_t)i * 32 * 512); rv[i] = *(const u32x4*)(vp + g2 + (size_t)i * 32 * 512); }
      }
      __builtin_amdgcn_sched_barrier(0);
      if (active) {
        bf16x8 pf[4];
        const float qrel = qposf - (float)(kt * 64 + 4 * h2);
        if (kt == ntw - 1) attn_tile_f<true>(ks, qf, pf, lsum, sl2, qrel, mref, m, r, h2);
        else attn_tile_f<false>(ks, qf, pf, lsum, sl2, qrel, mref, m, r, h2);
        attn_tile_b(ks + 17408, pf, O, h2, q, pp, blk);
      }
      __syncthreads();
    }
  } else {
    for (int it = 0; it < nit; ++it) {
      const int kt = ntb - 1 - it;
      const bool active = wact && kt >= kt0w && kt < ntw;
      const char* ks = smem + (it & 1) * 37888;
      char* wb = kw + ((it + 1) & 1) * 37888;
      char* wbv = vw + ((it + 1) & 1) * 37888;
#pragma unroll
      for (int i = 0; i < 2; ++i) { *(u32x4*)(wb + i * 32 * 272) = rk[i]; *(u32x4*)(wbv + i * 32 * 320) = rv[i]; }
      {
        const int k2 = kt - 2 > kt0b ? kt - 2 : kt0b;
        const size_t g2 = (size_t)k2 * 64 * 512;
#pragma unroll
        for (int i = 0; i < 2; ++i) { rk[i] = *(const u32x4*)(kp + g2 + (size_t)i * 32 * 512); rv[i] = *(const u32x4*)(vp + g2 + (size_t)i * 32 * 512); }
      }
      __builtin_amdgcn_sched_barrier(0);
      if (active) {
        bf16x8 pf[4];
        const float qrel = qposf - (float)(kt * 64 + 4 * h2);
        if (kt == ntw - 1) attn_tile_a<true>(ks, qf, O, pf, mrun, lsum, sl2, qrel, m, r, h2);
        else attn_tile_a<false>(ks, qf, O, pf, mrun, lsum, sl2, qrel, m, r, h2);
        attn_tile_b(ks + 17408, pf, O, h2, q, pp, blk);
      }
      __syncthreads();
    }
  }
  const float lt = lsum + __shfl_xor(lsum, 32);
  const float inv = wact ? 1.f / lt : 0.f;
  float* exch = (float*)smem + qg * 4096 + lane;
  if (m == 1) {
#pragma unroll
    for (int vt = 0; vt < 4; ++vt)
#pragma unroll
      for (int e = 0; e < 16; ++e) exch[(vt * 16 + e) * 64] = O[vt][e] * inv;
  }
  __syncthreads();
  if (m == 0 && wact) {
    float ss = 0.f;
#pragma unroll
    for (int vt = 0; vt < 4; ++vt)
#pragma unroll
      for (int e = 0; e < 16; ++e) { const float ov = O[vt][e] * inv - lam * exch[(vt * 16 + e) * 64]; O[vt][e] = ov; ss += ov * ov; }
    ss += __shfl_xor(ss, 32);
    const float rsn = rsqrtf(ss * (1.f / 128.f) + 1e-6f) * 0.8f;
#pragma unroll
    for (int vt = 0; vt < 4; ++vt)
#pragma unroll
      for (int g = 0; g < 4; ++g) {
        const int v = 32 * vt + 8 * g + 4 * h2;
        const f32x4 gg = *(const f32x4*)(p.subln_g + v);
        const u32x2 z = *(const u32x2*)(p.Za + (size_t)qtok * 512 + hd * 128 + v);
        u32x2 ov;
        ov[0] = pack2(O[vt][4 * g + 0] * rsn * gg[0] * bflo(z[0]), O[vt][4 * g + 1] * rsn * gg[1] * bfhi(z[0]));
        ov[1] = pack2(O[vt][4 * g + 2] * rsn * gg[2] * bflo(z[1]), O[vt][4 * g + 3] * rsn * gg[3] * bfhi(z[1]));
        *(u32x2*)(p.Mix + (size_t)qtok * 1024 + hd * 128 + v) = ov;
      }
  }
  __syncthreads();
}

DI void phase4(const Params& p, char* smem) {
  const int tid = threadIdx.x, lane = tid & 63;
  float lam;
  {
    const float a = p.lambda_qk[lane] * p.lambda_qk[64 + lane];
    const float b = p.lambda_qk[128 + lane] * p.lambda_qk[192 + lane];
    lam = __expf(wave_sum(a)) - __expf(wave_sum(b)) + 0.2f;
  }
  int* sitem = (int*)(smem + 153584);
  constexpr int NPA = 1024, NSA = 32, TOTAL = NPA + NSA + NITEM / 2;
  for (;;) {
    if (tid == 0) *sitem = atomicAdd(p.counter, 1);
    __syncthreads();
    const int item = *sitem;
    __syncthreads();
    if (item >= TOTAL) break;
    int tid_o = tid;
    asm volatile("" : "+v"(tid_o));
    if (item < NPA + NSA) {
      int tq0, qpos0, kvbase, ntb, hd, nq; bool can_skip;
      if (item < NPA) {
        const int qb = 127 - ((item & 255) >> 1), b = item & 1;
        hd = 3 - (item >> 8); tq0 = b * 16384 + qb * 128; qpos0 = qb * 128; kvbase = b * 16384; ntb = 2 * qb + 2; can_skip = true; nq = 4;
      } else {
        const int it = item - NPA, bs = it >> 2;
        hd = it & 3; tq0 = NPTOK + bs * 64; qpos0 = 1024; kvbase = NPTOK + bs * 1088; ntb = 17; can_skip = false; nq = 2;
      }
      attn_item(p, smem, tid_o, tq0, qpos0, kvbase, ntb, hd, lam, can_skip, nq);
    } else {
      const int hf = tid_o >> 8;
      r3_item(p, smem + hf * 65536, tid_o & 255, (item - NPA - NSA) * 2 + hf);
    }
  }
}

template <int RT>
DI void p5_strip(const Params& p, char* smem, int tid, int m0) {
  float* wsum = (float*)(smem + 132096);
  {
    const int lane = tid & 63, w = tid >> 6, r = lane & 31, h = lane >> 5;
    {
      const u16* gb = p.Mix + (size_t)m0 * 1024;
      const int loff = (tid >> 7) * 1024 + (tid & 127) * 8;
      char* lw = smem + (tid >> 7) * 2064 + (tid & 127) * 16;
#pragma unroll
      for (int i = 0; i < 8 * RT; ++i)
        *(u32x4*)(lw + i * 4 * 2064) = __builtin_nontemporal_load((const u32x4*)((gb + i * 4096) + loff));
    }
    f32x16 acc[RT][4];
#pragma unroll
    for (int i = 0; i < RT; ++i)
#pragma unroll
      for (int j = 0; j < 4; ++j) acc[i][j] = zero16();
    const u16* bp = p.WoutT + (size_t)(w * 4) * 64 * 512 + lane * 8;
    bf16x8 b[4][4];
#pragma unroll
    for (int u = 0; u < 3; ++u)
#pragma unroll
      for (int j = 0; j < 4; ++j) b[u][j] = *(const bf16x8*)(bp + (size_t)(j * 64 + u) * 512);
    __syncthreads();
    const char* ap = smem + r * 2064 + h * 16;
    for (int ks0 = 0; ks0 < 64; ks0 += 4) {
#pragma unroll
      for (int u = 0; u < 4; ++u) {
        const int ks = ks0 + u;
        {
          const int kn = ks + 3 < 64 ? ks + 3 : 63;
#pragma unroll
          for (int j = 0; j < 4; ++j) b[(u + 3) & 3][j] = *(const bf16x8*)(bp + (size_t)(j * 64 + kn) * 512);
        }
        const bf16x8 a0 = *(const bf16x8*)(ap + ks * 32);
#pragma unroll
        for (int j = 0; j < 4; ++j) acc[0][j] = MFMA(a0, b[u][j], acc[0][j]);
        if (RT == 2) {
          const bf16x8 a1 = *(const bf16x8*)(ap + 32 * 2064 + ks * 32);
#pragma unroll
          for (int j = 0; j < 4; ++j) acc[RT - 1][j] = MFMA(a1, b[u][j], acc[RT - 1][j]);
        }
        __builtin_amdgcn_sched_barrier(0);
      }
    }
    const float* xs_u = (m0 < NPTOK ? p.x_prompt : p.x_sample - (size_t)NPTOK * 1024) + (size_t)m0 * 1024;
    const int lane_off = h * 4096 + w * 128 + r;
#pragma unroll
    for (int i = 0; i < RT; ++i) {
      float ps[16];
#pragma unroll
      for (int e = 0; e < 16; ++e) ps[e] = 0.f;
#pragma unroll
      for (int j = 0; j < 4; ++j) {
#pragma unroll
        for (int e = 0; e < 16; ++e) {
          const float hv = acc[i][j][e] + __builtin_nontemporal_load((xs_u + (i * 32 + (e & 3) + 8 * (e >> 2)) * 1024 + j * 32) + lane_off);
          acc[i][j][e] = hv; ps[e] += hv * hv;
        }
        __builtin_amdgcn_sched_barrier(0);
      }
#pragma unroll
      for (int e = 0; e < 16; ++e) {
#pragma unroll
        for (int o = 16; o >= 1; o >>= 1) ps[e] += __shfl_xor(ps[e], o);
      }
      if (r == 0) {
#pragma unroll
        for (int e = 0; e < 16; ++e) wsum[w * 64 + i * 32 + crow(e, h)] = ps[e];
      }
      __builtin_amdgcn_sched_barrier(0);
    }
    __syncthreads();
    float* yo_u = p.out + OFF_Y + (size_t)m0 * 1024;
#pragma unroll
    for (int i = 0; i < RT; ++i) {
      float sc[16];
#pragma unroll
      for (int e = 0; e < 16; ++e) {
        const int rw = i * 32 + crow(e, h);
        float t = 0.f;
#pragma unroll
        for (int k = 0; k < 8; ++k) t += wsum[k * 64 + rw];
        sc[e] = rsqrtf(t * (1.f / 1024.f) + 1e-6f);
      }
#pragma unroll
      for (int j = 0; j < 4; ++j) {
        const float g = (p.final_g + j * 32)[w * 128 + r];
#pragma unroll
        for (int e = 0; e < 16; ++e)
          __builtin_nontemporal_store(acc[i][j][e] * sc[e] * g, (yo_u + (i * 32 + (e & 3) + 8 * (e >> 2)) * 1024 + j * 32) + lane_off);
        __builtin_amdgcn_sched_barrier(0);
      }
    }
    __syncthreads();
  }
}
DI void phase5(const Params& p, char* smem) {
  for (int it = blockIdx.x; it < NPTOK / 64 + (NTOK - NPTOK) / 32; it += gridDim.x) {
    int tid = threadIdx.x;
    asm volatile("" : "+v"(tid));
    if (it < NPTOK / 64) p5_strip<2>(p, smem, tid, it * 64);
    else p5_strip<1>(p, smem, tid, NPTOK + (it - NPTOK / 64) * 32);
  }
}


__global__ void __launch_bounds__(512, 2) fwd_megakernel(Params p) {
  __shared__ __attribute__((aligned(16))) char smem[153600];
  cg::grid_group grid = cg::this_grid();
  float* scratch_out = p.out + OFF_Y;
  const int lo = p.phase_lo, hi = p.phase_hi;
  if (lo <= 0 && hi >= 0) phase0(p, smem);
  if (lo <= 0 && hi >= 1) grid.sync();
  if (lo <= 1 && hi >= 1) phase1(p, smem);
  if (lo <= 1 && hi >= 2) grid.sync();
  if (lo <= 2 && hi >= 2) phase2(p, smem, (u16*)scratch_out);
  if (lo <= 2 && hi >= 3) grid.sync();
  if (lo <= 3 && hi >= 3) phase3(p, (const u16*)scratch_out);
  if (lo <= 3 && hi >= 4) grid.sync();
  if (lo <= 4 && hi >= 4) phase4(p, smem);
  if (lo <= 4 && hi >= 5) grid.sync();
  if (lo <= 5 && hi >= 5) phase5(p, smem);
}

extern "C" void kernel_launch(void* const* d_in, const int* in_sizes, int n_in, void* d_out, int out_size, void* d_ws, size_t ws_size,
                              hipStream_t stream) {
  static int grid_blocks = 0;
  if (!grid_blocks) {
    int dev = 0, cus = 0, per_cu = 0;
    hipGetDevice(&dev);
    hipDeviceGetAttribute(&cus, hipDeviceAttributeMultiprocessorCount, dev);
    hipOccupancyMaxActiveBlocksPerMultiprocessor(&per_cu, fwd_megakernel, 512, 0);
    if (per_cu > 1) per_cu = 1;
    if (per_cu < 1) per_cu = 1;
    grid_blocks = cus * per_cu;
  }
  Params p{};
  p.x_prompt = (const float*)d_in[0]; p.x_sample = (const float*)d_in[1]; p.cache_k = (const float*)d_in[2]; p.cache_v = (const float*)d_in[3];
  p.state_h = (const float*)d_in[4]; p.norm_g = (const float*)d_in[5]; p.w_in = (const float*)d_in[6]; p.lambda_qk = (const float*)d_in[7];
  p.subln_g = (const float*)d_in[8]; p.rec_lb = (const float*)d_in[9]; p.rec_norm_g = (const float*)d_in[10]; p.w_out = (const float*)d_in[11];
  p.final_g = (const float*)d_in[12];
  p.out = (float*)d_out;
  char* ws = (char*)d_ws; size_t off = 0;
  auto take = [&](size_t bytes) { char* r = ws + off; off += (bytes + 255) & ~(size_t)255; return r; };
  p.WinT = (u16*)take((size_t)4096 * 1024 * 2);
  p.WoutT = (u16*)take((size_t)1024 * 1024 * 2);
  p.Xn = (u16*)take((size_t)NTOK * 1024 * 2);
  p.SbufT = p.Xn;
  p.Qb = (u16*)take((size_t)NTOK * 512 * 2);
  p.Kall = (u16*)take((size_t)KVROWS * 512 * 2);
  p.Vall = (u16*)take((size_t)KVROWS * 512 * 2);
  p.Za = (u16*)take((size_t)NTOK * 512 * 2);
  p.Qr = (u16*)take((size_t)NTOK * 512 * 2);
  p.Ir = (u16*)take((size_t)NTOK * 512 * 2);
  p.Zr = (u16*)take((size_t)NTOK * 512 * 2);
  p.Mix = (u16*)take((size_t)NTOK * 1024 * 2);
  p.Fr = (float*)take((size_t)NTOK * 512 * 4);
  p.Abuf = (float*)take((size_t)NITEM * 128 * 4);
  p.NQ = (float*)take((size_t)NITEM * 4 * 4);
  p.counter = (int*)take(256);
  p.phase_lo = 0; p.phase_hi = 6; p.rep_mask = 0; p.pad_ = 0;
  if (off > ws_size) { fprintf(stderr, "workspace too small: need %zu have %zu\n", off, ws_size); return; }
  void* args[] = {&p};
  hipError_t e = hipLaunchCooperativeKernel((void*)fwd_megakernel, dim3(grid_blocks), dim3(512), args, 0, stream);
  if (e != hipSuccess) fprintf(stderr, "cooperative launch failed: %s (grid %d)\n", hipGetErrorString(e), grid_blocks);
}
```

```cpp
#include <hip/hip_runtime.h>
#include <hip/hip_cooperative_groups.h>
#include <cstdio>
namespace cg = cooperative_groups;

#define DI __device__ __forceinline__
typedef unsigned short u16;
using bf16x8 = __attribute__((ext_vector_type(8))) short;
using s16x4  = __attribute__((ext_vector_type(4))) short;
using f32x16 = __attribute__((ext_vector_type(16))) float;
using f32x4  = __attribute__((ext_vector_type(4))) float;
using f32x2  = __attribute__((ext_vector_type(2))) float;
using u32x4  = __attribute__((ext_vector_type(4))) unsigned;
using u32x2  = __attribute__((ext_vector_type(2))) unsigned;
typedef __bf16 bf2_t __attribute__((ext_vector_type(2)));

#define MFMA(a, b, c) __builtin_amdgcn_mfma_f32_32x32x16_bf16((a), (b), (c), 0, 0, 0)

static constexpr int NTOK = 33280;
static constexpr int NPTOK = 32768;
static constexpr int KVROWS = 32768 + 8 * 1088;
static constexpr int NITEM = 2080;
static constexpr size_t OFF_Y = 0;
static constexpr size_t OFF_NKP = 34078720;
static constexpr size_t OFF_NVP = 50855936;
static constexpr size_t OFF_NHP = 67633152;
static constexpr size_t OFF_NKS = 67764224;
static constexpr size_t OFF_NVS = 68026368;
static constexpr size_t OFF_NHS = 68288512;

struct Params {
  const float *x_prompt, *x_sample, *cache_k, *cache_v, *state_h, *norm_g, *w_in, *lambda_qk, *subln_g, *rec_lb, *rec_norm_g, *w_out, *final_g;
  float* out;
  u16 *WinT, *WoutT, *Xn, *Qb, *Kall, *Vall, *Za, *Qr, *Ir, *Zr, *Mix, *SbufT;
  float *Fr, *Abuf, *NQ;
  int* counter;
  int phase_lo, phase_hi, rep_mask, pad_;
};

DI unsigned pack2(float a, float b) { f32x2 v = {a, b}; bf2_t r = __builtin_convertvector(v, bf2_t); return __builtin_bit_cast(unsigned, r); }
DI u16 f2bf(float a) { return (u16)(pack2(a, 0.f) & 0xffffu); }
DI float bflo(unsigned u) { return __uint_as_float(u << 16); }
DI float bfhi(unsigned u) { return __uint_as_float(u & 0xffff0000u); }
DI int crow(int e, int h) { return (e & 3) + 8 * (e >> 2) + 4 * h; }
DI float wave_sum(float v) {
#pragma unroll
  for (int o = 32; o >= 1; o >>= 1) v += __shfl_xor(v, o);
  return v;
}
DI float silu_f(float v) { return v / (1.f + __expf(-v)); }
DI s16x4 tr_read(const char* p) {
  return __builtin_amdgcn_ds_read_tr16_b64_v4i16((__attribute__((address_space(3))) s16x4*)(p));
}
DI bf16x8 tr_frag(const char* p0, int stride4) {
  s16x4 lo = tr_read(p0), hi = tr_read(p0 + stride4);
  return __builtin_shufflevector(lo, hi, 0, 1, 2, 3, 4, 5, 6, 7);
}
DI bf16x8 pack8(const f32x16& x, int s) {
  u32x4 p;
  p[0] = pack2(x[8 * s + 0], x[8 * s + 1]);
  p[1] = pack2(x[8 * s + 2], x[8 * s + 3]);
  p[2] = pack2(x[8 * s + 4], x[8 * s + 5]);
  p[3] = pack2(x[8 * s + 6], x[8 * s + 7]);
  return __builtin_bit_cast(bf16x8, p);
}
DI f32x16 zero16() { f32x16 z; for (int i = 0; i < 16; ++i) z[i] = 0.f; return z; }

DI void phase0(const Params& p, char* smem) {
  const int tid = threadIdx.x, lane = tid & 63, w = tid >> 6;
  constexpr int NT_W1 = 16 * 64, NT_W2 = 16 * 16, NT_ROW = NTOK / 16, NT_CACHE = 1024;
  constexpr int total = NT_W1 + NT_W2 + NT_ROW + NT_CACHE;
  float (*tile)[65] = (float (*)[65])smem;
  if (blockIdx.x == 0 && tid < 16) p.counter[tid] = 0;
  for (int it = blockIdx.x; it < total; it += gridDim.x) {
    if (it < NT_W1 + NT_W2) {
      const float* src; u16* dst; int N, kt, nt;
      if (it < NT_W1) { src = p.w_in; dst = p.WinT; N = 4096; kt = it >> 6; nt = it & 63; }
      else { int j = it - NT_W1; src = p.w_out; dst = p.WoutT; N = 1024; kt = j >> 4; nt = j & 15; }
      const int c = tid & 63, r0 = tid >> 6;
      for (int i = 0; i < 8; ++i) { int r = r0 + 8 * i; tile[r][c] = src[(size_t)(kt * 64 + r) * N + nt * 64 + c]; }
      __syncthreads();
      if (it < NT_W1) {
        for (int i = 0; i < 8; ++i) { int r = r0 + 8 * i; dst[(size_t)(nt * 64 + r) * 1024 + kt * 64 + c] = f2bf(tile[c][r]); }
      } else {
        for (int i = 0; i < 8; ++i) {
          const int r = r0 + 8 * i, n = nt * 64 + r, k = kt * 64 + c;
          dst[((size_t)((n >> 5) * 64 + (k >> 4)) * 64 + ((k >> 3) & 1) * 32 + (n & 31)) * 8 + (k & 7)] = f2bf(tile[c][r]);
        }
      }
      __syncthreads();
    } else if (it < NT_W1 + NT_W2 + NT_ROW) {
      const int row0 = (it - NT_W1 - NT_W2) * 16 + w * 2;
      f32x4 v[2][4]; float ss[2] = {0.f, 0.f};
#pragma unroll
      for (int rr = 0; rr < 2; ++rr) {
        const int row = row0 + rr;
        const float* src = row < NPTOK ? p.x_prompt + (size_t)row * 1024 : p.x_sample + (size_t)(row - NPTOK) * 1024;
#pragma unroll
        for (int i = 0; i < 4; ++i) v[rr][i] = *(const f32x4*)(src + i * 256 + lane * 4);
      }
#pragma unroll
      for (int rr = 0; rr < 2; ++rr) {
#pragma unroll
        for (int i = 0; i < 4; ++i) ss[rr] += v[rr][i][0] * v[rr][i][0] + v[rr][i][1] * v[rr][i][1] + v[rr][i][2] * v[rr][i][2] + v[rr][i][3] * v[rr][i][3];
        ss[rr] = wave_sum(ss[rr]);
      }
#pragma unroll
      for (int rr = 0; rr < 2; ++rr) {
        const float sc = rsqrtf(ss[rr] * (1.f / 1024.f) + 1e-6f);
#pragma unroll
        for (int i = 0; i < 4; ++i) {
          f32x4 g = *(const f32x4*)(p.norm_g + i * 256 + lane * 4);
          u32x2 o; o[0] = pack2(v[rr][i][0] * sc * g[0], v[rr][i][1] * sc * g[1]); o[1] = pack2(v[rr][i][2] * sc * g[2], v[rr][i][3] * sc * g[3]);
          *(u32x2*)(p.Xn + (size_t)(row0 + rr) * 1024 + i * 256 + lane * 4) = o;
        }
      }
    } else {
      const int task0 = (it - NT_W1 - NT_W2 - NT_ROW) * 16 + w * 2;
      f32x4 a[2], b[2];
#pragma unroll
      for (int rr = 0; rr < 2; ++rr) {
        const int task = task0 + rr, which = task >> 13, r8 = task & 8191;
        const float* src = (which ? p.cache_v : p.cache_k) + (size_t)r8 * 512 + lane * 8;
        a[rr] = *(const f32x4*)src; b[rr] = *(const f32x4*)(src + 4);
      }
#pragma unroll
      for (int rr = 0; rr < 2; ++rr) {
        const int task = task0 + rr, which = task >> 13, r8 = task & 8191;
        u16* dst = (which ? p.Vall : p.Kall) + (size_t)(NPTOK + (r8 >> 10) * 1088 + (r8 & 1023)) * 512 + lane * 8;
        u32x4 o; o[0] = pack2(a[rr][0], a[rr][1]); o[1] = pack2(a[rr][2], a[rr][3]); o[2] = pack2(b[rr][0], b[rr][1]); o[3] = pack2(b[rr][2], b[rr][3]);
        *(u32x4*)dst = o;
      }
    }
  }
}

#define G_LOAD(RA, RB, KT_)                                                                                        \
  {                                                                                                                 \
    _Pragma("unroll") for (int i_ = 0; i_ < 4; ++i_) RA[i_] = *(const u32x4*)((ap + (size_t)i_ * 64 * K + (KT_) * 64) + loff); \
    _Pragma("unroll") for (int i_ = 0; i_ < 4; ++i_) RB[i_] = *(const u32x4*)((bp + (size_t)i_ * 64 * K + (KT_) * 64) + loff); \
  }
#define G_WRITE(RA, RB, BUF_)                                                                                      \
  {                                                                                                                 \
    _Pragma("unroll") for (int i_ = 0; i_ < 4; ++i_) *(u32x4*)(wbase + (BUF_) * 73728 + i_ * 64 * 144) = RA[i_];         \
    _Pragma("unroll") for (int i_ = 0; i_ < 4; ++i_) *(u32x4*)(wbase + (BUF_) * 73728 + 36864 + i_ * 64 * 144) = RB[i_]; \
  }
#define G_FRAGS(FA, FB, S_)                                                                                        \
  {                                                                                                                 \
    _Pragma("unroll") for (int i_ = 0; i_ < 4; ++i_) FA[i_] = *(const bf16x8*)(as_ + i_ * 32 * 144 + (S_) * 32);      \
    FB[0] = *(const bf16x8*)(bs_ + (S_) * 32); FB[1] = *(const bf16x8*)(bs_ + 32 * 144 + (S_) * 32);                \
  }
#define G_MFMA8(FA, FB)                                                                                            \
  {                                                                                                                 \
    _Pragma("unroll") for (int i_ = 0; i_ < 4; ++i_) {                                                              \
      acc[i_][0] = MFMA(FA[i_], FB[0], acc[i_][0]);                                                                 \
      acc[i_][1] = MFMA(FA[i_], FB[1], acc[i_][1]);                                                                 \
    }                                                                                                               \
  }
#define G_COMPUTE(BUF_)                                                                                            \
  {                                                                                                                 \
    const char* as_ = smem + (BUF_) * 73728 + (wm * 128 + r) * 144 + h * 16;                                        \
    const char* bs_ = smem + (BUF_) * 73728 + 36864 + (wn * 64 + r) * 144 + h * 16;                                 \
    bf16x8 fa0[4], fb0[2], fa1[4], fb1[2];                                                                          \
    G_FRAGS(fa0, fb0, 0);                                                                                           \
    G_FRAGS(fa1, fb1, 1); __builtin_amdgcn_sched_barrier(0); G_MFMA8(fa0, fb0); __builtin_amdgcn_sched_barrier(0);  \
    G_FRAGS(fa0, fb0, 2); __builtin_amdgcn_sched_barrier(0); G_MFMA8(fa1, fb1); __builtin_amdgcn_sched_barrier(0);  \
    G_FRAGS(fa1, fb1, 3); __builtin_amdgcn_sched_barrier(0); G_MFMA8(fa0, fb0); __builtin_amdgcn_sched_barrier(0);  \
    G_MFMA8(fa1, fb1);                                                                                              \
  }
DI void gemm_preload(const u16* __restrict__ A, const u16* __restrict__ BT, int K, int m0, int n0, int tid, u32x4 (&ra0)[4], u32x4 (&rb0)[4]) {
  const u16* ap = A + (size_t)m0 * K;
  const u16* bp = BT + (size_t)n0 * K;
  const int loff = (tid >> 3) * K + (tid & 7) * 8;
  G_LOAD(ra0, rb0, 0);
}
DI void gemm256(const u16* __restrict__ A, const u16* __restrict__ BT, int K, int m0, int n0, char* smem, int tid, f32x16 (&acc)[4][2],
                u32x4 (&ra0)[4], u32x4 (&rb0)[4]) {
  const int lane = tid & 63, w = tid >> 6, r = lane & 31, h = lane >> 5;
  const int wm = w >> 2, wn = w & 3;
#pragma unroll
  for (int i = 0; i < 4; ++i) { acc[i][0] = zero16(); acc[i][1] = zero16(); }
  const int KT = K >> 6;
  const u16* ap = A + (size_t)m0 * K;
  const u16* bp = BT + (size_t)n0 * K;
  const int loff = (tid >> 3) * K + (tid & 7) * 8;
  char* wbase = smem + (tid >> 3) * 144 + (tid & 7) * 16;
  G_WRITE(ra0, rb0, 0);
  __syncthreads();
  for (int kt = 0; kt < KT; kt += 2) {
    { const int k1 = kt + 1 < KT ? kt + 1 : KT - 1; G_LOAD(ra0, rb0, k1); }
    __builtin_amdgcn_sched_barrier(0);
    G_COMPUTE(0);
    __builtin_amdgcn_sched_barrier(0);
    G_WRITE(ra0, rb0, 1);
    __syncthreads();
    { const int k2 = kt + 2 < KT ? kt + 2 : KT - 1; G_LOAD(ra0, rb0, k2); }
    __builtin_amdgcn_sched_barrier(0);
    G_COMPUTE(1);
    __builtin_amdgcn_sched_barrier(0);
    G_WRITE(ra0, rb0, 0);
    __syncthreads();
  }
}
struct TileMap {
  int MT, NT, C, NG, NST, st, lb, lin;
  bool xcd;
  DI TileMap(int mt_, int nt_) : MT(mt_), NT(nt_) {
    const int nb = gridDim.x >> 3;
    C = nb >> 3;
    xcd = (gridDim.x & 63) == 0 && C > 0 && (NT % C) == 0;
    NG = xcd ? NT / C : 1;
    NST = ((MT + 7) >> 3) * NG;
    st = blockIdx.x & 7; lb = blockIdx.x >> 3; lin = blockIdx.x;
  }
  DI bool next(int& mt, int& nt) {
    if (!xcd) {
      if (lin >= MT * NT) return false;
      mt = lin / NT; nt = lin - mt * NT; lin += gridDim.x; return true;
    }
    while (st < NST) {
      const int mg = st / NG, ng = st - mg * NG;
      mt = mg * 8 + lb / C; nt = ng * C + lb % C;
      st += 8;
      if (mt < MT) return true;
    }
    return false;
  }
};
DI void stage_half(const f32x16 (&acc)[4][2], float* cs, int half, int wm, int wn, int r, int h) {
  if (wm == half) {
#pragma unroll
    for (int i = 0; i < 4; ++i)
#pragma unroll
      for (int j = 0; j < 2; ++j)
#pragma unroll
        for (int e = 0; e < 16; ++e) cs[(i * 32 + crow(e, h)) * 260 + wn * 64 + j * 32 + r] = acc[i][j][e];
  }
}

struct XcdTiles {
  int q, tried;
  DI XcdTiles() { q = (int)(__builtin_amdgcn_s_getreg((3 << 11) | 20) & 7u); tried = 0; }
  DI bool next(const Params& p, int* sl, int& mt, int& nt) {
    for (;;) {
      if (threadIdx.x == 0) *sl = atomicAdd(p.counter + 8 + q, 1);
      __syncthreads();
      const int t = *sl;
      __syncthreads();
      const int npatch = (68 - q + 7) >> 3;
      if (t < npatch * 32) {
        const int patch = q + 8 * (t >> 5), inner = t & 31;
        mt = (patch >> 2) * 8 + (inner >> 2); nt = (patch & 3) * 4 + (inner & 3);
        if (mt < NTOK / 256) return true;
      } else {
        q = (q + 1) & 7;
        if (++tried == 8) return false;
      }
    }
  }
};
DI void phase1(const Params& p, char* smem) {
  constexpr int MT = NTOK / 256, NT = 16;
  XcdTiles tm;
  int* sl = (int*)(smem + 153584);
  int mt, nt;
  bool have = tm.next(p, sl, mt, nt);
  u32x4 pa[4], pb[4];
  if (have) gemm_preload(p.Xn, p.WinT, 1024, mt * 256, nt * 256, threadIdx.x, pa, pb);
  while (have) {
    const int m0 = mt * 256, n0 = nt * 256;
    f32x16 acc[4][2];
    {
      int tg = threadIdx.x;
      asm volatile("" : "+v"(tg));
      gemm256(p.Xn, p.WinT, 1024, m0, n0, smem, tg, acc, pa, pb);
    }
    have = tm.next(p, sl, mt, nt);
    if (have) {
      int tg = threadIdx.x;
      asm volatile("" : "+v"(tg));
      gemm_preload(p.Xn, p.WinT, 1024, mt * 256, nt * 256, tg, pa, pb);
    }
    int tid = threadIdx.x;
    asm volatile("" : "+v"(tid));
    const int lane = tid & 63, w = tid >> 6, r = lane & 31, h = lane >> 5;
    const int wm = w >> 2, wn = w & 3;
    const int sec = n0 >> 9;
    const bool samp = m0 >= NPTOK;
    float* cs = (float*)smem;
    const int c0 = (tid & 31) * 8, rb = tid >> 5;
    const int csc = (n0 & 511) + c0;
#pragma unroll 1
    for (int half = 0; half < 2; ++half) {
      stage_half(acc, cs, half, wm, wn, r, h);
      __syncthreads();
#pragma unroll 2
      for (int ps = 0; ps < 8; ++ps) {
        const int row = rb + 16 * ps;
        const int t = m0 + half * 128 + row;
        f32x4 va = *(const f32x4*)(cs + row * 260 + c0), vb = *(const f32x4*)(cs + row * 260 + c0 + 4);
        const size_t o512 = (size_t)t * 512 + csc;
        if (sec == 5) { __builtin_nontemporal_store(va, (f32x4*)(p.Fr + o512)); __builtin_nontemporal_store(vb, (f32x4*)(p.Fr + o512 + 4)); }
        else {
          u16* dst;
          if (sec == 0) {
            const float qs = 0.125f * 1.44269504089f;
            va *= qs; vb *= qs; dst = p.Qb + o512;
          } else if (sec == 1 || sec == 2) {
            size_t kvr; float* od;
            if (!samp) { kvr = t; od = p.out + (sec == 1 ? OFF_NKP : OFF_NVP) + o512; }
            else { const int ts = t - NPTOK; kvr = NPTOK + (ts >> 6) * 1088 + 1024 + (ts & 63); od = p.out + (sec == 1 ? OFF_NKS : OFF_NVS) + (size_t)ts * 512 + csc; }
            __builtin_nontemporal_store(va, (f32x4*)od); __builtin_nontemporal_store(vb, (f32x4*)(od + 4));
            dst = (sec == 1 ? p.Kall : p.Vall) + kvr * 512 + csc;
          } else if (sec == 6) { dst = p.Ir + o512; }
          else {
#pragma unroll
            for (int i = 0; i < 4; ++i) { va[i] = silu_f(va[i]); vb[i] = silu_f(vb[i]); }
            dst = (sec == 3 ? p.Za : (sec == 4 ? p.Qr : p.Zr)) + o512;
          }
          u32x4 o; o[0] = pack2(va[0], va[1]); o[1] = pack2(va[2], va[3]); o[2] = pack2(vb[0], vb[1]); o[3] = pack2(vb[2], vb[3]);
          __builtin_nontemporal_store(o, (u32x4*)dst);
        }
      }
      __syncthreads();
    }
  }
}

DI void rec_load(const Params& p, int tid, int I, float (&xv)[32]) {
  const int d = tid & 127, half = tid >> 7;
  const int hd = I & 3, t0 = (I >> 2) * 64;
  const float* fp = p.Fr + (size_t)(t0 + half * 32) * 512 + hd * 128 + d;
#pragma unroll
  for (int i = 0; i < 32; ++i) xv[i] = fp[(size_t)i * 512];
}
DI void rec_pre_x(const Params& p, int tid, int I, float* totS, const float (&xv)[32], float (&cum)[32], float (&key)[32], float& lastv) {
  const int d = tid & 127, half = tid >> 7;
  const int hd = I & 3;
  const float r0 = p.rec_lb[hd * 128 + d], r1 = p.rec_lb[512 + hd * 128 + d];
  const float lb = 1.f / (1.f + __expf(r1 - r0));
  float run = 0.f;
#pragma unroll
  for (int i = 0; i < 32; ++i) {
    float x = xv[i];
    x = fminf(fmaxf(x, -30.f), 30.f);
    const float e = __expf(-x), sg = 1.f / (1.f + e);
    run += __logf(lb + (1.f - lb) * sg);
    cum[i] = run; key[i] = (1.f - lb) * e * sg;
  }
  totS[tid] = run;
  __syncthreads();
  const float tot0 = totS[d], tot1 = totS[128 + d];
  if (half) {
#pragma unroll
    for (int i = 0; i < 32; ++i) cum[i] += tot0;
  }
  lastv = tot0 + tot1;
}
DI void rec_pre(const Params& p, int tid, int I, float* totS, float (&cum)[32], float (&key)[32], float& lastv) {
  float xv[32];
  rec_load(p, tid, I, xv);
  rec_pre_x(p, tid, I, totS, xv, cum, key, lastv);
}

DI void phase2(const Params& p, char* smem0, u16* BbufT) {
  const int hf = threadIdx.x >> 8;
  const int tid = threadIdx.x & 255, lane = tid & 63, w = tid >> 6, r = lane & 31, h = lane >> 5;
  const int q = (lane & 15) >> 2, pp = lane & 3, blk = (lane >> 4) & 1;
  const int d = tid & 127, half = tid >> 7;
  char* smem = smem0 + hf * 65536;
  char* KdI = smem; char* VrI = smem + 17408; float* totS = (float*)(smem + 60000);
  float xv[32];
  rec_load(p, tid, blockIdx.x * 2 + hf < NITEM ? blockIdx.x * 2 + hf : NITEM - 1, xv);
  for (int I = blockIdx.x * 2 + hf; I < NITEM; I += gridDim.x * 2) {
    const int hd = I & 3, t0 = (I >> 2) * 64;
    if (I < 2048) {
      const int token = tid & 63, which = tid >> 6;
      const u16* src = (which < 2 ? p.Qb : p.Kall) + (size_t)(t0 + token) * 512 + hd * 128 + (which & 1) * 64;
      float ss = 0.f;
#pragma unroll
      for (int c = 0; c < 8; ++c) {
        const u32x4 v = *(const u32x4*)(src + c * 8);
#pragma unroll
        for (int i = 0; i < 4; ++i) { const float lo = bflo(v[i]), hi = bfhi(v[i]); ss += lo * lo + hi * hi; }
      }
#pragma unroll
      for (int o = 32; o >= 1; o >>= 1) ss = fmaxf(ss, __shfl_xor(ss, o));
      if (lane == 0) p.NQ[I * 4 + which] = sqrtf(ss);
    }
    float cum[32], key[32], lastv;
    rec_pre_x(p, tid, I, totS, xv, cum, key, lastv);
    {
      const int In = I + gridDim.x * 2;
      rec_load(p, tid, In < NITEM ? In : I, xv);
    }
#pragma unroll
    for (int i = 0; i < 32; ++i) {
      const int t = half * 32 + i;
      *(u16*)(KdI + t * 272 + d * 2) = f2bf(key[i] * __expf(lastv - cum[i]));
    }
#pragma unroll
    for (int i = 0; i < 4; ++i) {
      const int ch = tid + 256 * i, row = ch >> 4, cc = ch & 15;
      *(u32x4*)(VrI + row * 272 + cc * 16) = *(const u32x4*)(p.Ir + (size_t)(t0 + row) * 512 + hd * 128 + cc * 8);
    }
    if (half) p.Abuf[I * 128 + d] = __expf(lastv);
    __syncthreads();
    f32x16 acc[4];
#pragma unroll
    for (int ct = 0; ct < 4; ++ct) acc[ct] = zero16();
#pragma unroll
    for (int ks = 0; ks < 4; ++ks) {
      const int rowoff = (16 * ks + 8 * h + q) * 272 + 32 * blk + 8 * pp;
      bf16x8 a = tr_frag(VrI + rowoff + 64 * w, 4 * 272);
#pragma unroll
      for (int ct = 0; ct < 4; ++ct) {
        bf16x8 b = tr_frag(KdI + rowoff + 64 * ct, 4 * 272);
        acc[ct] = MFMA(a, b, acc[ct]);
      }
    }
    u16* ob = BbufT + (size_t)I * 16384;
#pragma unroll
    for (int ct = 0; ct < 4; ++ct)
#pragma unroll
      for (int e = 0; e < 16; ++e) ob[(32 * w + crow(e, h)) * 128 + 32 * ct + r] = f2bf(acc[ct][e]);
    __syncthreads();
  }
}

DI void phase3(const Params& p, const u16* BbufT) {
  const int tid = threadIdx.x & 255;
  for (int it = blockIdx.x * 2 + (threadIdx.x >> 8); it < 512 + 1024; it += gridDim.x * 2) {
    if (it < 512) {
      const int bh = it >> 6, b = bh >> 2, hd = bh & 3;
      const int e1 = (it & 63) * 256 + tid, v = e1 >> 7, d = e1 & 127;
      float sx = 0.f;
      const size_t eo = (size_t)v * 128 + d;
      const int I0 = (b * 256) * 4 + hd;
      const float* ap = p.Abuf + (size_t)I0 * 128 + d;
      const u16* bp = BbufT + (size_t)I0 * 16384 + eo;
      u16* sp = p.SbufT + (size_t)I0 * 16384 + eo;
      for (int c0 = 0; c0 < 256; c0 += 16) {
        float av[16]; u16 bw[16];
#pragma unroll
        for (int i = 0; i < 16; ++i) { av[i] = ap[(size_t)(c0 + i) * 4 * 128]; bw[i] = bp[(size_t)(c0 + i) * 4 * 16384]; }
#pragma unroll
        for (int i = 0; i < 16; ++i) {
          sp[(size_t)(c0 + i) * 4 * 16384] = f2bf(sx);
          sx = av[i] * sx + bflo(bw[i]);
        }
      }
      p.out[OFF_NHP + (size_t)(b * 4 + hd) * 16384 + d * 128 + v] = sx;
    } else {
      const int j = it - 512;
      const int sh = j >> 5, bs = sh >> 2, hd = sh & 3;
      const int e2 = (j & 31) * 256 + tid, v = e2 >> 6, d2 = (e2 & 63) * 2;
      const int I = (512 + bs) * 4 + hd;
      const float* sh0 = p.state_h + (size_t)(bs * 4 + hd) * 16384;
      float sx = sh0[d2 * 128 + v], sy = sh0[(d2 + 1) * 128 + v];
      const size_t eo = (size_t)v * 128 + d2;
      const f32x2 a = *(const f32x2*)(p.Abuf + I * 128 + d2);
      const unsigned bw = *(const unsigned*)(BbufT + (size_t)I * 16384 + eo);
      *(unsigned*)(p.SbufT + (size_t)I * 16384 + eo) = pack2(sx, sy);
      sx = a[0] * sx + bflo(bw); sy = a[1] * sy + bfhi(bw);
      float* oh = p.out + OFF_NHS + (size_t)(bs * 4 + hd) * 16384;
      oh[d2 * 128 + v] = sx; oh[(d2 + 1) * 128 + v] = sy;
    }
  }
}

DI void r3_item(const Params& p, char* smem, int tid, int I) {
  const int lane = tid & 63, w = tid >> 6, r = lane & 31, h = lane >> 5;
  const int q = (lane & 15) >> 2, pp = lane & 3, blk = (lane >> 4) & 1;
  const int d = tid & 127, half = tid >> 7;
  char* QdI = smem; char* KdI = smem + 17408; char* VrI = smem + 34816;
  float* totS = (float*)(smem + 60000); float* ssS = (float*)(smem + 62048);
  const int hd = I & 3, t0 = (I >> 2) * 64;
  {
    float cum[32], key[32], lastv;
    rec_pre(p, tid, I, totS, cum, key, lastv);
    const u16* qp = p.Qr + (size_t)(t0 + half * 32) * 512 + hd * 128 + d;
#pragma unroll
    for (int i = 0; i < 32; ++i) {
      const int t = half * 32 + i;
      const float qv = bflo(qp[(size_t)i * 512]);
      *(u16*)(QdI + t * 272 + d * 2) = f2bf(qv * __expf(cum[i]));
      *(u16*)(KdI + t * 272 + d * 2) = f2bf(key[i] * __expf(-cum[i]));
    }
  }
#pragma unroll
  for (int i = 0; i < 4; ++i) {
    const int ch = tid + 256 * i, row = ch >> 4, cc = ch & 15;
    *(u32x4*)(VrI + row * 272 + cc * 16) = *(const u32x4*)(p.Ir + (size_t)(t0 + row) * 512 + hd * 128 + cc * 8);
  }
  __syncthreads();
  const int tt = w & 1, vh = w >> 1;
  bf16x8 qf[8];
#pragma unroll
  for (int ks = 0; ks < 8; ++ks) qf[ks] = *(const bf16x8*)(QdI + (32 * tt + r) * 272 + ks * 32 + h * 16);
  f32x16 sc[2]; sc[0] = zero16(); sc[1] = zero16();
#pragma unroll
  for (int ks = 0; ks < 8; ++ks) {
    bf16x8 a0 = *(const bf16x8*)(KdI + r * 272 + ks * 32 + h * 16);
    sc[0] = MFMA(a0, qf[ks], sc[0]);
  }
  if (tt == 1) {
#pragma unroll
    for (int ks = 0; ks < 8; ++ks) {
      bf16x8 a1 = *(const bf16x8*)(KdI + (32 + r) * 272 + ks * 32 + h * 16);
      sc[1] = MFMA(a1, qf[ks], sc[1]);
    }
  }
#pragma unroll
  for (int e = 0; e < 16; ++e) {
    const bool keep = crow(e, h) <= r;
    if (tt == 0) { if (!keep) sc[0][e] = 0.f; }
    else { if (!keep) sc[1][e] = 0.f; }
  }
  bf16x8 pf[4];
  pf[0] = pack8(sc[0], 0); pf[1] = pack8(sc[0], 1); pf[2] = pack8(sc[1], 0); pf[3] = pack8(sc[1], 1);
  f32x16 o[2]; o[0] = zero16(); o[1] = zero16();
  const u16* sp = p.SbufT + (size_t)I * 16384;
#pragma unroll
  for (int vi = 0; vi < 2; ++vi) {
    const int vt = 2 * vh + vi;
#pragma unroll
    for (int k4 = 0; k4 < 4; ++k4) {
      if (k4 < 2 || tt == 1) {
        bf16x8 a = tr_frag(VrI + (16 * k4 + 4 * h + q) * 272 + (32 * vt + 16 * blk) * 2 + 8 * pp, 8 * 272);
        o[vi] = MFMA(a, pf[k4], o[vi]);
      }
    }
#pragma unroll
    for (int ks = 0; ks < 8; ++ks) {
      bf16x8 a = *(const bf16x8*)(sp + (size_t)(32 * vt + r) * 128 + ks * 16 + h * 8);
      o[vi] = MFMA(a, qf[ks], o[vi]);
    }
  }
  float ss = 0.f;
#pragma unroll
  for (int vi = 0; vi < 2; ++vi)
#pragma unroll
    for (int e = 0; e < 16; ++e) ss += o[vi][e] * o[vi][e];
  ss += __shfl_xor(ss, 32);
  if (h == 0) ssS[w * 32 + r] = ss;
  __syncthreads();
  const float tot = ssS[tt * 32 + r] + ssS[(tt + 2) * 32 + r];
  const float rs = rsqrtf(tot * (1.f / 128.f) + 1e-6f);
  const int tok = t0 + 32 * tt + r;
#pragma unroll
  for (int vi = 0; vi < 2; ++vi)
#pragma unroll
    for (int g = 0; g < 4; ++g) {
      const int v = 32 * (2 * vh + vi) + 8 * g + 4 * h;
      const f32x4 gg = *(const f32x4*)(p.rec_norm_g + v);
      const u32x2 z = *(const u32x2*)(p.Zr + (size_t)tok * 512 + hd * 128 + v);
      u32x2 ov;
      ov[0] = pack2(o[vi][4 * g + 0] * rs * gg[0] * bflo(z[0]), o[vi][4 * g + 1] * rs * gg[1] * bfhi(z[0]));
      ov[1] = pack2(o[vi][4 * g + 2] * rs * gg[2] * bflo(z[1]), o[vi][4 * g + 3] * rs * gg[3] * bfhi(z[1]));
      *(u32x2*)(p.Mix + (size_t)tok * 1024 + 512 + hd * 128 + v) = ov;
    }
  __syncthreads();
}

template <bool DIAG>
DI void attn_tile_a(const char* ks, const bf16x8 (&qf)[4], f32x16 (&O)[4], bf16x8 (&pf)[4], float& mrun, float& lsum, float sl2, float qrel,
                    int m, int r, int h2) {
  f32x16 S[2];
#pragma unroll
  for (int st = 0; st < 2; ++st) {
    S[st] = zero16();
#pragma unroll
    for (int s = 0; s < 4; ++s) {
      bf16x8 a = *(const bf16x8*)(ks + (32 * st + r) * 272 + m * 128 + s * 32 + h2 * 16);
      S[st] = MFMA(a, qf[s], S[st]);
    }
  }
  float mx = -1e30f;
#pragma unroll
  for (int st = 0; st < 2; ++st)
#pragma unroll
    for (int e = 0; e < 16; ++e) {
      const float cst = (float)(32 * st + (e & 3) + 8 * (e >> 2));
      float sv;
      if (DIAG) sv = fmaf(-sl2, fabsf(qrel - cst), S[st][e]);
      else sv = fmaf(sl2, cst, S[st][e]);
      S[st][e] = sv; mx = fmaxf(mx, sv);
    }
  const float L = DIAG ? 0.f : -sl2 * qrel;
  mx += L;
  mx = fmaxf(mx, __shfl_xor(mx, 32));
  if (__builtin_amdgcn_ballot_w64(mx > mrun + 6.f) != 0) {
    const float mnew = fmaxf(mrun, mx);
    const float alpha = __builtin_amdgcn_exp2f(mrun - mnew);
    mrun = mnew; lsum *= alpha;
#pragma unroll
    for (int vt = 0; vt < 4; ++vt)
#pragma unroll
      for (int e = 0; e < 16; ++e) O[vt][e] *= alpha;
  }
  const float off = L - mrun;
  float rs = 0.f;
#pragma unroll
  for (int st = 0; st < 2; ++st)
#pragma unroll
    for (int e = 0; e < 16; ++e) { const float pv = __builtin_amdgcn_exp2f(S[st][e] + off); S[st][e] = pv; rs += pv; }
  lsum += rs;
  pf[0] = pack8(S[0], 0); pf[1] = pack8(S[0], 1); pf[2] = pack8(S[1], 0); pf[3] = pack8(S[1], 1);
}
template <bool DIAG>
DI void attn_tile_f(const char* ks, const bf16x8 (&qf)[4], bf16x8 (&pf)[4], float& lsum, float sl2, float qrel, float mref, int m, int r, int h2) {
  f32x16 S[2];
  const float offL = -sl2 * qrel - mref;
#pragma unroll
  for (int st = 0; st < 2; ++st) {
#pragma unroll
    for (int e = 0; e < 16; ++e) {
      const float cst = (float)(32 * st + (e & 3) + 8 * (e >> 2));
      S[st][e] = DIAG ? (-sl2 * fabsf(qrel - cst) - mref) : fmaf(sl2, cst, offL);
    }
#pragma unroll
    for (int s = 0; s < 4; ++s) {
      bf16x8 a = *(const bf16x8*)(ks + (32 * st + r) * 272 + m * 128 + s * 32 + h2 * 16);
      S[st] = MFMA(a, qf[s], S[st]);
    }
  }
  float rs = 0.f;
#pragma unroll
  for (int st = 0; st < 2; ++st)
#pragma unroll
    for (int e = 0; e < 16; ++e) { const float pv = __builtin_amdgcn_exp2f(S[st][e]); S[st][e] = pv; rs += pv; }
  lsum += rs;
  pf[0] = pack8(S[0], 0); pf[1] = pack8(S[0], 1); pf[2] = pack8(S[1], 0); pf[3] = pack8(S[1], 1);
}
DI void attn_tile_b(const char* vs, const bf16x8 (&pf)[4], f32x16 (&O)[4], int h2, int q, int pp, int blk) {
  const char* vb = vs + (4 * h2 + q) * 320 + 32 * blk + 8 * pp;
  bf16x8 a0[4], a1[4];
#pragma unroll
  for (int vt = 0; vt < 4; ++vt) a0[vt] = tr_frag(vb + 64 * vt, 8 * 320);
#pragma unroll
  for (int vt = 0; vt < 4; ++vt) a1[vt] = tr_frag(vb + 16 * 320 + 64 * vt, 8 * 320);
#pragma unroll
  for (int vt = 0; vt < 4; ++vt) O[vt] = MFMA(a0[vt], pf[0], O[vt]);
#pragma unroll
  for (int vt = 0; vt < 4; ++vt) a0[vt] = tr_frag(vb + 32 * 320 + 64 * vt, 8 * 320);
#pragma unroll
  for (int vt = 0; vt < 4; ++vt) O[vt] = MFMA(a1[vt], pf[1], O[vt]);
#pragma unroll
  for (int vt = 0; vt < 4; ++vt) a1[vt] = tr_frag(vb + 48 * 320 + 64 * vt, 8 * 320);
#pragma unroll
  for (int vt = 0; vt < 4; ++vt) O[vt] = MFMA(a0[vt], pf[2], O[vt]);
#pragma unroll
  for (int vt = 0; vt < 4; ++vt) O[vt] = MFMA(a1[vt], pf[3], O[vt]);
}

DI void attn_item(const Params& p, char* smem, int tid, int tq0, int qpos0, int kvbase, int ntb, int hd, float lam, bool can_skip, int nq) {
  const int lane = tid & 63, w = tid >> 6, r = lane & 31, h2 = lane >> 5;
  const int q = (lane & 15) >> 2, pp = lane & 3, blk = (lane >> 4) & 1;
  const int qg = w & 3, m = w >> 2, ch = qg >> 1;
  const bool wact = qg < nq;
  const float sl2 = exp2f(-2.f * (float)(hd + 1)) * 1.44269504089f;
  const int qtok = tq0 + 32 * qg + r;
  const float qposf = (float)(qpos0 + 32 * qg + r);
  const int ntw = can_skip ? ntb - 1 + ch : ntb;
  int kt0w = 0, kt0b = 0;
  bool fast = false; float kn_w = 0.f;
  if (can_skip) {
    const int I0 = (tq0 >> 6) * 4 + hd;
    const int crk = kvbase >> 6;
    fast = true; kt0b = ntb;
#pragma unroll
    for (int mm = 0; mm < 2; ++mm) {
      float KN = 0.f;
      for (int c = lane; c < ntb; c += 64) KN = fmaxf(KN, p.NQ[((crk + c) * 4 + hd) * 4 + 2 + mm]);
#pragma unroll
      for (int o = 32; o >= 1; o >>= 1) KN = fmaxf(KN, __shfl_xor(KN, o));
#pragma unroll
      for (int cc = 0; cc < 2; ++cc) {
        const float QN = p.NQ[(I0 + 4 * cc) * 4 + mm];
        const float D = (2.02f * QN * KN + 66.f) / sl2;
        const float f = ((float)(qpos0 + 64 * cc - 63) - D) * (1.f / 64.f);
        const int k0 = f < 0.f ? 0 : (int)f + 1;
        kt0b = k0 < kt0b ? k0 : kt0b;
        fast = fast && (2.02f * QN * KN < 60.f);
        if (mm == m && cc == ch) { kt0w = k0; kn_w = KN; }
      }
    }
  }
  bf16x8 qf[4];
  if (wact) {
#pragma unroll
    for (int s = 0; s < 4; ++s) qf[s] = *(const bf16x8*)(p.Qb + (size_t)qtok * 512 + hd * 128 + m * 64 + 16 * s + 8 * h2);
  } else {
#pragma unroll
    for (int s = 0; s < 4; ++s) qf[s] = (bf16x8){0, 0, 0, 0, 0, 0, 0, 0};
  }
  float mref = 0.f;
  if (fast) {
    float qq = 0.f;
#pragma unroll
    for (int s = 0; s < 4; ++s) {
      const u32x4 u = __builtin_bit_cast(u32x4, qf[s]);
#pragma unroll
      for (int i = 0; i < 4; ++i) { const float lo = bflo(u[i]), hi = bfhi(u[i]); qq += lo * lo + hi * hi; }
    }
    qq += __shfl_xor(qq, 32);
    mref = sqrtf(qq) * kn_w * 1.01f + 0.5f;
  }
  f32x16 O[4];
#pragma unroll
  for (int vt = 0; vt < 4; ++vt) O[vt] = zero16();
  float mrun = -1e30f, lsum = 0.f;
  u32x4 rk[2], rv[2];
  const int lrow = tid >> 4, lcc = tid & 15;
  const size_t gofs = (size_t)(kvbase + lrow) * 512 + hd * 128 + lcc * 8;
  const u16* kp = p.Kall + gofs;
  const u16* vp = p.Vall + gofs;
  char* kw = smem + lrow * 272 + lcc * 16;
  char* vw = smem + 17408 + lrow * 320 + lcc * 16;
  const int nit = ntb - kt0b;
  {
    const size_t go = (size_t)(fast ? kt0b : ntb - 1) * 64 * 512;
#pragma unroll
    for (int i = 0; i < 2; ++i) { rk[i] = *(const u32x4*)(kp + go + (size_t)i * 32 * 512); rv[i] = *(const u32x4*)(vp + go + (size_t)i * 32 * 512); }
#pragma unroll
    for (int i = 0; i < 2; ++i) { *(u32x4*)(kw + i * 32 * 272) = rk[i]; *(u32x4*)(vw + i * 32 * 320) = rv[i]; }
    const int k1 = fast ? (kt0b + 1 < ntb ? kt0b + 1 : ntb - 1) : (ntb - 2 > kt0b ? ntb - 2 : kt0b);
    const size_t g1 = (size_t)k1 * 64 * 512;
#pragma unroll
    for (int i = 0; i < 2; ++i) { rk[i] = *(const u32x4*)(kp + g1 + (size_t)i * 32 * 512); rv[i] = *(const u32x4*)(vp + g1 + (size_t)i * 32 * 512); }
  }
  __syncthreads();
  if (fast) {
    for (int it = 0; it < nit; ++it) {
      const int kt = kt0b + it;
      const bool active = wact && kt >= kt0w && kt < ntw;
      const char* ks = smem + (it & 1) * 37888;
      char* wb = kw + ((it + 1) & 1) * 37888;
      char* wbv = vw + ((it + 1) & 1) * 37888;
#pragma unroll
      for (int i = 0; i < 2; ++i) { *(u32x4*)(wb + i * 32 * 272) = rk[i]; *(u32x4*)(wbv + i * 32 * 320) = rv[i]; }
      {
        const int k2 = kt + 2 < ntb ? kt + 2 : ntb - 1;
        const size_t g2 = (size_t)k2 * 64 * 512;
#pragma unroll
        for (int i = 0; i < 2; ++i) { rk[i] = *(const u32x4*)(kp + g2 + (size_t)i * 32 * 512); rv[i] = *(const u32x4*)(vp + g2 + (size_t)i * 32 * 512); }
      }
      __builtin_amdgcn_sched_barrier(0);
      if (active) {
        bf16x8 pf[4];
        const float qrel = qposf - (float)(kt * 64 + 4 * h2);
        if (kt == ntw - 1) attn_tile_f<true>(ks, qf, pf, lsum, sl2, qrel, mref, m, r, h2);
        else attn_tile_f<false>(ks, qf, pf, lsum, sl2, qrel, mref, m, r, h2);
        attn_tile_b(ks + 17408, pf, O, h2, q, pp, blk);
      }
      __syncthreads();
    }
  } else {
    for (int it = 0; it < nit; ++it) {
      const int kt = ntb - 1 - it;
      const bool active = wact && kt >= kt0w && kt < ntw;
      const char* ks = smem + (it & 1) * 37888;
      char* wb = kw + ((it + 1) & 1) * 37888;
      char* wbv = vw + ((it + 1) & 1) * 37888;
#pragma unroll
      for (int i = 0; i < 2; ++i) { *(u32x4*)(wb + i * 32 * 272) = rk[i]; *(u32x4*)(wbv + i * 32 * 320) = rv[i]; }
      {
        const int k2 = kt - 2 > kt0b ? kt - 2 : kt0b;
        const size_t g2 = (size_t)k2 * 64 * 512;
#pragma unroll
        for (int i = 0; i < 2; ++i) { rk[i] = *(const u32x4*)(kp + g2 + (size_t)i * 32 * 512); rv[i] = *(const u32x4*)(vp + g2 + (size_t)i * 32 * 512); }
      }
      __builtin_amdgcn_sched_barrier(0);
      if (active) {
        bf16x8 pf[4];
        const float qrel = qposf - (float)(kt * 64 + 4 * h2);
        if (kt == ntw - 1) attn_tile_a<true>(ks, qf, O, pf, mrun, lsum, sl2, qrel, m, r, h2);
        else attn_tile_a<false>(ks, qf, O, pf, mrun, lsum, sl2, qrel, m, r, h2);
        attn_tile_b(ks + 17408, pf, O, h2, q, pp, blk);
      }
      __syncthreads();
    }
  }
  const float lt = lsum + __shfl_xor(lsum, 32);
  const float inv = wact ? 1.f / lt : 0.f;
  float* exch = (float*)smem + qg * 4096 + lane;
  if (m == 1) {
#pragma unroll
    for (int vt = 0; vt < 4; ++vt)
#pragma unroll
      for (int e = 0; e < 16; ++e) exch[(vt * 16 + e) * 64] = O[vt][e] * inv;
  }
  __syncthreads();
  if (m == 0 && wact) {
    float ss = 0.f;
#pragma unroll
    for (int vt = 0; vt < 4; ++vt)
#pragma unroll
      for (int e = 0; e < 16; ++e) { const float ov = O[vt][e] * inv - lam * exch[(vt * 16 + e) * 64]; O[vt][e] = ov; ss += ov * ov; }
    ss += __shfl_xor(ss, 32);
    const float rsn = rsqrtf(ss * (1.f / 128.f) + 1e-6f) * 0.8f;
#pragma unroll
    for (int vt = 0; vt < 4; ++vt)
#pragma unroll
      for (int g = 0; g < 4; ++g) {
        const int v = 32 * vt + 8 * g + 4 * h2;
        const f32x4 gg = *(const f32x4*)(p.subln_g + v);
        const u32x2 z = *(const u32x2*)(p.Za + (size_t)qtok * 512 + hd * 128 + v);
        u32x2 ov;
        ov[0] = pack2(O[vt][4 * g + 0] * rsn * gg[0] * bflo(z[0]), O[vt][4 * g + 1] * rsn * gg[1] * bfhi(z[0]));
        ov[1] = pack2(O[vt][4 * g + 2] * rsn * gg[2] * bflo(z[1]), O[vt][4 * g + 3] * rsn * gg[3] * bfhi(z[1]));
        *(u32x2*)(p.Mix + (size_t)qtok * 1024 + hd * 128 + v) = ov;
      }
  }
  __syncthreads();
}

DI void phase4(const Params& p, char* smem) {
  const int tid = threadIdx.x, lane = tid & 63;
  float lam;
  {
    const float a = p.lambda_qk[lane] * p.lambda_qk[64 + lane];
    const float b = p.lambda_qk[128 + lane] * p.lambda_qk[192 + lane];
    lam = __expf(wave_sum(a)) - __expf(wave_sum(b)) + 0.2f;
  }
  int* sitem = (int*)(smem + 153584);
  constexpr int NPA = 1024, NSA = 32, TOTAL = NPA + NSA + NITEM / 2;
  for (;;) {
    if (tid == 0) *sitem = atomicAdd(p.counter, 1);
    __syncthreads();
    const int item = *sitem;
    __syncthreads();
    if (item >= TOTAL) break;
    int tid_o = tid;
    asm volatile("" : "+v"(tid_o));
    if (item < NPA + NSA) {
      int tq0, qpos0, kvbase, ntb, hd, nq; bool can_skip;
      if (item < NPA) {
        const int qb = 127 - ((item & 255) >> 1), b = item & 1;
        hd = 3 - (item >> 8); tq0 = b * 16384 + qb * 128; qpos0 = qb * 128; kvbase = b * 16384; ntb = 2 * qb + 2; can_skip = true; nq = 4;
      } else {
        const int it = item - NPA, bs = it >> 2;
        hd = it & 3; tq0 = NPTOK + bs * 64; qpos0 = 1024; kvbase = NPTOK + bs * 1088; ntb = 17; can_skip = false; nq = 2;
      }
      attn_item(p, smem, tid_o, tq0, qpos0, kvbase, ntb, hd, lam, can_skip, nq);
    } else {
      const int hf = tid_o >> 8;
      r3_item(p, smem + hf * 65536, tid_o & 255, (item - NPA - NSA) * 2 + hf);
    }
  }
}

template <int RT>
DI void p5_strip(const Params& p, char* smem, int tid, int m0) {
  float* wsum = (float*)(smem + 132096);
  {
    const int lane = tid & 63, w = tid >> 6, r = lane & 31, h = lane >> 5;
    {
      const u16* gb = p.Mix + (size_t)m0 * 1024;
      const int loff = (tid >> 7) * 1024 + (tid & 127) * 8;
      char* lw = smem + (tid >> 7) * 2064 + (tid & 127) * 16;
#pragma unroll
      for (int i = 0; i < 8 * RT; ++i)
        *(u32x4*)(lw + i * 4 * 2064) = __builtin_nontemporal_load((const u32x4*)((gb + i * 4096) + loff));
    }
    f32x16 acc[RT][4];
#pragma unroll
    for (int i = 0; i < RT; ++i)
#pragma unroll
      for (int j = 0; j < 4; ++j) acc[i][j] = zero16();
    const u16* bp = p.WoutT + (size_t)(w * 4) * 64 * 512 + lane * 8;
    bf16x8 b[4][4];
#pragma unroll
    for (int u = 0; u < 3; ++u)
#pragma unroll
      for (int j = 0; j < 4; ++j) b[u][j] = *(const bf16x8*)(bp + (size_t)(j * 64 + u) * 512);
    __syncthreads();
    const char* ap = smem + r * 2064 + h * 16;
    for (int ks0 = 0; ks0 < 64; ks0 += 4) {
#pragma unroll
      for (int u = 0; u < 4; ++u) {
        const int ks = ks0 + u;
        {
          const int kn = ks + 3 < 64 ? ks + 3 : 63;
#pragma unroll
          for (int j = 0; j < 4; ++j) b[(u + 3) & 3][j] = *(const bf16x8*)(bp + (size_t)(j * 64 + kn) * 512);
        }
        const bf16x8 a0 = *(const bf16x8*)(ap + ks * 32);
#pragma unroll
        for (int j = 0; j < 4; ++j) acc[0][j] = MFMA(a0, b[u][j], acc[0][j]);
        if (RT == 2) {
          const bf16x8 a1 = *(const bf16x8*)(ap + 32 * 2064 + ks * 32);
#pragma unroll
          for (int j = 0; j < 4; ++j) acc[RT - 1][j] = MFMA(a1, b[u][j], acc[RT - 1][j]);
        }
        __builtin_amdgcn_sched_barrier(0);
      }
    }
    const float* xs_u = (m0 < NPTOK ? p.x_prompt : p.x_sample - (size_t)NPTOK * 1024) + (size_t)m0 * 1024;
    const int lane_off = h * 4096 + w * 128 + r;
#pragma unroll
    for (int i = 0; i < RT; ++i) {
      float ps[16];
#pragma unroll
      for (int e = 0; e < 16; ++e) ps[e] = 0.f;
#pragma unroll
      for (int j = 0; j < 4; ++j) {
#pragma unroll
        for (int e = 0; e < 16; ++e) {
          const float hv = acc[i][j][e] + __builtin_nontemporal_load((xs_u + (i * 32 + (e & 3) + 8 * (e >> 2)) * 1024 + j * 32) + lane_off);
          acc[i][j][e] = hv; ps[e] += hv * hv;
        }
        __builtin_amdgcn_sched_barrier(0);
      }
#pragma unroll
      for (int e = 0; e < 16; ++e) {
#pragma unroll
        for (int o = 16; o >= 1; o >>= 1) ps[e] += __shfl_xor(ps[e], o);
      }
      if (r == 0) {
#pragma unroll
        for (int e = 0; e < 16; ++e) wsum[w * 64 + i * 32 + crow(e, h)] = ps[e];
      }
      __builtin_amdgcn_sched_barrier(0);
    }
    __syncthreads();
    float* yo_u = p.out + OFF_Y + (size_t)m0 * 1024;
#pragma unroll
    for (int i = 0; i < RT; ++i) {
      float sc[16];
#pragma unroll
      for (int e = 0; e < 16; ++e) {
        const int rw = i * 32 + crow(e, h);
        float t = 0.f;
#pragma unroll
        for (int k = 0; k < 8; ++k) t += wsum[k * 64 + rw];
        sc[e] = rsqrtf(t * (1.f / 1024.f) + 1e-6f);
      }
#pragma unroll
      for (int j = 0; j < 4; ++j) {
        const float g = (p.final_g + j * 32)[w * 128 + r];
#pragma unroll
        for (int e = 0; e < 16; ++e)
          __builtin_nontemporal_store(acc[i][j][e] * sc[e] * g, (yo_u + (i * 32 + (e & 3) + 8 * (e >> 2)) * 1024 + j * 32) + lane_off);
        __builtin_amdgcn_sched_barrier(0);
      }
    }
    __syncthreads();
  }
}
DI void phase5(const Params& p, char* smem) {
  for (int it = blockIdx.x; it < NPTOK / 64 + (NTOK - NPTOK) / 32; it += gridDim.x) {
    int tid = threadIdx.x;
    asm volatile("" : "+v"(tid));
    if (it < NPTOK / 64) p5_strip<2>(p, smem, tid, it * 64);
    else p5_strip<1>(p, smem, tid, NPTOK + (it - NPTOK / 64) * 32);
  }
}


__global__ void __launch_bounds__(512, 2) fwd_megakernel(Params p) {
  __shared__ __attribute__((aligned(16))) char smem[153600];
  cg::grid_group grid = cg::this_grid();
  float* scratch_out = p.out + OFF_Y;
  const int lo = p.phase_lo, hi = p.phase_hi;
  if (lo <= 0 && hi >= 0) phase0(p, smem);
  if (lo <= 0 && hi >= 1) grid.sync();
  if (lo <= 1 && hi >= 1) phase1(p, smem);
  if (lo <= 1 && hi >= 2) grid.sync();
  if (lo <= 2 && hi >= 2) phase2(p, smem, (u16*)scratch_out);
  if (lo <= 2 && hi >= 3) grid.sync();
  if (lo <= 3 && hi >= 3) phase3(p, (const u16*)scratch_out);
  if (lo <= 3 && hi >= 4) grid.sync();
  if (lo <= 4 && hi >= 4) phase4(p, smem);
  if (lo <= 4 && hi >= 5) grid.sync();
  if (lo <= 5 && hi >= 5) phase5(p, smem);
}

extern "C" void kernel_launch(void* const* d_in, const int* in_sizes, int n_in, void* d_out, int out_size, void* d_ws, size_t ws_size,
                              hipStream_t stream) {
  static int grid_blocks = 0;
  if (!grid_blocks) {
    int dev = 0, cus = 0, per_cu = 0;
    hipGetDevice(&dev);
    hipDeviceGetAttribute(&cus, hipDeviceAttributeMultiprocessorCount, dev);
    hipOccupancyMaxActiveBlocksPerMultiprocessor(&per_cu, fwd_megakernel, 512, 0);
    if (per_cu > 1) per_cu = 1;
    if (per_cu < 1) per_cu = 1;
    grid_blocks = cus * per_cu;
  }
  Params p{};
  p.x_prompt = (const float*)d_in[0]; p.x_sample = (const float*)d_in[1]; p.cache_k = (const float*)d_in[2]; p.cache_v = (const float*)d_in[3];
  p.state_h = (const float*)d_in[4]; p.norm_g = (const float*)d_in[5]; p.w_in = (const float*)d_in[6]; p.lambda_qk = (const float*)d_in[7];
  p.subln_g = (const float*)d_in[8]; p.rec_lb = (const float*)d_in[9]; p.rec_norm_g = (const float*)d_in[10]; p.w_out = (const float*)d_in[11];
  p.final_g = (const float*)d_in[12];
  p.out = (float*)d_out;
  char* ws = (char*)d_ws; size_t off = 0;
  auto take = [&](size_t bytes) { char* r = ws + off; off += (bytes + 255) & ~(size_t)255; return r; };
  p.WinT = (u16*)take((size_t)4096 * 1024 * 2);
  p.WoutT = (u16*)take((size_t)1024 * 1024 * 2);
  p.Xn = (u16*)take((size_t)NTOK * 1024 * 2);
  p.SbufT = p.Xn;
  p.Qb = (u16*)take((size_t)NTOK * 512 * 2);
  p.Kall = (u16*)take((size_t)KVROWS * 512 * 2);
  p.Vall = (u16*)take((size_t)KVROWS * 512 * 2);
  p.Za = (u16*)take((size_t)NTOK * 512 * 2);
  p.Qr = (u16*)take((size_t)NTOK * 512 * 2);
  p.Ir = (u16*)take((size_t)NTOK * 512 * 2);
  p.Zr = (u16*)take((size_t)NTOK * 512 * 2);
  p.Mix = (u16*)take((size_t)NTOK * 1024 * 2);
  p.Fr = (float*)take((size_t)NTOK * 512 * 4);
  p.Abuf = (float*)take((size_t)NITEM * 128 * 4);
  p.NQ = (float*)take((size_t)NITEM * 4 * 4);
  p.counter = (int*)take(256);
  p.phase_lo = 0; p.phase_hi = 6; p.rep_mask = 0; p.pad_ = 0;
  if (off > ws_size) { fprintf(stderr, "workspace too small: need %zu have %zu\n", off, ws_size); return; }
  void* args[] = {&p};
  hipError_t e = hipLaunchCooperativeKernel((void*)fwd_megakernel, dim3(grid_blocks), dim3(512), args, 0, stream);
  if (e != hipSuccess) fprintf(stderr, "cooperative launch failed: %s (grid %d)\n", hipGetErrorString(e), grid_blocks);
}
```

```cpp
#include <hip/hip_runtime.h>
#include <hip/hip_cooperative_groups.h>
#include <cstdio>
namespace cg = cooperative_groups;

#define DI __device__ __forceinline__
typedef unsigned short u16;
using bf16x8 = __attribute__((ext_vector_type(8))) short;
using s16x4  = __attribute__((ext_vector_type(4))) short;
using f32x16 = __attribute__((ext_vector_type(16))) float;
using f32x4  = __attribute__((ext_vector_type(4))) float;
using f32x2  = __attribute__((ext_vector_type(2))) float;
using u32x4  = __attribute__((ext_vector_type(4))) unsigned;
using u32x2  = __attribute__((ext_vector_type(2))) unsigned;
typedef __bf16 bf2_t __attribute__((ext_vector_type(2)));

#define MFMA(a, b, c) __builtin_amdgcn_mfma_f32_32x32x16_bf16((a), (b), (c), 0, 0, 0)

static constexpr int NTOK = 33280;
static constexpr int NPTOK = 32768;
static constexpr int KVROWS = 32768 + 8 * 1088;
static constexpr int NITEM = 2080;
static constexpr size_t OFF_Y = 0;
static constexpr size_t OFF_NKP = 34078720;
static constexpr size_t OFF_NVP = 50855936;
static constexpr size_t OFF_NHP = 67633152;
static constexpr size_t OFF_NKS = 67764224;
static constexpr size_t OFF_NVS = 68026368;
static constexpr size_t OFF_NHS = 68288512;

struct Params {
  const float *x_prompt, *x_sample, *cache_k, *cache_v, *state_h, *norm_g, *w_in, *lambda_qk, *subln_g, *rec_lb, *rec_norm_g, *w_out, *final_g;
  float* out;
  u16 *WinT, *WoutT, *Xn, *Qb, *Kall, *Vall, *Za, *Qr, *Ir, *Zr, *Mix, *SbufT;
  float *Fr, *Abuf, *NQ;
  int* counter;
  int phase_lo, phase_hi, rep_mask, pad_;
};

DI unsigned pack2(float a, float b) { f32x2 v = {a, b}; bf2_t r = __builtin_convertvector(v, bf2_t); return __builtin_bit_cast(unsigned, r); }
DI u16 f2bf(float a) { return (u16)(pack2(a, 0.f) & 0xffffu); }
DI float bflo(unsigned u) { return __uint_as_float(u << 16); }
DI float bfhi(unsigned u) { return __uint_as_float(u & 0xffff0000u); }
DI int crow(int e, int h) { return (e & 3) + 8 * (e >> 2) + 4 * h; }
DI float wave_sum(float v) {
#pragma unroll
  for (int o = 32; o >= 1; o >>= 1) v += __shfl_xor(v, o);
  return v;
}
DI float silu_f(float v) { return v / (1.f + __expf(-v)); }
DI s16x4 tr_read(const char* p) {
  return __builtin_amdgcn_ds_read_tr16_b64_v4i16((__attribute__((address_space(3))) s16x4*)(p));
}
DI bf16x8 tr_frag(const char* p0, int stride4) {
  s16x4 lo = tr_read(p0), hi = tr_read(p0 + stride4);
  return __builtin_shufflevector(lo, hi, 0, 1, 2, 3, 4, 5, 6, 7);
}
DI bf16x8 pack8(const f32x16& x, int s) {
  u32x4 p;
  p[0] = pack2(x[8 * s + 0], x[8 * s + 1]);
  p[1] = pack2(x[8 * s + 2], x[8 * s + 3]);
  p[2] = pack2(x[8 * s + 4], x[8 * s + 5]);
  p[3] = pack2(x[8 * s + 6], x[8 * s + 7]);
  return __builtin_bit_cast(bf16x8, p);
}
DI f32x16 zero16() { f32x16 z; for (int i = 0; i < 16; ++i) z[i] = 0.f; return z; }

DI void phase0(const Params& p, char* smem) {
  const int tid = threadIdx.x, lane = tid & 63, w = tid >> 6;
  constexpr int NT_W1 = 16 * 64, NT_W2 = 16 * 16, NT_ROW = NTOK / 16, NT_CACHE = 1024;
  constexpr int total = NT_W1 + NT_W2 + NT_ROW + NT_CACHE;
  float (*tile)[65] = (float (*)[65])smem;
  if (blockIdx.x == 0 && tid < 16) p.counter[tid] = 0;
  for (int it = blockIdx.x; it < total; it += gridDim.x) {
    if (it < NT_W1 + NT_W2) {
      const float* src; u16* dst; int N, kt, nt;
      if (it < NT_W1) { src = p.w_in; dst = p.WinT; N = 4096; kt = it >> 6; nt = it & 63; }
      else { int j = it - NT_W1; src = p.w_out; dst = p.WoutT; N = 1024; kt = j >> 4; nt = j & 15; }
      const int c = tid & 63, r0 = tid >> 6;
      for (int i = 0; i < 8; ++i) { int r = r0 + 8 * i; tile[r][c] = src[(size_t)(kt * 64 + r) * N + nt * 64 + c]; }
      __syncthreads();
      if (it < NT_W1) {
        for (int i = 0; i < 8; ++i) { int r = r0 + 8 * i; dst[(size_t)(nt * 64 + r) * 1024 + kt * 64 + c] = f2bf(tile[c][r]); }
      } else {
        for (int i = 0; i < 8; ++i) {
          const int r = r0 + 8 * i, n = nt * 64 + r, k = kt * 64 + c;
          dst[((size_t)((n >> 5) * 64 + (k >> 4)) * 64 + ((k >> 3) & 1) * 32 + (n & 31)) * 8 + (k & 7)] = f2bf(tile[c][r]);
        }
      }
      __syncthreads();
    } else if (it < NT_W1 + NT_W2 + NT_ROW) {
      const int row0 = (it - NT_W1 - NT_W2) * 16 + w * 2;
      f32x4 v[2][4]; float ss[2] = {0.f, 0.f};
#pragma unroll
      for (int rr = 0; rr < 2; ++rr) {
        const int row = row0 + rr;
        const float* src = row < NPTOK ? p.x_prompt + (size_t)row * 1024 : p.x_sample + (size_t)(row - NPTOK) * 1024;
#pragma unroll
        for (int i = 0; i < 4; ++i) v[rr][i] = *(const f32x4*)(src + i * 256 + lane * 4);
      }
#pragma unroll
      for (int rr = 0; rr < 2; ++rr) {
#pragma unroll
        for (int i = 0; i < 4; ++i) ss[rr] += v[rr][i][0] * v[rr][i][0] + v[rr][i][1] * v[rr][i][1] + v[rr][i][2] * v[rr][i][2] + v[rr][i][3] * v[rr][i][3];
        ss[rr] = wave_sum(ss[rr]);
      }
#pragma unroll
      for (int rr = 0; rr < 2; ++rr) {
        const float sc = rsqrtf(ss[rr] * (1.f / 1024.f) + 1e-6f);
#pragma unroll
        for (int i = 0; i < 4; ++i) {
          f32x4 g = *(const f32x4*)(p.norm_g + i * 256 + lane * 4);
          u32x2 o; o[0] = pack2(v[rr][i][0] * sc * g[0], v[rr][i][1] * sc * g[1]); o[1] = pack2(v[rr][i][2] * sc * g[2], v[rr][i][3] * sc * g[3]);
          *(u32x2*)(p.Xn + (size_t)(row0 + rr) * 1024 + i * 256 + lane * 4) = o;
        }
      }
    } else {
      const int task0 = (it - NT_W1 - NT_W2 - NT_ROW) * 16 + w * 2;
      f32x4 a[2], b[2];
#pragma unroll
      for (int rr = 0; rr < 2; ++rr) {
        const int task = task0 + rr, which = task >> 13, r8 = task & 8191;
        const float* src = (which ? p.cache_v : p.cache_k) + (size_t)r8 * 512 + lane * 8;
        a[rr] = *(const f32x4*)src; b[rr] = *(const f32x4*)(src + 4);
      }
#pragma unroll
      for (int rr = 0; rr < 2; ++rr) {
        const int task = task0 + rr, which = task >> 13, r8 = task & 8191;
        u16* dst = (which ? p.Vall : p.Kall) + (size_t)(NPTOK + (r8 >> 10) * 1088 + (r8 & 1023)) * 512 + lane * 8;
        u32x4 o; o[0] = pack2(a[rr][0], a[rr][1]); o[1] = pack2(a[rr][2], a[rr][3]); o[2] = pack2(b[rr][0], b[rr][1]); o[3] = pack2(b[rr][2], b[rr][3]);
        *(u32x4*)dst = o;
      }
    }
  }
}

#define G_LOAD(RA, RB, KT_)                                                                                        \
  {                                                                                                                 \
    _Pragma("unroll") for (int i_ = 0; i_ < 4; ++i_) RA[i_] = *(const u32x4*)((ap + (size_t)i_ * 64 * K + (KT_) * 64) + loff); \
    _Pragma("unroll") for (int i_ = 0; i_ < 4; ++i_) RB[i_] = *(const u32x4*)((bp + (size_t)i_ * 64 * K + (KT_) * 64) + loff); \
  }
#define G_WRITE(RA, RB, BUF_)                                                                                      \
  {                                                                                                                 \
    _Pragma("unroll") for (int i_ = 0; i_ < 4; ++i_) *(u32x4*)(wbase + (BUF_) * 73728 + i_ * 64 * 144) = RA[i_];         \
    _Pragma("unroll") for (int i_ = 0; i_ < 4; ++i_) *(u32x4*)(wbase + (BUF_) * 73728 + 36864 + i_ * 64 * 144) = RB[i_]; \
  }
#define G_FRAGS(FA, FB, S_)                                                                                        \
  {                                                                                                                 \
    _Pragma("unroll") for (int i_ = 0; i_ < 4; ++i_) FA[i_] = *(const bf16x8*)(as_ + i_ * 32 * 144 + (S_) * 32);      \
    FB[0] = *(const bf16x8*)(bs_ + (S_) * 32); FB[1] = *(const bf16x8*)(bs_ + 32 * 144 + (S_) * 32);                \
  }
#define G_MFMA8(FA, FB)                                                                                            \
  {                                                                                                                 \
    _Pragma("unroll") for (int i_ = 0; i_ < 4; ++i_) {                                                              \
      acc[i_][0] = MFMA(FA[i_], FB[0], acc[i_][0]);                                                                 \
      acc[i_][1] = MFMA(FA[i_], FB[1], acc[i_][1]);                                                                 \
    }                                                                                                               \
  }
#define G_COMPUTE(BUF_)                                                                                            \
  {                                                                                                                 \
    const char* as_ = smem + (BUF_) * 73728 + (wm * 128 + r) * 144 + h * 16;                                        \
    const char* bs_ = smem + (BUF_) * 73728 + 36864 + (wn * 64 + r) * 144 + h * 16;                                 \
    bf16x8 fa0[4], fb0[2], fa1[4], fb1[2];                                                                          \
    G_FRAGS(fa0, fb0, 0);                                                                                           \
    G_FRAGS(fa1, fb1, 1); __builtin_amdgcn_sched_barrier(0); G_MFMA8(fa0, fb0); __builtin_amdgcn_sched_barrier(0);  \
    G_FRAGS(fa0, fb0, 2); __builtin_amdgcn_sched_barrier(0); G_MFMA8(fa1, fb1); __builtin_amdgcn_sched_barrier(0);  \
    G_FRAGS(fa1, fb1, 3); __builtin_amdgcn_sched_barrier(0); G_MFMA8(fa0, fb0); __builtin_amdgcn_sched_barrier(0);  \
    G_MFMA8(fa1, fb1);                                                                                              \
  }
DI void gemm_preload(const u16* __restrict__ A, const u16* __restrict__ BT, int K, int m0, int n0, int tid, u32x4 (&ra0)[4], u32x4 (&rb0)[4]) {
  const u16* ap = A + (size_t)m0 * K;
  const u16* bp = BT + (size_t)n0 * K;
  const int loff = (tid >> 3) * K + (tid & 7) * 8;
  G_LOAD(ra0, rb0, 0);
}
DI void gemm256(const u16* __restrict__ A, const u16* __restrict__ BT, int K, int m0, int n0, char* smem, int tid, f32x16 (&acc)[4][2],
                u32x4 (&ra0)[4], u32x4 (&rb0)[4]) {
  const int lane = tid & 63, w = tid >> 6, r = lane & 31, h = lane >> 5;
  const int wm = w >> 2, wn = w & 3;
#pragma unroll
  for (int i = 0; i < 4; ++i) { acc[i][0] = zero16(); acc[i][1] = zero16(); }
  const int KT = K >> 6;
  const u16* ap = A + (size_t)m0 * K;
  const u16* bp = BT + (size_t)n0 * K;
  const int loff = (tid >> 3) * K + (tid & 7) * 8;
  char* wbase = smem + (tid >> 3) * 144 + (tid & 7) * 16;
  G_WRITE(ra0, rb0, 0);
  __syncthreads();
  for (int kt = 0; kt < KT; kt += 2) {
    { const int k1 = kt + 1 < KT ? kt + 1 : KT - 1; G_LOAD(ra0, rb0, k1); }
    __builtin_amdgcn_sched_barrier(0);
    G_COMPUTE(0);
    G_WRITE(ra0, rb0, 1);
    __syncthreads();
    { const int k2 = kt + 2 < KT ? kt + 2 : KT - 1; G_LOAD(ra0, rb0, k2); }
    __builtin_amdgcn_sched_barrier(0);
    G_COMPUTE(1);
    G_WRITE(ra0, rb0, 0);
    __syncthreads();
  }
}
struct TileMap {
  int MT, NT, C, NG, NST, st, lb, lin;
  bool xcd;
  DI TileMap(int mt_, int nt_) : MT(mt_), NT(nt_) {
    const int nb = gridDim.x >> 3;
    C = nb >> 3;
    xcd = (gridDim.x & 63) == 0 && C > 0 && (NT % C) == 0;
    NG = xcd ? NT / C : 1;
    NST = ((MT + 7) >> 3) * NG;
    st = blockIdx.x & 7; lb = blockIdx.x >> 3; lin = blockIdx.x;
  }
  DI bool next(int& mt, int& nt) {
    if (!xcd) {
      if (lin >= MT * NT) return false;
      mt = lin / NT; nt = lin - mt * NT; lin += gridDim.x; return true;
    }
    while (st < NST) {
      const int mg = st / NG, ng = st - mg * NG;
      mt = mg * 8 + lb / C; nt = ng * C + lb % C;
      st += 8;
      if (mt < MT) return true;
    }
    return false;
  }
};
DI void stage_half(const f32x16 (&acc)[4][2], float* cs, int half, int wm, int wn, int r, int h) {
  if (wm == half) {
#pragma unroll
    for (int i = 0; i < 4; ++i)
#pragma unroll
      for (int j = 0; j < 2; ++j)
#pragma unroll
        for (int e = 0; e < 16; ++e) cs[(i * 32 + crow(e, h)) * 260 + wn * 64 + j * 32 + r] = acc[i][j][e];
  }
}

struct XcdTiles {
  int q, tried;
  DI XcdTiles() { q = (int)(__builtin_amdgcn_s_getreg((3 << 11) | 20) & 7u); tried = 0; }
  DI bool next(const Params& p, int* sl, int& mt, int& nt) {
    for (;;) {
      if (threadIdx.x == 0) *sl = atomicAdd(p.counter + 8 + q, 1);
      __syncthreads();
      const int t = *sl;
      __syncthreads();
      const int npatch = (68 - q + 7) >> 3;
      if (t < npatch * 32) {
        const int patch = q + 8 * (t >> 5), inner = t & 31;
        mt = (patch >> 2) * 8 + (inner >> 2); nt = (patch & 3) * 4 + (inner & 3);
        if (mt < NTOK / 256) return true;
      } else {
        q = (q + 1) & 7;
        if (++tried == 8) return false;
      }
    }
  }
};
DI void phase1(const Params& p, char* smem) {
  constexpr int MT = NTOK / 256, NT = 16;
  XcdTiles tm;
  int* sl = (int*)(smem + 153584);
  int mt, nt;
  bool have = tm.next(p, sl, mt, nt);
  u32x4 pa[4], pb[4];
  if (have) gemm_preload(p.Xn, p.WinT, 1024, mt * 256, nt * 256, threadIdx.x, pa, pb);
  while (have) {
    const int m0 = mt * 256, n0 = nt * 256;
    f32x16 acc[4][2];
    {
      int tg = threadIdx.x;
      asm volatile("" : "+v"(tg));
      gemm256(p.Xn, p.WinT, 1024, m0, n0, smem, tg, acc, pa, pb);
    }
    have = tm.next(p, sl, mt, nt);
    if (have) {
      int tg = threadIdx.x;
      asm volatile("" : "+v"(tg));
      gemm_preload(p.Xn, p.WinT, 1024, mt * 256, nt * 256, tg, pa, pb);
    }
    int tid = threadIdx.x;
    asm volatile("" : "+v"(tid));
    const int lane = tid & 63, w = tid >> 6, r = lane & 31, h = lane >> 5;
    const int wm = w >> 2, wn = w & 3;
    const int sec = n0 >> 9;
    const bool samp = m0 >= NPTOK;
    float* cs = (float*)smem;
    const int c0 = (tid & 31) * 8, rb = tid >> 5;
    const int csc = (n0 & 511) + c0;
#pragma unroll 1
    for (int half = 0; half < 2; ++half) {
      stage_half(acc, cs, half, wm, wn, r, h);
      __syncthreads();
#pragma unroll 2
      for (int ps = 0; ps < 8; ++ps) {
        const int row = rb + 16 * ps;
        const int t = m0 + half * 128 + row;
        f32x4 va = *(const f32x4*)(cs + row * 260 + c0), vb = *(const f32x4*)(cs + row * 260 + c0 + 4);
        const size_t o512 = (size_t)t * 512 + csc;
        if (sec == 5) { __builtin_nontemporal_store(va, (f32x4*)(p.Fr + o512)); __builtin_nontemporal_store(vb, (f32x4*)(p.Fr + o512 + 4)); }
        else {
          u16* dst;
          if (sec == 0) {
            const float qs = 0.125f * 1.44269504089f;
            va *= qs; vb *= qs; dst = p.Qb + o512;
          } else if (sec == 1 || sec == 2) {
            size_t kvr; float* od;
            if (!samp) { kvr = t; od = p.out + (sec == 1 ? OFF_NKP : OFF_NVP) + o512; }
            else { const int ts = t - NPTOK; kvr = NPTOK + (ts >> 6) * 1088 + 1024 + (ts & 63); od = p.out + (sec == 1 ? OFF_NKS : OFF_NVS) + (size_t)ts * 512 + csc; }
            __builtin_nontemporal_store(va, (f32x4*)od); __builtin_nontemporal_store(vb, (f32x4*)(od + 4));
            dst = (sec == 1 ? p.Kall : p.Vall) + kvr * 512 + csc;
          } else if (sec == 6) { dst = p.Ir + o512; }
          else {
#pragma unroll
            for (int i = 0; i < 4; ++i) { va[i] = silu_f(va[i]); vb[i] = silu_f(vb[i]); }
            dst = (sec == 3 ? p.Za : (sec == 4 ? p.Qr : p.Zr)) + o512;
          }
          u32x4 o; o[0] = pack2(va[0], va[1]); o[1] = pack2(va[2], va[3]); o[2] = pack2(vb[0], vb[1]); o[3] = pack2(vb[2], vb[3]);
          __builtin_nontemporal_store(o, (u32x4*)dst);
        }
      }
      __syncthreads();
    }
  }
}

DI void rec_load(const Params& p, int tid, int I, float (&xv)[32]) {
  const int d = tid & 127, half = tid >> 7;
  const int hd = I & 3, t0 = (I >> 2) * 64;
  const float* fp = p.Fr + (size_t)(t0 + half * 32) * 512 + hd * 128 + d;
#pragma unroll
  for (int i = 0; i < 32; ++i) xv[i] = fp[(size_t)i * 512];
}
DI void rec_pre_x(const Params& p, int tid, int I, float* totS, const float (&xv)[32], float (&cum)[32], float (&key)[32], float& lastv) {
  const int d = tid & 127, half = tid >> 7;
  const int hd = I & 3;
  const float r0 = p.rec_lb[hd * 128 + d], r1 = p.rec_lb[512 + hd * 128 + d];
  const float lb = 1.f / (1.f + __expf(r1 - r0));
  float run = 0.f;
#pragma unroll
  for (int i = 0; i < 32; ++i) {
    float x = xv[i];
    x = fminf(fmaxf(x, -30.f), 30.f);
    const float e = __expf(-x), sg = 1.f / (1.f + e);
    run += __logf(lb + (1.f - lb) * sg);
    cum[i] = run; key[i] = (1.f - lb) * e * sg;
  }
  totS[tid] = run;
  __syncthreads();
  const float tot0 = totS[d], tot1 = totS[128 + d];
  if (half) {
#pragma unroll
    for (int i = 0; i < 32; ++i) cum[i] += tot0;
  }
  lastv = tot0 + tot1;
}
DI void rec_pre(const Params& p, int tid, int I, float* totS, float (&cum)[32], float (&key)[32], float& lastv) {
  float xv[32];
  rec_load(p, tid, I, xv);
  rec_pre_x(p, tid, I, totS, xv, cum, key, lastv);
}

DI void phase2(const Params& p, char* smem0, u16* BbufT) {
  const int hf = threadIdx.x >> 8;
  const int tid = threadIdx.x & 255, lane = tid & 63, w = tid >> 6, r = lane & 31, h = lane >> 5;
  const int q = (lane & 15) >> 2, pp = lane & 3, blk = (lane >> 4) & 1;
  const int d = tid & 127, half = tid >> 7;
  char* smem = smem0 + hf * 65536;
  char* KdI = smem; char* VrI = smem + 17408; float* totS = (float*)(smem + 60000);
  float xv[32];
  rec_load(p, tid, blockIdx.x * 2 + hf < NITEM ? blockIdx.x * 2 + hf : NITEM - 1, xv);
  for (int I = blockIdx.x * 2 + hf; I < NITEM; I += gridDim.x * 2) {
    const int hd = I & 3, t0 = (I >> 2) * 64;
    if (I < 2048) {
      const int token = tid & 63, which = tid >> 6;
      const u16* src = (which < 2 ? p.Qb : p.Kall) + (size_t)(t0 + token) * 512 + hd * 128 + (which & 1) * 64;
      float ss = 0.f;
#pragma unroll
      for (int c = 0; c < 8; ++c) {
        const u32x4 v = *(const u32x4*)(src + c * 8);
#pragma unroll
        for (int i = 0; i < 4; ++i) { const float lo = bflo(v[i]), hi = bfhi(v[i]); ss += lo * lo + hi * hi; }
      }
#pragma unroll
      for (int o = 32; o >= 1; o >>= 1) ss = fmaxf(ss, __shfl_xor(ss, o));
      if (lane == 0) p.NQ[I * 4 + which] = sqrtf(ss);
    }
    float cum[32], key[32], lastv;
    rec_pre_x(p, tid, I, totS, xv, cum, key, lastv);
    {
      const int In = I + gridDim.x * 2;
      rec_load(p, tid, In < NITEM ? In : I, xv);
    }
#pragma unroll
    for (int i = 0; i < 32; ++i) {
      const int t = half * 32 + i;
      *(u16*)(KdI + t * 272 + d * 2) = f2bf(key[i] * __expf(lastv - cum[i]));
    }
#pragma unroll
    for (int i = 0; i < 4; ++i) {
      const int ch = tid + 256 * i, row = ch >> 4, cc = ch & 15;
      *(u32x4*)(VrI + row * 272 + cc * 16) = *(const u32x4*)(p.Ir + (size_t)(t0 + row) * 512 + hd * 128 + cc * 8);
    }
    if (half) p.Abuf[I * 128 + d] = __expf(lastv);
    __syncthreads();
    f32x16 acc[4];
#pragma unroll
    for (int ct = 0; ct < 4; ++ct) acc[ct] = zero16();
#pragma unroll
    for (int ks = 0; ks < 4; ++ks) {
      const int rowoff = (16 * ks + 8 * h + q) * 272 + 32 * blk + 8 * pp;
      bf16x8 a = tr_frag(VrI + rowoff + 64 * w, 4 * 272);
#pragma unroll
      for (int ct = 0; ct < 4; ++ct) {
        bf16x8 b = tr_frag(KdI + rowoff + 64 * ct, 4 * 272);
        acc[ct] = MFMA(a, b, acc[ct]);
      }
    }
    u16* ob = BbufT + (size_t)I * 16384;
#pragma unroll
    for (int ct = 0; ct < 4; ++ct)
#pragma unroll
      for (int e = 0; e < 16; ++e) ob[(32 * w + crow(e, h)) * 128 + 32 * ct + r] = f2bf(acc[ct][e]);
    __syncthreads();
  }
}

DI void phase3(const Params& p, const u16* BbufT) {
  const int tid = threadIdx.x & 255;
  for (int it = blockIdx.x * 2 + (threadIdx.x >> 8); it < 512 + 1024; it += gridDim.x * 2) {
    if (it < 512) {
      const int bh = it >> 6, b = bh >> 2, hd = bh & 3;
      const int e1 = (it & 63) * 256 + tid, v = e1 >> 7, d = e1 & 127;
      float sx = 0.f;
      const size_t eo = (size_t)v * 128 + d;
      const int I0 = (b * 256) * 4 + hd;
      const float* ap = p.Abuf + (size_t)I0 * 128 + d;
      const u16* bp = BbufT + (size_t)I0 * 16384 + eo;
      u16* sp = p.SbufT + (size_t)I0 * 16384 + eo;
      for (int c0 = 0; c0 < 256; c0 += 16) {
        float av[16]; u16 bw[16];
#pragma unroll
        for (int i = 0; i < 16; ++i) { av[i] = ap[(size_t)(c0 + i) * 4 * 128]; bw[i] = bp[(size_t)(c0 + i) * 4 * 16384]; }
#pragma unroll
        for (int i = 0; i < 16; ++i) {
          sp[(size_t)(c0 + i) * 4 * 16384] = f2bf(sx);
          sx = av[i] * sx + bflo(bw[i]);
        }
      }
      p.out[OFF_NHP + (size_t)(b * 4 + hd) * 16384 + d * 128 + v] = sx;
    } else {
      const int j = it - 512;
      const int sh = j >> 5, bs = sh >> 2, hd = sh & 3;
      const int e2 = (j & 31) * 256 + tid, v = e2 >> 6, d2 = (e2 & 63) * 2;
      const int I = (512 + bs) * 4 + hd;
      const float* sh0 = p.state_h + (size_t)(bs * 4 + hd) * 16384;
      float sx = sh0[d2 * 128 + v], sy = sh0[(d2 + 1) * 128 + v];
      const size_t eo = (size_t)v * 128 + d2;
      const f32x2 a = *(const f32x2*)(p.Abuf + I * 128 + d2);
      const unsigned bw = *(const unsigned*)(BbufT + (size_t)I * 16384 + eo);
      *(unsigned*)(p.SbufT + (size_t)I * 16384 + eo) = pack2(sx, sy);
      sx = a[0] * sx + bflo(bw); sy = a[1] * sy + bfhi(bw);
      float* oh = p.out + OFF_NHS + (size_t)(bs * 4 + hd) * 16384;
      oh[d2 * 128 + v] = sx; oh[(d2 + 1) * 128 + v] = sy;
    }
  }
}

DI void r3_item(const Params& p, char* smem, int tid, int I) {
  const int lane = tid & 63, w = tid >> 6, r = lane & 31, h = lane >> 5;
  const int q = (lane & 15) >> 2, pp = lane & 3, blk = (lane >> 4) & 1;
  const int d = tid & 127, half = tid >> 7;
  char* QdI = smem; char* KdI = smem + 17408; char* VrI = smem + 34816;
  float* totS = (float*)(smem + 60000); float* ssS = (float*)(smem + 62048);
  const int hd = I & 3, t0 = (I >> 2) * 64;
  {
    float cum[32], key[32], lastv;
    rec_pre(p, tid, I, totS, cum, key, lastv);
    const u16* qp = p.Qr + (size_t)(t0 + half * 32) * 512 + hd * 128 + d;
#pragma unroll
    for (int i = 0; i < 32; ++i) {
      const int t = half * 32 + i;
      const float qv = bflo(qp[(size_t)i * 512]);
      *(u16*)(QdI + t * 272 + d * 2) = f2bf(qv * __expf(cum[i]));
      *(u16*)(KdI + t * 272 + d * 2) = f2bf(key[i] * __expf(-cum[i]));
    }
  }
#pragma unroll
  for (int i = 0; i < 4; ++i) {
    const int ch = tid + 256 * i, row = ch >> 4, cc = ch & 15;
    *(u32x4*)(VrI + row * 272 + cc * 16) = *(const u32x4*)(p.Ir + (size_t)(t0 + row) * 512 + hd * 128 + cc * 8);
  }
  __syncthreads();
  const int tt = w & 1, vh = w >> 1;
  bf16x8 qf[8];
#pragma unroll
  for (int ks = 0; ks < 8; ++ks) qf[ks] = *(const bf16x8*)(QdI + (32 * tt + r) * 272 + ks * 32 + h * 16);
  f32x16 sc[2]; sc[0] = zero16(); sc[1] = zero16();
#pragma unroll
  for (int ks = 0; ks < 8; ++ks) {
    bf16x8 a0 = *(const bf16x8*)(KdI + r * 272 + ks * 32 + h * 16);
    sc[0] = MFMA(a0, qf[ks], sc[0]);
  }
  if (tt == 1) {
#pragma unroll
    for (int ks = 0; ks < 8; ++ks) {
      bf16x8 a1 = *(const bf16x8*)(KdI + (32 + r) * 272 + ks * 32 + h * 16);
      sc[1] = MFMA(a1, qf[ks], sc[1]);
    }
  }
#pragma unroll
  for (int e = 0; e < 16; ++e) {
    const bool keep = crow(e, h) <= r;
    if (tt == 0) { if (!keep) sc[0][e] = 0.f; }
    else { if (!keep) sc[1][e] = 0.f; }
  }
  bf16x8 pf[4];
  pf[0] = pack8(sc[0], 0); pf[1] = pack8(sc[0], 1); pf[2] = pack8(sc[1], 0); pf[3] = pack8(sc[1], 1);
  f32x16 o[2]; o[0] = zero16(); o[1] = zero16();
  const u16* sp = p.SbufT + (size_t)I * 16384;
#pragma unroll
  for (int vi = 0; vi < 2; ++vi) {
    const int vt = 2 * vh + vi;
#pragma unroll
    for (int k4 = 0; k4 < 4; ++k4) {
      if (k4 < 2 || tt == 1) {
        bf16x8 a = tr_frag(VrI + (16 * k4 + 4 * h + q) * 272 + (32 * vt + 16 * blk) * 2 + 8 * pp, 8 * 272);
        o[vi] = MFMA(a, pf[k4], o[vi]);
      }
    }
#pragma unroll
    for (int ks = 0; ks < 8; ++ks) {
      bf16x8 a = *(const bf16x8*)(sp + (size_t)(32 * vt + r) * 128 + ks * 16 + h * 8);
      o[vi] = MFMA(a, qf[ks], o[vi]);
    }
  }
  float ss = 0.f;
#pragma unroll
  for (int vi = 0; vi < 2; ++vi)
#pragma unroll
    for (int e = 0; e < 16; ++e) ss += o[vi][e] * o[vi][e];
  ss += __shfl_xor(ss, 32);
  if (h == 0) ssS[w * 32 + r] = ss;
  __syncthreads();
  const float tot = ssS[tt * 32 + r] + ssS[(tt + 2) * 32 + r];
  const float rs = rsqrtf(tot * (1.f / 128.f) + 1e-6f);
  const int tok = t0 + 32 * tt + r;
#pragma unroll
  for (int vi = 0; vi < 2; ++vi)
#pragma unroll
    for (int g = 0; g < 4; ++g) {
      const int v = 32 * (2 * vh + vi) + 8 * g + 4 * h;
      const f32x4 gg = *(const f32x4*)(p.rec_norm_g + v);
      const u32x2 z = *(const u32x2*)(p.Zr + (size_t)tok * 512 + hd * 128 + v);
      u32x2 ov;
      ov[0] = pack2(o[vi][4 * g + 0] * rs * gg[0] * bflo(z[0]), o[vi][4 * g + 1] * rs * gg[1] * bfhi(z[0]));
      ov[1] = pack2(o[vi][4 * g + 2] * rs * gg[2] * bflo(z[1]), o[vi][4 * g + 3] * rs * gg[3] * bfhi(z[1]));
      *(u32x2*)(p.Mix + (size_t)tok * 1024 + 512 + hd * 128 + v) = ov;
    }
  __syncthreads();
}

template <bool DIAG>
DI void attn_tile_a(const char* ks, const bf16x8 (&qf)[4], f32x16 (&O)[4], bf16x8 (&pf)[4], float& mrun, float& lsum, float sl2, float qrel,
                    int m, int r, int h2) {
  f32x16 S[2];
#pragma unroll
  for (int st = 0; st < 2; ++st) {
    S[st] = zero16();
#pragma unroll
    for (int s = 0; s < 4; ++s) {
      bf16x8 a = *(const bf16x8*)(ks + (32 * st + r) * 272 + m * 128 + s * 32 + h2 * 16);
      S[st] = MFMA(a, qf[s], S[st]);
    }
  }
  float mx = -1e30f;
#pragma unroll
  for (int st = 0; st < 2; ++st)
#pragma unroll
    for (int e = 0; e < 16; ++e) {
      const float cst = (float)(32 * st + (e & 3) + 8 * (e >> 2));
      float sv;
      if (DIAG) sv = fmaf(-sl2, fabsf(qrel - cst), S[st][e]);
      else sv = fmaf(sl2, cst, S[st][e]);
      S[st][e] = sv; mx = fmaxf(mx, sv);
    }
  const float L = DIAG ? 0.f : -sl2 * qrel;
  mx += L;
  mx = fmaxf(mx, __shfl_xor(mx, 32));
  if (__builtin_amdgcn_ballot_w64(mx > mrun + 6.f) != 0) {
    const float mnew = fmaxf(mrun, mx);
    const float alpha = __builtin_amdgcn_exp2f(mrun - mnew);
    mrun = mnew; lsum *= alpha;
#pragma unroll
    for (int vt = 0; vt < 4; ++vt)
#pragma unroll
      for (int e = 0; e < 16; ++e) O[vt][e] *= alpha;
  }
  const float off = L - mrun;
  float rs = 0.f;
#pragma unroll
  for (int st = 0; st < 2; ++st)
#pragma unroll
    for (int e = 0; e < 16; ++e) { const float pv = __builtin_amdgcn_exp2f(S[st][e] + off); S[st][e] = pv; rs += pv; }
  lsum += rs;
  pf[0] = pack8(S[0], 0); pf[1] = pack8(S[0], 1); pf[2] = pack8(S[1], 0); pf[3] = pack8(S[1], 1);
}
template <bool DIAG>
DI void attn_tile_f(const char* ks, const bf16x8 (&qf)[4], bf16x8 (&pf)[4], float& lsum, float sl2, float qrel, float mref, int m, int r, int h2) {
  f32x16 S[2];
  const float offL = -sl2 * qrel - mref;
#pragma unroll
  for (int st = 0; st < 2; ++st) {
#pragma unroll
    for (int e = 0; e < 16; ++e) {
      const float cst = (float)(32 * st + (e & 3) + 8 * (e >> 2));
      S[st][e] = DIAG ? (-sl2 * fabsf(qrel - cst) - mref) : fmaf(sl2, cst, offL);
    }
#pragma unroll
    for (int s = 0; s < 4; ++s) {
      bf16x8 a = *(const bf16x8*)(ks + (32 * st + r) * 272 + m * 128 + s * 32 + h2 * 16);
      S[st] = MFMA(a, qf[s], S[st]);
    }
  }
  float rs = 0.f;
#pragma unroll
  for (int st = 0; st < 2; ++st)
#pragma unroll
    for (int e = 0; e < 16; ++e) { const float pv = __builtin_amdgcn_exp2f(S[st][e]); S[st][e] = pv; rs += pv; }
  lsum += rs;
  pf[0] = pack8(S[0], 0); pf[1] = pack8(S[0], 1); pf[2] = pack8(S[1], 0); pf[3] = pack8(S[1], 1);
}
DI void attn_tile_b(const char* vs, const bf16x8 (&pf)[4], f32x16 (&O)[4], int h2, int q, int pp, int blk) {
  const char* vb = vs + (4 * h2 + q) * 320 + 32 * blk + 8 * pp;
  bf16x8 a0[4], a1[4];
#pragma unroll
  for (int vt = 0; vt < 4; ++vt) a0[vt] = tr_frag(vb + 64 * vt, 8 * 320);
#pragma unroll
  for (int vt = 0; vt < 4; ++vt) a1[vt] = tr_frag(vb + 16 * 320 + 64 * vt, 8 * 320);
#pragma unroll
  for (int vt = 0; vt < 4; ++vt) O[vt] = MFMA(a0[vt], pf[0], O[vt]);
#pragma unroll
  for (int vt = 0; vt < 4; ++vt) a0[vt] = tr_frag(vb + 32 * 320 + 64 * vt, 8 * 320);
#pragma unroll
  for (int vt = 0; vt < 4; ++vt) O[vt] = MFMA(a1[vt], pf[1], O[vt]);
#pragma unroll
  for (int vt = 0; vt < 4; ++vt) a1[vt] = tr_frag(vb + 48 * 320 + 64 * vt, 8 * 320);
#pragma unroll
  for (int vt = 0; vt < 4; ++vt) O[vt] = MFMA(a0[vt], pf[2], O[vt]);
#pragma unroll
  for (int vt = 0; vt < 4; ++vt) O[vt] = MFMA(a1[vt], pf[3], O[vt]);
}

DI void attn_item(const Params& p, char* smem, int tid, int tq0, int qpos0, int kvbase, int ntb, int hd, float lam, bool can_skip, int nq) {
  const int lane = tid & 63, w = tid >> 6, r = lane & 31, h2 = lane >> 5;
  const int q = (lane & 15) >> 2, pp = lane & 3, blk = (lane >> 4) & 1;
  const int qg = w & 3, m = w >> 2, ch = qg >> 1;
  const bool wact = qg < nq;
  const float sl2 = exp2f(-2.f * (float)(hd + 1)) * 1.44269504089f;
  const int qtok = tq0 + 32 * qg + r;
  const float qposf = (float)(qpos0 + 32 * qg + r);
  const int ntw = can_skip ? ntb - 1 + ch : ntb;
  int kt0w = 0, kt0b = 0;
  bool fast = false; float kn_w = 0.f;
  if (can_skip) {
    const int I0 = (tq0 >> 6) * 4 + hd;
    const int crk = kvbase >> 6;
    fast = true; kt0b = ntb;
#pragma unroll
    for (int mm = 0; mm < 2; ++mm) {
      float KN = 0.f;
      for (int c = lane; c < ntb; c += 64) KN = fmaxf(KN, p.NQ[((crk + c) * 4 + hd) * 4 + 2 + mm]);
#pragma unroll
      for (int o = 32; o >= 1; o >>= 1) KN = fmaxf(KN, __shfl_xor(KN, o));
#pragma unroll
      for (int cc = 0; cc < 2; ++cc) {
        const float QN = p.NQ[(I0 + 4 * cc) * 4 + mm];
        const float D = (2.02f * QN * KN + 66.f) / sl2;
        const float f = ((float)(qpos0 + 64 * cc - 63) - D) * (1.f / 64.f);
        const int k0 = f < 0.f ? 0 : (int)f + 1;
        kt0b = k0 < kt0b ? k0 : kt0b;
        fast = fast && (2.02f * QN * KN < 60.f);
        if (mm == m && cc == ch) { kt0w = k0; kn_w = KN; }
      }
    }
  }
  bf16x8 qf[4];
  if (wact) {
#pragma unroll
    for (int s = 0; s < 4; ++s) qf[s] = *(const bf16x8*)(p.Qb + (size_t)qtok * 512 + hd * 128 + m * 64 + 16 * s + 8 * h2);
  } else {
#pragma unroll
    for (int s = 0; s < 4; ++s) qf[s] = (bf16x8){0, 0, 0, 0, 0, 0, 0, 0};
  }
  float mref = 0.f;
  if (fast) {
    float qq = 0.f;
#pragma unroll
    for (int s = 0; s < 4; ++s) {
      const u32x4 u = __builtin_bit_cast(u32x4, qf[s]);
#pragma unroll
      for (int i = 0; i < 4; ++i) { const float lo = bflo(u[i]), hi = bfhi(u[i]); qq += lo * lo + hi * hi; }
    }
    qq += __shfl_xor(qq, 32);
    mref = sqrtf(qq) * kn_w * 1.01f + 0.5f;
  }
  f32x16 O[4];
#pragma unroll
  for (int vt = 0; vt < 4; ++vt) O[vt] = zero16();
  float mrun = -1e30f, lsum = 0.f;
  u32x4 rk[2], rv[2];
  const int lrow = tid >> 4, lcc = tid & 15;
  const size_t gofs = (size_t)(kvbase + lrow) * 512 + hd * 128 + lcc * 8;
  const u16* kp = p.Kall + gofs;
  const u16* vp = p.Vall + gofs;
  char* kw = smem + lrow * 272 + lcc * 16;
  char* vw = smem + 17408 + lrow * 320 + lcc * 16;
  const int nit = ntb - kt0b;
  {
    const size_t go = (size_t)(fast ? kt0b : ntb - 1) * 64 * 512;
#pragma unroll
    for (int i = 0; i < 2; ++i) { rk[i] = *(const u32x4*)(kp + go + (size_t)i * 32 * 512); rv[i] = *(const u32x4*)(vp + go + (size_t)i * 32 * 512); }
#pragma unroll
    for (int i = 0; i < 2; ++i) { *(u32x4*)(kw + i * 32 * 272) = rk[i]; *(u32x4*)(vw + i * 32 * 320) = rv[i]; }
    const int k1 = fast ? (kt0b + 1 < ntb ? kt0b + 1 : ntb - 1) : (ntb - 2 > kt0b ? ntb - 2 : kt0b);
    const size_t g1 = (size_t)k1 * 64 * 512;
#pragma unroll
    for (int i = 0; i < 2; ++i) { rk[i] = *(const u32x4*)(kp + g1 + (size_t)i * 32 * 512); rv[i] = *(const u32x4*)(vp + g1 + (size_t)i * 32 * 512); }
  }
  __syncthreads();
  if (fast) {
    for (int it = 0; it < nit; ++it) {
      const int kt = kt0b + it;
      const bool active = wact && kt >= kt0w && kt < ntw;
      const char* ks = smem + (it & 1) * 37888;
      char* wb = kw + ((it + 1) & 1) * 37888;
      char* wbv = vw + ((it + 1) & 1) * 37888;
#pragma unroll
      for (int i = 0; i < 2; ++i) { *(u32x4*)(wb + i * 32 * 272) = rk[i]; *(u32x4*)(wbv + i * 32 * 320) = rv[i]; }
      {
        const int k2 = kt + 2 < ntb ? kt + 2 : ntb - 1;
        const size_t g2 = (size_t)k2 * 64 * 512;
#pragma unroll
        for (int i = 0; i < 2; ++i) { rk[i] = *(const u32x4*)(kp + g2 + (size_t)i * 32 * 512); rv[i] = *(const u32x4*)(vp + g2 + (size_t)i * 32 * 512); }
      }
      __builtin_amdgcn_sched_barrier(0);
      if (active) {
        bf16x8 pf[4];
        const float qrel = qposf - (float)(kt * 64 + 4 * h2);
        if (kt == ntw - 1) attn_tile_f<true>(ks, qf, pf, lsum, sl2, qrel, mref, m, r, h2);
        else attn_tile_f<false>(ks, qf, pf, lsum, sl2, qrel, mref, m, r, h2);
        attn_tile_b(ks + 17408, pf, O, h2, q, pp, blk);
      }
      __syncthreads();
    }
  } else {
    for (int it = 0; it < nit; ++it) {
      const int kt = ntb - 1 - it;
      const bool active = wact && kt >= kt0w && kt < ntw;
      const char* ks = smem + (it & 1) * 37888;
      char* wb = kw + ((it + 1) & 1) * 37888;
      char* wbv = vw + ((it + 1) & 1) * 37888;
#pragma unroll
      for (int i = 0; i < 2; ++i) { *(u32x4*)(wb + i * 32 * 272) = rk[i]; *(u32x4*)(wbv + i * 32 * 320) = rv[i]; }
      {
        const int k2 = kt - 2 > kt0b ? kt - 2 : kt0b;
        const size_t g2 = (size_t)k2 * 64 * 512;
#pragma unroll
        for (int i = 0; i < 2; ++i) { rk[i] = *(const u32x4*)(kp + g2 + (size_t)i * 32 * 512); rv[i] = *(const u32x4*)(vp + g2 + (size_t)i * 32 * 512); }
      }
      __builtin_amdgcn_sched_barrier(0);
      if (active) {
        bf16x8 pf[4];
        const float qrel = qposf - (float)(kt * 64 + 4 * h2);
        if (kt == ntw - 1) attn_tile_a<true>(ks, qf, O, pf, mrun, lsum, sl2, qrel, m, r, h2);
        else attn_tile_a<false>(ks, qf, O, pf, mrun, lsum, sl2, qrel, m, r, h2);
        attn_tile_b(ks + 17408, pf, O, h2, q, pp, blk);
      }
      __syncthreads();
    }
  }
  const float lt = lsum + __shfl_xor(lsum, 32);
  const float inv = wact ? 1.f / lt : 0.f;
  float* exch = (float*)smem + qg * 4096 + lane;
  if (m == 1) {
#pragma unroll
    for (int vt = 0; vt < 4; ++vt)
#pragma unroll
      for (int e = 0; e < 16; ++e) exch[(vt * 16 + e) * 64] = O[vt][e] * inv;
  }
  __syncthreads();
  if (m == 0 && wact) {
    float ss = 0.f;
#pragma unroll
    for (int vt = 0; vt < 4; ++vt)
#pragma unroll
      for (int e = 0; e < 16; ++e) { const float ov = O[vt][e] * inv - lam * exch[(vt * 16 + e) * 64]; O[vt][e] = ov; ss += ov * ov; }
    ss += __shfl_xor(ss, 32);
    const float rsn = rsqrtf(ss * (1.f / 128.f) + 1e-6f) * 0.8f;
#pragma unroll
    for (int vt = 0; vt < 4; ++vt)
#pragma unroll
      for (int g = 0; g < 4; ++g) {
        const int v = 32 * vt + 8 * g + 4 * h2;
        const f32x4 gg = *(const f32x4*)(p.subln_g + v);
        const u32x2 z = *(const u32x2*)(p.Za + (size_t)qtok * 512 + hd * 128 + v);
        u32x2 ov;
        ov[0] = pack2(O[vt][4 * g + 0] * rsn * gg[0] * bflo(z[0]), O[vt][4 * g + 1] * rsn * gg[1] * bfhi(z[0]));
        ov[1] = pack2(O[vt][4 * g + 2] * rsn * gg[2] * bflo(z[1]), O[vt][4 * g + 3] * rsn * gg[3] * bfhi(z[1]));
        *(u32x2*)(p.Mix + (size_t)qtok * 1024 + hd * 128 + v) = ov;
      }
  }
  __syncthreads();
}

DI void phase4(const Params& p, char* smem) {
  const int tid = threadIdx.x, lane = tid & 63;
  float lam;
  {
    const float a = p.lambda_qk[lane] * p.lambda_qk[64 + lane];
    const float b = p.lambda_qk[128 + lane] * p.lambda_qk[192 + lane];
    lam = __expf(wave_sum(a)) - __expf(wave_sum(b)) + 0.2f;
  }
  int* sitem = (int*)(smem + 153584);
  constexpr int NPA = 1024, NSA = 32, TOTAL = NPA + NSA + NITEM / 2;
  for (;;) {
    if (tid == 0) *sitem = atomicAdd(p.counter, 1);
    __syncthreads();
    const int item = *sitem;
    __syncthreads();
    if (item >= TOTAL) break;
    int tid_o = tid;
    asm volatile("" : "+v"(tid_o));
    if (item < NPA + NSA) {
      int tq0, qpos0, kvbase, ntb, hd, nq; bool can_skip;
      if (item < NPA) {
        const int qb = 127 - ((item & 255) >> 1), b = item & 1;
        hd = 3 - (item >> 8); tq0 = b * 16384 + qb * 128; qpos0 = qb * 128; kvbase = b * 16384; ntb = 2 * qb + 2; can_skip = true; nq = 4;
      } else {
        const int it = item - NPA, bs = it >> 2;
        hd = it & 3; tq0 = NPTOK + bs * 64; qpos0 = 1024; kvbase = NPTOK + bs * 1088; ntb = 17; can_skip = false; nq = 2;
      }
      attn_item(p, smem, tid_o, tq0, qpos0, kvbase, ntb, hd, lam, can_skip, nq);
    } else {
      const int hf = tid_o >> 8;
      r3_item(p, smem + hf * 65536, tid_o & 255, (item - NPA - NSA) * 2 + hf);
    }
  }
}

template <int RT>
DI void p5_strip(const Params& p, char* smem, int tid, int m0) {
  float* wsum = (float*)(smem + 132096);
  {
    const int lane = tid & 63, w = tid >> 6, r = lane & 31, h = lane >> 5;
    {
      const u16* gb = p.Mix + (size_t)m0 * 1024;
      const int loff = (tid >> 7) * 1024 + (tid & 127) * 8;
      char* lw = smem + (tid >> 7) * 2064 + (tid & 127) * 16;
#pragma unroll
      for (int i = 0; i < 8 * RT; ++i)
        *(u32x4*)(lw + i * 4 * 2064) = __builtin_nontemporal_load((const u32x4*)((gb + i * 4096) + loff));
    }
    f32x16 acc[RT][4];
#pragma unroll
    for (int i = 0; i < RT; ++i)
#pragma unroll
      for (int j = 0; j < 4; ++j) acc[i][j] = zero16();
    const u16* bp = p.WoutT + (size_t)(w * 4) * 64 * 512 + lane * 8;
    bf16x8 b[4][4];
#pragma unroll
    for (int u = 0; u < 3; ++u)
#pragma unroll
      for (int j = 0; j < 4; ++j) b[u][j] = *(const bf16x8*)(bp + (size_t)(j * 64 + u) * 512);
    __syncthreads();
    const char* ap = smem + r * 2064 + h * 16;
    for (int ks0 = 0; ks0 < 64; ks0 += 4) {
#pragma unroll
      for (int u = 0; u < 4; ++u) {
        const int ks = ks0 + u;
        {
          const int kn = ks + 3 < 64 ? ks + 3 : 63;
#pragma unroll
          for (int j = 0; j < 4; ++j) b[(u + 3) & 3][j] = *(const bf16x8*)(bp + (size_t)(j * 64 + kn) * 512);
        }
        const bf16x8 a0 = *(const bf16x8*)(ap + ks * 32);
#pragma unroll
        for (int j = 0; j < 4; ++j) acc[0][j] = MFMA(a0, b[u][j], acc[0][j]);
        if (RT == 2) {
          const bf16x8 a1 = *(const bf16x8*)(ap + 32 * 2064 + ks * 32);
#pragma unroll
          for (int j = 0; j < 4; ++j) acc[RT - 1][j] = MFMA(a1, b[u][j], acc[RT - 1][j]);
        }
        __builtin_amdgcn_sched_barrier(0);
      }
    }
    const float* xs_u = (m0 < NPTOK ? p.x_prompt : p.x_sample - (size_t)NPTOK * 1024) + (size_t)m0 * 1024;
    const int lane_off = h * 4096 + w * 128 + r;
#pragma unroll
    for (int i = 0; i < RT; ++i) {
      float ps[16];
#pragma unroll
      for (int e = 0; e < 16; ++e) ps[e] = 0.f;
#pragma unroll
      for (int j = 0; j < 4; ++j) {
#pragma unroll
        for (int e = 0; e < 16; ++e) {
          const float hv = acc[i][j][e] + __builtin_nontemporal_load((xs_u + (i * 32 + (e & 3) + 8 * (e >> 2)) * 1024 + j * 32) + lane_off);
          acc[i][j][e] = hv; ps[e] += hv * hv;
        }
        __builtin_amdgcn_sched_barrier(0);
      }
#pragma unroll
      for (int e = 0; e < 16; ++e) {
#pragma unroll
        for (int o = 16; o >= 1; o >>= 1) ps[e] += __shfl_xor(ps[e], o);
      }
      if (r == 0) {
#pragma unroll
        for (int e = 0; e < 16; ++e) wsum[w * 64 + i * 32 + crow(e, h)] = ps[e];
      }
      __builtin_amdgcn_sched_barrier(0);
    }
    __syncthreads();
    float* yo_u = p.out + OFF_Y + (size_t)m0 * 1024;
#pragma unroll
    for (int i = 0; i < RT; ++i) {
      float sc[16];
#pragma unroll
      for (int e = 0; e < 16; ++e) {
        const int rw = i * 32 + crow(e, h);
        float t = 0.f;
#pragma unroll
        for (int k = 0; k < 8; ++k) t += wsum[k * 64 + rw];
        sc[e] = rsqrtf(t * (1.f / 1024.f) + 1e-6f);
      }
#pragma unroll
      for (int j = 0; j < 4; ++j) {
        const float g = (p.final_g + j * 32)[w * 128 + r];
#pragma unroll
        for (int e = 0; e < 16; ++e)
          __builtin_nontemporal_store(acc[i][j][e] * sc[e] * g, (yo_u + (i * 32 + (e & 3) + 8 * (e >> 2)) * 1024 + j * 32) + lane_off);
        __builtin_amdgcn_sched_barrier(0);
      }
    }
    __syncthreads();
  }
}
DI void phase5(const Params& p, char* smem) {
  for (int it = blockIdx.x; it < NPTOK / 64 + (NTOK - NPTOK) / 32; it += gridDim.x) {
    int tid = threadIdx.x;
    asm volatile("" : "+v"(tid));
    if (it < NPTOK / 64) p5_strip<2>(p, smem, tid, it * 64);
    else p5_strip<1>(p, smem, tid, NPTOK + (it - NPTOK / 64) * 32);
  }
}


__global__ void __launch_bounds__(512, 2) fwd_megakernel(Params p) {
  __shared__ __attribute__((aligned(16))) char smem[153600];
  cg::grid_group grid = cg::this_grid();
  float* scratch_out = p.out + OFF_Y;
  const int lo = p.phase_lo, hi = p.phase_hi;
  if (lo <= 0 && hi >= 0) phase0(p, smem);
  if (lo <= 0 && hi >= 1) grid.sync();
  if (lo <= 1 && hi >= 1) phase1(p, smem);
  if (lo <= 1 && hi >= 2) grid.sync();
  if (lo <= 2 && hi >= 2) phase2(p, smem, (u16*)scratch_out);
  if (lo <= 2 && hi >= 3) grid.sync();
  if (lo <= 3 && hi >= 3) phase3(p, (const u16*)scratch_out);
  if (lo <= 3 && hi >= 4) grid.sync();
  if (lo <= 4 && hi >= 4) phase4(p, smem);
  if (lo <= 4 && hi >= 5) grid.sync();
  if (lo <= 5 && hi >= 5) phase5(p, smem);
}

extern "C" void kernel_launch(void* const* d_in, const int* in_sizes, int n_in, void* d_out, int out_size, void* d_ws, size_t ws_size,
                              hipStream_t stream) {
  static int grid_blocks = 0;
  if (!grid_blocks) {
    int dev = 0, cus = 0, per_cu = 0;
    hipGetDevice(&dev);
    hipDeviceGetAttribute(&cus, hipDeviceAttributeMultiprocessorCount, dev);
    hipOccupancyMaxActiveBlocksPerMultiprocessor(&per_cu, fwd_megakernel, 512, 0);
    if (per_cu > 1) per_cu = 1;
    if (per_cu < 1) per_cu = 1;
    grid_blocks = cus * per_cu;
  }
  Params p{};
  p.x_prompt = (const float*)d_in[0]; p.x_sample = (const float*)d_in[1]; p.cache_k = (const float*)d_in[2]; p.cache_v = (const float*)d_in[3];
  p.state_h = (const float*)d_in[4]; p.norm_g = (const float*)d_in[5]; p.w_in = (const float*)d_in[6]; p.lambda_qk = (const float*)d_in[7];
  p.subln_g = (const float*)d_in[8]; p.rec_lb = (const float*)d_in[9]; p.rec_norm_g = (const float*)d_in[10]; p.w_out = (const float*)d_in[11];
  p.final_g = (const float*)d_in[12];
  p.out = (float*)d_out;
  char* ws = (char*)d_ws; size_t off = 0;
  auto take = [&](size_t bytes) { char* r = ws + off; off += (bytes + 255) & ~(size_t)255; return r; };
  p.WinT = (u16*)take((size_t)4096 * 1024 * 2);
  p.WoutT = (u16*)take((size_t)1024 * 1024 * 2);
  p.Xn = (u16*)take((size_t)NTOK * 1024 * 2);
  p.SbufT = p.Xn;
  p.Qb = (u16*)take((size_t)NTOK * 512 * 2);
  p.Kall = (u16*)take((size_t)KVROWS * 512 * 2);
  p.Vall = (u16*)take((size_t)KVROWS * 512 * 2);
  p.Za = (u16*)take((size_t)NTOK * 512 * 2);
  p.Qr = (u16*)take((size_t)NTOK * 512 * 2);
  p.Ir = (u16*)take((size_t)NTOK * 512 * 2);
  p.Zr = (u16*)take((size_t)NTOK * 512 * 2);
  p.Mix = (u16*)take((size_t)NTOK * 1024 * 2);
  p.Fr = (float*)take((size_t)NTOK * 512 * 4);
  p.Abuf = (float*)take((size_t)NITEM * 128 * 4);
  p.NQ = (float*)take((size_t)NITEM * 4 * 4);
  p.counter = (int*)take(256);
  p.phase_lo = 0; p.phase_hi = 6; p.rep_mask = 0; p.pad_ = 0;
  if (off > ws_size) { fprintf(stderr, "workspace too small: need %zu have %zu\n", off, ws_size); return; }
  void* args[] = {&p};
  hipError_t e = hipLaunchCooperativeKernel((void*)fwd_megakernel, dim3(grid_blocks), dim3(512), args, 0, stream);
  if (e != hipSuccess) fprintf(stderr, "cooperative launch failed: %s (grid %d)\n", hipGetErrorString(e), grid_blocks);
}
```
